# Optimizing an MI355X kernel written in HIP

```python
import jax, jax.numpy as jnp
from jax import lax
import numpy as np

D_MODEL = 1024
BATCH = 2
SEQ = 8192
DEPTH = 1
DEC_BATCH = 32
DEC_SEQ = 4
PAST_LEN = 16384
PAGE_SIZE = 128

A_WIDTH = D_MODEL // 2
A_GROUPS = 8
A_GDIM = A_WIDTH // A_GROUPS
CHUNK = 128
N_HEADS = 8
HEAD_DIM = 64
N_KV = 2
GROUP = N_HEADS // N_KV
B_WIDTH = N_HEADS * HEAD_DIM
KV_WIDTH = N_KV * HEAD_DIM
CMP_BLOCK = 32
CMP_STRIDE = 16
SEL_BLOCK = 64
N_SELECT = 16
WINDOW = 512
ROT_DIM = HEAD_DIM // 4
ROPE_THETA = 500000.0
D_FF = 4 * D_MODEL
IN_COLS = 2 * A_WIDTH + B_WIDTH + 6 * KV_WIDTH + 3 * N_HEADS + 2 * D_MODEL
EPS = 1e-6
Q_BLOCK = 128
NEG = -1e30
FORCED_BONUS = 1e4

kernel_name = 'hybrid_gmlp_nsa_decode_step'


def rms_norm(x, g):
    xf = x.astype(jnp.float32)
    y = xf * lax.rsqrt(jnp.mean(xf * xf, axis=-1, keepdims=True) + EPS)
    return (y * g.astype(jnp.float32)).astype(x.dtype)


def layer_norm(x, g, b):
    xf = x.astype(jnp.float32)
    xc = xf - jnp.mean(xf, axis=-1, keepdims=True)
    y = xc * lax.rsqrt(jnp.mean(xc * xc, axis=-1, keepdims=True) + EPS)
    return (y * g.astype(jnp.float32) + b.astype(jnp.float32)).astype(x.dtype)


def rope(x, pos):
    inv = ROPE_THETA ** (-jnp.arange(0, ROT_DIM, 2, dtype=jnp.float32) / ROT_DIM)
    ang = pos.astype(jnp.float32)[:, None] * inv[None, :]
    cos = jnp.cos(ang)[None, :, None, :]
    sin = jnp.sin(ang)[None, :, None, :]
    xr = x[..., :ROT_DIM].astype(jnp.float32)
    x1, x2 = xr[..., :ROT_DIM // 2], xr[..., ROT_DIM // 2:]
    rot = jnp.concatenate([x1 * cos - x2 * sin, x2 * cos + x1 * sin], axis=-1)
    return jnp.concatenate([rot.astype(x.dtype), x[..., ROT_DIM:]], axis=-1)


def masked_softmax(s, mask):
    s = jnp.where(mask, s.astype(jnp.float32), NEG)
    return jax.nn.softmax(s, axis=-1) * mask


def in_projection(x, pos, g_norm1, w_in, ln_v_g, ln_v_b, g_q, g_ks, g_kw):
    B, T, _ = x.shape
    h = rms_norm(x, g_norm1)
    z = h @ w_in
    widths = [A_WIDTH, A_WIDTH, B_WIDTH] + [KV_WIDTH] * 6 + [3 * N_HEADS]
    points, acc = [], 0
    for w in widths:
        acc += w
        points.append(acc)
    u, v, q, kc, vc, ks, vs, kw, vw, nsa_gate, merge_gate = jnp.split(z, points, axis=-1)
    u = jax.nn.gelu(u)
    v_n = layer_norm(jax.nn.gelu(v), ln_v_g, ln_v_b)
    heads = lambda a, n: a.reshape(B, T, n, HEAD_DIM)
    q_n = rms_norm(heads(q, N_HEADS), g_q)
    q_r = rope(q_n, pos)
    ks = rope(rms_norm(heads(ks, N_KV), g_ks), pos)
    kw = rope(rms_norm(heads(kw, N_KV), g_kw), pos)
    return (u, v_n, q_n, q_r, heads(kc, N_KV), heads(vc, N_KV), ks, heads(vs, N_KV),
            kw, heads(vw, N_KV), nsa_gate, merge_gate)


def gmlp_mix(u, v_n, w_s, b_s):
    B, T, _ = v_n.shape
    n_chunks = -(-T // CHUNK)
    pad = n_chunks * CHUNK - T
    vp = jnp.pad(v_n, ((0, 0), (0, pad), (0, 0))).reshape(B, n_chunks, CHUNK, A_GROUPS, A_GDIM)
    causal = jnp.tril(jnp.ones((CHUNK, CHUNK), dtype=bool))
    ws = jnp.where(causal[None], w_s, jnp.zeros_like(w_s))
    s = jnp.einsum('gpr,bnrgc->bnpgc', ws, vp) + b_s.T[None, None, :, :, None]
    return u * s.reshape(B, n_chunks * CHUNK, A_WIDTH)[:, :T]


def compress(rows, w1, w2, pe):
    B, T, KV, hd = rows.shape
    C = T // CMP_STRIDE
    half = CMP_STRIDE * hd
    ch = rows[:, :C * CMP_STRIDE].reshape(B, C, CMP_STRIDE, KV, hd).transpose(0, 1, 3, 2, 4).reshape(B, C, KV, half)
    first = ch @ w1[:half]
    second = ch @ w1[half:]
    bias = pe.reshape(-1) @ w1
    return jax.nn.gelu(first[:, :-1] + second[:, 1:] + bias) @ w2


def nsa_attend(q_n, q_r, gate, pos_q, kc, vc, fetch_sel, k_w, v_w, pos_w, n_total):
    B, Tq = q_n.shape[:2]
    scale = HEAD_DIM ** -0.5
    qn = q_n.reshape(B, Tq, N_KV, GROUP, HEAD_DIM)
    qr = q_r.reshape(B, Tq, N_KV, GROUP, HEAD_DIM)
    NC = kc.shape[1]
    cmp_end = jnp.arange(NC) * CMP_STRIDE + CMP_BLOCK - 1
    m_c = cmp_end[None, :] <= pos_q[:, None]
    p_c = masked_softmax(jnp.einsum('bqkgd,bckd->bkgqc', qn, kc) * scale, m_c)
    o_c = jnp.einsum('bkgqc,bckd->bqkgd', p_c.astype(vc.dtype), vc)
    imp = p_c.sum(axis=2)
    n_sel = -(-n_total // SEL_BLOCK)
    n_ch = n_sel * (SEL_BLOCK // CMP_STRIDE)
    chunk_score = (jnp.pad(imp, ((0, 0), (0, 0), (0, 0), (0, n_ch - NC)))
                   + jnp.pad(imp, ((0, 0), (0, 0), (0, 0), (1, n_ch - NC - 1))))
    blk_score = chunk_score.reshape(B, N_KV, Tq, n_sel, SEL_BLOCK // CMP_STRIDE).sum(-1)
    j = jnp.arange(n_sel)[None, :]
    cur = (pos_q // SEL_BLOCK)[:, None]
    valid_b = j * SEL_BLOCK <= pos_q[:, None]
    forced = (j == 0) | (j == cur) | (j == cur - 1)
    rank = jnp.where(forced, FORCED_BONUS, jnp.where(valid_b, blk_score, -FORCED_BONUS))
    n_top = min(N_SELECT, n_sel)
    _, idx = lax.top_k(rank, n_top)
    pq = pos_q[None, None, :, None, None]
    pos_s = idx[..., None] * SEL_BLOCK + jnp.arange(SEL_BLOCK)
    m_s = ((idx[..., None] * SEL_BLOCK <= pq) & (pos_s <= pq)).reshape(B, N_KV, Tq, n_top * SEL_BLOCK)
    k_s, v_s = fetch_sel(pos_s.reshape(B, N_KV, Tq, n_top * SEL_BLOCK))
    p_s = masked_softmax(jnp.einsum('bqkgd,bkqsd->bkgqs', qr, k_s) * scale, m_s[:, :, None])
    o_s = jnp.einsum('bkgqs,bkqsd->bqkgd', p_s.astype(v_s.dtype), v_s)
    dpos = pos_q[:, None] - pos_w[None, :]
    m_w = (dpos >= 0) & (dpos < WINDOW) & (pos_w[None, :] >= 0)
    p_w = masked_softmax(jnp.einsum('bqkgd,bskd->bkgqs', qr, k_w) * scale, m_w)
    o_w = jnp.einsum('bkgqs,bskd->bqkgd', p_w.astype(v_w.dtype), v_w)
    g = jax.nn.sigmoid(gate).reshape(B, Tq, N_KV, GROUP, 3)
    o = g[..., 0:1] * o_c + g[..., 1:2] * o_s + g[..., 2:3] * o_w
    return o.reshape(B, Tq, B_WIDTH)


def nsa_prompt(q_n, q_r, gate, kc, vc, k_sel, v_sel, k_win, v_win):
    B, T = q_n.shape[:2]
    kw_pad = jnp.pad(k_win, ((0, 0), (WINDOW, 0), (0, 0), (0, 0)))
    vw_pad = jnp.pad(v_win, ((0, 0), (WINDOW, 0), (0, 0), (0, 0)))
    bi = jnp.arange(B)[:, None, None, None]
    ki = jnp.arange(N_KV)[None, :, None, None]

    def fetch(pos):
        p = jnp.clip(pos, 0, T - 1)
        return k_sel[bi, p, ki], v_sel[bi, p, ki]

    def one_block(s):
        pos_q = s + jnp.arange(Q_BLOCK, dtype=jnp.int32)
        sl = lambda a, n: lax.dynamic_slice_in_dim(a, s, n, axis=1)
        pos_w = s - WINDOW + jnp.arange(Q_BLOCK + WINDOW, dtype=jnp.int32)
        return nsa_attend(sl(q_n, Q_BLOCK), sl(q_r, Q_BLOCK), sl(gate, Q_BLOCK), pos_q, kc, vc, fetch,
                          sl(kw_pad, Q_BLOCK + WINDOW), sl(vw_pad, Q_BLOCK + WINDOW), pos_w, T)

    starts = jnp.arange(T // Q_BLOCK, dtype=jnp.int32) * Q_BLOCK
    o = lax.map(one_block, starts)
    return o.transpose(1, 0, 2, 3).reshape(B, T, B_WIDTH)


def nsa_sample(q_n, q_r, gate, kc, vc, ks_new, vs_new, k_w, v_w, pos_w, sk_pool, sv_pool, page_table):
    Bd = q_n.shape[0]
    bi = jnp.arange(Bd)[:, None, None, None]
    ki = jnp.arange(N_KV)[None, :, None, None]

    def fetch(pos):
        past = (pos < PAST_LEN)[..., None]
        pc = jnp.clip(pos, 0, PAST_LEN - 1)
        phys = page_table[bi, pc // PAGE_SIZE]
        off = pc % PAGE_SIZE
        pn = jnp.clip(pos - PAST_LEN, 0, DEC_SEQ - 1)
        k = jnp.where(past, sk_pool[phys, off, ki], ks_new[bi, pn, ki])
        v = jnp.where(past, sv_pool[phys, off, ki], vs_new[bi, pn, ki])
        return k, v

    pos_q = PAST_LEN + jnp.arange(DEC_SEQ, dtype=jnp.int32)
    return nsa_attend(q_n, q_r, gate, pos_q, kc, vc, fetch, k_w, v_w, pos_w, PAST_LEN + DEC_SEQ)


def gather_pages(pool, page_table):
    Bd, n_pages = page_table.shape
    return pool[page_table].reshape(Bd, n_pages * PAGE_SIZE, N_KV, HEAD_DIM)


def merge_and_ffn(x, o_a, o_b, merge_gate, w_branch, w_out, g_norm2, w_up, w_down):
    y_a = o_a @ w_branch[:A_WIDTH]
    y_b = o_b @ w_branch[A_WIDTH:]
    g_a, g_b = jnp.split(merge_gate, 2, axis=-1)
    x = x + (jax.nn.sigmoid(g_a) * y_a + jax.nn.sigmoid(g_b) * y_b) @ w_out
    h = rms_norm(x, g_norm2)
    return x + jnp.square(jax.nn.relu(h @ w_up)) @ w_down


def setup_inputs(seed: int = 0) -> dict:
    key = jax.random.key(seed)
    k = jax.random.split(key, 40)
    nrm = lambda kk, shape, scale: jax.random.normal(kk, shape, jnp.float32) * scale
    gain = lambda kk, n: 1.0 + nrm(kk, (DEPTH, n), 0.05)
    n_pages = PAST_LEN // PAGE_SIZE
    n_phys = (5 * DEC_BATCH * n_pages) // 4
    w_buf = min(WINDOW, PAST_LEN)
    pool = (DEPTH, n_phys, PAGE_SIZE, N_KV, HEAD_DIM)
    perm = jax.random.permutation(k[9], n_phys)
    page_table = perm[:DEC_BATCH * n_pages].reshape(DEC_BATCH, n_pages).astype(jnp.int32)
    return {
        'x_prompt': nrm(k[0], (BATCH, SEQ, D_MODEL), 1.0),
        'x_sample': nrm(k[1], (DEC_BATCH, DEC_SEQ, D_MODEL), 1.0),
        'cache_k_cmp': nrm(k[2], pool, 1.0),
        'cache_v_cmp': nrm(k[3], pool, 1.0),
        'cache_k_sel': nrm(k[4], pool, 1.0),
        'cache_v_sel': nrm(k[5], pool, 1.0),
        'cache_k_win': nrm(k[6], (DEPTH, DEC_BATCH, w_buf, N_KV, HEAD_DIM), 1.0),
        'cache_v_win': nrm(k[7], (DEPTH, DEC_BATCH, w_buf, N_KV, HEAD_DIM), 1.0),
        'page_table': page_table,
        'g_norm1': gain(k[10], D_MODEL),
        'w_in': nrm(k[11], (DEPTH, D_MODEL, IN_COLS), D_MODEL ** -0.5),
        'ln_v_g': gain(k[12], A_WIDTH),
        'ln_v_b': nrm(k[13], (DEPTH, A_WIDTH), 0.02),
        'w_s': nrm(k[14], (DEPTH, A_GROUPS, CHUNK, CHUNK), 0.5 * CHUNK ** -0.5),
        'b_s': 1.0 + nrm(k[15], (DEPTH, A_GROUPS, CHUNK), 0.1),
        'g_q': gain(k[16], HEAD_DIM),
        'g_kc': gain(k[17], HEAD_DIM),
        'g_ks': gain(k[18], HEAD_DIM),
        'g_kw': gain(k[19], HEAD_DIM),
        'w_ck1': nrm(k[20], (DEPTH, CMP_BLOCK * HEAD_DIM, HEAD_DIM), (CMP_BLOCK * HEAD_DIM) ** -0.5),
        'w_ck2': nrm(k[21], (DEPTH, HEAD_DIM, HEAD_DIM), HEAD_DIM ** -0.5),
        'pe_k': nrm(k[22], (DEPTH, CMP_BLOCK, HEAD_DIM), 0.1),
        'w_cv1': nrm(k[23], (DEPTH, CMP_BLOCK * HEAD_DIM, HEAD_DIM), (CMP_BLOCK * HEAD_DIM) ** -0.5),
        'w_cv2': nrm(k[24], (DEPTH, HEAD_DIM, HEAD_DIM), HEAD_DIM ** -0.5),
        'pe_v': nrm(k[25], (DEPTH, CMP_BLOCK, HEAD_DIM), 0.1),
        'w_branch': nrm(k[26], (DEPTH, A_WIDTH + B_WIDTH, D_MODEL), (A_WIDTH + B_WIDTH) ** -0.5),
        'w_out': nrm(k[27], (DEPTH, D_MODEL, D_MODEL), D_MODEL ** -0.5),
        'g_norm2': gain(k[28], D_MODEL),
        'w_up': nrm(k[29], (DEPTH, D_MODEL, D_FF), D_MODEL ** -0.5),
        'w_down': nrm(k[30], (DEPTH, D_FF, D_MODEL), D_FF ** -0.5),
    }


def reference(x_prompt, x_sample, cache_k_cmp, cache_v_cmp, cache_k_sel, cache_v_sel, cache_k_win,
              cache_v_win, page_table, g_norm1, w_in, ln_v_g, ln_v_b, w_s, b_s, g_q, g_kc, g_ks, g_kw,
              w_ck1, w_ck2, pe_k, w_cv1, w_cv2, pe_v, w_branch, w_out, g_norm2, w_up, w_down):
    pos_p = jnp.arange(SEQ, dtype=jnp.int32)
    pos_d = PAST_LEN + jnp.arange(DEC_SEQ, dtype=jnp.int32)
    w_p = min(WINDOW, SEQ)
    chunk_start = ((SEQ - 1) // CHUNK) * CHUNK
    xp, xs = x_prompt, x_sample
    new_p = [[] for _ in range(7)]
    new_s = [[] for _ in range(7)]
    for l in range(DEPTH):
        proj = lambda x, pos: in_projection(x, pos, g_norm1[l], w_in[l], ln_v_g[l], ln_v_b[l], g_q[l], g_ks[l], g_kw[l])
        u, v_n, q_n, q_r, kcr, vcr, ks, vs, kw, vw, gate, mg = proj(xp, pos_p)
        o_a = gmlp_mix(u, v_n, w_s[l], b_s[l])
        kc = rms_norm(compress(kcr, w_ck1[l], w_ck2[l], pe_k[l]), g_kc[l])
        vc = compress(vcr, w_cv1[l], w_cv2[l], pe_v[l])
        o_b = nsa_prompt(q_n, q_r, gate, kc, vc, ks, vs, kw, vw)
        xp = merge_and_ffn(xp, o_a, o_b, mg, w_branch[l], w_out[l], g_norm2[l], w_up[l], w_down[l])
        for lst, a in zip(new_p, (kcr, vcr, ks, vs, kw[:, SEQ - w_p:], vw[:, SEQ - w_p:], v_n[:, chunk_start:])):
            lst.append(a)
        u, v_n, q_n, q_r, kcr, vcr, ks, vs, kw, vw, gate, mg = proj(xs, pos_d)
        o_a = gmlp_mix(u, v_n, w_s[l], b_s[l])
        kc_all = jnp.concatenate([gather_pages(cache_k_cmp[l], page_table), kcr], axis=1)
        vc_all = jnp.concatenate([gather_pages(cache_v_cmp[l], page_table), vcr], axis=1)
        kc = rms_norm(compress(kc_all, w_ck1[l], w_ck2[l], pe_k[l]), g_kc[l])
        vc = compress(vc_all, w_cv1[l], w_cv2[l], pe_v[l])
        w_buf = cache_k_win.shape[2]
        k_w = jnp.concatenate([cache_k_win[l], kw], axis=1)
        v_w = jnp.concatenate([cache_v_win[l], vw], axis=1)
        pos_w = PAST_LEN - w_buf + jnp.arange(w_buf + DEC_SEQ, dtype=jnp.int32)
        o_b = nsa_sample(q_n, q_r, gate, kc, vc, ks, vs, k_w, v_w, pos_w, cache_k_sel[l], cache_v_sel[l], page_table)
        xs = merge_and_ffn(xs, o_a, o_b, mg, w_branch[l], w_out[l], g_norm2[l], w_up[l], w_down[l])
        for lst, a in zip(new_s, (kcr, vcr, ks, vs, kw, vw, v_n)):
            lst.append(a)
    p_kc, p_vc, p_ks, p_vs, p_kw, p_vw, p_va = [jnp.stack(a) for a in new_p]
    s_kc, s_vc, s_ks, s_vs, s_kw, s_vw, s_va = [jnp.stack(a) for a in new_s]
    return (xp, xs, p_kc, p_vc, p_ks, p_vs, p_kw, p_vw, p_va, s_kc, s_vc, s_ks, s_vs, s_kw, s_vw, s_va)
```

```cpp
#include <hip/hip_runtime.h>
#include <hip/hip_bf16.h>
#include <cstdio>
#include <cstdint>
#include <cmath>

constexpr int DM = 1024, SEQ = 8192, NBAT = 2, MP = NBAT * SEQ, NSMP = 128, MT = MP + NSMP, MPAD = 16640;
constexpr int AW = 512, NHEAD = 8, HD = 64, NKV = 2, DFF = 4096, INC = 4376, NIN = 4608;
constexpr int PAST = 16384, NPAGES = 128, DECB = 32, DECS = 4, WIN = 512;
constexpr int NCP = 512, NCS = 1024;
constexpr float EPS = 1e-6f;
constexpr float QC2 = 0.125f * 1.4426950408889634f;

enum { I_XP = 0, I_XS, I_CKC, I_CVC, I_CKS, I_CVS, I_CKW, I_CVW, I_PT, I_G1, I_WIN, I_LNG, I_LNB, I_WS, I_BS, I_GQ, I_GKC, I_GKS, I_GKW,
       I_WCK1, I_WCK2, I_PEK, I_WCV1, I_WCV2, I_PEV, I_WBR, I_WOUT, I_G2, I_WUP, I_WDN, N_IN };
constexpr size_t O_YP = 0, O_YS = O_YP + (size_t)MP * DM, O_PKC = O_YS + (size_t)NSMP * DM, O_PVC = O_PKC + (size_t)MP * 128, O_PKS = O_PVC + (size_t)MP * 128,
                 O_PVS = O_PKS + (size_t)MP * 128, O_PKW = O_PVS + (size_t)MP * 128, O_PVW = O_PKW + (size_t)NBAT * WIN * 128, O_PVA = O_PVW + (size_t)NBAT * WIN * 128,
                 O_SKC = O_PVA + (size_t)NBAT * 128 * AW, O_SVC = O_SKC + NSMP * 128, O_SKS = O_SVC + NSMP * 128, O_SVS = O_SKS + NSMP * 128, O_SKW = O_SVS + NSMP * 128,
                 O_SVW = O_SKW + NSMP * 128, O_SVA = O_SVW + NSMP * 128, O_END = O_SVA + (size_t)NSMP * AW;
static_assert(O_END == 25853952, "output size");

constexpr size_t al256(size_t x) { return (x + 255) & ~(size_t)255; }
constexpr size_t WS_CTL = 0, CTL_ZERO_BYTES = 1u << 20;
constexpr size_t WS_WINT = CTL_ZERO_BYTES;
constexpr size_t WS_WBA = WS_WINT + (size_t)NIN * DM * 2;
constexpr size_t WS_WBB = WS_WBA + (size_t)DM * 512 * 2;
constexpr size_t WS_WOT = WS_WBB + (size_t)DM * 512 * 2;
constexpr size_t WS_WUP = WS_WOT + (size_t)DM * DM * 2;
constexpr size_t WS_WDN = WS_WUP + (size_t)DFF * DM * 2;
constexpr size_t WS_WC1K = WS_WDN + (size_t)DM * DFF * 2;
constexpr size_t WS_WC1V = WS_WC1K + 128 * 1024 * 2;
constexpr size_t WS_WSP = WS_WC1V + 128 * 1024 * 2;
constexpr size_t WS_WSS = WS_WSP + 8 * 128 * 128 * 2;
constexpr size_t WS_ROPE = WS_WSS + 8 * 128 * 128 * 2;
constexpr size_t WS_BPART = al256(WS_ROPE + 8196 * 16 * 4);
constexpr size_t WS_GAINS = al256(WS_BPART + 2 * 32 * 64 * 4);
constexpr size_t WS_XN = al256(WS_GAINS + 3 * 64 * 4);
constexpr size_t WS_U = WS_XN + (size_t)MPAD * DM * 2;
constexpr size_t WS_GV = WS_U + (size_t)MPAD * 512 * 2;
constexpr size_t WS_QN = WS_GV + (size_t)MPAD * 512 * 2;
constexpr size_t WS_QR = WS_QN + (size_t)MPAD * 512 * 2;
constexpr size_t WS_KCA = WS_QR + (size_t)MPAD * 512 * 2;
constexpr size_t WS_VCA = WS_KCA + 2048 * 1024 * 2;
constexpr size_t KVROWS = MPAD + 256;
constexpr size_t WS_KS = WS_VCA + 2048 * 1024 * 2;
constexpr size_t WS_VS = WS_KS + KVROWS * 128 * 2;
constexpr size_t WS_KW = WS_VS + KVROWS * 128 * 2;
constexpr size_t WS_VW = WS_KW + KVROWS * 128 * 2;
constexpr size_t WS_SG = WS_VW + KVROWS * 128 * 2;
constexpr size_t WS_NG = WS_SG + (size_t)MPAD * 2048 * 2;
constexpr size_t WS_FSPK = WS_NG + (size_t)MPAD * 32 * 4;
constexpr size_t WS_FSPV = WS_FSPK + 2048 * 128 * 4;
constexpr size_t WS_FSSK = WS_FSPV + 2048 * 128 * 4;
constexpr size_t WS_FSSV = WS_FSSK + (size_t)65536 * 128 * 4;
constexpr size_t WS_KCP = WS_FSSV + (size_t)65536 * 128 * 4;
constexpr size_t WS_VCP = WS_KCP + 4 * NCP * 64 * 2;
constexpr size_t WS_KCS = WS_VCP + 4 * NCP * 64 * 2;
constexpr size_t WS_VCS = WS_KCS + (size_t)64 * NCS * 64 * 2;
constexpr size_t WS_OA = WS_VCS + (size_t)64 * NCS * 64 * 2;
constexpr size_t WS_OB = WS_OA + (size_t)MPAD * 512 * 2;
constexpr size_t WS_T1 = WS_OB + (size_t)MPAD * 512 * 2;
constexpr size_t WS_MG = WS_T1 + (size_t)MPAD * DM * 2;
constexpr size_t WS_X1B = WS_MG + (size_t)MPAD * DM * 2;
constexpr size_t WS_SSQ = WS_X1B + (size_t)MPAD * DM * 2;
constexpr size_t WS_H = al256(WS_SSQ + (size_t)MPAD * 16 * 4);
constexpr size_t WS_OBF = WS_H + (size_t)MPAD * DFF * 2;
constexpr size_t WS_DBG = WS_OBF + (size_t)MP * 512 * 4;
constexpr size_t WS_END = WS_DBG + (1u << 20);

constexpr int CW_TMO = 0, CW_CODE = 1, CW_BAR = 4096;

constexpr int LDS_BYTES = 147456;
constexpr int MISC_OFF = LDS_BYTES - 256;
constexpr int NWAVES = 8;

#define GAS __attribute__((address_space(1)))
#define LAS __attribute__((address_space(3)))
typedef unsigned short bf16;
typedef unsigned v4u __attribute__((ext_vector_type(4)));
typedef unsigned v2u __attribute__((ext_vector_type(2)));
typedef float f32x4 __attribute__((ext_vector_type(4)));
typedef float f32x16 __attribute__((ext_vector_type(16)));
typedef short bf16x8 __attribute__((ext_vector_type(8)));
typedef GAS unsigned gu32;
#define RLX_AGENT __ATOMIC_RELAXED, __HIP_MEMORY_SCOPE_AGENT
#define LDS_WAIT() asm volatile("s_waitcnt lgkmcnt(0)" ::: "memory")
#define VM_WAIT() asm volatile("s_waitcnt vmcnt(0)" ::: "memory")
__device__ __forceinline__ unsigned f2bf(float f) { unsigned u = __builtin_bit_cast(unsigned, f); return (u + 0x7fffu + ((u >> 16) & 1u)) >> 16; }
__device__ __forceinline__ unsigned pk2(float lo, float hi) { return f2bf(lo) | (f2bf(hi) << 16); }
__device__ __forceinline__ float bf2f(unsigned h) { return __builtin_bit_cast(float, h << 16); }
__device__ __forceinline__ float bflo(unsigned w) { return __builtin_bit_cast(float, w << 16); }
__device__ __forceinline__ float bfhi(unsigned w) { return __builtin_bit_cast(float, w & 0xffff0000u); }
__device__ __forceinline__ float fast_sigmoid(float x) { return __builtin_amdgcn_rcpf(1.f + __builtin_amdgcn_exp2f(-1.4426950408889634f * x)); }
__device__ __forceinline__ float gelu_tanh(float x) {
    const float u = 1.5957691216057308f * (x + 0.044715f * x * x * x);
    return x * __builtin_amdgcn_rcpf(1.f + __builtin_amdgcn_exp2f(-1.4426950408889634f * u));
}
__device__ __forceinline__ float wave_sum(float v) {
#pragma unroll
    for (int o = 1; o < 64; o <<= 1) v += __shfl_xor(v, o);
    return v;
}
__device__ __forceinline__ float wave_max(float v) {
#pragma unroll
    for (int o = 1; o < 64; o <<= 1) v = fmaxf(v, __shfl_xor(v, o));
    return v;
}
__host__ __device__ __forceinline__ int dmap(int s) { if (s >= 16) return s; const int f = s >> 3, p = s & 7; return p < 4 ? 4 * f + p : 4 + 4 * f + p; }
__host__ __device__ __forceinline__ int win_map(int j) {
    const int t = j >> 8, L = j & 255;
    if (t < 4) return j;
    const int h = (L >> 5) & 3, s = ((L >> 7) << 5) | (L & 31);
    if (t < 6) return 1024 + ((t - 4) * 4 + h) * 64 + dmap(s);
    if (t == 6) return 1536 + L;
    if (t == 7) return 1792 + (h >> 1) * 128 + (h & 1) * 64 + dmap(s);
    if (t == 8) return 2048 + (h >> 1) * 128 + (h & 1) * 64 + dmap(s);
    if (t < 17) return 2328 + (j - 9 * 256);
    return L < 24 ? 2304 + L : -1;
}
namespace pg8 {
#define PG8_LAS __attribute__((address_space(3)))
typedef unsigned short bf16_t;
typedef short bf16x8 __attribute__((ext_vector_type(8)));
typedef float f32x4 __attribute__((ext_vector_type(4)));
typedef unsigned u32x4 __attribute__((ext_vector_type(4)));
constexpr int BM = 256, BK = 64, HALF = 128, HTB = HALF * BK * 2  , STAGE_BYTES = 8 * HTB, NXCD = 8, WGM = 8;

__host__ __device__ __forceinline__ int lds_byte(int r, int c) { const int st = (r >> 4) * 2 + (c >> 5), rr = r & 15, cc = c & 31, ob = rr * 64 + cc * 2; return st * 1024 + (ob ^ (((ob >> 9) & 1) << 5)); }
__host__ __device__ __forceinline__ void stage_rc(int b, int& R, int& C) { const int st = b / 1024, sb = b % 1024, swz = sb ^ (((sb >> 9) & 1) << 5); R = (st >> 1) * 16 + swz / 64; C = (st & 1) * 32 + (swz % 64) / 2; }
__host__ __device__ __forceinline__ int perm32(int rho) { const int n = rho >> 4, i = rho & 15; return 8 * (i >> 2) + 4 * n + (i & 3); }

struct Unit { int pm, pn; };
struct Gemm { const bf16_t* A; const bf16_t* Bt; int M, N, K; };

struct StaticOrder {
    int nM, nN, nwg, G, c;
    __host__ __device__ void init(int M, int N, int G_, int c_) { nM = M / BM; nN = N / BM; nwg = nM * nN; G = G_; c = c_; }
    __host__ __device__ bool next(int i, Unit& u) const {
        const long L = (long)i * G + c; if (L >= nwg) return false;
        int wgid = (int)L; { const int q = nwg / NXCD, r = nwg % NXCD, xcd = wgid % NXCD, off = wgid / NXCD; wgid = (xcd < r ? xcd * (q + 1) : r * (q + 1) + (xcd - r) * q) + off; }
        const int nig = WGM * nN, gid = wgid / nig, fm = gid * WGM, gsz = (nM - fm) < WGM ? (nM - fm) : WGM;
        u.pm = fm + ((wgid % nig) % gsz); u.pn = (wgid % nig) / gsz; return true;
    }
    __device__ __forceinline__ void a_ready(const Unit&) const {}
    __device__ __forceinline__ void done(const Unit&) const {}
};

__device__ __forceinline__ unsigned cvt_pk_bf16(float lo, float hi) { unsigned r; asm volatile("v_cvt_pk_bf16_f32 %0, %1, %2" : "=v"(r) : "v"(lo), "v"(hi)); return r; }
typedef float f32x2 __attribute__((ext_vector_type(2)));
__device__ __forceinline__ u32x4 pack8(const f32x4 a, const f32x4 b) { u32x4 w; w.x = cvt_pk_bf16(a[0], a[1]); w.y = cvt_pk_bf16(a[2], a[3]); w.z = cvt_pk_bf16(b[0], b[1]); w.w = cvt_pk_bf16(b[2], b[3]); return w; }
typedef unsigned u32x2 __attribute__((ext_vector_type(2)));

struct EpiIn {
    static constexpr bool PERM = true, AFTER_DRAIN = false;
    unsigned char* ws; float* out;
    __device__ __forceinline__ void operator()(const f32x4 (&acc)[2][2][4][2], const Unit& u, int wr, int wc, int fr, int fq) const {
        const int pn = u.pn, rbase = u.pm * BM + wr * 64 + fr;
        if (pn < 4) {
            bf16_t* dst = (bf16_t*)(ws + (pn < 2 ? WS_U : WS_GV)) + (pn & 1) * 256 + wc * 32 + 8 * fq;
#pragma unroll
            for (int ai = 0; ai < 2; ++ai)
#pragma unroll
                for (int m = 0; m < 4; ++m) { const int row = rbase + ai * HALF + m * 16;
#pragma unroll
                    for (int bj = 0; bj < 2; ++bj) { f32x4 v0 = acc[ai][bj][m][0], v1 = acc[ai][bj][m][1];
#pragma unroll
                        for (int i = 0; i < 4; ++i) { v0[i] = gelu_tanh(v0[i]); v1[i] = gelu_tanh(v1[i]); }
                        *(u32x4*)(dst + (size_t)row * 512 + bj * HALF) = pack8(v0, v1); } }
        } else if (pn < 6 || pn == 7 || pn == 8) {
            const bool isq = pn < 6, isk = isq || wc < 2;
            const float* g = (const float*)(ws + WS_GAINS) + (isq ? 0 : (pn == 7 ? 64 : 128)); const float* rope = (const float*)(ws + WS_ROPE);
            const int d1 = fq < 2 ? 4 * fq : 8 * fq, d2 = fq < 2 ? 8 + 4 * fq : 8 * fq + 4, d3 = 32 + 8 * fq;
            f32x4 g1 = {1.f, 1.f, 1.f, 1.f}, g2 = g1, g3a = g1, g3b = g1;
            if (isk) { g1 = *(const f32x4*)(g + d1); g2 = *(const f32x4*)(g + d2); g3a = *(const f32x4*)(g + d3); g3b = *(const f32x4*)(g + d3 + 4); }
            const float osc = isq ? QC2 : 1.f;
#pragma unroll
            for (int ai = 0; ai < 2; ++ai)
#pragma unroll
                for (int m = 0; m < 4; ++m) { const int row = rbase + ai * HALF + m * 16;
                    f32x4 a = acc[ai][0][m][0], b = acc[ai][0][m][1], c = acc[ai][1][m][0], d = acc[ai][1][m][1];
                    f32x4 ra = a, rb = b;
                    if (isk) {
                        float ss = (a[0] * a[0] + a[1] * a[1]) + (a[2] * a[2] + a[3] * a[3]) + (b[0] * b[0] + b[1] * b[1]) + (b[2] * b[2] + b[3] * b[3])
                                 + (c[0] * c[0] + c[1] * c[1]) + (c[2] * c[2] + c[3] * c[3]) + (d[0] * d[0] + d[1] * d[1]) + (d[2] * d[2] + d[3] * d[3]);
                        ss += __shfl_xor(ss, 16); ss += __shfl_xor(ss, 32);
                        const float rstd = 1.f / sqrtf(ss * (1.f / 64.f) + EPS);
                        a = a * rstd * g1; b = b * rstd * g2; c = c * rstd * g3a; d = d * rstd * g3b;
                        const int pidx = row < MP ? (row & (SEQ - 1)) : SEQ + ((row - MP) & 3);
                        f32x4 cs = {1.f, 1.f, 1.f, 1.f}, sn = {0.f, 0.f, 0.f, 0.f};
                        if (fq < 2) { cs = *(const f32x4*)(rope + pidx * 16 + 4 * fq); sn = *(const f32x4*)(rope + pidx * 16 + 8 + 4 * fq); }
                        ra = a * cs - b * sn; rb = b * cs + a * sn;
                    }
                    if (isq) {
                        const int head = (pn - 4) * 4 + wc; bf16_t* qn = (bf16_t*)(ws + WS_QN) + (size_t)row * 512 + head * 64; bf16_t* qr = (bf16_t*)(ws + WS_QR) + (size_t)row * 512 + head * 64;
                        const f32x4 cc = c * osc, dd = d * osc;
                        { f32x4 x = a * osc, y = b * osc; u32x2 w; w.x = cvt_pk_bf16(x[0], x[1]); w.y = cvt_pk_bf16(x[2], x[3]); *(u32x2*)(qn + d1) = w; w.x = cvt_pk_bf16(y[0], y[1]); w.y = cvt_pk_bf16(y[2], y[3]); *(u32x2*)(qn + d2) = w; }
                        { f32x4 x = ra * osc, y = rb * osc; u32x2 w; w.x = cvt_pk_bf16(x[0], x[1]); w.y = cvt_pk_bf16(x[2], x[3]); *(u32x2*)(qr + d1) = w; w.x = cvt_pk_bf16(y[0], y[1]); w.y = cvt_pk_bf16(y[2], y[3]); *(u32x2*)(qr + d2) = w; }
                        const u32x4 w3 = pack8(cc, dd); *(u32x4*)(qn + d3) = w3; *(u32x4*)(qr + d3) = w3;
                    } else {
                        const int kvh = wc & 1; const bool kw = (pn == 8);
                        bf16_t* bd = (bf16_t*)(ws + (isk ? (kw ? WS_KW : WS_KS) : (kw ? WS_VW : WS_VS))) + (size_t)row * 128 + kvh * 64;
                        { u32x2 w; w.x = cvt_pk_bf16(ra[0], ra[1]); w.y = cvt_pk_bf16(ra[2], ra[3]); *(u32x2*)(bd + d1) = w; w.x = cvt_pk_bf16(rb[0], rb[1]); w.y = cvt_pk_bf16(rb[2], rb[3]); *(u32x2*)(bd + d2) = w; }
                        *(u32x4*)(bd + d3) = pack8(c, d);
                        float* so = nullptr;
                        if (row < MP) { if (!kw) so = out + (isk ? O_PKS : O_PVS) + (size_t)row * 128; else { const int t = row & (SEQ - 1), b = row >> 13; if (t >= SEQ - WIN) so = out + (isk ? O_PKW : O_PVW) + ((size_t)b * WIN + (t - (SEQ - WIN))) * 128; } }
                        else if (row < MT) so = out + (kw ? (isk ? O_SKW : O_SVW) : (isk ? O_SKS : O_SVS)) + (size_t)(row - MP) * 128;
                        if (so) { so += kvh * 64; *(f32x4*)(so + d1) = ra; *(f32x4*)(so + d2) = rb; *(f32x4*)(so + d3) = c; *(f32x4*)(so + d3 + 4) = d; }
                    }
                }
        } else if (pn == 6) {
#pragma unroll
            for (int ai = 0; ai < 2; ++ai)
#pragma unroll
                for (int m = 0; m < 4; ++m) { const int row = rbase + ai * HALF + m * 16;
#pragma unroll
                    for (int bj = 0; bj < 2; ++bj) { const f32x4 v0 = acc[ai][bj][m][0], v1 = acc[ai][bj][m][1]; const int col = wc * 32 + 8 * fq;
                        if (row < MT) { float* so = out + (row < MP ? (bj ? O_PVC : O_PKC) + (size_t)row * 128 : (bj ? O_SVC : O_SKC) + (size_t)(row - MP) * 128) + col; *(f32x4*)so = v0; *(f32x4*)(so + 4) = v1; }
                        if (row < MP) { bf16_t* ca = (bf16_t*)(ws + (bj ? WS_VCA : WS_KCA)) + ((size_t)(row >> 4) * 2 + (wc >> 1)) * 1024 + (row & 15) * 64 + (wc & 1) * 32 + 8 * fq; *(u32x4*)ca = pack8(v0, v1); } } }
        } else if (pn < 17) {
            bf16_t* dst = (bf16_t*)(ws + WS_SG) + (pn - 9) * 256 + wc * 32 + 8 * fq;
#pragma unroll
            for (int ai = 0; ai < 2; ++ai)
#pragma unroll
                for (int m = 0; m < 4; ++m) { const int row = rbase + ai * HALF + m * 16;
#pragma unroll
                    for (int bj = 0; bj < 2; ++bj) { f32x4 v0 = acc[ai][bj][m][0], v1 = acc[ai][bj][m][1];
#pragma unroll
                        for (int i = 0; i < 4; ++i) { v0[i] = fast_sigmoid(v0[i]); v1[i] = fast_sigmoid(v1[i]); }
                        *(u32x4*)(dst + (size_t)row * 2048 + bj * HALF) = pack8(v0, v1); } }
        } else {
            if (wc == 0 && fq < 3) {
#pragma unroll
                for (int ai = 0; ai < 2; ++ai)
#pragma unroll
                    for (int m = 0; m < 4; ++m) { const int row = rbase + ai * HALF + m * 16; f32x4 v0 = acc[ai][0][m][0], v1 = acc[ai][0][m][1];
#pragma unroll
                        for (int i = 0; i < 4; ++i) { v0[i] = fast_sigmoid(v0[i]); v1[i] = fast_sigmoid(v1[i]); }
                        float* d = (float*)(ws + WS_NG) + (size_t)row * 32 + 8 * fq; *(f32x4*)d = v0; *(f32x4*)(d + 4) = v1; }
            }
        }
    }
};

struct EpiT1 {
    static constexpr bool PERM = true, AFTER_DRAIN = false;
    bf16_t* O; int ldc;
    __device__ __forceinline__ void operator()(const f32x4 (&acc)[2][2][4][2], const Unit& u, int wr, int wc, int fr, int fq) const {
        bf16_t* base = O + (size_t)(u.pm * BM + wr * 64 + fr) * ldc + u.pn * BM + wc * 32 + 8 * fq;
#pragma unroll
        for (int ai = 0; ai < 2; ++ai)
#pragma unroll
            for (int m = 0; m < 4; ++m)
#pragma unroll
                for (int bj = 0; bj < 2; ++bj) *(u32x4*)(base + (size_t)(ai * HALF + m * 16) * ldc + bj * HALF) = pack8(acc[ai][bj][m][0], acc[ai][bj][m][1]);
    }
};
__device__ __forceinline__ void unpack8(const u32x4 w, float (&f)[8]) {
    f[0] = __builtin_bit_cast(float, w.x << 16); f[1] = __builtin_bit_cast(float, w.x & 0xffff0000u); f[2] = __builtin_bit_cast(float, w.y << 16); f[3] = __builtin_bit_cast(float, w.y & 0xffff0000u);
    f[4] = __builtin_bit_cast(float, w.z << 16); f[5] = __builtin_bit_cast(float, w.z & 0xffff0000u); f[6] = __builtin_bit_cast(float, w.w << 16); f[7] = __builtin_bit_cast(float, w.w & 0xffff0000u);
}
struct EpiMerge {
    static constexpr bool PERM = true, AFTER_DRAIN = false;
    const bf16_t* T1; const bf16_t* SG; bf16_t* MG;
    __device__ __forceinline__ void operator()(const f32x4 (&acc)[2][2][4][2], const Unit& u, int wr, int wc, int fr, int fq) const {
        const int row0 = u.pm * BM + wr * 64 + fr, col0 = u.pn * BM + wc * 32 + 8 * fq;
#pragma unroll
        for (int ai = 0; ai < 2; ++ai)
#pragma unroll
            for (int m = 0; m < 4; ++m) { const size_t row = (size_t)(row0 + ai * HALF + m * 16);
#pragma unroll
                for (int bj = 0; bj < 2; ++bj) { const int col = col0 + bj * HALF;
                    float t[8], ga[8], gb[8]; unpack8(*(const u32x4*)(T1 + row * DM + col), t); unpack8(*(const u32x4*)(SG + row * 2048 + col), ga); unpack8(*(const u32x4*)(SG + row * 2048 + 1024 + col), gb);
                    const f32x4 v0 = acc[ai][bj][m][0], v1 = acc[ai][bj][m][1]; f32x4 o0, o1;
#pragma unroll
                    for (int i = 0; i < 4; ++i) { o0[i] = ga[i] * t[i] + gb[i] * v0[i]; o1[i] = ga[4 + i] * t[4 + i] + gb[4 + i] * v1[i]; }
                    *(u32x4*)(MG + row * DM + col) = pack8(o0, o1); } }
    }
};
__device__ __forceinline__ float* yrow(float* out, int row) { return row < MP ? out + O_YP + (size_t)row * DM : out + O_YS + (size_t)(row - MP) * DM; }
struct EpiOut {
    static constexpr bool PERM = true, AFTER_DRAIN = false;
    const float* xp; const float* xs; float* out; bf16_t* X1B; float* SSQ;
    __device__ __forceinline__ void operator()(const f32x4 (&acc)[2][2][4][2], const Unit& u, int wr, int wc, int fr, int fq) const {
        const int row0 = u.pm * BM + wr * 64 + fr, col0 = u.pn * BM + wc * 32 + 8 * fq;
#pragma unroll
        for (int ai = 0; ai < 2; ++ai)
#pragma unroll
            for (int m = 0; m < 4; ++m) { const int row = row0 + ai * HALF + m * 16; float ss = 0.f;
                const float* xr = xp + (size_t)row * DM; if (row >= MP) xr = xs + (size_t)(row - MP) * DM;
#pragma unroll
                for (int bj = 0; bj < 2; ++bj) { const int col = col0 + bj * HALF; f32x4 v0 = acc[ai][bj][m][0], v1 = acc[ai][bj][m][1];
                    if (row < MT) { v0 = v0 + *(const f32x4*)(xr + col); v1 = v1 + *(const f32x4*)(xr + col + 4); float* y = yrow(out, row) + col; *(f32x4*)y = v0; *(f32x4*)(y + 4) = v1; }
                    ss += (v0[0] * v0[0] + v0[1] * v0[1]) + (v0[2] * v0[2] + v0[3] * v0[3]) + (v1[0] * v1[0] + v1[1] * v1[1]) + (v1[2] * v1[2] + v1[3] * v1[3]);
                    *(u32x4*)(X1B + (size_t)row * DM + col) = pack8(v0, v1); }
                ss += __shfl_xor(ss, 16); ss += __shfl_xor(ss, 32);
                if (fq == 0) SSQ[(size_t)row * 16 + u.pn * 4 + wc] = ss; }
    }
};
struct EpiUp {
    static constexpr bool PERM = true, AFTER_DRAIN = false;
    const float* SSQ; bf16_t* H;
    __device__ __forceinline__ void operator()(const f32x4 (&acc)[2][2][4][2], const Unit& u, int wr, int wc, int fr, int fq) const {
        const int row0 = u.pm * BM + wr * 64 + fr, col0 = u.pn * BM + wc * 32 + 8 * fq;
#pragma unroll
        for (int ai = 0; ai < 2; ++ai)
#pragma unroll
            for (int m = 0; m < 4; ++m) { const size_t row = (size_t)(row0 + ai * HALF + m * 16);
                const f32x4 s0 = *(const f32x4*)(SSQ + row * 16), s1 = *(const f32x4*)(SSQ + row * 16 + 4), s2 = *(const f32x4*)(SSQ + row * 16 + 8), s3 = *(const f32x4*)(SSQ + row * 16 + 12);
                const f32x4 st = (s0 + s1) + (s2 + s3); const float rstd = 1.f / sqrtf(((st[0] + st[1]) + (st[2] + st[3])) * (1.f / DM) + EPS);
#pragma unroll
                for (int bj = 0; bj < 2; ++bj) { f32x4 v0 = acc[ai][bj][m][0] * rstd, v1 = acc[ai][bj][m][1] * rstd;
#pragma unroll
                    for (int i = 0; i < 4; ++i) { const float a = fmaxf(v0[i], 0.f), b = fmaxf(v1[i], 0.f); v0[i] = a * a; v1[i] = b * b; }
                    *(u32x4*)(H + row * DFF + col0 + bj * HALF) = pack8(v0, v1); } }
    }
};
struct EpiDown {
    static constexpr bool PERM = true, AFTER_DRAIN = false;
    float* out;
    __device__ __forceinline__ void operator()(const f32x4 (&acc)[2][2][4][2], const Unit& u, int wr, int wc, int fr, int fq) const {
        const int row0 = u.pm * BM + wr * 64 + fr, col0 = u.pn * BM + wc * 32 + 8 * fq;
#pragma unroll
        for (int ai = 0; ai < 2; ++ai)
#pragma unroll
            for (int m = 0; m < 4; ++m) { const int row = row0 + ai * HALF + m * 16;
                if (row < MT) { float* y = yrow(out, row) + col0;
#pragma unroll
                    for (int bj = 0; bj < 2; ++bj) { *(f32x4*)(y + bj * HALF) = *(const f32x4*)(y + bj * HALF) + acc[ai][bj][m][0]; *(f32x4*)(y + bj * HALF + 4) = *(const f32x4*)(y + bj * HALF + 4) + acc[ai][bj][m][1]; } } }
    }
};
template <class Epi, class Sched, bool ALIGN_EPI = false, bool SP2 = false>
__device__ __forceinline__ void gemm_phase(PG8_LAS unsigned char* lds, const Gemm g, const Sched& S, const Epi& E) {
    const int tid = threadIdx.x, wid = __builtin_amdgcn_readfirstlane(tid >> 6), lane = tid & 63, wr = wid >> 2, wc = wid & 3, fr = lane & 15, fq = lane >> 4;
    const int K = g.K, nt = K / BK;
    unsigned voffA[2], voffB[2];
#pragma unroll
    for (int i = 0; i < 2; ++i) { int R, C; stage_rc(tid * 16 + i * 8192, R, C); const int Rb = Epi::PERM ? ((R & ~31) + perm32(R & 31)) : R;
        voffA[i] = (unsigned)(R * K + C) * 2u; voffB[i] = (unsigned)(Rb * K + C) * 2u; }
    const size_t kstep = (size_t)(BK * 2);
    const size_t hstep = (size_t)HALF * K * 2;
    const size_t tstep = 2 * hstep;
    const unsigned ldsw = (unsigned)wid * 1024u;
    const int aoff = lds_byte(wr * 64 + fr, fq * 8), boff = lds_byte(wc * 32 + fr, fq * 8);
#define PG8_SA(b, h) (((b) * 2 + (h)) * HTB)
#define PG8_SB(b, h) ((4 + (b) * 2 + (h)) * HTB)
#define PG8_STAGE(bufoff, gbase, voff) do { _Pragma("unroll") for (int _i = 0; _i < 2; ++_i) \
        __builtin_amdgcn_global_load_lds((const unsigned*)((const char*)(gbase) + (voff)[_i]), (PG8_LAS unsigned*)(lds + (bufoff) + ldsw + _i * 8192), 16, 0, 0); } while (0)
#define PG8_LDA(dst, b, h) do { _Pragma("unroll") for (int m = 0; m < 4; ++m) _Pragma("unroll") for (int k = 0; k < 2; ++k) dst[m][k] = *(const PG8_LAS bf16x8*)(lds + PG8_SA(b, h) + aoff + m * 2048 + k * 1024); } while (0)
#define PG8_LDB(dst, b, h) do { _Pragma("unroll") for (int n = 0; n < 2; ++n) _Pragma("unroll") for (int k = 0; k < 2; ++k) dst[n][k] = *(const PG8_LAS bf16x8*)(lds + PG8_SB(b, h) + boff + n * 2048 + k * 1024); } while (0)
#define PG8_MMA(ai, bj, At, Bt) do { __builtin_amdgcn_s_setprio(1); _Pragma("unroll") for (int m = 0; m < 4; ++m) _Pragma("unroll") for (int n = 0; n < 2; ++n) _Pragma("unroll") for (int k = 0; k < 2; ++k) \
        acc[ai][bj][m][n] = __builtin_amdgcn_mfma_f32_16x16x32_bf16(Bt[n][k], At[m][k], acc[ai][bj][m][n], 0, 0, 0); __builtin_amdgcn_s_setprio(0); } while (0)
#define PG8_WAIT_V(n) asm volatile("s_waitcnt vmcnt(" #n ")" ::: "memory")
#define PG8_WAIT_L(n) asm volatile("s_waitcnt lgkmcnt(" #n ")" ::: "memory")
#define PG8_BAR __builtin_amdgcn_s_barrier()
#define PG8_SCHED __builtin_amdgcn_sched_barrier(0)
    Unit cur, nxt; int ui = 0;
    if (!S.next(0, cur)) return;
    f32x4 acc[2][2][4][2];
#pragma unroll
    for (int a = 0; a < 2; ++a)
#pragma unroll
        for (int b = 0; b < 2; ++b)
#pragma unroll
            for (int m = 0; m < 4; ++m)
#pragma unroll
                for (int n = 0; n < 2; ++n) acc[a][b][m][n] = (f32x4){0.f, 0.f, 0.f, 0.f};
    bf16x8 At[4][2], B0[2][2], B1[2][2];
    const char* cA = (const char*)g.A + (size_t)cur.pm * tstep; const char* cB = (const char*)g.Bt + (size_t)cur.pn * tstep;
    S.a_ready(cur);
    if constexpr (SP2) {
        PG8_STAGE(PG8_SB(0, 0), cB, voffB); PG8_STAGE(PG8_SB(0, 1), cB + hstep, voffB); PG8_STAGE(PG8_SA(0, 0), cA, voffA); PG8_STAGE(PG8_SA(0, 1), cA + hstep, voffA);
        if (wr == 1) PG8_BAR;
        PG8_WAIT_V(2); PG8_BAR;
        PG8_STAGE(PG8_SB(1, 0), cB + kstep, voffB); PG8_STAGE(PG8_SA(1, 0), cA + kstep, voffA); PG8_STAGE(PG8_SB(1, 1), cB + hstep + kstep, voffB);
        PG8_WAIT_V(6); PG8_BAR;
    } else {
        PG8_STAGE(PG8_SB(0, 0), cB, voffB); PG8_STAGE(PG8_SA(0, 0), cA, voffA); PG8_STAGE(PG8_SB(0, 1), cB + hstep, voffB); PG8_STAGE(PG8_SA(0, 1), cA + hstep, voffA);
        if (wr == 1) PG8_BAR;
        PG8_WAIT_V(4); PG8_BAR;
        PG8_STAGE(PG8_SB(1, 0), cB + kstep, voffB); PG8_STAGE(PG8_SA(1, 0), cA + kstep, voffA); PG8_STAGE(PG8_SB(1, 1), cB + hstep + kstep, voffB);
        PG8_WAIT_V(6); PG8_BAR;
    }
    for (;;) {
        const bool has_next = S.next(ui + 1, nxt);
        const char* nA = has_next ? (const char*)g.A + (size_t)nxt.pm * tstep : cA; const char* nB = has_next ? (const char*)g.Bt + (size_t)nxt.pn * tstep : cB;
        for (int t = 0; t < nt; t += 2) {
            const bool last = (t == nt - 2);
            const char* a1 = cA + (size_t)(t + 1) * kstep;
            const char* a2 = last ? nA : cA + (size_t)(t + 2) * kstep; const char* b2 = last ? nB : cB + (size_t)(t + 2) * kstep;
            const char* a3 = a2 + kstep; const char* b3 = b2 + kstep;
            if (last && has_next) S.a_ready(nxt);
            if constexpr (SP2) {
            PG8_LDB(B0, 0, 0); PG8_LDB(B1, 0, 1); PG8_SCHED; PG8_LDA(At, 0, 0); PG8_STAGE(PG8_SA(1, 1), a1 + hstep, voffA);
            PG8_WAIT_V(8); PG8_WAIT_L(0); PG8_BAR; PG8_MMA(0, 0, At, B0); PG8_MMA(0, 1, At, B1); PG8_BAR; PG8_SCHED;
            PG8_LDA(At, 0, 1); PG8_STAGE(PG8_SB(0, 0), b2, voffB); PG8_STAGE(PG8_SB(0, 1), b2 + hstep, voffB); PG8_STAGE(PG8_SA(0, 0), a2, voffA);
            PG8_WAIT_V(8); PG8_WAIT_L(0); PG8_BAR; PG8_MMA(1, 0, At, B0); PG8_MMA(1, 1, At, B1); PG8_BAR; PG8_SCHED;
            PG8_LDB(B0, 1, 0); PG8_LDB(B1, 1, 1); PG8_SCHED; PG8_LDA(At, 1, 0); PG8_STAGE(PG8_SA(0, 1), a2 + hstep, voffA);
            PG8_WAIT_V(8); PG8_WAIT_L(0); PG8_BAR; PG8_MMA(0, 0, At, B0); PG8_MMA(0, 1, At, B1); PG8_BAR; PG8_SCHED;
            PG8_LDA(At, 1, 1); PG8_STAGE(PG8_SB(1, 0), b3, voffB); PG8_STAGE(PG8_SB(1, 1), b3 + hstep, voffB); PG8_STAGE(PG8_SA(1, 0), a3, voffA);
            PG8_WAIT_V(8); PG8_WAIT_L(0); PG8_BAR; PG8_MMA(1, 0, At, B0); PG8_MMA(1, 1, At, B1); PG8_BAR; PG8_SCHED;
            } else {
            PG8_LDB(B0, 0, 0); PG8_SCHED; PG8_LDA(At, 0, 0); PG8_STAGE(PG8_SA(1, 1), a1 + hstep, voffA);
            PG8_WAIT_L(8); PG8_BAR; PG8_WAIT_L(0); PG8_MMA(0, 0, At, B0); PG8_BAR; PG8_SCHED;
            PG8_LDB(B1, 0, 1); PG8_STAGE(PG8_SB(0, 0), b2, voffB);
            PG8_BAR; PG8_WAIT_L(0); PG8_MMA(0, 1, At, B1); PG8_BAR;
            PG8_LDA(At, 0, 1); PG8_STAGE(PG8_SA(0, 0), a2, voffA);
            PG8_BAR; PG8_WAIT_L(0); PG8_MMA(1, 0, At, B0); PG8_BAR; PG8_SCHED;
            PG8_STAGE(PG8_SB(0, 1), b2 + hstep, voffB);
            PG8_WAIT_V(6); PG8_BAR; PG8_MMA(1, 1, At, B1); PG8_BAR;
            PG8_LDB(B0, 1, 0); PG8_SCHED; PG8_LDA(At, 1, 0); PG8_STAGE(PG8_SA(0, 1), a2 + hstep, voffA);
            PG8_WAIT_L(8); PG8_BAR; PG8_WAIT_L(0); PG8_MMA(0, 0, At, B0); PG8_BAR; PG8_SCHED;
            PG8_LDB(B1, 1, 1); PG8_STAGE(PG8_SB(1, 0), b3, voffB);
            PG8_BAR; PG8_WAIT_L(0); PG8_MMA(0, 1, At, B1); PG8_BAR;
            PG8_LDA(At, 1, 1); PG8_STAGE(PG8_SA(1, 0), a3, voffA);
            PG8_BAR; PG8_WAIT_L(0); PG8_MMA(1, 0, At, B0); PG8_BAR; PG8_SCHED;
            PG8_STAGE(PG8_SB(1, 1), b3 + hstep, voffB);
            PG8_WAIT_V(6); PG8_BAR; PG8_MMA(1, 1, At, B1); PG8_BAR;
            }
        }
        if constexpr (ALIGN_EPI) { if (wr == 0) PG8_BAR; }
        if constexpr (!Epi::AFTER_DRAIN) { E(acc, cur, wr, wc, fr, fq); S.done(cur); }
        if (!has_next) break;
#pragma unroll
        for (int a = 0; a < 2; ++a)
#pragma unroll
            for (int b = 0; b < 2; ++b)
#pragma unroll
                for (int m = 0; m < 4; ++m)
#pragma unroll
                    for (int n = 0; n < 2; ++n) acc[a][b][m][n] = (f32x4){0.f, 0.f, 0.f, 0.f};
        cur = nxt; cA = nA; cB = nB; ++ui;
        if constexpr (ALIGN_EPI) { if (wr == 1) PG8_BAR; }
    }
    PG8_WAIT_V(0);
    if constexpr (!ALIGN_EPI) { if (wr == 0) PG8_BAR; }
    PG8_BAR;
    if constexpr (Epi::AFTER_DRAIN) { E.fused(acc, cur, wr, wc, fr, fq, lds, wid, lane); S.done(cur); }
#undef PG8_SA
#undef PG8_SB
#undef PG8_STAGE
#undef PG8_LDA
#undef PG8_LDB
#undef PG8_MMA
#undef PG8_WAIT_V
#undef PG8_WAIT_L
#undef PG8_BAR
#undef PG8_SCHED
}
}
#define XB_TMO      128
#define XB_XCNT(j)  (256  + 64 * (j))
#define XB_XSUB(j)  (1280 + 64 * (j))
#define XB_XGEN(j)  (2304 + 64 * (j))
#define XB_TOP      3328
#define XB_TOPGEN   3392
#define XCD_BAR_WORDS 3456
#define XB_SPIN_CAP (1u << 18)

__device__ __forceinline__ unsigned xb_ld(unsigned* p)              { return __hip_atomic_load(p, __ATOMIC_RELAXED, __HIP_MEMORY_SCOPE_AGENT); }
__device__ __forceinline__ unsigned xb_add(unsigned* p, unsigned v) { return __hip_atomic_fetch_add(p, v, __ATOMIC_RELAXED, __HIP_MEMORY_SCOPE_AGENT); }
__device__ __forceinline__ unsigned xb_xcc_id() { return (unsigned)__builtin_amdgcn_s_getreg((3 << 11) | 20) & 0xFu; }
#define XB_SPIN(cond, bar) do { unsigned _sp = 0; while (cond) { __builtin_amdgcn_s_sleep(1); \
    if ((++_sp & 255u) == 0u) { if (xb_ld(&(bar)[XB_TMO])) break; if (_sp > XB_SPIN_CAP) { atomicAdd(&(bar)[XB_TMO], 1u); break; } } } } while (0)

struct XcdBarrier {
    unsigned* bar; unsigned x;
    volatile LAS unsigned* st;
};

__device__ __forceinline__ XcdBarrier xcd_barrier_post(unsigned* bar, volatile LAS unsigned* st) {
    XcdBarrier b; b.bar = bar; b.x = xb_xcc_id(); b.st = st;
    if (threadIdx.x == 0) (void)xb_add(&bar[XB_XCNT(b.x)], 1u);
    return b;
}
__device__ __forceinline__ void xcd_barrier_complete(unsigned* bar, unsigned x, unsigned& nloc, unsigned& nx) {
    const unsigned G = gridDim.x * gridDim.y * gridDim.z;
    unsigned sum, cnt, mine, sp = 0u;
    for (;;) {
        sum = 0u; cnt = 0u; mine = 0u;
#pragma unroll
        for (unsigned j = 0; j < 16; ++j) { const unsigned c = xb_ld(&bar[XB_XCNT(j)]); sum += c; cnt += (c > 0u) ? 1u : 0u; mine = (j == x) ? c : mine; }
        if (sum == G) break;
        __builtin_amdgcn_s_sleep(1);
        if ((++sp & 255u) == 0u) { if (xb_ld(&bar[XB_TMO])) break; if (sp > XB_SPIN_CAP) { atomicAdd(&bar[XB_TMO], 1u); break; } }
    }
    nloc = mine > 0u ? mine : 1u; nx = cnt > 0u ? cnt : 1u;
}

__device__ __forceinline__ void xcd_barrier(const XcdBarrier& b) {
    asm volatile("s_waitcnt vmcnt(0)" ::: "memory");
    __syncthreads();
    if (threadIdx.x == 0) {
        unsigned* bar = b.bar;
        __builtin_amdgcn_s_waitcnt(0);
        unsigned nloc = b.st[0], nx = b.st[1];
        if (nloc == 0u) { xcd_barrier_complete(bar, b.x, nloc, nx); b.st[0] = nloc; b.st[1] = nx; }
        const unsigned old = xb_add(&bar[XB_XSUB(b.x)], 1u);
        const unsigned gen = old / nloc;
        if (old + 1u == (gen + 1u) * nloc) {
            __builtin_amdgcn_fence(__ATOMIC_RELEASE, "agent");
            asm volatile("s_waitcnt vmcnt(0)" ::: "memory");
            const unsigned og = xb_add(&bar[XB_TOP], 1u);
            const unsigned tg = og / nx;
            if (og + 1u == (tg + 1u) * nx) xb_add(&bar[XB_TOPGEN], 1u);
            else XB_SPIN(xb_ld(&bar[XB_TOPGEN]) == tg, bar);
            __builtin_amdgcn_fence(__ATOMIC_ACQUIRE, "agent");
            xb_add(&bar[XB_XGEN(b.x)], 1u);
            asm volatile("s_waitcnt vmcnt(0)" ::: "memory");
        } else {
            XB_SPIN(xb_ld(&bar[XB_XGEN(b.x)]) == gen, bar);
            __builtin_amdgcn_fence(__ATOMIC_ACQUIRE, "agent");
            asm volatile("s_waitcnt vmcnt(0)" ::: "memory");
        }
    }
    __syncthreads();
}
struct Frame {
    LAS unsigned char* lds; volatile LAS unsigned* MISC; gu32* ctl;
    int tid, lane, wave, vcu, G;
    const float* in[N_IN]; float* out; unsigned char* ws;
};
#define WSP(T, off) ((T*)(F.ws + (off)))
typedef __attribute__((address_space(3))) float lds_f;

template <class Map>
__device__ __forceinline__ void tr_item(const float* W, int ldw, int K, bf16* WT, LAS float* scr, int item, int nblk, int lane, const Map& map, const float* kscale) {
    const int kb = item / nblk, nb = item % nblk, k0 = 64 * kb, n0 = 32 * nb;
    const int sc = map(n0 + (lane & 31));
#pragma unroll 8
    for (int i = 0; i < 32; ++i) { const int kk = 2 * i + (lane >> 5); float v = sc >= 0 ? W[(size_t)(k0 + kk) * ldw + sc] : 0.f; if (kscale) v *= kscale[k0 + kk]; scr[kk * 33 + (lane & 31)] = v; }
    LDS_WAIT(); asm volatile("" ::: "memory");
    const int c = lane & 7;
#pragma unroll
    for (int j = 0; j < 4; ++j) { const int n = (lane >> 3) + 8 * j; const LAS float* s = scr + (8 * c) * 33 + n;
        v4u o; o.x = pk2(s[0 * 33], s[1 * 33]); o.y = pk2(s[2 * 33], s[3 * 33]); o.z = pk2(s[4 * 33], s[5 * 33]); o.w = pk2(s[6 * 33], s[7 * 33]);
        *(GAS v4u*)(WT + (size_t)(n0 + n) * K + k0 + 8 * c) = o; }
    LDS_WAIT(); asm volatile("" ::: "memory");
}
struct MapId { __device__ __forceinline__ int operator()(int j) const { return j; } };
struct MapWin { __device__ __forceinline__ int operator()(int j) const { return win_map(j); } };

__device__ __forceinline__ void rms_row_to_bf16(int lane, const float* xrow, const float* g, bf16* orow) {
    const GAS f32x4* xr = (const GAS f32x4*)xrow + lane; const GAS f32x4* gr = (const GAS f32x4*)g + lane;
    f32x4 v[4]; float s = 0.f;
#pragma unroll
    for (int j = 0; j < 4; ++j) { v[j] = xr[64 * j]; s += (v[j].x * v[j].x + v[j].y * v[j].y) + (v[j].z * v[j].z + v[j].w * v[j].w); }
    const float rstd = 1.f / sqrtf(wave_sum(s) * (1.f / DM) + EPS);
    GAS unsigned long long* o8 = (GAS unsigned long long*)orow + lane;
#pragma unroll
    for (int j = 0; j < 4; ++j) { const f32x4 gg = gr[64 * j]; o8[64 * j] = (unsigned long long)pk2(v[j].x * rstd * gg.x, v[j].y * rstd * gg.y) | ((unsigned long long)pk2(v[j].z * rstd * gg.z, v[j].w * rstd * gg.w) << 32); }
}

__device__ __forceinline__ void p0_prologue(Frame& F) {
    LAS float* scr = (LAS float*)(F.lds + F.wave * 16384);
    const int gw = F.vcu * NWAVES + F.wave, NGW = F.G * NWAVES;
    constexpr int I_IN = 16 * (NIN / 32), I_BA = 8 * 32, I_BB = 8 * 32, I_O = 16 * 32, I_UP = 16 * (DFF / 32), I_DN = 64 * 32, I_C = 16 * 2;
    constexpr int NITEMS = I_IN + I_BA + I_BB + I_O + I_UP + I_DN + 4 * I_C;
    for (int it = gw; it < NITEMS; it += NGW) {
        int r = it;
        if (r < I_IN) { tr_item(F.in[I_WIN], INC, DM, WSP(bf16, WS_WINT), scr, r, NIN / 32, F.lane, MapWin{}, nullptr); continue; } r -= I_IN;
        if (r < I_BA) { tr_item(F.in[I_WBR], DM, 512, WSP(bf16, WS_WBA), scr, r, 32, F.lane, MapId{}, nullptr); continue; } r -= I_BA;
        if (r < I_BB) { tr_item(F.in[I_WBR] + (size_t)512 * DM, DM, 512, WSP(bf16, WS_WBB), scr, r, 32, F.lane, MapId{}, nullptr); continue; } r -= I_BB;
        if (r < I_O) { tr_item(F.in[I_WOUT], DM, DM, WSP(bf16, WS_WOT), scr, r, 32, F.lane, MapId{}, nullptr); continue; } r -= I_O;
        if (r < I_UP) { tr_item(F.in[I_WUP], DFF, DM, WSP(bf16, WS_WUP), scr, r, DFF / 32, F.lane, MapId{}, F.in[I_G2]); continue; } r -= I_UP;
        if (r < I_DN) { tr_item(F.in[I_WDN], DM, DFF, WSP(bf16, WS_WDN), scr, r, 32, F.lane, MapId{}, nullptr); continue; } r -= I_DN;
        { const int which = r / I_C, rr = r % I_C; const float* w1 = F.in[(which >> 1) ? I_WCV1 : I_WCK1] + (size_t)(which & 1) * 1024 * 64;
          tr_item(w1, 64, 1024, WSP(bf16, (which >> 1) ? WS_WC1V : WS_WC1K) + (size_t)(which & 1) * 64 * 1024, scr, rr, 2, F.lane, MapId{}, nullptr); }
    }
    for (int m = gw; m < MPAD; m += NGW) {
        bf16* o = WSP(bf16, WS_XN) + (size_t)m * DM;
        if (m < MP) rms_row_to_bf16(F.lane, F.in[I_XP] + (size_t)m * DM, F.in[I_G1], o);
        else if (m < MT) rms_row_to_bf16(F.lane, F.in[I_XS] + (size_t)(m - MP) * DM, F.in[I_G1], o);
        else { GAS v4u* z = (GAS v4u*)o + F.lane; z[0] = (v4u){0, 0, 0, 0}; z[64] = (v4u){0, 0, 0, 0};
               GAS v4u* za = (GAS v4u*)(WSP(bf16, WS_OA) + (size_t)m * 512) + F.lane; za[0] = (v4u){0, 0, 0, 0};
               GAS v4u* zb = (GAS v4u*)(WSP(bf16, WS_OB) + (size_t)m * 512) + F.lane; zb[0] = (v4u){0, 0, 0, 0}; }
    }
    const int gt = F.vcu * (NWAVES * 64) + F.tid, NGT = F.G * NWAVES * 64;
    for (int e = gt; e < 8196 * 8; e += NGT) {
        const int pidx = e >> 3, i = e & 7; const float pos = (float)(pidx < SEQ ? pidx : PAST + pidx - SEQ);
        const float inv = powf(500000.0f, -(float)(2 * i) / 16.0f); const float ang = pos * inv;
        WSP(float, WS_ROPE)[pidx * 16 + i] = cosf(ang); WSP(float, WS_ROPE)[pidx * 16 + 8 + i] = sinf(ang);
    }
    for (int e = gt; e < 8 * 128 * 128; e += NGT) {
        const int g = e >> 14, p = (e >> 7) & 127, r = e & 127; const float* ws = F.in[I_WS] + (size_t)g * 128 * 128;
        WSP(bf16, WS_WSP)[e] = (bf16)(r <= p ? f2bf(ws[p * 128 + r]) : 0u);
        WSP(bf16, WS_WSS)[e] = (bf16)(((p >> 2) == (r >> 2) && (r & 3) <= (p & 3)) ? f2bf(ws[(p & 3) * 128 + (r & 3)]) : 0u);
    }
    if (gt < 64) WSP(float, WS_GAINS)[gt] = F.in[I_GQ][gt]; else if (gt < 128) WSP(float, WS_GAINS)[gt] = F.in[I_GKS][gt - 64]; else if (gt < 192) WSP(float, WS_GAINS)[gt] = F.in[I_GKW][gt - 128];
    for (int it = gw; it < 64; it += NGW) { const int which = it >> 5, part = it & 31; const float* pe = F.in[which ? I_PEV : I_PEK]; const float* w1 = F.in[which ? I_WCV1 : I_WCK1];
        float s = 0.f;
#pragma unroll 16
        for (int i = 0; i < 64; ++i) { const int ii = part * 64 + i; s += pe[ii] * w1[(size_t)ii * 64 + F.lane]; }
        WSP(float, WS_BPART)[(which * 32 + part) * 64 + F.lane] = s; }
}

constexpr int CP_PITCH = 2064;
constexpr int CP_TASKS = DECB * NPAGES + 128;
__device__ __forceinline__ void compress_stage1(Frame& F) {
    const int lane = F.lane, w = F.wave, fr = lane & 15, fq = lane >> 4, tid = F.tid;
    LAS unsigned char* At = F.lds;
    for (int which = 0; which < 2; ++which) {
        const bf16* Wc = WSP(bf16, which ? WS_WC1V : WS_WC1K) + (size_t)(16 * w + fr) * 1024 + 8 * fq;
        bf16x8 wf[32];
#pragma unroll
        for (int ks = 0; ks < 32; ++ks) wf[ks] = *(const bf16x8*)(Wc + 32 * ks);
        const float* cache = F.in[which ? I_CVC : I_CKC]; const int* pt = (const int*)F.in[I_PT];
        for (int task = blockIdx.x; task < CP_TASKS; task += F.G) {
            __syncthreads();
            float* fs;
            if (task < DECB * NPAGES) {
                const int phys = pt[task]; const f32x4* src = (const f32x4*)(cache + (size_t)phys * (128 * 128));
#pragma unroll
                for (int i = 0; i < 8; ++i) { const int q = i * 512 + tid; const f32x4 v = src[q]; const int tok = q >> 5, rem = q & 31, kv = rem >> 4, d4 = rem & 15;
                    v2u o; o.x = pk2(v.x, v.y); o.y = pk2(v.z, v.w);
                    *(LAS v2u*)(At + ((tok >> 4) * 2 + kv) * CP_PITCH + ((tok & 15) * 64 + 4 * d4) * 2) = o; }
                fs = WSP(float, which ? WS_FSSV : WS_FSSK) + (size_t)task * 16 * 128;
            } else {
                const int pg = task - DECB * NPAGES; const v4u* src = (const v4u*)(WSP(bf16, which ? WS_VCA : WS_KCA) + (size_t)pg * 16 * 1024);
#pragma unroll
                for (int i = 0; i < 4; ++i) { const int q = i * 512 + tid; const v4u v = src[q]; const int row = q >> 7, c16 = q & 127;
                    *(LAS v4u*)(At + row * CP_PITCH + c16 * 16) = v; }
                fs = WSP(float, which ? WS_FSPV : WS_FSPK) + (size_t)pg * 16 * 128;
            }
            __syncthreads();
            f32x4 acc = {0.f, 0.f, 0.f, 0.f};
            const LAS unsigned char* ap = At + fr * CP_PITCH + fq * 16;
#pragma unroll
            for (int ks = 0; ks < 32; ++ks) { const bf16x8 a = *(const LAS bf16x8*)(ap + ks * 64); acc = __builtin_amdgcn_mfma_f32_16x16x32_bf16(wf[ks], a, acc, 0, 0, 0); }
            *(f32x4*)(fs + (size_t)fr * 128 + 16 * w + 4 * fq) = acc;
        }
    }
    __syncthreads();
}

__device__ __forceinline__ void compress_stage2(Frame& F) {
    const int lane = F.lane, gw = F.vcu * NWAVES + F.wave, NGW = F.G * NWAVES;
    for (int which = 0; which < 2; ++which) {
        float bias = 0.f;
#pragma unroll 8
        for (int p = 0; p < 32; ++p) bias += WSP(float, WS_BPART)[(which * 32 + p) * 64 + lane];
        float w2c[64]; const float* w2 = F.in[which ? I_WCV2 : I_WCK2];
#pragma unroll
        for (int j = 0; j < 64; ++j) w2c[j] = w2[j * 64 + lane];
        const float gk = F.in[I_GKC][lane];
        constexpr int NRS = DECB * NCS * 2, NRP = NBAT * NCP * 2;
        for (int r = gw; r < NRS + NRP; r += NGW) {
            const bool smp = r < NRS; const int rr = smp ? r : r - NRS; const int kv = rr & 1, bc = rr >> 1; const int nc = smp ? NCS : NCP; const int b = bc / nc, c = bc % nc;
            const float* fs = WSP(float, smp ? (which ? WS_FSSV : WS_FSSK) : (which ? WS_FSPV : WS_FSPK));
            bf16* dst = WSP(bf16, smp ? (which ? WS_VCS : WS_KCS) : (which ? WS_VCP : WS_KCP)) + ((size_t)(b * 2 + kv) * nc + c) * 64 + lane;
            if (c == nc - 1) { *dst = 0; continue; }
            const float h = gelu_tanh(fs[(size_t)rr * 128 + lane] + fs[(size_t)(rr + 2) * 128 + 64 + lane] + bias);
            float o = 0.f;
#pragma unroll
            for (int j = 0; j < 64; ++j) o += __builtin_bit_cast(float, __builtin_amdgcn_readlane(__builtin_bit_cast(int, h), j)) * w2c[j];
            if (which == 0) { const float ss = wave_sum(o * o); o = o * (1.f / sqrtf(ss * (1.f / 64.f) + EPS)) * gk; }
            *dst = (bf16)f2bf(o);
        }
    }
}

constexpr int VT_PITCH = 136;
__device__ __forceinline__ void gmlp_unit(Frame& F, int n) {
    const int lane = F.lane, w = F.wave, r32 = lane & 31, hi = lane >> 5;
    LAS bf16* vT = (LAS bf16*)F.lds;
    const int m0 = n * 128; const bool smp = (n == 128);
    __syncthreads();
    {
        const f32x4 g0 = *(const f32x4*)(F.in[I_LNG] + 8 * lane), g1 = *(const f32x4*)(F.in[I_LNG] + 8 * lane + 4), b0 = *(const f32x4*)(F.in[I_LNB] + 8 * lane), b1 = *(const f32x4*)(F.in[I_LNB] + 8 * lane + 4);
        for (int i = 0; i < 16; ++i) { const int r = 16 * w + i, m = m0 + r;
            const v4u raw = *(const v4u*)(WSP(bf16, WS_GV) + (size_t)m * 512 + 8 * lane);
            float x[8] = {bflo(raw.x), bfhi(raw.x), bflo(raw.y), bfhi(raw.y), bflo(raw.z), bfhi(raw.z), bflo(raw.w), bfhi(raw.w)};
            float s = 0.f;
#pragma unroll
            for (int k = 0; k < 8; ++k) s += x[k];
            const float mean = wave_sum(s) * (1.f / 512.f); float s2 = 0.f;
#pragma unroll
            for (int k = 0; k < 8; ++k) { x[k] -= mean; s2 += x[k] * x[k]; }
            const float rstd = 1.f / sqrtf(wave_sum(s2) * (1.f / 512.f) + EPS);
            f32x4 y0 = {x[0] * rstd * g0.x + b0.x, x[1] * rstd * g0.y + b0.y, x[2] * rstd * g0.z + b0.z, x[3] * rstd * g0.w + b0.w};
            f32x4 y1 = {x[4] * rstd * g1.x + b1.x, x[5] * rstd * g1.y + b1.y, x[6] * rstd * g1.z + b1.z, x[7] * rstd * g1.w + b1.w};
            float* so = nullptr;
            if (smp) so = F.out + O_SVA + (size_t)r * 512; else if ((n & 63) == 63) so = F.out + O_PVA + ((size_t)(n >> 6) * 128 + r) * 512;
            if (so) { *(f32x4*)(so + 8 * lane) = y0; *(f32x4*)(so + 8 * lane + 4) = y1; }
#pragma unroll
            for (int k = 0; k < 4; ++k) { vT[(8 * lane + k) * VT_PITCH + r] = (bf16)f2bf(y0[k]); vT[(8 * lane + 4 + k) * VT_PITCH + r] = (bf16)f2bf(y1[k]); }
        }
    }
    __syncthreads();
    {
        const int g = w; const bf16* Wg = WSP(bf16, smp ? WS_WSS : WS_WSP) + (size_t)g * 128 * 128; const float* bs = F.in[I_BS] + g * 128;
        for (int ib = 0; ib < 4; ++ib) {
            f32x16 acc0 = {}, acc1 = {};
            for (int kb = 0; kb <= 2 * ib + 1; ++kb) {
                const bf16x8 a = *(const bf16x8*)(Wg + (size_t)(32 * ib + r32) * 128 + 16 * kb + 8 * hi);
                const bf16x8 b0 = *(const LAS bf16x8*)(vT + (64 * g + r32) * VT_PITCH + 16 * kb + 8 * hi);
                const bf16x8 b1 = *(const LAS bf16x8*)(vT + (64 * g + 32 + r32) * VT_PITCH + 16 * kb + 8 * hi);
                acc0 = __builtin_amdgcn_mfma_f32_32x32x16_bf16(a, b0, acc0, 0, 0, 0); acc1 = __builtin_amdgcn_mfma_f32_32x32x16_bf16(a, b1, acc1, 0, 0, 0);
            }
#pragma unroll
            for (int r = 0; r < 16; ++r) { const int p = 32 * ib + (r & 3) + 8 * (r >> 2) + 4 * hi; const size_t m = (size_t)(m0 + p);
                const float bias = bs[smp ? (p & 3) : p];
                const int c0 = 64 * g + r32, c1 = c0 + 32;
                const float u0 = bf2f(WSP(bf16, WS_U)[m * 512 + c0]), u1 = bf2f(WSP(bf16, WS_U)[m * 512 + c1]);
                WSP(bf16, WS_OA)[m * 512 + c0] = (bf16)f2bf(u0 * (acc0[r] + bias)); WSP(bf16, WS_OA)[m * 512 + c1] = (bf16)f2bf(u1 * (acc1[r] + bias)); }
        }
    }
}

namespace att {
using s16x4 = __attribute__((ext_vector_type(4))) short;
using u32x4 = __attribute__((ext_vector_type(4))) unsigned;
constexpr int NW = 8, KVBLK = 64;
constexpr int NSLOT = 3, SLOTB = 8192;
constexpr int LDS_K = 0, LDS_V = NSLOT * SLOTB, LDS_WS = 2 * NSLOT * SLOTB, LDS_Q = LDS_WS + NW * 64 * 4, LDS_SELB = LDS_Q + NW * 4096, LDS_END = LDS_SELB + NW * 8 * 16;
constexpr int BLKS_PITCH = 132;
static_assert(NW * 8 * BLKS_PITCH * 4 <= LDS_WS, "block scores fit the ring region");
#define SBAR() __builtin_amdgcn_sched_barrier(0)
__device__ __forceinline__ int crow(int r, int hi) { return (r & 3) + 8 * (r >> 2) + 4 * hi; }
__device__ __forceinline__ void glds16(const void* gsrc, unsigned lds_dst) { unsigned keep;
  asm volatile("s_mov_b32 %0, m0\n\ts_mov_b32 m0, %2\n\ts_nop 0\n\tglobal_load_lds_dwordx4 %1, off\n\ts_mov_b32 m0, %0" : "=&s"(keep) : "v"(gsrc), "s"(lds_dst) : "memory"); }
__device__ __forceinline__ float max3f(float a, float b, float c) { float r; asm("v_max3_f32 %0, %1, %2, %3" : "=v"(r) : "v"(a), "v"(b), "v"(c)); return r; }
__device__ __forceinline__ float max2f(float a, float b) { float r; asm("v_max_f32_e32 %0, %1, %2" : "=v"(r) : "v"(a), "v"(b)); return r; }
__device__ __forceinline__ float fadd_s(float a, float b) { float r; asm("v_add_f32_e32 %0, %1, %2" : "=v"(r) : "v"(a), "v"(b)); return r; }
__device__ __forceinline__ float fsub_s(float a, float b) { float r; asm("v_sub_f32_e32 %0, %1, %2" : "=v"(r) : "v"(a), "v"(b)); return r; }
typedef float f32x2_t __attribute__((ext_vector_type(2))); typedef __bf16 bf16x2_t __attribute__((ext_vector_type(2)));
__device__ __forceinline__ unsigned cvtpk_s(float lo, float hi) { f32x2_t v = {lo, hi}; bf16x2_t b = __builtin_convertvector(v, bf16x2_t); return __builtin_bit_cast(unsigned, b); }
#define WAIT_BAR(N) asm volatile("s_waitcnt vmcnt(" #N ") lgkmcnt(0)\n\ts_barrier" ::: "memory")

typedef __attribute__((address_space(3))) const char* lds_cptr;
__device__ __forceinline__ void qkt(f32x16& p0, f32x16& p1, const char* Kslot, lds_cptr qp, int r32, int hi) { const f32x16 negm = f32x16{}; bf16x8 qr[4];
  _Pragma("unroll") for (int d0 = 0; d0 < 4; ++d0) qr[d0] = *(const __attribute__((address_space(3))) bf16x8*)(qp + d0 * 1024);
  const char* kb = Kslot + hi * 1024 + r32 * 16;
#pragma unroll
  for (int d0 = 0; d0 < 4; ++d0) {
    const bf16x8 b0 = *reinterpret_cast<const bf16x8*>(kb + d0 * 2048);
    const bf16x8 b1 = *reinterpret_cast<const bf16x8*>(kb + d0 * 2048 + 512);
    if (d0 == 0) { p0 = __builtin_amdgcn_mfma_f32_32x32x16_bf16(b0, qr[0], negm, 0, 0, 0); p1 = __builtin_amdgcn_mfma_f32_32x32x16_bf16(b1, qr[0], negm, 0, 0, 0); }
    else { p0 = __builtin_amdgcn_mfma_f32_32x32x16_bf16(b0, qr[d0], p0, 0, 0, 0); p1 = __builtin_amdgcn_mfma_f32_32x32x16_bf16(b1, qr[d0], p1, 0, 0, 0); } }
}
typedef short v4i16_t __attribute__((ext_vector_type(4)));
__device__ __forceinline__ void kload8(bf16x8* kf, lds_cptr kp) {
  kf[0] = *(const __attribute__((address_space(3))) bf16x8*)(kp);        kf[1] = *(const __attribute__((address_space(3))) bf16x8*)(kp + 512);
  kf[2] = *(const __attribute__((address_space(3))) bf16x8*)(kp + 2048); kf[3] = *(const __attribute__((address_space(3))) bf16x8*)(kp + 2560);
  kf[4] = *(const __attribute__((address_space(3))) bf16x8*)(kp + 4096); kf[5] = *(const __attribute__((address_space(3))) bf16x8*)(kp + 4608);
  kf[6] = *(const __attribute__((address_space(3))) bf16x8*)(kp + 6144); kf[7] = *(const __attribute__((address_space(3))) bf16x8*)(kp + 6656);
}
__device__ __forceinline__ void kload2(bf16x8* kf, lds_cptr kp, int j) { kf[2 * j] = *(const __attribute__((address_space(3))) bf16x8*)(kp + j * 2048); kf[2 * j + 1] = *(const __attribute__((address_space(3))) bf16x8*)(kp + j * 2048 + 512); }
__device__ __forceinline__ s16x4 vtr(lds_cptr p) { return __builtin_bit_cast(s16x4, __builtin_amdgcn_ds_read_tr16_b64_v4i16((__attribute__((address_space(3))) v4i16_t*)p)); }
__device__ __forceinline__ float rowmax(const f32x16& p0, const f32x16& p1) {
  float a = max3f(p0[0], p0[1], p1[0]), b = max3f(p0[2], p0[3], p1[1]); a = max3f(a, p1[2], p1[3]);
#pragma unroll
  for (int r = 4; r < 16; r += 4) { a = max3f(a, p0[r], p0[r + 1]); b = max3f(b, p0[r + 2], p0[r + 3]); a = max3f(a, p1[r], p1[r + 1]); b = max3f(b, p1[r + 2], p1[r + 3]); }
  const float m = max2f(a, b);
  auto rr = __builtin_amdgcn_permlane32_swap(__float_as_uint(m), __float_as_uint(m), false, false);
  return max2f(__uint_as_float(rr[0]), __uint_as_float(rr[1]));
}
__device__ __forceinline__ void pv(f32x16* o, int vb, bf16x8 pa0, bf16x8 pa1, bf16x8 pa2, bf16x8 pa3) {
#pragma unroll
  for (int d0 = 0; d0 < 2; ++d0) { s16x4 lo[4], hi[4];
#pragma unroll
    for (int ks = 0; ks < 4; ++ks) {
      asm volatile("ds_read_b64_tr_b16 %0,%1 offset:%c2" : "=&v"(lo[ks]) : "v"(vb), "i"(d0 * 4096 + ks * 1024) : "memory");
      asm volatile("ds_read_b64_tr_b16 %0,%1 offset:%c2" : "=&v"(hi[ks]) : "v"(vb), "i"(d0 * 4096 + ks * 1024 + 512) : "memory"); }
    asm volatile("s_waitcnt lgkmcnt(0)" ::: "memory"); SBAR();
#define PK(k) (bf16x8){lo[k][0], lo[k][1], lo[k][2], lo[k][3], hi[k][0], hi[k][1], hi[k][2], hi[k][3]}
    o[d0] = __builtin_amdgcn_mfma_f32_32x32x16_bf16(pa0, PK(0), o[d0], 0, 0, 0);
    o[d0] = __builtin_amdgcn_mfma_f32_32x32x16_bf16(pa1, PK(1), o[d0], 0, 0, 0);
    o[d0] = __builtin_amdgcn_mfma_f32_32x32x16_bf16(pa2, PK(2), o[d0], 0, 0, 0);
    o[d0] = __builtin_amdgcn_mfma_f32_32x32x16_bf16(pa3, PK(3), o[d0], 0, 0, 0);
#undef PK
  }
}
template <int MODE> __device__ __forceinline__ void amask(f32x16& p0, f32x16& p1, int tabs, int blk, int hi, int mlo, int mspan1, const unsigned selword, const float mh) {
  const float NEG = -1e30f;
  const int kb = 64 * tabs + 4 * hi;
  int hiB;
  if (MODE == 1) {
    const bool en = (selword >> (tabs & 31)) & 1u;
    if (tabs < blk) {
#pragma unroll
      for (int r = 0; r < 16; ++r) { p0[r] = en ? p0[r] - mh : NEG; p1[r] = en ? p1[r] - mh : NEG; }
      return; }
    hiB = en ? mspan1 - kb : 0;
  } else if (MODE == 0) hiB = mspan1 - kb;
  else {
    if (tabs < blk) {
      if (tabs + 8 <= blk) { const int loB = mlo - kb;
#pragma unroll
        for (int r = 0; r < 16; ++r) { const int c = (r & 3) + 8 * (r >> 2); p0[r] = (loB <= c) ? p0[r] - mh : NEG; p1[r] = (loB <= c + 32) ? p1[r] - mh : NEG; }
      } else {
#pragma unroll
        for (int r = 0; r < 16; ++r) { p0[r] -= mh; p1[r] -= mh; }
      }
      return; }
    hiB = mlo + mspan1 - kb;
  }
#pragma unroll
  for (int r = 0; r < 16; ++r) { const int c = (r & 3) + 8 * (r >> 2); p0[r] = (hiB > c) ? p0[r] - mh : NEG; p1[r] = (hiB > c + 32) ? p1[r] - mh : NEG; }
}

template <int MODE, int THRL>
__device__ __forceinline__ void attn_unit(const bf16* Qlane, const bf16* __restrict__ Kt, const bf16* __restrict__ Vt, const int t0abs, const int NT, const int blk,
                                          const int pos, const float* gatep, float* obf, bf16* ob, char* shm, float& mhat_o, float& rl_o) {
  constexpr int KP = (MODE == 0) ? 64 : 128;
  const int tid = threadIdx.x, lane = tid & 63, r32 = lane & 31, hi = lane >> 5; const int wid = __builtin_amdgcn_readfirstlane(tid >> 6);
  const unsigned lds0 = (unsigned)(uintptr_t)shm;
  float* wsf = (float*)(shm + LDS_WS) + wid * 64;
  const bf16* ksrc = Kt + (long)lane * KP + wid * 8;
  const bf16* vsrc = Vt + (long)(16 * (wid & 3) + (lane >> 2)) * KP + (wid >> 2) * 32 + (lane & 3) * 8;
  const unsigned kdst = lds0 + LDS_K + wid * 1024, vdst = lds0 + LDS_V + wid * 1024;
#define DMA_K(t, slot) glds16(ksrc + (long)(t) * KVBLK * KP, (unsigned)__builtin_amdgcn_readfirstlane(kdst + (slot)))
#define DMA_V(t, slot) glds16(vsrc + (long)(t) * KVBLK * KP, (unsigned)__builtin_amdgcn_readfirstlane(vdst + (slot)))
  const int vb0 = (int)(lds0 + LDS_V) + ((lane >> 4) & 1) * 32 + (lane & 3) * 8 + (4 * hi + ((lane & 15) >> 2)) * 64;
  const char* Kbase = shm + LDS_K; bf16x8 kf[8];
  const lds_cptr shm3 = (lds_cptr)shm; const lds_cptr kp0 = shm3 + LDS_K + hi * 1024 + r32 * 16; const lds_cptr vp0 = shm3 + LDS_V + ((lane >> 4) & 1) * 32 + (lane & 3) * 8 + (4 * hi + ((lane & 15) >> 2)) * 64;
  const lds_cptr qp = shm3 + LDS_Q + wid * 4096 + lane * 16;
  const lds_cptr selp = shm3 + LDS_SELB + wid * 128 + (r32 >> 2) * 16;
#define QF(j) (*(const __attribute__((address_space(3))) bf16x8*)(qp + (j) * 1024))
  DMA_K(0, 0); DMA_V(0, 0); DMA_K(1, SLOTB);
#pragma unroll
  for (int d0 = 0; d0 < 4; ++d0) *(__attribute__((address_space(3))) bf16x8*)((__attribute__((address_space(3))) char*)qp + d0 * 1024) = *reinterpret_cast<const bf16x8*>(&Qlane[d0 * 16 + hi * 8]);
  float mhat = 0.f, l_reg = 0.f; f32x16 o[2]; o[0] = f32x16{}; o[1] = f32x16{}; const f32x16 zero16 = f32x16{};
  const int mlo = (MODE == 2) ? pos - (WIN - 1) : 0;
  const int mspan1 = (MODE == 0) ? (((pos - 31) >> 4) + 1 > 0 ? ((pos - 31) >> 4) + 1 : 0) : (MODE == 1 ? pos + 1 : WIN);
#define SELW(t) (MODE == 1 ? *(const __attribute__((address_space(3))) unsigned*)(selp + (((t0abs + (t)) >> 5) << 2)) : 0u)
#define CMASK(P0, P1, t, SW) amask<MODE>(P0, P1, t0abs + (t), blk, hi, mlo, mspan1, SW, mhat)
  bool resc = false;
#define START(P0, P1) do { const float rm = max2f(rowmax(P0, P1), -500.f); resc = false; \
    { const float dl = rm; mhat = fadd_s(mhat, dl); \
      _Pragma("unroll") for (int r = 0; r < 16; ++r) { P0[r] = fsub_s(P0[r], dl); P1[r] = fsub_s(P1[r], dl); } } \
    _Pragma("unroll") for (int r = 0; r < 16; ++r) P0[r] = __builtin_amdgcn_exp2f(P0[r]); } while (0)
#define RESC() do { if (resc) { asm volatile("s_waitcnt lgkmcnt(0)" ::: "memory"); \
      _Pragma("unroll") for (int d_ = 0; d_ < 2; ++d_) _Pragma("unroll") for (int r = 0; r < 16; ++r) o[d_][r] *= wsf[crow(r, hi)]; } } while (0)
  f32x16 pA0, pA1, pB0, pB1;
  int sl_prev = 0, sl_cur = 0, sl_next = SLOTB;
#define ROT() do { sl_prev = sl_cur; sl_cur = sl_next; sl_next = (sl_next == (NSLOT - 1) * SLOTB) ? 0 : sl_next + SLOTB; } while (0)
  DMA_K(2, 2 * SLOTB);
  WAIT_BAR(3);
  { const unsigned sw0 = SELW(0); qkt(pA0, pA1, Kbase, qp, r32, hi); asm volatile("s_nop 15\n\ts_nop 7" : "+v"(pA0), "+v"(pA1)); CMASK(pA0, pA1, 0, sw0); }
  START(pA0, pA1);
  _Pragma("unroll") for (int r = 0; r < 16; ++r) pA1[r] = __builtin_amdgcn_exp2f(pA1[r]);
  WAIT_BAR(0);
  DMA_K(3, 0); DMA_V(1, SLOTB);
  ROT();
  kload8(kf, kp0 + sl_cur);
  WAIT_BAR(2);
  s16x4 vlo[8], vhi[8]; u32x4 pw0, pw1, pw2, pw3;
#define PKW(P, B) cvtpk_s(P[B], P[B + 1])
#define PAF(k) __builtin_bit_cast(bf16x8, pw##k)
#define VFR(i) (bf16x8){vlo[i][0], vlo[i][1], vlo[i][2], vlo[i][3], vhi[i][0], vhi[i][1], vhi[i][2], vhi[i][3]}
#define PIN(x) asm volatile("" : "+v"(x))
#define MX3(a, b, c) __builtin_fmaxf(__builtin_fmaxf((a), (b)), (c))
#define GAPA(MF, A0, A1, A2, A3, W0, W1, PW) do { MF; sacc += A0; sacc += A1; sacc += A2; sacc += A3; PIN(sacc); W0; W1; PIN(PW); SBAR(); } while (0)
#define EX(v) __builtin_amdgcn_exp2f(v)
#define GAPB(MF, X, B) do { MF; X[B] = EX(X[B]); X[B + 1] = EX(X[B + 1]); X[B + 2] = EX(X[B + 2]); X[B + 3] = EX(X[B + 3]); PIN(X); SBAR(); } while (0)
#define VRD(i) do { vlo[i] = vtr(vp_ + (((i) >> 2) * 4096 + ((i) & 3) * 1024)); vhi[i] = vtr(vp_ + (((i) >> 2) * 4096 + ((i) & 3) * 1024 + 512)); } while (0)
#define KRD(G, j) do { if (G) { kload2(kf, kp0 + sl_next, j); SBAR(); } } while (0)
#define STEP(C0, C1, P0, P1, t, GK, GV, GL) do { SBAR(); \
    const lds_cptr vp_ = vp0 + sl_prev; const unsigned sw_ = SELW(t); \
    bf16x8 qa_ = QF(0); \
    VRD(0); SBAR(); float sacc = (P0[0] + P0[1]); \
    GAPA(C0 = __builtin_amdgcn_mfma_f32_32x32x16_bf16(kf[0], qa_, zero16, 0, 0, 0), P0[2], P0[3], P0[4], P0[5],     pw0[0] = PKW(P0, 0), pw0[1] = PKW(P0, 2), pw0); \
    VRD(4); SBAR(); GAPA(C1 = __builtin_amdgcn_mfma_f32_32x32x16_bf16(kf[1], qa_, zero16, 0, 0, 0), P0[6], P0[7], P0[8], P0[9],     pw0[2] = PKW(P0, 4), pw0[3] = PKW(P0, 6), pw0); \
    qa_ = QF(1); \
    VRD(1); SBAR(); GAPA(C0 = __builtin_amdgcn_mfma_f32_32x32x16_bf16(kf[2], qa_, C0, 0, 0, 0),   P0[10], P0[11], P0[12], P0[13], pw1[0] = PKW(P0, 8), pw1[1] = PKW(P0, 10), pw1); \
    VRD(5); SBAR(); GAPA(C1 = __builtin_amdgcn_mfma_f32_32x32x16_bf16(kf[3], qa_, C1, 0, 0, 0),   P0[14], P0[15], P1[0], P1[1],   pw1[2] = PKW(P0, 12), pw1[3] = PKW(P0, 14), pw1); \
    qa_ = QF(2); \
    VRD(2); SBAR(); GAPA(C0 = __builtin_amdgcn_mfma_f32_32x32x16_bf16(kf[4], qa_, C0, 0, 0, 0),   P1[2], P1[3], P1[4], P1[5],     pw2[0] = PKW(P1, 0), pw2[1] = PKW(P1, 2), pw2); \
    VRD(6); SBAR(); GAPA(C1 = __builtin_amdgcn_mfma_f32_32x32x16_bf16(kf[5], qa_, C1, 0, 0, 0),   P1[6], P1[7], P1[8], P1[9],     pw2[2] = PKW(P1, 4), pw2[3] = PKW(P1, 6), pw2); \
    qa_ = QF(3); \
    VRD(3); SBAR(); GAPA(C0 = __builtin_amdgcn_mfma_f32_32x32x16_bf16(kf[6], qa_, C0, 0, 0, 0),   P1[10], P1[11], P1[12], P1[13], pw3[0] = PKW(P1, 8), pw3[1] = PKW(P1, 10), pw3); \
    VRD(7); SBAR(); GAPA(C1 = __builtin_amdgcn_mfma_f32_32x32x16_bf16(kf[7], qa_, C1, 0, 0, 0),   P1[14], P1[15], 0.f, 0.f,       pw3[2] = PKW(P1, 12), pw3[3] = PKW(P1, 14), pw3); \
    l_reg += sacc; \
    if (GK) { DMA_K((t) + 3, sl_cur); } if (GV) { DMA_V((t) + 1, sl_next); } \
    CMASK(C0, C1, t, sw_); \
    { float a = MX3(C0[0], C0[1], C1[0]), b = MX3(C0[2], C0[3], C1[1]); a = MX3(a, C1[2], C1[3]); \
      _Pragma("unroll") for (int r = 4; r < 16; r += 4) { a = MX3(a, C0[r], C0[r + 1]); b = MX3(b, C0[r + 2], C0[r + 3]); a = MX3(a, C1[r], C1[r + 1]); b = MX3(b, C1[r + 2], C1[r + 3]); } \
      float rm = __builtin_fmaxf(a, b); { auto rr = __builtin_amdgcn_permlane32_swap(__float_as_uint(rm), __float_as_uint(rm), false, false); rm = __builtin_fmaxf(__uint_as_float(rr[0]), __uint_as_float(rr[1])); } \
      resc = false; \
      if (__builtin_expect(__any(rm > (float)THRL), 0)) { const float dl = __builtin_fmaxf(rm, 0.f); mhat += dl; \
        _Pragma("unroll") for (int r = 0; r < 16; ++r) { C0[r] -= dl; C1[r] -= dl; } \
        const float f = __builtin_amdgcn_exp2f(-dl); l_reg *= f; if (hi == 0) wsf[r32] = f; resc = true; } } \
    SBAR(); \
    GAPB(o[0] = __builtin_amdgcn_mfma_f32_32x32x16_bf16(PAF(0), VFR(0), o[0], 0, 0, 0), C0, 0); \
    GAPB(o[1] = __builtin_amdgcn_mfma_f32_32x32x16_bf16(PAF(0), VFR(4), o[1], 0, 0, 0), C0, 4); \
    KRD(GL, 0); GAPB(o[0] = __builtin_amdgcn_mfma_f32_32x32x16_bf16(PAF(1), VFR(1), o[0], 0, 0, 0), C0, 8); \
    KRD(GL, 1); GAPB(o[1] = __builtin_amdgcn_mfma_f32_32x32x16_bf16(PAF(1), VFR(5), o[1], 0, 0, 0), C0, 12); \
    KRD(GL, 2); GAPB(o[0] = __builtin_amdgcn_mfma_f32_32x32x16_bf16(PAF(2), VFR(2), o[0], 0, 0, 0), C1, 0); \
    KRD(GL, 3); GAPB(o[1] = __builtin_amdgcn_mfma_f32_32x32x16_bf16(PAF(2), VFR(6), o[1], 0, 0, 0), C1, 4); \
    GAPB(o[0] = __builtin_amdgcn_mfma_f32_32x32x16_bf16(PAF(3), VFR(3), o[0], 0, 0, 0), C1, 8); \
    GAPB(o[1] = __builtin_amdgcn_mfma_f32_32x32x16_bf16(PAF(3), VFR(7), o[1], 0, 0, 0), C1, 12); \
    } while (0)
  int t = 1;
  for (; t + 5 < NT; t += 2) {
    STEP(pB0, pB1, pA0, pA1, t, true, true, true);     WAIT_BAR(2); RESC(); ROT();
    STEP(pA0, pA1, pB0, pB1, t + 1, true, true, true); WAIT_BAR(2); RESC(); ROT();
  }
#define ENDW(tt) do { if ((tt) + 3 < NT) { WAIT_BAR(2); } else if ((tt) + 2 < NT) { WAIT_BAR(1); } else { WAIT_BAR(0); } } while (0)
  for (; t + 1 < NT; t += 2) {
    STEP(pB0, pB1, pA0, pA1, t, (t + 3 < NT), (t + 1 < NT), (t + 1 < NT));         ENDW(t);     RESC(); ROT();
    STEP(pA0, pA1, pB0, pB1, t + 1, (t + 4 < NT), (t + 2 < NT), (t + 2 < NT));     ENDW(t + 1); RESC(); ROT();
  }
  STEP(pB0, pB1, pA0, pA1, NT - 1, false, false, false); RESC();
  { float sacc = pB0[0] + pB0[1]; _Pragma("unroll") for (int r = 2; r < 16; ++r) sacc += pB0[r]; _Pragma("unroll") for (int r = 0; r < 16; ++r) sacc += pB1[r]; l_reg += sacc;
    pw0 = (u32x4){PKW(pB0, 0), PKW(pB0, 2), PKW(pB0, 4), PKW(pB0, 6)}; pw1 = (u32x4){PKW(pB0, 8), PKW(pB0, 10), PKW(pB0, 12), PKW(pB0, 14)}; pw2 = (u32x4){PKW(pB1, 0), PKW(pB1, 2), PKW(pB1, 4), PKW(pB1, 6)}; pw3 = (u32x4){PKW(pB1, 8), PKW(pB1, 10), PKW(pB1, 12), PKW(pB1, 14)};
    SBAR(); pv(o, vb0 + sl_cur, PAF(0), PAF(1), PAF(2), PAF(3)); }
#undef PKW
#undef PAF
#undef VFR
#undef PIN
#undef MX3
#undef GAPA
#undef GAPB
#undef EX
#undef VRD
#undef KRD
#undef STEP
#undef ENDW
  { auto rr = __builtin_amdgcn_permlane32_swap(__float_as_uint(l_reg), __float_as_uint(l_reg), false, false); l_reg = __uint_as_float(rr[0]) + __uint_as_float(rr[1]); }
  const float rl = l_reg > 0.f ? __builtin_amdgcn_rcpf(l_reg) : 0.f;
  mhat_o = mhat; rl_o = rl;
  if (hi == 0) wsf[32 + r32] = rl * (*gatep); asm volatile("s_waitcnt lgkmcnt(0)" ::: "memory");
#pragma unroll
  for (int r = 0; r < 16; ++r) { const float sc = wsf[32 + crow(r, hi)];
#pragma unroll
    for (int d0 = 0; d0 < 2; ++d0) { const int off = (2 * (r >> 2)) * 512 + (r & 3) * 64 + 32 * d0; float v = o[d0][r] * sc;
      if (MODE != 0) v += obf[off];
      if (MODE == 2) ob[off] = (bf16)f2bf(v); else obf[off] = v; } }
  asm volatile("s_waitcnt lgkmcnt(0)\n\ts_barrier" ::: "memory");
#undef DMA_K
#undef DMA_V
#undef CMASK
#undef SELW
#undef QF
#undef START
#undef RESC
#undef ROT
}

__device__ __forceinline__ int dppx1(int v) { return __builtin_amdgcn_mov_dpp(v, 0xB1, 0xF, 0xF, true); }
__device__ __forceinline__ int dppx2(int v) { return __builtin_amdgcn_mov_dpp(v, 0x4E, 0xF, 0xF, true); }
__device__ __forceinline__ float quad_sum(float v) { v += __builtin_bit_cast(float, dppx1(__builtin_bit_cast(int, v))); v += __builtin_bit_cast(float, dppx2(__builtin_bit_cast(int, v))); return v; }

__device__ __forceinline__ void nsa_prompt_unit(const unsigned char* ws, int b, int kv, int blk, char* shm) {
  float mhat = 0.f, rl = 0.f, dm0, dm1;
#define LANE_SETUP() const int lane = threadIdx.x & 63, r32 = lane & 31, hi = lane >> 5; const int wid = __builtin_amdgcn_readfirstlane(threadIdx.x >> 6); \
    const int tl = r32 >> 2, hl = r32 & 3, pos = 64 * blk + 8 * wid + tl; const size_t m = (size_t)b * SEQ + pos; const int head = 4 * kv + hl; (void)hi; (void)head; (void)m; (void)tl; (void)hl; \
    const size_t obo = ((size_t)b * SEQ + 64 * blk + 8 * wid + hi) * 512 + (4 * kv) * 64 + r32; (void)obo
  const int ntc_real = blk / 16 + 1;
  { LANE_SETUP(); const int NTc = ntc_real < 4 ? 4 : ((ntc_real + 1) & ~1);
    const bf16* kc = (const bf16*)(ws + WS_KCP) + (size_t)(b * 2 + kv) * NCP * 64; const bf16* vc = (const bf16*)(ws + WS_VCP) + (size_t)(b * 2 + kv) * NCP * 64;
#ifndef NO_M0
    attn_unit<0, 8>((const bf16*)(ws + WS_QN) + m * 512 + head * 64, kc, vc, 0, NTc, blk, pos, (const float*)(ws + WS_NG) + m * 32 + head * 3 + 0, (float*)(ws + WS_OBF) + obo, (bf16*)(ws + WS_OB) + obo, shm, mhat, rl);
#endif
 }
  {
    LANE_SETUP();
    LAS float* bsw = (LAS float*)(shm + LDS_K) + wid * 8 * BLKS_PITCH;
    for (int i = lane; i < 8 * BLKS_PITCH; i += 64) bsw[i] = 0.f;
    asm volatile("s_waitcnt lgkmcnt(0)" ::: "memory");
    const int cthr = (pos - 31) >> 4; const int cspan = cthr + 1 > 0 ? cthr + 1 : 0;
    const bf16* kc = (const bf16*)(ws + WS_KCP) + (size_t)(b * 2 + kv) * NCP * 64; const bf16* qn = (const bf16*)(ws + WS_QN) + m * 512 + head * 64;
    bf16x8 qf[4];
#pragma unroll
    for (int d0 = 0; d0 < 4; ++d0) qf[d0] = *reinterpret_cast<const bf16x8*>(&qn[d0 * 16 + hi * 8]);
    const f32x16 zero16 = f32x16{};
    for (int t = 0; t < ntc_real; ++t) {
      f32x16 p0, p1; const bf16* kr = kc + (size_t)(64 * t + r32) * 64 + hi * 8;
#pragma unroll
      for (int d0 = 0; d0 < 4; ++d0) { const bf16x8 b0 = *reinterpret_cast<const bf16x8*>(kr + d0 * 16); const bf16x8 b1 = *reinterpret_cast<const bf16x8*>(kr + 32 * 64 + d0 * 16);
        if (d0 == 0) { p0 = __builtin_amdgcn_mfma_f32_32x32x16_bf16(b0, qf[0], zero16, 0, 0, 0); p1 = __builtin_amdgcn_mfma_f32_32x32x16_bf16(b1, qf[0], zero16, 0, 0, 0); }
        else { p0 = __builtin_amdgcn_mfma_f32_32x32x16_bf16(b0, qf[d0], p0, 0, 0, 0); p1 = __builtin_amdgcn_mfma_f32_32x32x16_bf16(b1, qf[d0], p1, 0, 0, 0); } }
      const int base = 64 * t + 4 * hi;
#pragma unroll
      for (int r = 0; r < 16; ++r) { const int c0 = base + (r & 3) + 8 * (r >> 2); p0[r] = (c0 < cspan) ? __builtin_amdgcn_exp2f(p0[r] - mhat) * rl : 0.f; p1[r] = (c0 + 32 < cspan) ? __builtin_amdgcn_exp2f(p1[r] - mhat) * rl : 0.f; }
#pragma unroll
      for (int ph = 0; ph < 2; ++ph)
#pragma unroll
        for (int g = 0; g < 4; ++g) { const float a0 = ph ? p1[4 * g] : p0[4 * g], a1 = ph ? p1[4 * g + 1] : p0[4 * g + 1], a2 = ph ? p1[4 * g + 2] : p0[4 * g + 2], a3 = ph ? p1[4 * g + 3] : p0[4 * g + 3];
          const float A = quad_sum(2.f * (a0 + a1 + a2) + a3), B = quad_sum(a3);
          const int j = 16 * t + 8 * ph + 2 * g + hi;
          if (hl == 0) { __hip_atomic_fetch_add(bsw + tl * BLKS_PITCH + j, A, __ATOMIC_RELAXED, __HIP_MEMORY_SCOPE_WORKGROUP); __hip_atomic_fetch_add(bsw + tl * BLKS_PITCH + j + 1, B, __ATOMIC_RELAXED, __HIP_MEMORY_SCOPE_WORKGROUP); } }
    }
    asm volatile("s_waitcnt lgkmcnt(0)" ::: "memory");
    LAS unsigned* selb = (LAS unsigned*)(shm + LDS_SELB) + wid * 32;
    const int cur = blk, nf = cur >= 2 ? 3 : cur + 1, need = 16 - nf;
    for (int tk = 0; tk < 8; ++tk) {
      const LAS float* bs = bsw + tk * BLKS_PITCH;
      const int j0 = lane, j1 = lane + 64; const float s0 = bs[j0], s1 = bs[j1];
      int c0 = 0, c1 = 0;
      for (int i = 1; i <= cur - 2; ++i) { const float si = bs[i]; c0 += (si > s0 || (si == s0 && i < j0)) ? 1 : 0; c1 += (si > s1 || (si == s1 && i < j1)) ? 1 : 0; }
      const bool f0 = (j0 == 0 || j0 == cur || j0 == cur - 1), f1 = (j1 == cur || j1 == cur - 1);
      const bool sel0 = f0 || (j0 >= 1 && j0 <= cur - 2 && c0 < need), sel1 = f1 || (j1 <= cur - 2 && c1 < need);
      const unsigned long long m0 = __ballot(sel0), m1 = __ballot(sel1);
      if (lane == 0) { selb[tk * 4 + 0] = (unsigned)m0; selb[tk * 4 + 1] = (unsigned)(m0 >> 32); selb[tk * 4 + 2] = (unsigned)m1; selb[tk * 4 + 3] = (unsigned)(m1 >> 32); }
    }
    asm volatile("s_waitcnt lgkmcnt(0)\n\ts_barrier" ::: "memory");
  }
  { LANE_SETUP(); const int nt_real = blk + 1; const int NTs = nt_real < 4 ? 4 : ((nt_real + 1) & ~1);
    const bf16* ks = (const bf16*)(ws + WS_KS) + (size_t)b * SEQ * 128 + kv * 64; const bf16* vs = (const bf16*)(ws + WS_VS) + (size_t)b * SEQ * 128 + kv * 64;
#ifndef NO_M1
    attn_unit<1, 8>((const bf16*)(ws + WS_QR) + m * 512 + head * 64, ks, vs, 0, NTs, blk, pos, (const float*)(ws + WS_NG) + m * 32 + head * 3 + 1, (float*)(ws + WS_OBF) + obo, (bf16*)(ws + WS_OB) + obo, shm, dm0, dm1);
#endif
 }
  { LANE_SETUP(); int t0, NTw; if (blk >= 9) { t0 = blk - 9; NTw = 10; } else { t0 = 0; const int nt_real = blk + 1; NTw = nt_real < 4 ? 4 : ((nt_real + 1) & ~1); }
    const bf16* kw = (const bf16*)(ws + WS_KW) + ((size_t)b * SEQ + 64 * t0) * 128 + kv * 64; const bf16* vw = (const bf16*)(ws + WS_VW) + ((size_t)b * SEQ + 64 * t0) * 128 + kv * 64;
#ifndef NO_M2
    attn_unit<2, 8>((const bf16*)(ws + WS_QR) + m * 512 + head * 64, kw, vw, t0, NTw, blk, pos, (const float*)(ws + WS_NG) + m * 32 + head * 3 + 2, (float*)(ws + WS_OBF) + obo, (bf16*)(ws + WS_OB) + obo, shm, dm0, dm1);
#endif
 }
#undef LANE_SETUP
}
#undef SBAR
#undef WAIT_BAR
}

namespace smp {
constexpr int SCP = 1040;
constexpr int L_SC = 0, L_PART = L_SC + 4 * SCP * 4, L_OB = L_PART + 8 * 256 * 4, L_BLK = L_OB + 1024, L_SEL = L_BLK + 272 * 4, L_END = L_SEL + 128;
constexpr float NEG = -1e30f;

template <class KF, class VF>
__device__ __forceinline__ void branch(LAS unsigned char* L, int nslots, const float (&q)[4][4], const KF& kf, const VF& vf, const float* gates  ) {
    const int tid = threadIdx.x, lane = tid & 63, w = tid >> 6, sub = lane >> 4, d4 = lane & 15;
    LAS float* sc = (LAS float*)(L + L_SC); LAS float* part = (LAS float*)(L + L_PART); LAS float* ob = (LAS float*)(L + L_OB);
    const int ngroups = (nslots + 3) >> 2;
    for (int gi = w; gi < ngroups; gi += 8) {
        const int slot = 4 * gi + sub; f32x4 kx = {0.f, 0.f, 0.f, 0.f}; const bool valid = (slot < nslots) && kf(slot, d4, kx);
        float s0 = q[0][0] * kx.x + q[0][1] * kx.y + q[0][2] * kx.z + q[0][3] * kx.w, s1 = q[1][0] * kx.x + q[1][1] * kx.y + q[1][2] * kx.z + q[1][3] * kx.w;
        float s2 = q[2][0] * kx.x + q[2][1] * kx.y + q[2][2] * kx.z + q[2][3] * kx.w, s3 = q[3][0] * kx.x + q[3][1] * kx.y + q[3][2] * kx.z + q[3][3] * kx.w;
#pragma unroll
        for (int o = 1; o < 16; o <<= 1) { s0 += __shfl_xor(s0, o); s1 += __shfl_xor(s1, o); s2 += __shfl_xor(s2, o); s3 += __shfl_xor(s3, o); }
        if (d4 < 4 && slot < nslots) { const float sv = d4 == 0 ? s0 : (d4 == 1 ? s1 : (d4 == 2 ? s2 : s3)); sc[d4 * SCP + slot] = valid ? sv : NEG; }
    }
    __syncthreads();
    if (w < 4) {
        LAS float* s = sc + w * SCP; float mx = -500.f;
        for (int i = lane; i < nslots; i += 64) mx = fmaxf(mx, s[i]);
        mx = wave_max(mx); float sum = 0.f;
        for (int i = lane; i < nslots; i += 64) { const float e = __builtin_amdgcn_exp2f(s[i] - mx); s[i] = e; sum += e; }
        sum = wave_sum(sum); const float rs = sum > 0.f ? 1.f / sum : 0.f;
        for (int i = lane; i < nslots; i += 64) s[i] *= rs;
    }
    __syncthreads();
    float acc[4][4] = {};
    for (int gi = w; gi < ngroups; gi += 8) {
        const int slot = 4 * gi + sub; if (slot >= nslots) continue;
        const float p0 = sc[slot], p1 = sc[SCP + slot], p2 = sc[2 * SCP + slot], p3 = sc[3 * SCP + slot];
        if (p0 == 0.f && p1 == 0.f && p2 == 0.f && p3 == 0.f) continue;
        const f32x4 vx = vf(slot, d4);
        acc[0][0] += p0 * vx.x; acc[0][1] += p0 * vx.y; acc[0][2] += p0 * vx.z; acc[0][3] += p0 * vx.w;
        acc[1][0] += p1 * vx.x; acc[1][1] += p1 * vx.y; acc[1][2] += p1 * vx.z; acc[1][3] += p1 * vx.w;
        acc[2][0] += p2 * vx.x; acc[2][1] += p2 * vx.y; acc[2][2] += p2 * vx.z; acc[2][3] += p2 * vx.w;
        acc[3][0] += p3 * vx.x; acc[3][1] += p3 * vx.y; acc[3][2] += p3 * vx.z; acc[3][3] += p3 * vx.w;
    }
#pragma unroll
    for (int h = 0; h < 4; ++h)
#pragma unroll
        for (int i = 0; i < 4; ++i) { float v = acc[h][i]; v += __shfl_xor(v, 16); v += __shfl_xor(v, 32); acc[h][i] = v; }
    if (sub == 0) {
#pragma unroll
        for (int h = 0; h < 4; ++h) *(LAS f32x4*)(part + w * 256 + h * 64 + 4 * d4) = (f32x4){acc[h][0], acc[h][1], acc[h][2], acc[h][3]};
    }
    __syncthreads();
    if (tid < 256) { float s = 0.f;
#pragma unroll
        for (int ww = 0; ww < 8; ++ww) s += part[ww * 256 + tid];
        ob[tid] += gates[(tid >> 6) * 3] * s; }
    __syncthreads();
}

__device__ __forceinline__ f32x4 ld_bf4(const bf16* p) { const v2u w = *(const v2u*)p; return (f32x4){bflo(w.x), bfhi(w.x), bflo(w.y), bfhi(w.y)}; }

struct SampleBufs { const bf16 *QN, *QR, *KCS, *VCS, *KS, *VS, *KW, *VW; const float* NG; bf16* OB; const float *cks, *cvs, *ckw, *cvw; const int* pt; };

__device__ __forceinline__ void nsa_sample_unit(const SampleBufs& S, LAS unsigned char* L, int sb, int kv, int st) {
    const int tid = threadIdx.x, lane = tid & 63, d4 = lane & 15;
    const size_t m = (size_t)MP + 4 * sb + st; const int pos = PAST + st;
    LAS float* sc = (LAS float*)(L + L_SC); LAS float* ob = (LAS float*)(L + L_OB); LAS float* blk = (LAS float*)(L + L_BLK); LAS int* sel = (LAS int*)(L + L_SEL);
    float qn[4][4], qr[4][4];
#pragma unroll
    for (int h = 0; h < 4; ++h) { const f32x4 a = ld_bf4(S.QN + m * 512 + (4 * kv + h) * 64 + 4 * d4), b = ld_bf4(S.QR + m * 512 + (4 * kv + h) * 64 + 4 * d4);
        qn[h][0] = a.x; qn[h][1] = a.y; qn[h][2] = a.z; qn[h][3] = a.w; qr[h][0] = b.x; qr[h][1] = b.y; qr[h][2] = b.z; qr[h][3] = b.w; }
    const float* gates = S.NG + m * 32 + (4 * kv) * 3;
    __syncthreads();
    if (tid < 256) ob[tid] = 0.f;
    if (tid == 0) { sel[0] = 0; sel[1] = 255; sel[2] = 256; sel[16] = 3; }
    __syncthreads();
    { const bf16* kc = S.KCS + (size_t)(sb * 2 + kv) * NCS * 64; const bf16* vc = S.VCS + (size_t)(sb * 2 + kv) * NCS * 64;
      auto kf = [&](int slot, int dd, f32x4& o) -> bool { o = ld_bf4(kc + (size_t)slot * 64 + 4 * dd); return true; };
      auto vf = [&](int slot, int dd) -> f32x4 { return ld_bf4(vc + (size_t)slot * 64 + 4 * dd); };
      branch(L, NCS - 1, qn, kf, vf, gates + 0); }
    if (tid < 257) { const int j = tid; float v[5];
#pragma unroll
        for (int i = 0; i < 5; ++i) { const int c = 4 * j - 1 + i; v[i] = (c >= 0 && c < NCS - 1) ? (sc[c] + sc[SCP + c]) + (sc[2 * SCP + c] + sc[3 * SCP + c]) : 0.f; }
        blk[j] = v[0] + 2.f * (v[1] + v[2] + v[3]) + v[4]; }
    __syncthreads();
    if (tid >= 1 && tid <= 254) { const float sj = blk[tid]; int cnt = 0;
        for (int i = 1; i <= 254; ++i) { const float si = blk[i]; cnt += (si > sj || (si == sj && i < tid)) ? 1 : 0; }
        if (cnt < 13) { const int k = __hip_atomic_fetch_add(sel + 16, 1, __ATOMIC_RELAXED, __HIP_MEMORY_SCOPE_WORKGROUP); if (k < 16) sel[k] = tid; } }
    __syncthreads();
    { const float* ck = S.cks; const float* cv = S.cvs; const int* pt = S.pt + sb * NPAGES;
      auto kf = [&](int slot, int dd, f32x4& o) -> bool { const int kp = sel[slot >> 6] * 64 + (slot & 63); if (kp > pos) return false;
          if (kp < PAST) { const int pg = pt[kp >> 7]; o = *(const f32x4*)(ck + ((size_t)pg * 128 + (kp & 127)) * 128 + kv * 64 + 4 * dd); }
          else o = ld_bf4(S.KS + ((size_t)MP + 4 * sb + (kp - PAST)) * 128 + kv * 64 + 4 * dd);
          return true; };
      auto vf = [&](int slot, int dd) -> f32x4 { const int kp = sel[slot >> 6] * 64 + (slot & 63);
          if (kp < PAST) { const int pg = pt[kp >> 7]; return *(const f32x4*)(cv + ((size_t)pg * 128 + (kp & 127)) * 128 + kv * 64 + 4 * dd); }
          return ld_bf4(S.VS + ((size_t)MP + 4 * sb + (kp - PAST)) * 128 + kv * 64 + 4 * dd); };
      branch(L, 1024, qr, kf, vf, gates + 1); }
    { const float* ck = S.ckw + (size_t)sb * WIN * 128 + kv * 64; const float* cv = S.cvw + (size_t)sb * WIN * 128 + kv * 64;
      auto kf = [&](int slot, int dd, f32x4& o) -> bool {
          if (slot < WIN) { if (slot < st + 1) return false; o = *(const f32x4*)(ck + (size_t)slot * 128 + 4 * dd); return true; }
          if (slot - WIN > st) return false; o = ld_bf4(S.KW + ((size_t)MP + 4 * sb + (slot - WIN)) * 128 + kv * 64 + 4 * dd); return true; };
      auto vf = [&](int slot, int dd) -> f32x4 { if (slot < WIN) return *(const f32x4*)(cv + (size_t)slot * 128 + 4 * dd);
          return ld_bf4(S.VW + ((size_t)MP + 4 * sb + (slot - WIN)) * 128 + kv * 64 + 4 * dd); };
      branch(L, WIN + DECS, qr, kf, vf, gates + 2); }
    if (tid < 256) S.OB[m * 512 + (4 * kv) * 64 + tid] = (bf16)f2bf(ob[tid]);
    __syncthreads();
}
}

#ifndef MK_N_LAUNCHES
#define MK_N_LAUNCHES 1
#endif
constexpr int N_PHASES = 9;
struct Args { const void* in[N_IN]; float* out; unsigned char* ws; int ph_lo, ph_hi; };
static_assert(sizeof(Args) == (N_IN + 2) * 8 + 8, "no padding bytes in Args");

__global__ void __launch_bounds__(NWAVES * 64, 2) hybrid_fwd(Args args) {
    extern __shared__ __attribute__((aligned(16))) unsigned char lds[];
    Frame F;
    F.lds = (LAS unsigned char*)lds;
    F.MISC = (volatile LAS unsigned*)(F.lds + MISC_OFF);
    F.tid = threadIdx.x; F.lane = F.tid & 63; F.wave = __builtin_amdgcn_readfirstlane(F.tid >> 6);
    F.G = gridDim.x; { const int bx = blockIdx.x; F.vcu = (F.G % 8 == 0) ? (bx % 8) * (F.G / 8) + bx / 8 : bx; }
    F.ws = args.ws; F.out = args.out; F.ctl = (gu32*)(args.ws + WS_CTL);
#pragma unroll
    for (int i = 0; i < N_IN; ++i) F.in[i] = (const float*)args.in[i];
    for (int u = F.tid; u < 64; u += NWAVES * 64) ((LAS unsigned*)(F.lds + MISC_OFF))[u] = 0u;
    __syncthreads();
    XcdBarrier bar; bar.bar = (unsigned*)(F.ctl + CW_BAR); bar.x = 0; bar.st = nullptr;
    if (MK_N_LAUNCHES == 1) bar = xcd_barrier_post((unsigned*)(F.ctl + CW_BAR), F.MISC + 8);
#define GRID_BAR() do { if (MK_N_LAUNCHES == 1) xcd_barrier(bar); } while (0)
    const int lo = args.ph_lo, hi = args.ph_hi;
#ifndef PH_MASK
#define PH_MASK 0x1ff
#endif
#define IN(k) (((PH_MASK >> (k)) & 1) && lo <= (k) && (k) < hi)
#define BOTH(k) (IN(k) && IN((k) + 1))

    if (IN(0)) { p0_prologue(F); if (BOTH(0)) GRID_BAR(); }

    if (IN(1)) {
        pg8::Gemm g{WSP(bf16, WS_XN), WSP(bf16, WS_WINT), MPAD, NIN, DM}; pg8::StaticOrder S; S.init(MPAD, NIN, F.G, (int)blockIdx.x);
        pg8::EpiIn E{F.ws, F.out};
        pg8::gemm_phase<pg8::EpiIn, pg8::StaticOrder, true, true>(F.lds, g, S, E);
        if (BOTH(1)) GRID_BAR();
    }

    if (IN(2)) {
        compress_stage1(F);
        for (int n = F.G - 1 - (int)blockIdx.x; n < 129; n += F.G) gmlp_unit(F, n);
        __syncthreads();
        if (BOTH(2)) GRID_BAR();
    }

    if (IN(3)) { compress_stage2(F); if (BOTH(3)) GRID_BAR(); }

    if (IN(4)) {
        #ifndef NO_PROMPT
        for (int pr = F.vcu; pr < 256; pr += F.G) { const int bk = pr >> 6, s = pr & 63;
            att::nsa_prompt_unit(F.ws, bk >> 1, bk & 1, 127 - s, (char*)lds);
            att::nsa_prompt_unit(F.ws, bk >> 1, bk & 1, s, (char*)lds); }
#endif
#ifndef NO_SMP
        const smp::SampleBufs Sb{WSP(bf16, WS_QN), WSP(bf16, WS_QR), WSP(bf16, WS_KCS), WSP(bf16, WS_VCS), WSP(bf16, WS_KS), WSP(bf16, WS_VS), WSP(bf16, WS_KW), WSP(bf16, WS_VW), WSP(float, WS_NG), WSP(bf16, WS_OB),
                                 F.in[I_CKS], F.in[I_CVS], F.in[I_CKW], F.in[I_CVW], (const int*)F.in[I_PT]};
        for (int su = (int)blockIdx.x; su < 256; su += F.G) smp::nsa_sample_unit(Sb, F.lds, su >> 3, (su >> 2) & 1, su & 3);
#endif
        if (BOTH(4)) GRID_BAR();
    }

    if (IN(5)) {
        pg8::StaticOrder S; S.init(MPAD, DM, F.G, (int)blockIdx.x);
        { pg8::Gemm g{WSP(bf16, WS_OA), WSP(bf16, WS_WBA), MPAD, DM, 512}; pg8::EpiT1 E{WSP(bf16, WS_T1), DM};
          pg8::gemm_phase<pg8::EpiT1, pg8::StaticOrder, true, true>(F.lds, g, S, E); }
        { pg8::Gemm g{WSP(bf16, WS_OB), WSP(bf16, WS_WBB), MPAD, DM, 512}; pg8::EpiMerge E{WSP(bf16, WS_T1), WSP(bf16, WS_SG), WSP(bf16, WS_MG)};
          pg8::gemm_phase<pg8::EpiMerge, pg8::StaticOrder, true, true>(F.lds, g, S, E); }
        if (BOTH(5)) GRID_BAR();
    }

    if (IN(6)) {
        pg8::Gemm g{WSP(bf16, WS_MG), WSP(bf16, WS_WOT), MPAD, DM, DM}; pg8::StaticOrder S; S.init(MPAD, DM, F.G, (int)blockIdx.x);
        pg8::EpiOut E{F.in[I_XP], F.in[I_XS], F.out, WSP(bf16, WS_X1B), WSP(float, WS_SSQ)};
        pg8::gemm_phase<pg8::EpiOut, pg8::StaticOrder, true, true>(F.lds, g, S, E);
        if (BOTH(6)) GRID_BAR();
    }

    if (IN(7)) {
        pg8::Gemm g{WSP(bf16, WS_X1B), WSP(bf16, WS_WUP), MPAD, DFF, DM}; pg8::StaticOrder S; S.init(MPAD, DFF, F.G, (int)blockIdx.x);
        pg8::EpiUp E{WSP(float, WS_SSQ), WSP(bf16, WS_H)};
        pg8::gemm_phase<pg8::EpiUp, pg8::StaticOrder, true, true>(F.lds, g, S, E);
        if (BOTH(7)) GRID_BAR();
    }

    if (IN(8)) {
        pg8::Gemm g{WSP(bf16, WS_H), WSP(bf16, WS_WDN), MPAD, DM, DFF}; pg8::StaticOrder S; S.init(MPAD, DM, F.G, (int)blockIdx.x);
        pg8::EpiDown E{F.out};
        pg8::gemm_phase<pg8::EpiDown, pg8::StaticOrder, true, true>(F.lds, g, S, E);
    }
#undef IN
#undef BOTH
}

extern "C" void kernel_launch(void* const* d_in, const int* in_sizes, int n_in, void* d_out, int out_size, void* d_ws, size_t ws_size, hipStream_t stream) {
    static int grid = 0;
    if (grid == 0) {
        if (n_in != N_IN || in_sizes[0] != MP * DM || (size_t)out_size != O_END || ws_size < WS_END) {
            fprintf(stderr, "kernel_launch: unexpected problem: n_in %d in0 %d out %d ws %zu (need %zu); nothing launched\n", n_in, n_in > 0 ? in_sizes[0] : -1, out_size, ws_size, (size_t)WS_END); grid = -1; return; }
        int dev = 0, cus = 0, per_cu = 0;
        if (hipGetDevice(&dev) != hipSuccess || hipDeviceGetAttribute(&cus, hipDeviceAttributeMultiprocessorCount, dev) != hipSuccess) { grid = -1; return; }
        if (hipFuncSetAttribute((const void*)hybrid_fwd, hipFuncAttributeMaxDynamicSharedMemorySize, LDS_BYTES) != hipSuccess) { fprintf(stderr, "kernel_launch: hipFuncSetAttribute failed\n"); grid = -1; return; }
        if (hipOccupancyMaxActiveBlocksPerMultiprocessor(&per_cu, (const void*)hybrid_fwd, NWAVES * 64, LDS_BYTES) != hipSuccess || per_cu < 1)
            fprintf(stderr, "kernel_launch: note: occupancy query reports %d workgroups per CU\n", per_cu);
        (void)hipGetLastError();
        grid = cus;
    }
    if (grid < 0) return;
    if (hipMemsetAsync((char*)d_ws + WS_CTL, 0, CTL_ZERO_BYTES, stream) != hipSuccess) return;
    Args a{};
    for (int i = 0; i < N_IN; ++i) a.in[i] = d_in[i];
    a.out = (float*)d_out; a.ws = (unsigned char*)d_ws;
    if (MK_N_LAUNCHES == 1) { a.ph_lo = 0; a.ph_hi = N_PHASES; hipLaunchKernelGGL(hybrid_fwd, dim3(grid), dim3(NWAVES * 64), LDS_BYTES, stream, a); }
    else for (int p = 0; p < N_PHASES; ++p) { a.ph_lo = p; a.ph_hi = p + 1; hipLaunchKernelGGL(hybrid_fwd, dim3(grid), dim3(NWAVES * 64), LDS_BYTES, stream, a); }
    const hipError_t le = hipPeekAtLastError();
    if (le != hipSuccess) fprintf(stderr, "kernel_launch: launch failed: %s\n", hipGetErrorName(le));
}
```

```cpp
#include <hip/hip_runtime.h>
#include <hip/hip_bf16.h>
#include <cstdio>
#include <cstdint>
#include <cmath>

constexpr int DM = 1024, SEQ = 8192, NBAT = 2, MP = NBAT * SEQ, NSMP = 128, MT = MP + NSMP, MPAD = 16640;
constexpr int AW = 512, NHEAD = 8, HD = 64, NKV = 2, DFF = 4096, INC = 4376, NIN = 4608;
constexpr int PAST = 16384, NPAGES = 128, DECB = 32, DECS = 4, WIN = 512;
constexpr int NCP = 512, NCS = 1024;
constexpr float EPS = 1e-6f;
constexpr float QC2 = 0.125f * 1.4426950408889634f;

enum { I_XP = 0, I_XS, I_CKC, I_CVC, I_CKS, I_CVS, I_CKW, I_CVW, I_PT, I_G1, I_WIN, I_LNG, I_LNB, I_WS, I_BS, I_GQ, I_GKC, I_GKS, I_GKW,
       I_WCK1, I_WCK2, I_PEK, I_WCV1, I_WCV2, I_PEV, I_WBR, I_WOUT, I_G2, I_WUP, I_WDN, N_IN };
constexpr size_t O_YP = 0, O_YS = O_YP + (size_t)MP * DM, O_PKC = O_YS + (size_t)NSMP * DM, O_PVC = O_PKC + (size_t)MP * 128, O_PKS = O_PVC + (size_t)MP * 128,
                 O_PVS = O_PKS + (size_t)MP * 128, O_PKW = O_PVS + (size_t)MP * 128, O_PVW = O_PKW + (size_t)NBAT * WIN * 128, O_PVA = O_PVW + (size_t)NBAT * WIN * 128,
                 O_SKC = O_PVA + (size_t)NBAT * 128 * AW, O_SVC = O_SKC + NSMP * 128, O_SKS = O_SVC + NSMP * 128, O_SVS = O_SKS + NSMP * 128, O_SKW = O_SVS + NSMP * 128,
                 O_SVW = O_SKW + NSMP * 128, O_SVA = O_SVW + NSMP * 128, O_END = O_SVA + (size_t)NSMP * AW;
static_assert(O_END == 25853952, "output size");

constexpr size_t al256(size_t x) { return (x + 255) & ~(size_t)255; }
constexpr size_t WS_CTL = 0, CTL_ZERO_BYTES = 1u << 20;
constexpr size_t WS_WINT = CTL_ZERO_BYTES;
constexpr size_t WS_WBA = WS_WINT + (size_t)NIN * DM * 2;
constexpr size_t WS_WBB = WS_WBA + (size_t)DM * 512 * 2;
constexpr size_t WS_WOT = WS_WBB + (size_t)DM * 512 * 2;
constexpr size_t WS_WUP = WS_WOT + (size_t)DM * DM * 2;
constexpr size_t WS_WDN = WS_WUP + (size_t)DFF * DM * 2;
constexpr size_t WS_WC1K = WS_WDN + (size_t)DM * DFF * 2;
constexpr size_t WS_WC1V = WS_WC1K + 128 * 1024 * 2;
constexpr size_t WS_WSP = WS_WC1V + 128 * 1024 * 2;
constexpr size_t WS_WSS = WS_WSP + 8 * 128 * 128 * 2;
constexpr size_t WS_ROPE = WS_WSS + 8 * 128 * 128 * 2;
constexpr size_t WS_BPART = al256(WS_ROPE + 8196 * 16 * 4);
constexpr size_t WS_GAINS = al256(WS_BPART + 2 * 32 * 64 * 4);
constexpr size_t WS_XN = al256(WS_GAINS + 3 * 64 * 4);
constexpr size_t WS_U = WS_XN + (size_t)MPAD * DM * 2;
constexpr size_t WS_GV = WS_U + (size_t)MPAD * 512 * 2;
constexpr size_t WS_QN = WS_GV + (size_t)MPAD * 512 * 2;
constexpr size_t WS_QR = WS_QN + (size_t)MPAD * 512 * 2;
constexpr size_t WS_KCA = WS_QR + (size_t)MPAD * 512 * 2;
constexpr size_t WS_VCA = WS_KCA + 2048 * 1024 * 2;
constexpr size_t KVROWS = MPAD + 256;
constexpr size_t WS_KS = WS_VCA + 2048 * 1024 * 2;
constexpr size_t WS_VS = WS_KS + KVROWS * 128 * 2;
constexpr size_t WS_KW = WS_VS + KVROWS * 128 * 2;
constexpr size_t WS_VW = WS_KW + KVROWS * 128 * 2;
constexpr size_t WS_SG = WS_VW + KVROWS * 128 * 2;
constexpr size_t WS_NG = WS_SG + (size_t)MPAD * 2048 * 2;
constexpr size_t WS_FSPK = WS_NG + (size_t)MPAD * 32 * 4;
constexpr size_t WS_FSPV = WS_FSPK + 2048 * 128 * 4;
constexpr size_t WS_FSSK = WS_FSPV + 2048 * 128 * 4;
constexpr size_t WS_FSSV = WS_FSSK + (size_t)65536 * 128 * 4;
constexpr size_t WS_KCP = WS_FSSV + (size_t)65536 * 128 * 4;
constexpr size_t WS_VCP = WS_KCP + 4 * NCP * 64 * 2;
constexpr size_t WS_KCS = WS_VCP + 4 * NCP * 64 * 2;
constexpr size_t WS_VCS = WS_KCS + (size_t)64 * NCS * 64 * 2;
constexpr size_t WS_OA = WS_VCS + (size_t)64 * NCS * 64 * 2;
constexpr size_t WS_OB = WS_OA + (size_t)MPAD * 512 * 2;
constexpr size_t WS_T1 = WS_OB + (size_t)MPAD * 512 * 2;
constexpr size_t WS_MG = WS_T1 + (size_t)MPAD * DM * 2;
constexpr size_t WS_X1B = WS_MG + (size_t)MPAD * DM * 2;
constexpr size_t WS_SSQ = WS_X1B + (size_t)MPAD * DM * 2;
constexpr size_t WS_H = al256(WS_SSQ + (size_t)MPAD * 16 * 4);
constexpr size_t WS_OBF = WS_H + (size_t)MPAD * DFF * 2;
constexpr size_t WS_SSQS = WS_OBF + (size_t)MP * 512 * 4;
constexpr size_t WS_DBG = WS_SSQS + 128 * 64 * 4;
constexpr size_t WS_END = WS_DBG + (1u << 20);

constexpr int CW_TMO = 0, CW_CODE = 1, CW_BAR = 4096;

constexpr int LDS_BYTES = 147456;
constexpr int MISC_OFF = LDS_BYTES - 256;
constexpr int NWAVES = 8;

#define GAS __attribute__((address_space(1)))
#define LAS __attribute__((address_space(3)))
typedef unsigned short bf16;
typedef unsigned v4u __attribute__((ext_vector_type(4)));
typedef unsigned v2u __attribute__((ext_vector_type(2)));
typedef float f32x4 __attribute__((ext_vector_type(4)));
typedef float f32x16 __attribute__((ext_vector_type(16)));
typedef short bf16x8 __attribute__((ext_vector_type(8)));
typedef GAS unsigned gu32;
#define RLX_AGENT __ATOMIC_RELAXED, __HIP_MEMORY_SCOPE_AGENT
#define LDS_WAIT() asm volatile("s_waitcnt lgkmcnt(0)" ::: "memory")
#define VM_WAIT() asm volatile("s_waitcnt vmcnt(0)" ::: "memory")
__device__ __forceinline__ unsigned f2bf(float f) { unsigned u = __builtin_bit_cast(unsigned, f); return (u + 0x7fffu + ((u >> 16) & 1u)) >> 16; }
__device__ __forceinline__ unsigned pk2(float lo, float hi) { return f2bf(lo) | (f2bf(hi) << 16); }
__device__ __forceinline__ float bf2f(unsigned h) { return __builtin_bit_cast(float, h << 16); }
__device__ __forceinline__ float bflo(unsigned w) { return __builtin_bit_cast(float, w << 16); }
__device__ __forceinline__ float bfhi(unsigned w) { return __builtin_bit_cast(float, w & 0xffff0000u); }
__device__ __forceinline__ float fast_sigmoid(float x) { return __builtin_amdgcn_rcpf(1.f + __builtin_amdgcn_exp2f(-1.4426950408889634f * x)); }
__device__ __forceinline__ float gelu_tanh(float x) {
    const float u = 1.5957691216057308f * (x + 0.044715f * x * x * x);
    return x * __builtin_amdgcn_rcpf(1.f + __builtin_amdgcn_exp2f(-1.4426950408889634f * u));
}
__device__ __forceinline__ float wave_sum(float v) {
#pragma unroll
    for (int o = 1; o < 64; o <<= 1) v += __shfl_xor(v, o);
    return v;
}
__device__ __forceinline__ float wave_max(float v) {
#pragma unroll
    for (int o = 1; o < 64; o <<= 1) v = fmaxf(v, __shfl_xor(v, o));
    return v;
}
__host__ __device__ __forceinline__ int dmap(int s) { if (s >= 16) return s; const int f = s >> 3, p = s & 7; return p < 4 ? 4 * f + p : 4 + 4 * f + p; }
__host__ __device__ __forceinline__ int win_map(int j) {
    const int t = j >> 8, L = j & 255;
    if (t < 4) return j;
    const int h = (L >> 5) & 3, s = ((L >> 7) << 5) | (L & 31);
    if (t < 6) return 1024 + ((t - 4) * 4 + h) * 64 + dmap(s);
    if (t == 6) return 1536 + L;
    if (t == 7) return 1792 + (h >> 1) * 128 + (h & 1) * 64 + dmap(s);
    if (t == 8) return 2048 + (h >> 1) * 128 + (h & 1) * 64 + dmap(s);
    if (t < 17) return 2328 + (j - 9 * 256);
    return L < 24 ? 2304 + L : -1;
}
namespace pg8 {
#define PG8_LAS __attribute__((address_space(3)))
typedef unsigned short bf16_t;
typedef short bf16x8 __attribute__((ext_vector_type(8)));
typedef float f32x4 __attribute__((ext_vector_type(4)));
typedef unsigned u32x4 __attribute__((ext_vector_type(4)));
constexpr int BM = 256, BK = 64, HALF = 128, HTB = HALF * BK * 2  , STAGE_BYTES = 8 * HTB, NXCD = 8, WGM = 8;

__host__ __device__ __forceinline__ int lds_byte(int r, int c) { const int st = (r >> 4) * 2 + (c >> 5), rr = r & 15, cc = c & 31, ob = rr * 64 + cc * 2; return st * 1024 + (ob ^ (((ob >> 9) & 1) << 5)); }
__host__ __device__ __forceinline__ void stage_rc(int b, int& R, int& C) { const int st = b / 1024, sb = b % 1024, swz = sb ^ (((sb >> 9) & 1) << 5); R = (st >> 1) * 16 + swz / 64; C = (st & 1) * 32 + (swz % 64) / 2; }
__host__ __device__ __forceinline__ int perm32(int rho) { const int n = rho >> 4, i = rho & 15; return 8 * (i >> 2) + 4 * n + (i & 3); }

struct Unit { int pm, pn; };
struct Gemm { const bf16_t* A; const bf16_t* Bt; int M, N, K; };

struct StaticOrder {
    int nM, nN, nwg, G, c;
    __host__ __device__ void init(int M, int N, int G_, int c_) { nM = M / BM; nN = N / BM; nwg = nM * nN; G = G_; c = c_; }
    __host__ __device__ bool next(int i, Unit& u) const {
        const long L = (long)i * G + c; if (L >= nwg) return false;
        int wgid = (int)L; { const int q = nwg / NXCD, r = nwg % NXCD, xcd = wgid % NXCD, off = wgid / NXCD; wgid = (xcd < r ? xcd * (q + 1) : r * (q + 1) + (xcd - r) * q) + off; }
        const int nig = WGM * nN, gid = wgid / nig, fm = gid * WGM, gsz = (nM - fm) < WGM ? (nM - fm) : WGM;
        u.pm = fm + ((wgid % nig) % gsz); u.pn = (wgid % nig) / gsz; return true;
    }
    __device__ __forceinline__ void a_ready(const Unit&) const {}
    __device__ __forceinline__ void done(const Unit&) const {}
};

__device__ __forceinline__ unsigned cvt_pk_bf16(float lo, float hi) { unsigned r; asm volatile("v_cvt_pk_bf16_f32 %0, %1, %2" : "=v"(r) : "v"(lo), "v"(hi)); return r; }
typedef float f32x2 __attribute__((ext_vector_type(2)));
__device__ __forceinline__ u32x4 pack8(const f32x4 a, const f32x4 b) { u32x4 w; w.x = cvt_pk_bf16(a[0], a[1]); w.y = cvt_pk_bf16(a[2], a[3]); w.z = cvt_pk_bf16(b[0], b[1]); w.w = cvt_pk_bf16(b[2], b[3]); return w; }
typedef unsigned u32x2 __attribute__((ext_vector_type(2)));

struct EpiIn {
    static constexpr bool PERM = true, AFTER_DRAIN = false;
    unsigned char* ws; float* out;
    __device__ __forceinline__ void operator()(const f32x4 (&acc)[2][2][4][2], const Unit& u, int wr, int wc, int fr, int fq) const {
        const int pn = u.pn, rbase = u.pm * BM + wr * 64 + fr;
        if (pn < 4) {
            bf16_t* dst = (bf16_t*)(ws + (pn < 2 ? WS_U : WS_GV)) + (pn & 1) * 256 + wc * 32 + 8 * fq;
#pragma unroll
            for (int ai = 0; ai < 2; ++ai)
#pragma unroll
                for (int m = 0; m < 4; ++m) { const int row = rbase + ai * HALF + m * 16;
#pragma unroll
                    for (int bj = 0; bj < 2; ++bj) { f32x4 v0 = acc[ai][bj][m][0], v1 = acc[ai][bj][m][1];
#pragma unroll
                        for (int i = 0; i < 4; ++i) { v0[i] = gelu_tanh(v0[i]); v1[i] = gelu_tanh(v1[i]); }
                        *(u32x4*)(dst + (size_t)row * 512 + bj * HALF) = pack8(v0, v1); } }
        } else if (pn < 6 || pn == 7 || pn == 8) {
            const bool isq = pn < 6, isk = isq || wc < 2;
            const float* g = (const float*)(ws + WS_GAINS) + (isq ? 0 : (pn == 7 ? 64 : 128)); const float* rope = (const float*)(ws + WS_ROPE);
            const int d1 = fq < 2 ? 4 * fq : 8 * fq, d2 = fq < 2 ? 8 + 4 * fq : 8 * fq + 4, d3 = 32 + 8 * fq;
            f32x4 g1 = {1.f, 1.f, 1.f, 1.f}, g2 = g1, g3a = g1, g3b = g1;
            if (isk) { g1 = *(const f32x4*)(g + d1); g2 = *(const f32x4*)(g + d2); g3a = *(const f32x4*)(g + d3); g3b = *(const f32x4*)(g + d3 + 4); }
            const float osc = isq ? QC2 : 1.f;
#pragma unroll
            for (int ai = 0; ai < 2; ++ai)
#pragma unroll
                for (int m = 0; m < 4; ++m) { const int row = rbase + ai * HALF + m * 16;
                    f32x4 a = acc[ai][0][m][0], b = acc[ai][0][m][1], c = acc[ai][1][m][0], d = acc[ai][1][m][1];
                    f32x4 ra = a, rb = b;
                    if (isk) {
                        float ss = (a[0] * a[0] + a[1] * a[1]) + (a[2] * a[2] + a[3] * a[3]) + (b[0] * b[0] + b[1] * b[1]) + (b[2] * b[2] + b[3] * b[3])
                                 + (c[0] * c[0] + c[1] * c[1]) + (c[2] * c[2] + c[3] * c[3]) + (d[0] * d[0] + d[1] * d[1]) + (d[2] * d[2] + d[3] * d[3]);
                        ss += __shfl_xor(ss, 16); ss += __shfl_xor(ss, 32);
                        const float rstd = 1.f / sqrtf(ss * (1.f / 64.f) + EPS);
                        a = a * rstd * g1; b = b * rstd * g2; c = c * rstd * g3a; d = d * rstd * g3b;
                        const int pidx = row < MP ? (row & (SEQ - 1)) : SEQ + ((row - MP) & 3);
                        f32x4 cs = {1.f, 1.f, 1.f, 1.f}, sn = {0.f, 0.f, 0.f, 0.f};
                        if (fq < 2) { cs = *(const f32x4*)(rope + pidx * 16 + 4 * fq); sn = *(const f32x4*)(rope + pidx * 16 + 8 + 4 * fq); }
                        ra = a * cs - b * sn; rb = b * cs + a * sn;
                    }
                    if (isq) {
                        const int head = (pn - 4) * 4 + wc; bf16_t* qn = (bf16_t*)(ws + WS_QN) + (size_t)row * 512 + head * 64; bf16_t* qr = (bf16_t*)(ws + WS_QR) + (size_t)row * 512 + head * 64;
                        const f32x4 cc = c * osc, dd = d * osc;
                        { f32x4 x = a * osc, y = b * osc; u32x2 w; w.x = cvt_pk_bf16(x[0], x[1]); w.y = cvt_pk_bf16(x[2], x[3]); *(u32x2*)(qn + d1) = w; w.x = cvt_pk_bf16(y[0], y[1]); w.y = cvt_pk_bf16(y[2], y[3]); *(u32x2*)(qn + d2) = w; }
                        { f32x4 x = ra * osc, y = rb * osc; u32x2 w; w.x = cvt_pk_bf16(x[0], x[1]); w.y = cvt_pk_bf16(x[2], x[3]); *(u32x2*)(qr + d1) = w; w.x = cvt_pk_bf16(y[0], y[1]); w.y = cvt_pk_bf16(y[2], y[3]); *(u32x2*)(qr + d2) = w; }
                        const u32x4 w3 = pack8(cc, dd); *(u32x4*)(qn + d3) = w3; *(u32x4*)(qr + d3) = w3;
                    } else {
                        const int kvh = wc & 1; const bool kw = (pn == 8);
                        bf16_t* bd = (bf16_t*)(ws + (isk ? (kw ? WS_KW : WS_KS) : (kw ? WS_VW : WS_VS))) + (size_t)row * 128 + kvh * 64;
                        { u32x2 w; w.x = cvt_pk_bf16(ra[0], ra[1]); w.y = cvt_pk_bf16(ra[2], ra[3]); *(u32x2*)(bd + d1) = w; w.x = cvt_pk_bf16(rb[0], rb[1]); w.y = cvt_pk_bf16(rb[2], rb[3]); *(u32x2*)(bd + d2) = w; }
                        *(u32x4*)(bd + d3) = pack8(c, d);
                        float* so = nullptr;
                        if (row < MP) { if (!kw) so = out + (isk ? O_PKS : O_PVS) + (size_t)row * 128; else { const int t = row & (SEQ - 1), b = row >> 13; if (t >= SEQ - WIN) so = out + (isk ? O_PKW : O_PVW) + ((size_t)b * WIN + (t - (SEQ - WIN))) * 128; } }
                        else if (row < MT) so = out + (kw ? (isk ? O_SKW : O_SVW) : (isk ? O_SKS : O_SVS)) + (size_t)(row - MP) * 128;
                        if (so) { so += kvh * 64; *(f32x4*)(so + d1) = ra; *(f32x4*)(so + d2) = rb; *(f32x4*)(so + d3) = c; *(f32x4*)(so + d3 + 4) = d; }
                    }
                }
        } else if (pn == 6) {
#pragma unroll
            for (int ai = 0; ai < 2; ++ai)
#pragma unroll
                for (int m = 0; m < 4; ++m) { const int row = rbase + ai * HALF + m * 16;
#pragma unroll
                    for (int bj = 0; bj < 2; ++bj) { const f32x4 v0 = acc[ai][bj][m][0], v1 = acc[ai][bj][m][1]; const int col = wc * 32 + 8 * fq;
                        if (row < MT) { float* so = out + (row < MP ? (bj ? O_PVC : O_PKC) + (size_t)row * 128 : (bj ? O_SVC : O_SKC) + (size_t)(row - MP) * 128) + col; *(f32x4*)so = v0; *(f32x4*)(so + 4) = v1; }
                        if (row < MP) { bf16_t* ca = (bf16_t*)(ws + (bj ? WS_VCA : WS_KCA)) + ((size_t)(row >> 4) * 2 + (wc >> 1)) * 1024 + (row & 15) * 64 + (wc & 1) * 32 + 8 * fq; *(u32x4*)ca = pack8(v0, v1); } } }
        } else if (pn < 17) {
            bf16_t* dst = (bf16_t*)(ws + WS_SG) + (pn - 9) * 256 + wc * 32 + 8 * fq;
#pragma unroll
            for (int ai = 0; ai < 2; ++ai)
#pragma unroll
                for (int m = 0; m < 4; ++m) { const int row = rbase + ai * HALF + m * 16;
#pragma unroll
                    for (int bj = 0; bj < 2; ++bj) { f32x4 v0 = acc[ai][bj][m][0], v1 = acc[ai][bj][m][1];
#pragma unroll
                        for (int i = 0; i < 4; ++i) { v0[i] = fast_sigmoid(v0[i]); v1[i] = fast_sigmoid(v1[i]); }
                        *(u32x4*)(dst + (size_t)row * 2048 + bj * HALF) = pack8(v0, v1); } }
        } else {
            if (wc == 0 && fq < 3) {
#pragma unroll
                for (int ai = 0; ai < 2; ++ai)
#pragma unroll
                    for (int m = 0; m < 4; ++m) { const int row = rbase + ai * HALF + m * 16; f32x4 v0 = acc[ai][0][m][0], v1 = acc[ai][0][m][1];
#pragma unroll
                        for (int i = 0; i < 4; ++i) { v0[i] = fast_sigmoid(v0[i]); v1[i] = fast_sigmoid(v1[i]); }
                        float* d = (float*)(ws + WS_NG) + (size_t)row * 32 + 8 * fq; *(f32x4*)d = v0; *(f32x4*)(d + 4) = v1; }
            }
        }
    }
};

struct EpiT1 {
    static constexpr bool PERM = true, AFTER_DRAIN = false;
    bf16_t* O; int ldc;
    __device__ __forceinline__ void operator()(const f32x4 (&acc)[2][2][4][2], const Unit& u, int wr, int wc, int fr, int fq) const {
        bf16_t* base = O + (size_t)(u.pm * BM + wr * 64 + fr) * ldc + u.pn * BM + wc * 32 + 8 * fq;
#pragma unroll
        for (int ai = 0; ai < 2; ++ai)
#pragma unroll
            for (int m = 0; m < 4; ++m)
#pragma unroll
                for (int bj = 0; bj < 2; ++bj) *(u32x4*)(base + (size_t)(ai * HALF + m * 16) * ldc + bj * HALF) = pack8(acc[ai][bj][m][0], acc[ai][bj][m][1]);
    }
};
__device__ __forceinline__ void unpack8(const u32x4 w, float (&f)[8]) {
    f[0] = __builtin_bit_cast(float, w.x << 16); f[1] = __builtin_bit_cast(float, w.x & 0xffff0000u); f[2] = __builtin_bit_cast(float, w.y << 16); f[3] = __builtin_bit_cast(float, w.y & 0xffff0000u);
    f[4] = __builtin_bit_cast(float, w.z << 16); f[5] = __builtin_bit_cast(float, w.z & 0xffff0000u); f[6] = __builtin_bit_cast(float, w.w << 16); f[7] = __builtin_bit_cast(float, w.w & 0xffff0000u);
}
struct EpiMerge {
    static constexpr bool PERM = true, AFTER_DRAIN = false;
    const bf16_t* T1; const bf16_t* SG; bf16_t* MG;
    __device__ __forceinline__ void operator()(const f32x4 (&acc)[2][2][4][2], const Unit& u, int wr, int wc, int fr, int fq) const {
        const int row0 = u.pm * BM + wr * 64 + fr, col0 = u.pn * BM + wc * 32 + 8 * fq;
#pragma unroll
        for (int ai = 0; ai < 2; ++ai)
#pragma unroll
            for (int m = 0; m < 4; ++m) { const size_t row = (size_t)(row0 + ai * HALF + m * 16);
#pragma unroll
                for (int bj = 0; bj < 2; ++bj) { const int col = col0 + bj * HALF;
                    float t[8], ga[8], gb[8]; unpack8(*(const u32x4*)(T1 + row * DM + col), t); unpack8(*(const u32x4*)(SG + row * 2048 + col), ga); unpack8(*(const u32x4*)(SG + row * 2048 + 1024 + col), gb);
                    const f32x4 v0 = acc[ai][bj][m][0], v1 = acc[ai][bj][m][1]; f32x4 o0, o1;
#pragma unroll
                    for (int i = 0; i < 4; ++i) { o0[i] = ga[i] * t[i] + gb[i] * v0[i]; o1[i] = ga[4 + i] * t[4 + i] + gb[4 + i] * v1[i]; }
                    *(u32x4*)(MG + row * DM + col) = pack8(o0, o1); } }
    }
};
__device__ __forceinline__ float* yrow(float* out, int row) { return row < MP ? out + O_YP + (size_t)row * DM : out + O_YS + (size_t)(row - MP) * DM; }
struct EpiOut {
    static constexpr bool PERM = true, AFTER_DRAIN = false;
    const float* xp; const float* xs; float* out; bf16_t* X1B; float* SSQ;
    __device__ __forceinline__ void operator()(const f32x4 (&acc)[2][2][4][2], const Unit& u, int wr, int wc, int fr, int fq) const {
        const int row0 = u.pm * BM + wr * 64 + fr, col0 = u.pn * BM + wc * 32 + 8 * fq;
#pragma unroll
        for (int ai = 0; ai < 2; ++ai)
#pragma unroll
            for (int m = 0; m < 4; ++m) { const int row = row0 + ai * HALF + m * 16; float ss = 0.f;
                const float* xr = xp + (size_t)row * DM; if (row >= MP) xr = xs + (size_t)(row - MP) * DM;
#pragma unroll
                for (int bj = 0; bj < 2; ++bj) { const int col = col0 + bj * HALF; f32x4 v0 = acc[ai][bj][m][0], v1 = acc[ai][bj][m][1];
                    if (row < MT) { v0 = v0 + *(const f32x4*)(xr + col); v1 = v1 + *(const f32x4*)(xr + col + 4); float* y = yrow(out, row) + col; *(f32x4*)y = v0; *(f32x4*)(y + 4) = v1; }
                    ss += (v0[0] * v0[0] + v0[1] * v0[1]) + (v0[2] * v0[2] + v0[3] * v0[3]) + (v1[0] * v1[0] + v1[1] * v1[1]) + (v1[2] * v1[2] + v1[3] * v1[3]);
                    *(u32x4*)(X1B + (size_t)row * DM + col) = pack8(v0, v1); }
                ss += __shfl_xor(ss, 16); ss += __shfl_xor(ss, 32);
                if (fq == 0) SSQ[(size_t)row * 16 + u.pn * 4 + wc] = ss; }
    }
};
struct EpiUp {
    static constexpr bool PERM = true, AFTER_DRAIN = false;
    const float* SSQ; bf16_t* H;
    __device__ __forceinline__ void operator()(const f32x4 (&acc)[2][2][4][2], const Unit& u, int wr, int wc, int fr, int fq) const {
        const int row0 = u.pm * BM + wr * 64 + fr, col0 = u.pn * BM + wc * 32 + 8 * fq;
#pragma unroll
        for (int ai = 0; ai < 2; ++ai)
#pragma unroll
            for (int m = 0; m < 4; ++m) { const size_t row = (size_t)(row0 + ai * HALF + m * 16);
                const f32x4 s0 = *(const f32x4*)(SSQ + row * 16), s1 = *(const f32x4*)(SSQ + row * 16 + 4), s2 = *(const f32x4*)(SSQ + row * 16 + 8), s3 = *(const f32x4*)(SSQ + row * 16 + 12);
                const f32x4 st = (s0 + s1) + (s2 + s3); const float rstd = 1.f / sqrtf(((st[0] + st[1]) + (st[2] + st[3])) * (1.f / DM) + EPS);
#pragma unroll
                for (int bj = 0; bj < 2; ++bj) { f32x4 v0 = acc[ai][bj][m][0] * rstd, v1 = acc[ai][bj][m][1] * rstd;
#pragma unroll
                    for (int i = 0; i < 4; ++i) { const float a = fmaxf(v0[i], 0.f), b = fmaxf(v1[i], 0.f); v0[i] = a * a; v1[i] = b * b; }
                    *(u32x4*)(H + row * DFF + col0 + bj * HALF) = pack8(v0, v1); } }
    }
};
struct EpiDown {
    static constexpr bool PERM = true, AFTER_DRAIN = false;
    float* out;
    __device__ __forceinline__ void operator()(const f32x4 (&acc)[2][2][4][2], const Unit& u, int wr, int wc, int fr, int fq) const {
        const int row0 = u.pm * BM + wr * 64 + fr, col0 = u.pn * BM + wc * 32 + 8 * fq;
#pragma unroll
        for (int ai = 0; ai < 2; ++ai)
#pragma unroll
            for (int m = 0; m < 4; ++m) { const int row = row0 + ai * HALF + m * 16;
                if (row < MT) { float* y = yrow(out, row) + col0;
#pragma unroll
                    for (int bj = 0; bj < 2; ++bj) { *(f32x4*)(y + bj * HALF) = *(const f32x4*)(y + bj * HALF) + acc[ai][bj][m][0]; *(f32x4*)(y + bj * HALF + 4) = *(const f32x4*)(y + bj * HALF + 4) + acc[ai][bj][m][1]; } } }
    }
};
template <class Epi, class Sched, bool ALIGN_EPI = false, bool SP2 = false>
__device__ __forceinline__ void gemm_phase(PG8_LAS unsigned char* lds, const Gemm g, const Sched& S, const Epi& E) {
    const int tid = threadIdx.x, wid = __builtin_amdgcn_readfirstlane(tid >> 6), lane = tid & 63, wr = wid >> 2, wc = wid & 3, fr = lane & 15, fq = lane >> 4;
    const int K = g.K, nt = K / BK;
    unsigned voffA[2], voffB[2];
#pragma unroll
    for (int i = 0; i < 2; ++i) { int R, C; stage_rc(tid * 16 + i * 8192, R, C); const int Rb = Epi::PERM ? ((R & ~31) + perm32(R & 31)) : R;
        voffA[i] = (unsigned)(R * K + C) * 2u; voffB[i] = (unsigned)(Rb * K + C) * 2u; }
    const size_t kstep = (size_t)(BK * 2);
    const size_t hstep = (size_t)HALF * K * 2;
    const size_t tstep = 2 * hstep;
    const unsigned ldsw = (unsigned)wid * 1024u;
    const int aoff = lds_byte(wr * 64 + fr, fq * 8), boff = lds_byte(wc * 32 + fr, fq * 8);
#define PG8_SA(b, h) (((b) * 2 + (h)) * HTB)
#define PG8_SB(b, h) ((4 + (b) * 2 + (h)) * HTB)
#define PG8_STAGE(bufoff, gbase, voff) do { _Pragma("unroll") for (int _i = 0; _i < 2; ++_i) \
        __builtin_amdgcn_global_load_lds((const unsigned*)((const char*)(gbase) + (voff)[_i]), (PG8_LAS unsigned*)(lds + (bufoff) + ldsw + _i * 8192), 16, 0, 0); } while (0)
#define PG8_LDA(dst, b, h) do { _Pragma("unroll") for (int m = 0; m < 4; ++m) _Pragma("unroll") for (int k = 0; k < 2; ++k) dst[m][k] = *(const PG8_LAS bf16x8*)(lds + PG8_SA(b, h) + aoff + m * 2048 + k * 1024); } while (0)
#define PG8_LDB(dst, b, h) do { _Pragma("unroll") for (int n = 0; n < 2; ++n) _Pragma("unroll") for (int k = 0; k < 2; ++k) dst[n][k] = *(const PG8_LAS bf16x8*)(lds + PG8_SB(b, h) + boff + n * 2048 + k * 1024); } while (0)
#define PG8_MMA(ai, bj, At, Bt) do { __builtin_amdgcn_s_setprio(1); _Pragma("unroll") for (int m = 0; m < 4; ++m) _Pragma("unroll") for (int n = 0; n < 2; ++n) _Pragma("unroll") for (int k = 0; k < 2; ++k) \
        acc[ai][bj][m][n] = __builtin_amdgcn_mfma_f32_16x16x32_bf16(Bt[n][k], At[m][k], acc[ai][bj][m][n], 0, 0, 0); __builtin_amdgcn_s_setprio(0); } while (0)
#define PG8_WAIT_V(n) asm volatile("s_waitcnt vmcnt(" #n ")" ::: "memory")
#define PG8_WAIT_L(n) asm volatile("s_waitcnt lgkmcnt(" #n ")" ::: "memory")
#define PG8_BAR __builtin_amdgcn_s_barrier()
#define PG8_SCHED __builtin_amdgcn_sched_barrier(0)
    Unit cur, nxt; int ui = 0;
    if (!S.next(0, cur)) return;
    f32x4 acc[2][2][4][2];
#pragma unroll
    for (int a = 0; a < 2; ++a)
#pragma unroll
        for (int b = 0; b < 2; ++b)
#pragma unroll
            for (int m = 0; m < 4; ++m)
#pragma unroll
                for (int n = 0; n < 2; ++n) acc[a][b][m][n] = (f32x4){0.f, 0.f, 0.f, 0.f};
    bf16x8 At[4][2], B0[2][2], B1[2][2];
    const char* cA = (const char*)g.A + (size_t)cur.pm * tstep; const char* cB = (const char*)g.Bt + (size_t)cur.pn * tstep;
    S.a_ready(cur);
    if constexpr (SP2) {
        PG8_STAGE(PG8_SB(0, 0), cB, voffB); PG8_STAGE(PG8_SB(0, 1), cB + hstep, voffB); PG8_STAGE(PG8_SA(0, 0), cA, voffA); PG8_STAGE(PG8_SA(0, 1), cA + hstep, voffA);
        if (wr == 1) PG8_BAR;
        PG8_WAIT_V(2); PG8_BAR;
        PG8_STAGE(PG8_SB(1, 0), cB + kstep, voffB); PG8_STAGE(PG8_SA(1, 0), cA + kstep, voffA); PG8_STAGE(PG8_SB(1, 1), cB + hstep + kstep, voffB);
        PG8_WAIT_V(6); PG8_BAR;
    } else {
        PG8_STAGE(PG8_SB(0, 0), cB, voffB); PG8_STAGE(PG8_SA(0, 0), cA, voffA); PG8_STAGE(PG8_SB(0, 1), cB + hstep, voffB); PG8_STAGE(PG8_SA(0, 1), cA + hstep, voffA);
        if (wr == 1) PG8_BAR;
        PG8_WAIT_V(4); PG8_BAR;
        PG8_STAGE(PG8_SB(1, 0), cB + kstep, voffB); PG8_STAGE(PG8_SA(1, 0), cA + kstep, voffA); PG8_STAGE(PG8_SB(1, 1), cB + hstep + kstep, voffB);
        PG8_WAIT_V(6); PG8_BAR;
    }
    for (;;) {
        const bool has_next = S.next(ui + 1, nxt);
        const char* nA = has_next ? (const char*)g.A + (size_t)nxt.pm * tstep : cA; const char* nB = has_next ? (const char*)g.Bt + (size_t)nxt.pn * tstep : cB;
        for (int t = 0; t < nt; t += 2) {
            const bool last = (t == nt - 2);
            const char* a1 = cA + (size_t)(t + 1) * kstep;
            const char* a2 = last ? nA : cA + (size_t)(t + 2) * kstep; const char* b2 = last ? nB : cB + (size_t)(t + 2) * kstep;
            const char* a3 = a2 + kstep; const char* b3 = b2 + kstep;
            if (last && has_next) S.a_ready(nxt);
            if constexpr (SP2) {
            PG8_LDB(B0, 0, 0); PG8_LDB(B1, 0, 1); PG8_SCHED; PG8_LDA(At, 0, 0); PG8_STAGE(PG8_SA(1, 1), a1 + hstep, voffA);
            PG8_WAIT_V(8); PG8_WAIT_L(0); PG8_BAR; PG8_MMA(0, 0, At, B0); PG8_MMA(0, 1, At, B1); PG8_BAR; PG8_SCHED;
            PG8_LDA(At, 0, 1); PG8_STAGE(PG8_SB(0, 0), b2, voffB); PG8_STAGE(PG8_SB(0, 1), b2 + hstep, voffB); PG8_STAGE(PG8_SA(0, 0), a2, voffA);
            PG8_WAIT_V(8); PG8_WAIT_L(0); PG8_BAR; PG8_MMA(1, 0, At, B0); PG8_MMA(1, 1, At, B1); PG8_BAR; PG8_SCHED;
            PG8_LDB(B0, 1, 0); PG8_LDB(B1, 1, 1); PG8_SCHED; PG8_LDA(At, 1, 0); PG8_STAGE(PG8_SA(0, 1), a2 + hstep, voffA);
            PG8_WAIT_V(8); PG8_WAIT_L(0); PG8_BAR; PG8_MMA(0, 0, At, B0); PG8_MMA(0, 1, At, B1); PG8_BAR; PG8_SCHED;
            PG8_LDA(At, 1, 1); PG8_STAGE(PG8_SB(1, 0), b3, voffB); PG8_STAGE(PG8_SB(1, 1), b3 + hstep, voffB); PG8_STAGE(PG8_SA(1, 0), a3, voffA);
            PG8_WAIT_V(8); PG8_WAIT_L(0); PG8_BAR; PG8_MMA(1, 0, At, B0); PG8_MMA(1, 1, At, B1); PG8_BAR; PG8_SCHED;
            } else {
            PG8_LDB(B0, 0, 0); PG8_SCHED; PG8_LDA(At, 0, 0); PG8_STAGE(PG8_SA(1, 1), a1 + hstep, voffA);
            PG8_WAIT_L(8); PG8_BAR; PG8_WAIT_L(0); PG8_MMA(0, 0, At, B0); PG8_BAR; PG8_SCHED;
            PG8_LDB(B1, 0, 1); PG8_STAGE(PG8_SB(0, 0), b2, voffB);
            PG8_BAR; PG8_WAIT_L(0); PG8_MMA(0, 1, At, B1); PG8_BAR;
            PG8_LDA(At, 0, 1); PG8_STAGE(PG8_SA(0, 0), a2, voffA);
            PG8_BAR; PG8_WAIT_L(0); PG8_MMA(1, 0, At, B0); PG8_BAR; PG8_SCHED;
            PG8_STAGE(PG8_SB(0, 1), b2 + hstep, voffB);
            PG8_WAIT_V(6); PG8_BAR; PG8_MMA(1, 1, At, B1); PG8_BAR;
            PG8_LDB(B0, 1, 0); PG8_SCHED; PG8_LDA(At, 1, 0); PG8_STAGE(PG8_SA(0, 1), a2 + hstep, voffA);
            PG8_WAIT_L(8); PG8_BAR; PG8_WAIT_L(0); PG8_MMA(0, 0, At, B0); PG8_BAR; PG8_SCHED;
            PG8_LDB(B1, 1, 1); PG8_STAGE(PG8_SB(1, 0), b3, voffB);
            PG8_BAR; PG8_WAIT_L(0); PG8_MMA(0, 1, At, B1); PG8_BAR;
            PG8_LDA(At, 1, 1); PG8_STAGE(PG8_SA(1, 0), a3, voffA);
            PG8_BAR; PG8_WAIT_L(0); PG8_MMA(1, 0, At, B0); PG8_BAR; PG8_SCHED;
            PG8_STAGE(PG8_SB(1, 1), b3 + hstep, voffB);
            PG8_WAIT_V(6); PG8_BAR; PG8_MMA(1, 1, At, B1); PG8_BAR;
            }
        }
        if constexpr (ALIGN_EPI) { if (wr == 0) PG8_BAR; }
        if constexpr (!Epi::AFTER_DRAIN) { E(acc, cur, wr, wc, fr, fq); S.done(cur); }
        if (!has_next) break;
#pragma unroll
        for (int a = 0; a < 2; ++a)
#pragma unroll
            for (int b = 0; b < 2; ++b)
#pragma unroll
                for (int m = 0; m < 4; ++m)
#pragma unroll
                    for (int n = 0; n < 2; ++n) acc[a][b][m][n] = (f32x4){0.f, 0.f, 0.f, 0.f};
        cur = nxt; cA = nA; cB = nB; ++ui;
        if constexpr (ALIGN_EPI) { if (wr == 1) PG8_BAR; }
    }
    PG8_WAIT_V(0);
    if constexpr (!ALIGN_EPI) { if (wr == 0) PG8_BAR; }
    PG8_BAR;
    if constexpr (Epi::AFTER_DRAIN) { E.fused(acc, cur, wr, wc, fr, fq, lds, wid, lane); S.done(cur); }
#undef PG8_SA
#undef PG8_SB
#undef PG8_STAGE
#undef PG8_LDA
#undef PG8_LDB
#undef PG8_MMA
#undef PG8_WAIT_V
#undef PG8_WAIT_L
#undef PG8_BAR
#undef PG8_SCHED
}
}
#define XB_TMO      128
#define XB_XCNT(j)  (256  + 64 * (j))
#define XB_XSUB(j)  (1280 + 64 * (j))
#define XB_XGEN(j)  (2304 + 64 * (j))
#define XB_TOP      3328
#define XB_TOPGEN   3392
#define XCD_BAR_WORDS 3456
#define XB_SPIN_CAP (1u << 18)

__device__ __forceinline__ unsigned xb_ld(unsigned* p)              { return __hip_atomic_load(p, __ATOMIC_RELAXED, __HIP_MEMORY_SCOPE_AGENT); }
__device__ __forceinline__ unsigned xb_add(unsigned* p, unsigned v) { return __hip_atomic_fetch_add(p, v, __ATOMIC_RELAXED, __HIP_MEMORY_SCOPE_AGENT); }
__device__ __forceinline__ unsigned xb_xcc_id() { return (unsigned)__builtin_amdgcn_s_getreg((3 << 11) | 20) & 0xFu; }
#define XB_SPIN(cond, bar) do { unsigned _sp = 0; while (cond) { __builtin_amdgcn_s_sleep(1); \
    if ((++_sp & 255u) == 0u) { if (xb_ld(&(bar)[XB_TMO])) break; if (_sp > XB_SPIN_CAP) { atomicAdd(&(bar)[XB_TMO], 1u); break; } } } } while (0)

struct XcdBarrier {
    unsigned* bar; unsigned x;
    volatile LAS unsigned* st;
};

__device__ __forceinline__ XcdBarrier xcd_barrier_post(unsigned* bar, volatile LAS unsigned* st) {
    XcdBarrier b; b.bar = bar; b.x = xb_xcc_id(); b.st = st;
    if (threadIdx.x == 0) (void)xb_add(&bar[XB_XCNT(b.x)], 1u);
    return b;
}
__device__ __forceinline__ void xcd_barrier_complete(unsigned* bar, unsigned x, unsigned& nloc, unsigned& nx) {
    const unsigned G = gridDim.x * gridDim.y * gridDim.z;
    unsigned sum, cnt, mine, sp = 0u;
    for (;;) {
        sum = 0u; cnt = 0u; mine = 0u;
#pragma unroll
        for (unsigned j = 0; j < 16; ++j) { const unsigned c = xb_ld(&bar[XB_XCNT(j)]); sum += c; cnt += (c > 0u) ? 1u : 0u; mine = (j == x) ? c : mine; }
        if (sum == G) break;
        __builtin_amdgcn_s_sleep(1);
        if ((++sp & 255u) == 0u) { if (xb_ld(&bar[XB_TMO])) break; if (sp > XB_SPIN_CAP) { atomicAdd(&bar[XB_TMO], 1u); break; } }
    }
    nloc = mine > 0u ? mine : 1u; nx = cnt > 0u ? cnt : 1u;
}

__device__ __forceinline__ void xcd_barrier(const XcdBarrier& b) {
    asm volatile("s_waitcnt vmcnt(0)" ::: "memory");
    __syncthreads();
    if (threadIdx.x == 0) {
        unsigned* bar = b.bar;
        __builtin_amdgcn_s_waitcnt(0);
        unsigned nloc = b.st[0], nx = b.st[1];
        if (nloc == 0u) { xcd_barrier_complete(bar, b.x, nloc, nx); b.st[0] = nloc; b.st[1] = nx; }
        const unsigned old = xb_add(&bar[XB_XSUB(b.x)], 1u);
        const unsigned gen = old / nloc;
        if (old + 1u == (gen + 1u) * nloc) {
            __builtin_amdgcn_fence(__ATOMIC_RELEASE, "agent");
            asm volatile("s_waitcnt vmcnt(0)" ::: "memory");
            const unsigned og = xb_add(&bar[XB_TOP], 1u);
            const unsigned tg = og / nx;
            if (og + 1u == (tg + 1u) * nx) xb_add(&bar[XB_TOPGEN], 1u);
            else XB_SPIN(xb_ld(&bar[XB_TOPGEN]) == tg, bar);
            __builtin_amdgcn_fence(__ATOMIC_ACQUIRE, "agent");
            xb_add(&bar[XB_XGEN(b.x)], 1u);
            asm volatile("s_waitcnt vmcnt(0)" ::: "memory");
        } else {
            XB_SPIN(xb_ld(&bar[XB_XGEN(b.x)]) == gen, bar);
            __builtin_amdgcn_fence(__ATOMIC_ACQUIRE, "agent");
            asm volatile("s_waitcnt vmcnt(0)" ::: "memory");
        }
    }
    __syncthreads();
}
struct Frame {
    LAS unsigned char* lds; volatile LAS unsigned* MISC; gu32* ctl;
    int tid, lane, wave, vcu, G;
    const float* in[N_IN]; float* out; unsigned char* ws;
};
#define WSP(T, off) ((T*)(F.ws + (off)))
typedef __attribute__((address_space(3))) float lds_f;

template <class Map>
__device__ __forceinline__ void tr_item(const float* W, int ldw, int K, bf16* WT, LAS float* scr, int item, int nblk, int lane, const Map& map, const float* kscale) {
    const int kb = item / nblk, nb = item % nblk, k0 = 64 * kb, n0 = 32 * nb;
    const int sc = map(n0 + (lane & 31));
#pragma unroll 8
    for (int i = 0; i < 32; ++i) { const int kk = 2 * i + (lane >> 5); float v = sc >= 0 ? W[(size_t)(k0 + kk) * ldw + sc] : 0.f; if (kscale) v *= kscale[k0 + kk]; scr[kk * 33 + (lane & 31)] = v; }
    LDS_WAIT(); asm volatile("" ::: "memory");
    const int c = lane & 7;
#pragma unroll
    for (int j = 0; j < 4; ++j) { const int n = (lane >> 3) + 8 * j; const LAS float* s = scr + (8 * c) * 33 + n;
        v4u o; o.x = pk2(s[0 * 33], s[1 * 33]); o.y = pk2(s[2 * 33], s[3 * 33]); o.z = pk2(s[4 * 33], s[5 * 33]); o.w = pk2(s[6 * 33], s[7 * 33]);
        *(GAS v4u*)(WT + (size_t)(n0 + n) * K + k0 + 8 * c) = o; }
    LDS_WAIT(); asm volatile("" ::: "memory");
}
struct MapId { __device__ __forceinline__ int operator()(int j) const { return j; } };
struct MapWin { __device__ __forceinline__ int operator()(int j) const { return win_map(j); } };

__device__ __forceinline__ void rms_row_to_bf16(int lane, const float* xrow, const float* g, bf16* orow) {
    const GAS f32x4* xr = (const GAS f32x4*)xrow + lane; const GAS f32x4* gr = (const GAS f32x4*)g + lane;
    f32x4 v[4]; float s = 0.f;
#pragma unroll
    for (int j = 0; j < 4; ++j) { v[j] = xr[64 * j]; s += (v[j].x * v[j].x + v[j].y * v[j].y) + (v[j].z * v[j].z + v[j].w * v[j].w); }
    const float rstd = 1.f / sqrtf(wave_sum(s) * (1.f / DM) + EPS);
    GAS unsigned long long* o8 = (GAS unsigned long long*)orow + lane;
#pragma unroll
    for (int j = 0; j < 4; ++j) { const f32x4 gg = gr[64 * j]; o8[64 * j] = (unsigned long long)pk2(v[j].x * rstd * gg.x, v[j].y * rstd * gg.y) | ((unsigned long long)pk2(v[j].z * rstd * gg.z, v[j].w * rstd * gg.w) << 32); }
}

__device__ __forceinline__ void p0_prologue(Frame& F) {
    LAS float* scr = (LAS float*)(F.lds + F.wave * 16384);
    const int gw = F.vcu * NWAVES + F.wave, NGW = F.G * NWAVES;
    constexpr int I_IN = 16 * (NIN / 32), I_BA = 8 * 32, I_BB = 8 * 32, I_O = 16 * 32, I_UP = 16 * (DFF / 32), I_DN = 64 * 32, I_C = 16 * 2;
    constexpr int NITEMS = I_IN + I_BA + I_BB + I_O + I_UP + I_DN + 4 * I_C;
    for (int it = gw; it < NITEMS; it += NGW) {
        int r = it;
        if (r < I_IN) { tr_item(F.in[I_WIN], INC, DM, WSP(bf16, WS_WINT), scr, r, NIN / 32, F.lane, MapWin{}, nullptr); continue; } r -= I_IN;
        if (r < I_BA) { tr_item(F.in[I_WBR], DM, 512, WSP(bf16, WS_WBA), scr, r, 32, F.lane, MapId{}, nullptr); continue; } r -= I_BA;
        if (r < I_BB) { tr_item(F.in[I_WBR] + (size_t)512 * DM, DM, 512, WSP(bf16, WS_WBB), scr, r, 32, F.lane, MapId{}, nullptr); continue; } r -= I_BB;
        if (r < I_O) { tr_item(F.in[I_WOUT], DM, DM, WSP(bf16, WS_WOT), scr, r, 32, F.lane, MapId{}, nullptr); continue; } r -= I_O;
        if (r < I_UP) { tr_item(F.in[I_WUP], DFF, DM, WSP(bf16, WS_WUP), scr, r, DFF / 32, F.lane, MapId{}, F.in[I_G2]); continue; } r -= I_UP;
        if (r < I_DN) { tr_item(F.in[I_WDN], DM, DFF, WSP(bf16, WS_WDN), scr, r, 32, F.lane, MapId{}, nullptr); continue; } r -= I_DN;
        { const int which = r / I_C, rr = r % I_C; const float* w1 = F.in[(which >> 1) ? I_WCV1 : I_WCK1] + (size_t)(which & 1) * 1024 * 64;
          tr_item(w1, 64, 1024, WSP(bf16, (which >> 1) ? WS_WC1V : WS_WC1K) + (size_t)(which & 1) * 64 * 1024, scr, rr, 2, F.lane, MapId{}, nullptr); }
    }
    for (int m = gw; m < MPAD; m += NGW) {
        bf16* o = WSP(bf16, WS_XN) + (size_t)m * DM;
        if (m < MP) rms_row_to_bf16(F.lane, F.in[I_XP] + (size_t)m * DM, F.in[I_G1], o);
        else if (m < MT) rms_row_to_bf16(F.lane, F.in[I_XS] + (size_t)(m - MP) * DM, F.in[I_G1], o);
        else { GAS v4u* z = (GAS v4u*)o + F.lane; z[0] = (v4u){0, 0, 0, 0}; z[64] = (v4u){0, 0, 0, 0};
               GAS v4u* za = (GAS v4u*)(WSP(bf16, WS_OA) + (size_t)m * 512) + F.lane; za[0] = (v4u){0, 0, 0, 0};
               GAS v4u* zb = (GAS v4u*)(WSP(bf16, WS_OB) + (size_t)m * 512) + F.lane; zb[0] = (v4u){0, 0, 0, 0}; }
    }
    const int gt = F.vcu * (NWAVES * 64) + F.tid, NGT = F.G * NWAVES * 64;
    for (int e = gt; e < 8196 * 8; e += NGT) {
        const int pidx = e >> 3, i = e & 7; const float pos = (float)(pidx < SEQ ? pidx : PAST + pidx - SEQ);
        const float inv = powf(500000.0f, -(float)(2 * i) / 16.0f); const float ang = pos * inv;
        WSP(float, WS_ROPE)[pidx * 16 + i] = cosf(ang); WSP(float, WS_ROPE)[pidx * 16 + 8 + i] = sinf(ang);
    }
    for (int e = gt; e < 8 * 128 * 128; e += NGT) {
        const int g = e >> 14, p = (e >> 7) & 127, r = e & 127; const float* ws = F.in[I_WS] + (size_t)g * 128 * 128;
        WSP(bf16, WS_WSP)[e] = (bf16)(r <= p ? f2bf(ws[p * 128 + r]) : 0u);
        WSP(bf16, WS_WSS)[e] = (bf16)(((p >> 2) == (r >> 2) && (r & 3) <= (p & 3)) ? f2bf(ws[(p & 3) * 128 + (r & 3)]) : 0u);
    }
    if (gt < 64) WSP(float, WS_GAINS)[gt] = F.in[I_GQ][gt]; else if (gt < 128) WSP(float, WS_GAINS)[gt] = F.in[I_GKS][gt - 64]; else if (gt < 192) WSP(float, WS_GAINS)[gt] = F.in[I_GKW][gt - 128];
    for (int it = gw; it < 64; it += NGW) { const int which = it >> 5, part = it & 31; const float* pe = F.in[which ? I_PEV : I_PEK]; const float* w1 = F.in[which ? I_WCV1 : I_WCK1];
        float s = 0.f;
#pragma unroll 16
        for (int i = 0; i < 64; ++i) { const int ii = part * 64 + i; s += pe[ii] * w1[(size_t)ii * 64 + F.lane]; }
        WSP(float, WS_BPART)[(which * 32 + part) * 64 + F.lane] = s; }
}

constexpr int CP_PITCH = 2064;
constexpr int CP_TASKS = DECB * NPAGES + 128;
__device__ __forceinline__ void compress_stage1(Frame& F) {
    const int lane = F.lane, w = F.wave, fr = lane & 15, fq = lane >> 4, tid = F.tid;
    LAS unsigned char* At = F.lds;
    for (int which = 0; which < 2; ++which) {
        const bf16* Wc = WSP(bf16, which ? WS_WC1V : WS_WC1K) + (size_t)(16 * w + fr) * 1024 + 8 * fq;
        bf16x8 wf[32];
#pragma unroll
        for (int ks = 0; ks < 32; ++ks) wf[ks] = *(const bf16x8*)(Wc + 32 * ks);
        const float* cache = F.in[which ? I_CVC : I_CKC]; const int* pt = (const int*)F.in[I_PT];
        f32x4 pf[8]; v4u pb[4];
#define CP_FETCH(task_) do { const int tk_ = (task_); if (tk_ < DECB * NPAGES) { const f32x4* src = (const f32x4*)(cache + (size_t)pt[tk_] * (128 * 128)); \
            _Pragma("unroll") for (int i = 0; i < 8; ++i) pf[i] = src[i * 512 + tid]; } \
          else if (tk_ < CP_TASKS) { const v4u* src = (const v4u*)(WSP(bf16, which ? WS_VCA : WS_KCA) + (size_t)(tk_ - DECB * NPAGES) * 16 * 1024); \
            _Pragma("unroll") for (int i = 0; i < 4; ++i) pb[i] = src[i * 512 + tid]; } } while (0)
        CP_FETCH((int)blockIdx.x);
        for (int task = blockIdx.x; task < CP_TASKS; task += F.G) {
            __syncthreads();
            float* fs;
            if (task < DECB * NPAGES) {
#pragma unroll
                for (int i = 0; i < 8; ++i) { const int q = i * 512 + tid; const f32x4 v = pf[i]; const int tok = q >> 5, rem = q & 31, kv = rem >> 4, d4 = rem & 15;
                    v2u o; o.x = pk2(v.x, v.y); o.y = pk2(v.z, v.w);
                    *(LAS v2u*)(At + ((tok >> 4) * 2 + kv) * CP_PITCH + ((tok & 15) * 64 + 4 * d4) * 2) = o; }
                fs = WSP(float, which ? WS_FSSV : WS_FSSK) + (size_t)task * 16 * 128;
            } else {
                const int pg = task - DECB * NPAGES;
#pragma unroll
                for (int i = 0; i < 4; ++i) { const int q = i * 512 + tid; const int row = q >> 7, c16 = q & 127;
                    *(LAS v4u*)(At + row * CP_PITCH + c16 * 16) = pb[i]; }
                fs = WSP(float, which ? WS_FSPV : WS_FSPK) + (size_t)pg * 16 * 128;
            }
            __syncthreads();
            CP_FETCH(task + F.G);
            f32x4 acc = {0.f, 0.f, 0.f, 0.f};
            const LAS unsigned char* ap = At + fr * CP_PITCH + fq * 16;
#pragma unroll
            for (int ks = 0; ks < 32; ++ks) { const bf16x8 a = *(const LAS bf16x8*)(ap + ks * 64); acc = __builtin_amdgcn_mfma_f32_16x16x32_bf16(wf[ks], a, acc, 0, 0, 0); }
            *(f32x4*)(fs + (size_t)fr * 128 + 16 * w + 4 * fq) = acc;
        }
#undef CP_FETCH
    }
    __syncthreads();
}

__device__ __forceinline__ void compress_stage2(Frame& F) {
    const int lane = F.lane, fr = lane & 15, fq = lane >> 4, gw = F.vcu * NWAVES + F.wave, NGW = F.G * NWAVES;
    constexpr int NRS = DECB * NCS * 2, NRP = NBAT * NCP * 2, NGRP = (NRS + NRP) / 16;
    LAS float* biasL = (LAS float*)F.lds;
    __syncthreads();
    if (F.tid < 128) { float s = 0.f;
#pragma unroll 4
        for (int p = 0; p < 32; ++p) s += WSP(float, WS_BPART)[((F.tid >> 6) * 32 + p) * 64 + (F.tid & 63)];
        biasL[F.tid] = s; }
    __syncthreads();
    for (int which = 0; which < 2; ++which) {
        float bias[2][8]; const float* w2 = F.in[which ? I_WCV2 : I_WCK2]; bf16x8 wfr[4][2];
#pragma unroll
        for (int ks = 0; ks < 2; ++ks)
#pragma unroll
            for (int j = 0; j < 8; ++j) bias[ks][j] = biasL[which * 64 + 32 * ks + 8 * fq + j];
#pragma unroll
        for (int nb = 0; nb < 4; ++nb)
#pragma unroll
            for (int ks = 0; ks < 2; ++ks) { unsigned short t[8];
#pragma unroll
                for (int j = 0; j < 8; ++j) t[j] = (unsigned short)f2bf(w2[(32 * ks + 8 * fq + j) * 64 + 16 * nb + fr]);
                wfr[nb][ks] = (bf16x8){(short)t[0], (short)t[1], (short)t[2], (short)t[3], (short)t[4], (short)t[5], (short)t[6], (short)t[7]}; }
        f32x4 gk[4];
#pragma unroll
        for (int nb = 0; nb < 4; ++nb) { const float g = F.in[I_GKC][16 * nb + fr]; gk[nb] = (f32x4){g, g, g, g}; }
        for (int grp = gw; grp < NGRP; grp += NGW) {
            const bool smp = grp < NRS / 16; const int rr0 = smp ? grp * 16 : grp * 16 - NRS; const int nr = smp ? NRS : NRP, nc = smp ? NCS : NCP;
            const float* fs = WSP(float, smp ? (which ? WS_FSSV : WS_FSSK) : (which ? WS_FSPV : WS_FSPK));
            const int rr = rr0 + fr; const int rr2 = rr + 2 < nr ? rr + 2 : nr - 1;
            bf16x8 af[2];
#pragma unroll
            for (int ks = 0; ks < 2; ++ks) { const int k0 = 32 * ks + 8 * fq;
                const f32x4 a0 = *(const f32x4*)(fs + (size_t)rr * 128 + k0), a1 = *(const f32x4*)(fs + (size_t)rr * 128 + k0 + 4), b0 = *(const f32x4*)(fs + (size_t)rr2 * 128 + 64 + k0), b1 = *(const f32x4*)(fs + (size_t)rr2 * 128 + 64 + k0 + 4);
                float h[8];
#pragma unroll
                for (int j = 0; j < 4; ++j) { h[j] = gelu_tanh(a0[j] + b0[j] + bias[ks][j]); h[4 + j] = gelu_tanh(a1[j] + b1[j] + bias[ks][4 + j]); }
                v4u pk; pk.x = pk2(h[0], h[1]); pk.y = pk2(h[2], h[3]); pk.z = pk2(h[4], h[5]); pk.w = pk2(h[6], h[7]); af[ks] = __builtin_bit_cast(bf16x8, pk); }
            f32x4 acc[4];
#pragma unroll
            for (int nb = 0; nb < 4; ++nb) { acc[nb] = __builtin_amdgcn_mfma_f32_16x16x32_bf16(af[0], wfr[nb][0], (f32x4){0.f, 0.f, 0.f, 0.f}, 0, 0, 0); acc[nb] = __builtin_amdgcn_mfma_f32_16x16x32_bf16(af[1], wfr[nb][1], acc[nb], 0, 0, 0); }
            if (which == 0) {
                f32x4 ss = acc[0] * acc[0] + acc[1] * acc[1] + acc[2] * acc[2] + acc[3] * acc[3];
#pragma unroll
                for (int r = 0; r < 4; ++r) { float v = ss[r]; v += __shfl_xor(v, 1); v += __shfl_xor(v, 2); v += __shfl_xor(v, 4); v += __shfl_xor(v, 8); ss[r] = 1.f / sqrtf(v * (1.f / 64.f) + EPS); }
#pragma unroll
                for (int nb = 0; nb < 4; ++nb) acc[nb] = acc[nb] * ss * gk[nb];
            }
            bf16* dstb = WSP(bf16, smp ? (which ? WS_VCS : WS_KCS) : (which ? WS_VCP : WS_KCP));
#pragma unroll
            for (int r = 0; r < 4; ++r) { const int row = rr0 + 4 * fq + r; const int kv = row & 1, bc = row >> 1; const int b = bc / nc, c = bc % nc; const bool zero = (c == nc - 1);
                bf16* dst = dstb + ((size_t)(b * 2 + kv) * nc + c) * 64 + fr;
#pragma unroll
                for (int nb = 0; nb < 4; ++nb) dst[16 * nb] = zero ? (bf16)0 : (bf16)f2bf(acc[nb][r]); }
        }
    }
}

constexpr int VT_PITCH = 136;
constexpr int GMLP_UNITS = 129 * 2;
__device__ __forceinline__ void gmlp_unit(Frame& F, int unit) {
    const int lane = F.lane, w = F.wave, r32 = lane & 31, hi = lane >> 5, n = unit >> 1, hf = unit & 1;
    LAS bf16* vT = (LAS bf16*)F.lds;
    const int m0 = n * 128; const bool smp = (n == 128);
    __syncthreads();
    {
        const f32x4 g0 = *(const f32x4*)(F.in[I_LNG] + 8 * lane), g1 = *(const f32x4*)(F.in[I_LNG] + 8 * lane + 4), b0 = *(const f32x4*)(F.in[I_LNB] + 8 * lane), b1 = *(const f32x4*)(F.in[I_LNB] + 8 * lane + 4);
        v4u raw[16];
#pragma unroll
        for (int i = 0; i < 16; ++i) raw[i] = *(const v4u*)(WSP(bf16, WS_GV) + (size_t)(m0 + 16 * w + i) * 512 + 8 * lane);
        const bool mine = (lane >> 5) == hf; const int cl = 8 * (lane & 31);
#pragma unroll
        for (int i = 0; i < 16; ++i) { const int r = 16 * w + i;
            float x[8] = {bflo(raw[i].x), bfhi(raw[i].x), bflo(raw[i].y), bfhi(raw[i].y), bflo(raw[i].z), bfhi(raw[i].z), bflo(raw[i].w), bfhi(raw[i].w)};
            float s = 0.f;
#pragma unroll
            for (int k = 0; k < 8; ++k) s += x[k];
            const float mean = wave_sum(s) * (1.f / 512.f); float s2 = 0.f;
#pragma unroll
            for (int k = 0; k < 8; ++k) { x[k] -= mean; s2 += x[k] * x[k]; }
            const float rstd = 1.f / sqrtf(wave_sum(s2) * (1.f / 512.f) + EPS);
            f32x4 y0 = {x[0] * rstd * g0.x + b0.x, x[1] * rstd * g0.y + b0.y, x[2] * rstd * g0.z + b0.z, x[3] * rstd * g0.w + b0.w};
            f32x4 y1 = {x[4] * rstd * g1.x + b1.x, x[5] * rstd * g1.y + b1.y, x[6] * rstd * g1.z + b1.z, x[7] * rstd * g1.w + b1.w};
            if (mine) {
                float* so = nullptr;
                if (smp) so = F.out + O_SVA + (size_t)r * 512; else if ((n & 63) == 63) so = F.out + O_PVA + ((size_t)(n >> 6) * 128 + r) * 512;
                if (so) { *(f32x4*)(so + 8 * lane) = y0; *(f32x4*)(so + 8 * lane + 4) = y1; }
#pragma unroll
                for (int k = 0; k < 4; ++k) { vT[(cl + k) * VT_PITCH + r] = (bf16)f2bf(y0[k]); vT[(cl + 4 + k) * VT_PITCH + r] = (bf16)f2bf(y1[k]); } }
        }
    }
    __syncthreads();
    {
        const int gl = w & 3, g = 4 * hf + gl; const bf16* Wg = WSP(bf16, smp ? WS_WSS : WS_WSP) + (size_t)g * 128 * 128; const float* bs = F.in[I_BS] + g * 128;
#pragma unroll
        for (int ii = 0; ii < 2; ++ii) { const int ib = (w < 4) ? (ii ? 3 : 0) : (ii ? 2 : 1);
            bf16x8 a[8];
#pragma unroll
            for (int kb = 0; kb < 8; ++kb) a[kb] = *(const bf16x8*)(Wg + (size_t)(32 * ib + r32) * 128 + 16 * kb + 8 * hi);
            unsigned short uu[2][16];
#pragma unroll
            for (int r = 0; r < 16; ++r) { const int p = 32 * ib + (r & 3) + 8 * (r >> 2) + 4 * hi; const bf16* up = WSP(bf16, WS_U) + (size_t)(m0 + p) * 512 + 64 * g + r32; uu[0][r] = up[0]; uu[1][r] = up[32]; }
            f32x16 acc0 = {}, acc1 = {};
#pragma unroll
            for (int kb = 0; kb < 8; ++kb) {
                const bf16x8 b0 = *(const LAS bf16x8*)(vT + (64 * gl + r32) * VT_PITCH + 16 * kb + 8 * hi);
                const bf16x8 b1 = *(const LAS bf16x8*)(vT + (64 * gl + 32 + r32) * VT_PITCH + 16 * kb + 8 * hi);
                acc0 = __builtin_amdgcn_mfma_f32_32x32x16_bf16(a[kb], b0, acc0, 0, 0, 0); acc1 = __builtin_amdgcn_mfma_f32_32x32x16_bf16(a[kb], b1, acc1, 0, 0, 0);
            }
#pragma unroll
            for (int r = 0; r < 16; ++r) { const int p = 32 * ib + (r & 3) + 8 * (r >> 2) + 4 * hi; const size_t m = (size_t)(m0 + p);
                const float bias = bs[smp ? (p & 3) : p]; bf16* op = WSP(bf16, WS_OA) + m * 512 + 64 * g + r32;
                op[0] = (bf16)f2bf(bf2f(uu[0][r]) * (acc0[r] + bias)); op[32] = (bf16)f2bf(bf2f(uu[1][r]) * (acc1[r] + bias)); }
        }
    }
}

constexpr size_t WS_SSQS_DUMMY = 0;
template <class Epi>
__device__ __forceinline__ void skinny_gemm(const bf16* A, const bf16* Bt, int N, int K, int G, int first, const Epi& E) {
    const int lane = threadIdx.x & 63, w = __builtin_amdgcn_readfirstlane(threadIdx.x >> 6), fr = lane & 15, fq = lane >> 4;
    const bf16* ap = A + (size_t)(16 * w + fr) * K + 8 * fq;
    for (int cb = first; cb < N / 16; cb += G) {
        const bf16* bp = Bt + (size_t)(16 * cb + fr) * K + 8 * fq;
        f32x4 acc = {0.f, 0.f, 0.f, 0.f};
#pragma unroll 8
        for (int ks = 0; ks < K / 32; ++ks) { const bf16x8 a = *(const bf16x8*)(ap + 32 * ks); const bf16x8 b = *(const bf16x8*)(bp + 32 * ks); acc = __builtin_amdgcn_mfma_f32_16x16x32_bf16(b, a, acc, 0, 0, 0); }
        E(16 * w + fr, 16 * cb + 4 * fq, acc, fq);
    }
}
__device__ __forceinline__ v2u pack4(const f32x4 v) { v2u o; o.x = pk2(v.x, v.y); o.y = pk2(v.z, v.w); return o; }
__device__ __forceinline__ f32x4 unpack4(const v2u w) { return (f32x4){bflo(w.x), bfhi(w.x), bflo(w.y), bfhi(w.y)}; }
struct SkT1 { unsigned char* ws; __device__ __forceinline__ void operator()(int r, int c, const f32x4 acc, int) const { *(v2u*)((bf16*)(ws + WS_T1) + (size_t)(MP + r) * DM + c) = pack4(acc); } };
struct SkMerge { unsigned char* ws; __device__ __forceinline__ void operator()(int r, int c, const f32x4 acc, int) const { const size_t row = MP + r;
    const f32x4 t = unpack4(*(const v2u*)((const bf16*)(ws + WS_T1) + row * DM + c)), ga = unpack4(*(const v2u*)((const bf16*)(ws + WS_SG) + row * 2048 + c)), gb = unpack4(*(const v2u*)((const bf16*)(ws + WS_SG) + row * 2048 + 1024 + c));
    *(v2u*)((bf16*)(ws + WS_MG) + row * DM + c) = pack4(ga * t + gb * acc); } };
struct SkOut { unsigned char* ws; const float* xs; float* out; __device__ __forceinline__ void operator()(int r, int c, const f32x4 acc, int fq) const {
    const f32x4 v = acc + *(const f32x4*)(xs + (size_t)r * DM + c); *(f32x4*)(out + O_YS + (size_t)r * DM + c) = v; *(v2u*)((bf16*)(ws + WS_X1B) + (size_t)(MP + r) * DM + c) = pack4(v);
    float ss = (v.x * v.x + v.y * v.y) + (v.z * v.z + v.w * v.w); ss += __shfl_xor(ss, 16); ss += __shfl_xor(ss, 32);
    if (fq == 0) ((float*)(ws + WS_SSQS))[r * 64 + (c >> 4)] = ss; } };
struct SkUp { unsigned char* ws; __device__ __forceinline__ void operator()(int r, int c, const f32x4 acc, int) const {
    const f32x4* sp = (const f32x4*)((const float*)(ws + WS_SSQS) + r * 64); f32x4 s = sp[0];
#pragma unroll
    for (int i = 1; i < 16; ++i) s = s + sp[i];
    const float rstd = 1.f / sqrtf(((s.x + s.y) + (s.z + s.w)) * (1.f / DM) + EPS); f32x4 v = acc * rstd;
#pragma unroll
    for (int i = 0; i < 4; ++i) { const float a = fmaxf(v[i], 0.f); v[i] = a * a; }
    *(v2u*)((bf16*)(ws + WS_H) + (size_t)(MP + r) * DFF + c) = pack4(v); } };
struct SkDown { float* out; __device__ __forceinline__ void operator()(int r, int c, const f32x4 acc, int) const { float* y = out + O_YS + (size_t)r * DM + c; *(f32x4*)y = *(const f32x4*)y + acc; } };

namespace att {
using s16x4 = __attribute__((ext_vector_type(4))) short;
using u32x4 = __attribute__((ext_vector_type(4))) unsigned;
constexpr int NW = 8, KVBLK = 64;
constexpr int NSLOT = 3, SLOTB = 8192;
constexpr int LDS_K = 0, LDS_V = NSLOT * SLOTB, LDS_WS = 2 * NSLOT * SLOTB, LDS_Q = LDS_WS + NW * 64 * 4, LDS_SELB = LDS_Q + NW * 4096, LDS_END = LDS_SELB + NW * 8 * 16;
constexpr int BLKS_PITCH = 132;
static_assert(NW * 8 * BLKS_PITCH * 4 <= LDS_WS, "block scores fit the ring region");
#define SBAR() __builtin_amdgcn_sched_barrier(0)
__device__ __forceinline__ int crow(int r, int hi) { return (r & 3) + 8 * (r >> 2) + 4 * hi; }
__device__ __forceinline__ void glds16(const void* gsrc, unsigned lds_dst) { unsigned keep;
  asm volatile("s_mov_b32 %0, m0\n\ts_mov_b32 m0, %2\n\ts_nop 0\n\tglobal_load_lds_dwordx4 %1, off\n\ts_mov_b32 m0, %0" : "=&s"(keep) : "v"(gsrc), "s"(lds_dst) : "memory"); }
__device__ __forceinline__ float max3f(float a, float b, float c) { float r; asm("v_max3_f32 %0, %1, %2, %3" : "=v"(r) : "v"(a), "v"(b), "v"(c)); return r; }
__device__ __forceinline__ float max2f(float a, float b) { float r; asm("v_max_f32_e32 %0, %1, %2" : "=v"(r) : "v"(a), "v"(b)); return r; }
__device__ __forceinline__ float fadd_s(float a, float b) { float r; asm("v_add_f32_e32 %0, %1, %2" : "=v"(r) : "v"(a), "v"(b)); return r; }
__device__ __forceinline__ float fsub_s(float a, float b) { float r; asm("v_sub_f32_e32 %0, %1, %2" : "=v"(r) : "v"(a), "v"(b)); return r; }
typedef float f32x2_t __attribute__((ext_vector_type(2))); typedef __bf16 bf16x2_t __attribute__((ext_vector_type(2)));
__device__ __forceinline__ unsigned cvtpk_s(float lo, float hi) { f32x2_t v = {lo, hi}; bf16x2_t b = __builtin_convertvector(v, bf16x2_t); return __builtin_bit_cast(unsigned, b); }
#define WAIT_BAR(N) asm volatile("s_waitcnt vmcnt(" #N ") lgkmcnt(0)\n\ts_barrier" ::: "memory")

typedef __attribute__((address_space(3))) const char* lds_cptr;
__device__ __forceinline__ void qkt(f32x16& p0, f32x16& p1, const char* Kslot, lds_cptr qp, int r32, int hi) { const f32x16 negm = f32x16{}; bf16x8 qr[4];
  _Pragma("unroll") for (int d0 = 0; d0 < 4; ++d0) qr[d0] = *(const __attribute__((address_space(3))) bf16x8*)(qp + d0 * 1024);
  const char* kb = Kslot + hi * 1024 + r32 * 16;
#pragma unroll
  for (int d0 = 0; d0 < 4; ++d0) {
    const bf16x8 b0 = *reinterpret_cast<const bf16x8*>(kb + d0 * 2048);
    const bf16x8 b1 = *reinterpret_cast<const bf16x8*>(kb + d0 * 2048 + 512);
    if (d0 == 0) { p0 = __builtin_amdgcn_mfma_f32_32x32x16_bf16(b0, qr[0], negm, 0, 0, 0); p1 = __builtin_amdgcn_mfma_f32_32x32x16_bf16(b1, qr[0], negm, 0, 0, 0); }
    else { p0 = __builtin_amdgcn_mfma_f32_32x32x16_bf16(b0, qr[d0], p0, 0, 0, 0); p1 = __builtin_amdgcn_mfma_f32_32x32x16_bf16(b1, qr[d0], p1, 0, 0, 0); } }
}
typedef short v4i16_t __attribute__((ext_vector_type(4)));
__device__ __forceinline__ void kload8(bf16x8* kf, lds_cptr kp) {
  kf[0] = *(const __attribute__((address_space(3))) bf16x8*)(kp);        kf[1] = *(const __attribute__((address_space(3))) bf16x8*)(kp + 512);
  kf[2] = *(const __attribute__((address_space(3))) bf16x8*)(kp + 2048); kf[3] = *(const __attribute__((address_space(3))) bf16x8*)(kp + 2560);
  kf[4] = *(const __attribute__((address_space(3))) bf16x8*)(kp + 4096); kf[5] = *(const __attribute__((address_space(3))) bf16x8*)(kp + 4608);
  kf[6] = *(const __attribute__((address_space(3))) bf16x8*)(kp + 6144); kf[7] = *(const __attribute__((address_space(3))) bf16x8*)(kp + 6656);
}
__device__ __forceinline__ void kload2(bf16x8* kf, lds_cptr kp, int j) { kf[2 * j] = *(const __attribute__((address_space(3))) bf16x8*)(kp + j * 2048); kf[2 * j + 1] = *(const __attribute__((address_space(3))) bf16x8*)(kp + j * 2048 + 512); }
__device__ __forceinline__ s16x4 vtr(lds_cptr p) { return __builtin_bit_cast(s16x4, __builtin_amdgcn_ds_read_tr16_b64_v4i16((__attribute__((address_space(3))) v4i16_t*)p)); }
__device__ __forceinline__ float rowmax(const f32x16& p0, const f32x16& p1) {
  float a = max3f(p0[0], p0[1], p1[0]), b = max3f(p0[2], p0[3], p1[1]); a = max3f(a, p1[2], p1[3]);
#pragma unroll
  for (int r = 4; r < 16; r += 4) { a = max3f(a, p0[r], p0[r + 1]); b = max3f(b, p0[r + 2], p0[r + 3]); a = max3f(a, p1[r], p1[r + 1]); b = max3f(b, p1[r + 2], p1[r + 3]); }
  const float m = max2f(a, b);
  auto rr = __builtin_amdgcn_permlane32_swap(__float_as_uint(m), __float_as_uint(m), false, false);
  return max2f(__uint_as_float(rr[0]), __uint_as_float(rr[1]));
}
__device__ __forceinline__ void pv(f32x16* o, int vb, bf16x8 pa0, bf16x8 pa1, bf16x8 pa2, bf16x8 pa3) {
#pragma unroll
  for (int d0 = 0; d0 < 2; ++d0) { s16x4 lo[4], hi[4];
#pragma unroll
    for (int ks = 0; ks < 4; ++ks) {
      asm volatile("ds_read_b64_tr_b16 %0,%1 offset:%c2" : "=&v"(lo[ks]) : "v"(vb), "i"(d0 * 4096 + ks * 1024) : "memory");
      asm volatile("ds_read_b64_tr_b16 %0,%1 offset:%c2" : "=&v"(hi[ks]) : "v"(vb), "i"(d0 * 4096 + ks * 1024 + 512) : "memory"); }
    asm volatile("s_waitcnt lgkmcnt(0)" ::: "memory"); SBAR();
#define PK(k) (bf16x8){lo[k][0], lo[k][1], lo[k][2], lo[k][3], hi[k][0], hi[k][1], hi[k][2], hi[k][3]}
    o[d0] = __builtin_amdgcn_mfma_f32_32x32x16_bf16(pa0, PK(0), o[d0], 0, 0, 0);
    o[d0] = __builtin_amdgcn_mfma_f32_32x32x16_bf16(pa1, PK(1), o[d0], 0, 0, 0);
    o[d0] = __builtin_amdgcn_mfma_f32_32x32x16_bf16(pa2, PK(2), o[d0], 0, 0, 0);
    o[d0] = __builtin_amdgcn_mfma_f32_32x32x16_bf16(pa3, PK(3), o[d0], 0, 0, 0);
#undef PK
  }
}
template <int MODE> __device__ __forceinline__ void amask(f32x16& p0, f32x16& p1, int tabs, int blk, int hi, int mlo, int mspan1, const unsigned selword, const float mh) {
  const float NEG = -1e30f;
  const int kb = 64 * tabs + 4 * hi;
  int hiB;
  if (MODE == 1) {
    const bool en = (selword >> (tabs & 31)) & 1u;
    if (tabs < blk) {
#pragma unroll
      for (int r = 0; r < 16; ++r) { p0[r] = en ? p0[r] - mh : NEG; p1[r] = en ? p1[r] - mh : NEG; }
      return; }
    hiB = en ? mspan1 - kb : 0;
  } else if (MODE == 0) hiB = mspan1 - kb;
  else {
    if (tabs < blk) {
      if (tabs + 8 <= blk) { const int loB = mlo - kb;
#pragma unroll
        for (int r = 0; r < 16; ++r) { const int c = (r & 3) + 8 * (r >> 2); p0[r] = (loB <= c) ? p0[r] - mh : NEG; p1[r] = (loB <= c + 32) ? p1[r] - mh : NEG; }
      } else {
#pragma unroll
        for (int r = 0; r < 16; ++r) { p0[r] -= mh; p1[r] -= mh; }
      }
      return; }
    hiB = mlo + mspan1 - kb;
  }
#pragma unroll
  for (int r = 0; r < 16; ++r) { const int c = (r & 3) + 8 * (r >> 2); p0[r] = (hiB > c) ? p0[r] - mh : NEG; p1[r] = (hiB > c + 32) ? p1[r] - mh : NEG; }
}

template <int MODE, int THRL>
__device__ __forceinline__ void attn_unit(const bf16* Qlane, const bf16* __restrict__ Kt, const bf16* __restrict__ Vt, const int t0abs, const int NT, const int blk,
                                          const int pos, const float* gatep, float* obf, bf16* ob, char* shm, float& mhat_o, float& rl_o) {
  constexpr int KP = (MODE == 0) ? 64 : 128;
  const int tid = threadIdx.x, lane = tid & 63, r32 = lane & 31, hi = lane >> 5; const int wid = __builtin_amdgcn_readfirstlane(tid >> 6);
  const unsigned lds0 = (unsigned)(uintptr_t)shm;
  float* wsf = (float*)(shm + LDS_WS) + wid * 64;
  const bf16* ksrc = Kt + (long)lane * KP + wid * 8;
  const bf16* vsrc = Vt + (long)(16 * (wid & 3) + (lane >> 2)) * KP + (wid >> 2) * 32 + (lane & 3) * 8;
  const unsigned kdst = lds0 + LDS_K + wid * 1024, vdst = lds0 + LDS_V + wid * 1024;
#define DMA_K(t, slot) glds16(ksrc + (long)(t) * KVBLK * KP, (unsigned)__builtin_amdgcn_readfirstlane(kdst + (slot)))
#define DMA_V(t, slot) glds16(vsrc + (long)(t) * KVBLK * KP, (unsigned)__builtin_amdgcn_readfirstlane(vdst + (slot)))
  const int vb0 = (int)(lds0 + LDS_V) + ((lane >> 4) & 1) * 32 + (lane & 3) * 8 + (4 * hi + ((lane & 15) >> 2)) * 64;
  const char* Kbase = shm + LDS_K; bf16x8 kf[8];
  const lds_cptr shm3 = (lds_cptr)shm; const lds_cptr kp0 = shm3 + LDS_K + hi * 1024 + r32 * 16; const lds_cptr vp0 = shm3 + LDS_V + ((lane >> 4) & 1) * 32 + (lane & 3) * 8 + (4 * hi + ((lane & 15) >> 2)) * 64;
  const lds_cptr qp = shm3 + LDS_Q + wid * 4096 + lane * 16;
  const lds_cptr selp = shm3 + LDS_SELB + wid * 128 + (r32 >> 2) * 16;
#ifndef ATT_QREG
#define ATT_QREG 2
#endif
  constexpr bool QREG = (ATT_QREG >> MODE) & 1;
  bf16x8 qrg[4];
#define QF(j) (QREG ? qrg[j] : *(const __attribute__((address_space(3))) bf16x8*)(qp + (j) * 1024))
  DMA_K(0, 0); DMA_V(0, 0); DMA_K(1, SLOTB);
#pragma unroll
  for (int d0 = 0; d0 < 4; ++d0) { qrg[d0] = *reinterpret_cast<const bf16x8*>(&Qlane[d0 * 16 + hi * 8]); *(__attribute__((address_space(3))) bf16x8*)((__attribute__((address_space(3))) char*)qp + d0 * 1024) = qrg[d0]; }
  float mhat = 0.f, l_reg = 0.f; f32x16 o[2]; o[0] = f32x16{}; o[1] = f32x16{}; const f32x16 zero16 = f32x16{};
  const int mlo = (MODE == 2) ? pos - (WIN - 1) : 0;
  const int mspan1 = (MODE == 0) ? (((pos - 31) >> 4) + 1 > 0 ? ((pos - 31) >> 4) + 1 : 0) : (MODE == 1 ? pos + 1 : WIN);
#define SELW(t) (MODE == 1 ? *(const __attribute__((address_space(3))) unsigned*)(selp + (((t0abs + (t)) >> 5) << 2)) : 0u)
#define CMASK(P0, P1, t, SW) amask<MODE>(P0, P1, t0abs + (t), blk, hi, mlo, mspan1, SW, mhat)
  bool resc = false;
#define START(P0, P1) do { const float rm = max2f(rowmax(P0, P1), -500.f); resc = false; \
    { const float dl = rm; mhat = fadd_s(mhat, dl); \
      _Pragma("unroll") for (int r = 0; r < 16; ++r) { P0[r] = fsub_s(P0[r], dl); P1[r] = fsub_s(P1[r], dl); } } \
    _Pragma("unroll") for (int r = 0; r < 16; ++r) P0[r] = __builtin_amdgcn_exp2f(P0[r]); } while (0)
#define RESC() do { if (resc) { asm volatile("s_waitcnt lgkmcnt(0)" ::: "memory"); \
      _Pragma("unroll") for (int d_ = 0; d_ < 2; ++d_) _Pragma("unroll") for (int r = 0; r < 16; ++r) o[d_][r] *= wsf[crow(r, hi)]; } } while (0)
  f32x16 pA0, pA1, pB0, pB1;
  int sl_prev = 0, sl_cur = 0, sl_next = SLOTB;
#define ROT() do { sl_prev = sl_cur; sl_cur = sl_next; sl_next = (sl_next == (NSLOT - 1) * SLOTB) ? 0 : sl_next + SLOTB; } while (0)
  DMA_K(2, 2 * SLOTB);
  WAIT_BAR(3);
  { const unsigned sw0 = SELW(0); qkt(pA0, pA1, Kbase, qp, r32, hi); asm volatile("s_nop 15\n\ts_nop 7" : "+v"(pA0), "+v"(pA1)); CMASK(pA0, pA1, 0, sw0); }
  START(pA0, pA1);
  _Pragma("unroll") for (int r = 0; r < 16; ++r) pA1[r] = __builtin_amdgcn_exp2f(pA1[r]);
  WAIT_BAR(0);
  DMA_K(3, 0); DMA_V(1, SLOTB);
  ROT();
  kload8(kf, kp0 + sl_cur);
  WAIT_BAR(2);
  s16x4 vlo[8], vhi[8]; u32x4 pw0, pw1, pw2, pw3;
#define PKW(P, B) cvtpk_s(P[B], P[B + 1])
#define PAF(k) __builtin_bit_cast(bf16x8, pw##k)
#define VFR(i) (bf16x8){vlo[i][0], vlo[i][1], vlo[i][2], vlo[i][3], vhi[i][0], vhi[i][1], vhi[i][2], vhi[i][3]}
#define PIN(x) asm volatile("" : "+v"(x))
#define MX3(a, b, c) __builtin_fmaxf(__builtin_fmaxf((a), (b)), (c))
#define GAPA(MF, A0, A1, A2, A3, W0, W1, PW) do { MF; sacc += A0; sacc += A1; sacc += A2; sacc += A3; PIN(sacc); W0; W1; PIN(PW); SBAR(); } while (0)
#define EX(v) __builtin_amdgcn_exp2f(v)
#define GAPB(MF, X, B) do { MF; X[B] = EX(X[B]); X[B + 1] = EX(X[B + 1]); X[B + 2] = EX(X[B + 2]); X[B + 3] = EX(X[B + 3]); PIN(X); SBAR(); } while (0)
#define VRD(i) do { vlo[i] = vtr(vp_ + (((i) >> 2) * 4096 + ((i) & 3) * 1024)); vhi[i] = vtr(vp_ + (((i) >> 2) * 4096 + ((i) & 3) * 1024 + 512)); } while (0)
#define KRD(G, j) do { if (G) { kload2(kf, kp0 + sl_next, j); SBAR(); } } while (0)
#define STEP(C0, C1, P0, P1, t, GK, GV, GL) do { SBAR(); \
    const lds_cptr vp_ = vp0 + sl_prev; const unsigned sw_ = SELW(t); \
    bf16x8 qa_ = QF(0); \
    VRD(0); SBAR(); float sacc = (P0[0] + P0[1]); \
    GAPA(C0 = __builtin_amdgcn_mfma_f32_32x32x16_bf16(kf[0], qa_, zero16, 0, 0, 0), P0[2], P0[3], P0[4], P0[5],     pw0[0] = PKW(P0, 0), pw0[1] = PKW(P0, 2), pw0); \
    VRD(4); SBAR(); GAPA(C1 = __builtin_amdgcn_mfma_f32_32x32x16_bf16(kf[1], qa_, zero16, 0, 0, 0), P0[6], P0[7], P0[8], P0[9],     pw0[2] = PKW(P0, 4), pw0[3] = PKW(P0, 6), pw0); \
    qa_ = QF(1); \
    VRD(1); SBAR(); GAPA(C0 = __builtin_amdgcn_mfma_f32_32x32x16_bf16(kf[2], qa_, C0, 0, 0, 0),   P0[10], P0[11], P0[12], P0[13], pw1[0] = PKW(P0, 8), pw1[1] = PKW(P0, 10), pw1); \
    VRD(5); SBAR(); GAPA(C1 = __builtin_amdgcn_mfma_f32_32x32x16_bf16(kf[3], qa_, C1, 0, 0, 0),   P0[14], P0[15], P1[0], P1[1],   pw1[2] = PKW(P0, 12), pw1[3] = PKW(P0, 14), pw1); \
    qa_ = QF(2); \
    VRD(2); SBAR(); GAPA(C0 = __builtin_amdgcn_mfma_f32_32x32x16_bf16(kf[4], qa_, C0, 0, 0, 0),   P1[2], P1[3], P1[4], P1[5],     pw2[0] = PKW(P1, 0), pw2[1] = PKW(P1, 2), pw2); \
    VRD(6); SBAR(); GAPA(C1 = __builtin_amdgcn_mfma_f32_32x32x16_bf16(kf[5], qa_, C1, 0, 0, 0),   P1[6], P1[7], P1[8], P1[9],     pw2[2] = PKW(P1, 4), pw2[3] = PKW(P1, 6), pw2); \
    qa_ = QF(3); \
    VRD(3); SBAR(); GAPA(C0 = __builtin_amdgcn_mfma_f32_32x32x16_bf16(kf[6], qa_, C0, 0, 0, 0),   P1[10], P1[11], P1[12], P1[13], pw3[0] = PKW(P1, 8), pw3[1] = PKW(P1, 10), pw3); \
    VRD(7); SBAR(); GAPA(C1 = __builtin_amdgcn_mfma_f32_32x32x16_bf16(kf[7], qa_, C1, 0, 0, 0),   P1[14], P1[15], 0.f, 0.f,       pw3[2] = PKW(P1, 12), pw3[3] = PKW(P1, 14), pw3); \
    l_reg += sacc; \
    if (GK) { DMA_K((t) + 3, sl_cur); } if (GV) { DMA_V((t) + 1, sl_next); } \
    CMASK(C0, C1, t, sw_); \
    { float a = MX3(C0[0], C0[1], C1[0]), b = MX3(C0[2], C0[3], C1[1]); a = MX3(a, C1[2], C1[3]); \
      _Pragma("unroll") for (int r = 4; r < 16; r += 4) { a = MX3(a, C0[r], C0[r + 1]); b = MX3(b, C0[r + 2], C0[r + 3]); a = MX3(a, C1[r], C1[r + 1]); b = MX3(b, C1[r + 2], C1[r + 3]); } \
      float rm = __builtin_fmaxf(a, b); { auto rr = __builtin_amdgcn_permlane32_swap(__float_as_uint(rm), __float_as_uint(rm), false, false); rm = __builtin_fmaxf(__uint_as_float(rr[0]), __uint_as_float(rr[1])); } \
      resc = false; \
      if (__builtin_expect(__any(rm > (float)THRL), 0)) { const float dl = __builtin_fmaxf(rm, 0.f); mhat += dl; \
        _Pragma("unroll") for (int r = 0; r < 16; ++r) { C0[r] -= dl; C1[r] -= dl; } \
        const float f = __builtin_amdgcn_exp2f(-dl); l_reg *= f; if (hi == 0) wsf[r32] = f; resc = true; } } \
    SBAR(); \
    GAPB(o[0] = __builtin_amdgcn_mfma_f32_32x32x16_bf16(PAF(0), VFR(0), o[0], 0, 0, 0), C0, 0); \
    GAPB(o[1] = __builtin_amdgcn_mfma_f32_32x32x16_bf16(PAF(0), VFR(4), o[1], 0, 0, 0), C0, 4); \
    KRD(GL, 0); GAPB(o[0] = __builtin_amdgcn_mfma_f32_32x32x16_bf16(PAF(1), VFR(1), o[0], 0, 0, 0), C0, 8); \
    KRD(GL, 1); GAPB(o[1] = __builtin_amdgcn_mfma_f32_32x32x16_bf16(PAF(1), VFR(5), o[1], 0, 0, 0), C0, 12); \
    KRD(GL, 2); GAPB(o[0] = __builtin_amdgcn_mfma_f32_32x32x16_bf16(PAF(2), VFR(2), o[0], 0, 0, 0), C1, 0); \
    KRD(GL, 3); GAPB(o[1] = __builtin_amdgcn_mfma_f32_32x32x16_bf16(PAF(2), VFR(6), o[1], 0, 0, 0), C1, 4); \
    GAPB(o[0] = __builtin_amdgcn_mfma_f32_32x32x16_bf16(PAF(3), VFR(3), o[0], 0, 0, 0), C1, 8); \
    GAPB(o[1] = __builtin_amdgcn_mfma_f32_32x32x16_bf16(PAF(3), VFR(7), o[1], 0, 0, 0), C1, 12); \
    } while (0)
  int t = 1;
  for (; t + 5 < NT; t += 2) {
    STEP(pB0, pB1, pA0, pA1, t, true, true, true);     WAIT_BAR(2); RESC(); ROT();
    STEP(pA0, pA1, pB0, pB1, t + 1, true, true, true); WAIT_BAR(2); RESC(); ROT();
  }
#define ENDW(tt) do { if ((tt) + 3 < NT) { WAIT_BAR(2); } else if ((tt) + 2 < NT) { WAIT_BAR(1); } else { WAIT_BAR(0); } } while (0)
  for (; t + 1 < NT; t += 2) {
    STEP(pB0, pB1, pA0, pA1, t, (t + 3 < NT), (t + 1 < NT), (t + 1 < NT));         ENDW(t);     RESC(); ROT();
    STEP(pA0, pA1, pB0, pB1, t + 1, (t + 4 < NT), (t + 2 < NT), (t + 2 < NT));     ENDW(t + 1); RESC(); ROT();
  }
  STEP(pB0, pB1, pA0, pA1, NT - 1, false, false, false); RESC();
  { float sacc = pB0[0] + pB0[1]; _Pragma("unroll") for (int r = 2; r < 16; ++r) sacc += pB0[r]; _Pragma("unroll") for (int r = 0; r < 16; ++r) sacc += pB1[r]; l_reg += sacc;
    pw0 = (u32x4){PKW(pB0, 0), PKW(pB0, 2), PKW(pB0, 4), PKW(pB0, 6)}; pw1 = (u32x4){PKW(pB0, 8), PKW(pB0, 10), PKW(pB0, 12), PKW(pB0, 14)}; pw2 = (u32x4){PKW(pB1, 0), PKW(pB1, 2), PKW(pB1, 4), PKW(pB1, 6)}; pw3 = (u32x4){PKW(pB1, 8), PKW(pB1, 10), PKW(pB1, 12), PKW(pB1, 14)};
    SBAR(); pv(o, vb0 + sl_cur, PAF(0), PAF(1), PAF(2), PAF(3)); }
#undef PKW
#undef PAF
#undef VFR
#undef PIN
#undef MX3
#undef GAPA
#undef GAPB
#undef EX
#undef VRD
#undef KRD
#undef STEP
#undef ENDW
  { auto rr = __builtin_amdgcn_permlane32_swap(__float_as_uint(l_reg), __float_as_uint(l_reg), false, false); l_reg = __uint_as_float(rr[0]) + __uint_as_float(rr[1]); }
  const float rl = l_reg > 0.f ? __builtin_amdgcn_rcpf(l_reg) : 0.f;
  mhat_o = mhat; rl_o = rl;
  if (hi == 0) wsf[32 + r32] = rl * (*gatep); asm volatile("s_waitcnt lgkmcnt(0)" ::: "memory");
#pragma unroll
  for (int r = 0; r < 16; ++r) { const float sc = wsf[32 + crow(r, hi)];
#pragma unroll
    for (int d0 = 0; d0 < 2; ++d0) { const int off = (2 * (r >> 2)) * 512 + (r & 3) * 64 + 32 * d0; float v = o[d0][r] * sc;
      if (MODE != 0) v += obf[off];
      if (MODE == 2) ob[off] = (bf16)f2bf(v); else obf[off] = v; } }
  asm volatile("s_waitcnt lgkmcnt(0)\n\ts_barrier" ::: "memory");
#undef DMA_K
#undef DMA_V
#undef CMASK
#undef SELW
#undef QF
#undef START
#undef RESC
#undef ROT
}

__device__ __forceinline__ int dppx1(int v) { return __builtin_amdgcn_mov_dpp(v, 0xB1, 0xF, 0xF, true); }
__device__ __forceinline__ int dppx2(int v) { return __builtin_amdgcn_mov_dpp(v, 0x4E, 0xF, 0xF, true); }
__device__ __forceinline__ float quad_sum(float v) { v += __builtin_bit_cast(float, dppx1(__builtin_bit_cast(int, v))); v += __builtin_bit_cast(float, dppx2(__builtin_bit_cast(int, v))); return v; }

__device__ __forceinline__ void nsa_prompt_unit(const unsigned char* ws, int b, int kv, int blk, char* shm) {
  float mhat = 0.f, rl = 0.f, dm0, dm1;
#define LANE_SETUP() const int lane = threadIdx.x & 63, r32 = lane & 31, hi = lane >> 5; const int wid = __builtin_amdgcn_readfirstlane(threadIdx.x >> 6); \
    const int tl = r32 >> 2, hl = r32 & 3, pos = 64 * blk + 8 * wid + tl; const size_t m = (size_t)b * SEQ + pos; const int head = 4 * kv + hl; (void)hi; (void)head; (void)m; (void)tl; (void)hl; \
    const size_t obo = ((size_t)b * SEQ + 64 * blk + 8 * wid + hi) * 512 + (4 * kv) * 64 + r32; (void)obo
  const int ntc_real = blk / 16 + 1;
  { LANE_SETUP(); const int NTc = ntc_real < 4 ? 4 : ((ntc_real + 1) & ~1);
    const bf16* kc = (const bf16*)(ws + WS_KCP) + (size_t)(b * 2 + kv) * NCP * 64; const bf16* vc = (const bf16*)(ws + WS_VCP) + (size_t)(b * 2 + kv) * NCP * 64;
#ifndef NO_M0
    attn_unit<0, 8>((const bf16*)(ws + WS_QN) + m * 512 + head * 64, kc, vc, 0, NTc, blk, pos, (const float*)(ws + WS_NG) + m * 32 + head * 3 + 0, (float*)(ws + WS_OBF) + obo, (bf16*)(ws + WS_OB) + obo, shm, mhat, rl);
#endif
 }
  {
    LANE_SETUP();
    LAS float* bsw = (LAS float*)(shm + LDS_K) + wid * 8 * BLKS_PITCH;
    for (int i = lane; i < 8 * BLKS_PITCH; i += 64) bsw[i] = 0.f;
    asm volatile("s_waitcnt lgkmcnt(0)" ::: "memory");
    const int cthr = (pos - 31) >> 4; const int cspan = cthr + 1 > 0 ? cthr + 1 : 0;
    const bf16* kc = (const bf16*)(ws + WS_KCP) + (size_t)(b * 2 + kv) * NCP * 64; const bf16* qn = (const bf16*)(ws + WS_QN) + m * 512 + head * 64;
    bf16x8 qf[4];
#pragma unroll
    for (int d0 = 0; d0 < 4; ++d0) qf[d0] = *reinterpret_cast<const bf16x8*>(&qn[d0 * 16 + hi * 8]);
    const f32x16 zero16 = f32x16{};
    for (int t = 0; t < ntc_real; ++t) {
      f32x16 p0, p1; const bf16* kr = kc + (size_t)(64 * t + r32) * 64 + hi * 8;
#pragma unroll
      for (int d0 = 0; d0 < 4; ++d0) { const bf16x8 b0 = *reinterpret_cast<const bf16x8*>(kr + d0 * 16); const bf16x8 b1 = *reinterpret_cast<const bf16x8*>(kr + 32 * 64 + d0 * 16);
        if (d0 == 0) { p0 = __builtin_amdgcn_mfma_f32_32x32x16_bf16(b0, qf[0], zero16, 0, 0, 0); p1 = __builtin_amdgcn_mfma_f32_32x32x16_bf16(b1, qf[0], zero16, 0, 0, 0); }
        else { p0 = __builtin_amdgcn_mfma_f32_32x32x16_bf16(b0, qf[d0], p0, 0, 0, 0); p1 = __builtin_amdgcn_mfma_f32_32x32x16_bf16(b1, qf[d0], p1, 0, 0, 0); } }
      const int base = 64 * t + 4 * hi;
#pragma unroll
      for (int r = 0; r < 16; ++r) { const int c0 = base + (r & 3) + 8 * (r >> 2); p0[r] = (c0 < cspan) ? __builtin_amdgcn_exp2f(p0[r] - mhat) * rl : 0.f; p1[r] = (c0 + 32 < cspan) ? __builtin_amdgcn_exp2f(p1[r] - mhat) * rl : 0.f; }
#pragma unroll
      for (int ph = 0; ph < 2; ++ph)
#pragma unroll
        for (int g = 0; g < 4; ++g) { const float a0 = ph ? p1[4 * g] : p0[4 * g], a1 = ph ? p1[4 * g + 1] : p0[4 * g + 1], a2 = ph ? p1[4 * g + 2] : p0[4 * g + 2], a3 = ph ? p1[4 * g + 3] : p0[4 * g + 3];
          const float A = quad_sum(2.f * (a0 + a1 + a2) + a3), B = quad_sum(a3);
          const int j = 16 * t + 8 * ph + 2 * g + hi;
          if (hl == 0) { __hip_atomic_fetch_add(bsw + tl * BLKS_PITCH + j, A, __ATOMIC_RELAXED, __HIP_MEMORY_SCOPE_WORKGROUP); __hip_atomic_fetch_add(bsw + tl * BLKS_PITCH + j + 1, B, __ATOMIC_RELAXED, __HIP_MEMORY_SCOPE_WORKGROUP); } }
    }
    asm volatile("s_waitcnt lgkmcnt(0)" ::: "memory");
    LAS unsigned* selb = (LAS unsigned*)(shm + LDS_SELB) + wid * 32;
    const int cur = blk, nf = cur >= 2 ? 3 : cur + 1, need = 16 - nf;
    for (int tk = 0; tk < 8; ++tk) {
      const LAS float* bs = bsw + tk * BLKS_PITCH;
      const int j0 = lane, j1 = lane + 64; const float s0 = bs[j0], s1 = bs[j1];
      int c0 = 0, c1 = 0;
      for (int i = 1; i <= cur - 2; ++i) { const float si = bs[i]; c0 += (si > s0 || (si == s0 && i < j0)) ? 1 : 0; c1 += (si > s1 || (si == s1 && i < j1)) ? 1 : 0; }
      const bool f0 = (j0 == 0 || j0 == cur || j0 == cur - 1), f1 = (j1 == cur || j1 == cur - 1);
      const bool sel0 = f0 || (j0 >= 1 && j0 <= cur - 2 && c0 < need), sel1 = f1 || (j1 <= cur - 2 && c1 < need);
      const unsigned long long m0 = __ballot(sel0), m1 = __ballot(sel1);
      if (lane == 0) { selb[tk * 4 + 0] = (unsigned)m0; selb[tk * 4 + 1] = (unsigned)(m0 >> 32); selb[tk * 4 + 2] = (unsigned)m1; selb[tk * 4 + 3] = (unsigned)(m1 >> 32); }
    }
    asm volatile("s_waitcnt lgkmcnt(0)\n\ts_barrier" ::: "memory");
  }
  { LANE_SETUP(); const int nt_real = blk + 1; const int NTs = nt_real < 4 ? 4 : ((nt_real + 1) & ~1);
    const bf16* ks = (const bf16*)(ws + WS_KS) + (size_t)b * SEQ * 128 + kv * 64; const bf16* vs = (const bf16*)(ws + WS_VS) + (size_t)b * SEQ * 128 + kv * 64;
#ifndef NO_M1
    attn_unit<1, 8>((const bf16*)(ws + WS_QR) + m * 512 + head * 64, ks, vs, 0, NTs, blk, pos, (const float*)(ws + WS_NG) + m * 32 + head * 3 + 1, (float*)(ws + WS_OBF) + obo, (bf16*)(ws + WS_OB) + obo, shm, dm0, dm1);
#endif
 }
  { LANE_SETUP(); int t0, NTw; if (blk >= 9) { t0 = blk - 9; NTw = 10; } else { t0 = 0; const int nt_real = blk + 1; NTw = nt_real < 4 ? 4 : ((nt_real + 1) & ~1); }
    const bf16* kw = (const bf16*)(ws + WS_KW) + ((size_t)b * SEQ + 64 * t0) * 128 + kv * 64; const bf16* vw = (const bf16*)(ws + WS_VW) + ((size_t)b * SEQ + 64 * t0) * 128 + kv * 64;
#ifndef NO_M2
    attn_unit<2, 8>((const bf16*)(ws + WS_QR) + m * 512 + head * 64, kw, vw, t0, NTw, blk, pos, (const float*)(ws + WS_NG) + m * 32 + head * 3 + 2, (float*)(ws + WS_OBF) + obo, (bf16*)(ws + WS_OB) + obo, shm, dm0, dm1);
#endif
 }
#undef LANE_SETUP
}
#undef SBAR
#undef WAIT_BAR
}

namespace smp {
constexpr int SCP = 1040;
constexpr int L_SC = 0, L_PART = L_SC + 4 * SCP * 4, L_OB = L_PART + 8 * 256 * 4, L_BLK = L_OB + 1024, L_SEL = L_BLK + 272 * 4, L_END = L_SEL + 256;
constexpr float NEG = -1e30f;
constexpr int UK = 2;

__device__ __forceinline__ void ld16(const float* row, int c, float (&v)[16]) {
#pragma unroll
    for (int j = 0; j < 4; ++j) { const f32x4 t = *(const f32x4*)(row + 16 * j + 4 * c); v[4 * j] = t.x; v[4 * j + 1] = t.y; v[4 * j + 2] = t.z; v[4 * j + 3] = t.w; }
}
__device__ __forceinline__ void ld16(const bf16* row, int c, float (&v)[16]) {
#pragma unroll
    for (int j = 0; j < 4; ++j) { const v2u t = *(const v2u*)(row + 16 * j + 4 * c); v[4 * j] = bflo(t.x); v[4 * j + 1] = bfhi(t.x); v[4 * j + 2] = bflo(t.y); v[4 * j + 3] = bfhi(t.y); }
}
__device__ __forceinline__ float qsum(float v) { v += __builtin_bit_cast(float, __builtin_amdgcn_mov_dpp(__builtin_bit_cast(int, v), 0xB1, 0xF, 0xF, true)); v += __builtin_bit_cast(float, __builtin_amdgcn_mov_dpp(__builtin_bit_cast(int, v), 0x4E, 0xF, 0xF, true)); return v; }

template <class T, class RP>
__device__ __forceinline__ void scores(LAS float* sc, int s0, int n, const float (&q)[4][16], const RP& rp) {
    const int lane = threadIdx.x & 63, w = threadIdx.x >> 6, ks = lane >> 2, c = lane & 3;
    for (int base = w * 16 * UK; base < n; base += 8 * 16 * UK) {
        float kx[UK][16]; bool ok[UK];
#pragma unroll
        for (int u = 0; u < UK; ++u) { const int sl = base + 16 * u + ks; ok[u] = sl < n; if (ok[u]) ld16((const T*)rp(sl), c, kx[u]); else { _Pragma("unroll") for (int i = 0; i < 16; ++i) kx[u][i] = 0.f; } }
#pragma unroll
        for (int u = 0; u < UK; ++u) { float s[4];
#pragma unroll
            for (int h = 0; h < 4; ++h) { float a = 0.f; _Pragma("unroll") for (int i = 0; i < 16; ++i) a += q[h][i] * kx[u][i]; s[h] = qsum(a); }
            const float sv = c == 0 ? s[0] : (c == 1 ? s[1] : (c == 2 ? s[2] : s[3]));
            if (ok[u]) sc[c * SCP + s0 + base + 16 * u + ks] = sv; }
    }
}
template <class T, class RP>
__device__ __forceinline__ void pvacc(const LAS float* sc, int s0, int n, float (&acc)[4][16], const RP& rp) {
    const int lane = threadIdx.x & 63, w = threadIdx.x >> 6, ks = lane >> 2, c = lane & 3;
    for (int base = w * 16 * UK; base < n; base += 8 * 16 * UK) {
        float vx[UK][16]; float p[UK][4];
#pragma unroll
        for (int u = 0; u < UK; ++u) { const int sl = base + 16 * u + ks; const bool ok = sl < n;
            if (ok) { ld16((const T*)rp(sl), c, vx[u]); _Pragma("unroll") for (int h = 0; h < 4; ++h) p[u][h] = sc[h * SCP + s0 + sl]; }
            else { _Pragma("unroll") for (int i = 0; i < 16; ++i) vx[u][i] = 0.f; _Pragma("unroll") for (int h = 0; h < 4; ++h) p[u][h] = 0.f; } }
#pragma unroll
        for (int u = 0; u < UK; ++u)
#pragma unroll
            for (int h = 0; h < 4; ++h)
#pragma unroll
                for (int i = 0; i < 16; ++i) acc[h][i] += p[u][h] * vx[u][i];
    }
}
__device__ __forceinline__ void softmax4(LAS float* sc, int n) {
    const int lane = threadIdx.x & 63, w = threadIdx.x >> 6;
    __syncthreads();
    if (w < 4) { LAS float* s = sc + w * SCP; float mx = -500.f;
        for (int i = lane; i < n; i += 64) mx = fmaxf(mx, s[i]);
        mx = wave_max(mx); float sum = 0.f;
        for (int i = lane; i < n; i += 64) { const float e = __builtin_amdgcn_exp2f(s[i] - mx); s[i] = e; sum += e; }
        sum = wave_sum(sum); const float rs = sum > 0.f ? 1.f / sum : 0.f;
        for (int i = lane; i < n; i += 64) s[i] *= rs; }
    __syncthreads();
}
__device__ __forceinline__ void finish(LAS unsigned char* L, float (&acc)[4][16], const float* gates) {
    const int tid = threadIdx.x, lane = tid & 63, w = tid >> 6, c = lane & 3;
    LAS float* part = (LAS float*)(L + L_PART); LAS float* ob = (LAS float*)(L + L_OB);
#pragma unroll
    for (int h = 0; h < 4; ++h)
#pragma unroll
        for (int i = 0; i < 16; ++i) { float v = acc[h][i]; v += __shfl_xor(v, 4); v += __shfl_xor(v, 8); v += __shfl_xor(v, 16); v += __shfl_xor(v, 32); acc[h][i] = v; }
    if (lane < 4) {
#pragma unroll
        for (int h = 0; h < 4; ++h)
#pragma unroll
            for (int j = 0; j < 4; ++j) *(LAS f32x4*)(part + w * 256 + h * 64 + 16 * j + 4 * c) = (f32x4){acc[h][4 * j], acc[h][4 * j + 1], acc[h][4 * j + 2], acc[h][4 * j + 3]};
    }
    __syncthreads();
    if (tid < 256) { float s = 0.f;
#pragma unroll
        for (int ww = 0; ww < 8; ++ww) s += part[ww * 256 + tid];
        ob[tid] += gates[(tid >> 6) * 3] * s; }
    __syncthreads();
}

__device__ __forceinline__ void nsa_sample_unit(const unsigned char* ws, const float* cks, const float* cvs, const float* ckw, const float* cvw, const int* ptab, LAS unsigned char* L, int sb, int kv, int st) {
    const int tid = threadIdx.x, lane = tid & 63, c = lane & 3;
    const size_t m = (size_t)MP + 4 * sb + st;
    LAS float* sc = (LAS float*)(L + L_SC); LAS float* ob = (LAS float*)(L + L_OB); LAS float* blk = (LAS float*)(L + L_BLK); LAS int* sel = (LAS int*)(L + L_SEL);
    const float* gates = (const float*)(ws + WS_NG) + m * 32 + (4 * kv) * 3;
    const bf16* KSn = (const bf16*)(ws + WS_KS) + ((size_t)MP + 4 * sb) * 128 + kv * 64; const bf16* VSn = (const bf16*)(ws + WS_VS) + ((size_t)MP + 4 * sb) * 128 + kv * 64;
    const bf16* KWn = (const bf16*)(ws + WS_KW) + ((size_t)MP + 4 * sb) * 128 + kv * 64; const bf16* VWn = (const bf16*)(ws + WS_VW) + ((size_t)MP + 4 * sb) * 128 + kv * 64;
    __syncthreads();
    if (tid < 256) ob[tid] = 0.f;
    if (tid == 0) { sel[0] = 0; sel[1] = 255; sel[32] = 2; }
    {
        float q[4][16];
#pragma unroll
        for (int h = 0; h < 4; ++h) ld16((const bf16*)(ws + WS_QN) + m * 512 + (4 * kv + h) * 64, c, q[h]);
        const bf16* kc = (const bf16*)(ws + WS_KCS) + (size_t)(sb * 2 + kv) * NCS * 64; const bf16* vc = (const bf16*)(ws + WS_VCS) + (size_t)(sb * 2 + kv) * NCS * 64;
        auto kp = [&](int sl) { return kc + (size_t)sl * 64; }; auto vp = [&](int sl) { return vc + (size_t)sl * 64; };
        scores<bf16>(sc, 0, NCS - 1, q, kp);
        softmax4(sc, NCS - 1);
        float acc[4][16] = {};
        pvacc<bf16>(sc, 0, NCS - 1, acc, vp);
        finish(L, acc, gates + 0);
    }
    if (tid < 257) { const int j = tid; float v[5];
#pragma unroll
        for (int i = 0; i < 5; ++i) { const int cc = 4 * j - 1 + i; v[i] = (cc >= 0 && cc < NCS - 1) ? (sc[cc] + sc[SCP + cc]) + (sc[2 * SCP + cc] + sc[3 * SCP + cc]) : 0.f; }
        blk[j] = v[0] + 2.f * (v[1] + v[2] + v[3]) + v[4]; }
    __syncthreads();
    if (tid >= 1 && tid <= 254) { const float sj = blk[tid]; int cnt = 0;
        for (int i = 1; i <= 254; ++i) { const float si = blk[i]; cnt += (si > sj || (si == sj && i < tid)) ? 1 : 0; }
        if (cnt < 13) { const int k = __hip_atomic_fetch_add(sel + 32, 1, __ATOMIC_RELAXED, __HIP_MEMORY_SCOPE_WORKGROUP); if (k < 15) sel[k] = tid; } }
    __syncthreads();
    if (tid < 15) { const int b = sel[tid]; sel[16 + tid] = ptab[sb * NPAGES + (b >> 1)] * 128 + (b & 1) * 64; }
    __syncthreads();
    {
        float q[4][16];
#pragma unroll
        for (int h = 0; h < 4; ++h) ld16((const bf16*)(ws + WS_QR) + m * 512 + (4 * kv + h) * 64, c, q[h]);
        auto kp = [&](int sl) { return cks + ((size_t)sel[16 + (sl >> 6)] + (sl & 63)) * 128 + kv * 64; }; auto vp = [&](int sl) { return cvs + ((size_t)sel[16 + (sl >> 6)] + (sl & 63)) * 128 + kv * 64; };
        auto kn = [&](int sl) { return KSn + (size_t)sl * 128; }; auto vn = [&](int sl) { return VSn + (size_t)sl * 128; };
        scores<float>(sc, 0, 960, q, kp); scores<bf16>(sc, 960, st + 1, q, kn);
        softmax4(sc, 960 + st + 1);
        float acc[4][16] = {};
        pvacc<float>(sc, 0, 960, acc, vp); pvacc<bf16>(sc, 960, st + 1, acc, vn);
        finish(L, acc, gates + 1);
    }
    {
        float q[4][16];
#pragma unroll
        for (int h = 0; h < 4; ++h) ld16((const bf16*)(ws + WS_QR) + m * 512 + (4 * kv + h) * 64, c, q[h]);
        const float* ck = ckw + ((size_t)sb * WIN + st + 1) * 128 + kv * 64; const float* cv = cvw + ((size_t)sb * WIN + st + 1) * 128 + kv * 64; const int nc = WIN - 1 - st;
        auto kp = [&](int sl) { return ck + (size_t)sl * 128; }; auto vp = [&](int sl) { return cv + (size_t)sl * 128; };
        auto kn = [&](int sl) { return KWn + (size_t)sl * 128; }; auto vn = [&](int sl) { return VWn + (size_t)sl * 128; };
        scores<float>(sc, 0, nc, q, kp); scores<bf16>(sc, nc, st + 1, q, kn);
        softmax4(sc, WIN);
        float acc[4][16] = {};
        pvacc<float>(sc, 0, nc, acc, vp); pvacc<bf16>(sc, nc, st + 1, acc, vn);
        finish(L, acc, gates + 2);
    }
    if (tid < 256) ((bf16*)(ws + WS_OB))[m * 512 + (4 * kv) * 64 + tid] = (bf16)f2bf(ob[tid]);
    __syncthreads();
}
}

#ifdef ATT_CHECK
namespace chk {
constexpr int C_Q = 0, C_SC = C_Q + 2 * 8 * 64 * 4, C_IMP = C_SC + 4 * 1032 * 4, C_BLK = C_IMP + 1032 * 4, C_IDX = C_BLK + 264 * 4, C_O = C_IDX + 64, C_RED = C_O + 256 * 4, C_END = C_RED + 64;
constexpr int SP = 1032;
struct Src { const unsigned char* ws; const float* const* in; };

__device__ __forceinline__ float sel_fetch(const unsigned char* ws, const float* cache, const int* pt, bool smp, int b, int kv, int kpos, int d, size_t wsoff) {
    if (!smp) { int p = kpos < 0 ? 0 : (kpos > SEQ - 1 ? SEQ - 1 : kpos); return bf2f(((const bf16*)(ws + wsoff))[((size_t)b * SEQ + p) * 128 + kv * 64 + d]); }
    if (kpos < PAST) { int pc = kpos < 0 ? 0 : kpos; const int pg = pt[b * NPAGES + (pc >> 7)]; return cache[((size_t)pg * 128 + (pc & 127)) * 128 + kv * 64 + d]; }
    int pn = kpos - PAST; pn = pn > 3 ? 3 : pn; return bf2f(((const bf16*)(ws + wsoff))[((size_t)MP + 4 * b + pn) * 128 + kv * 64 + d]);
}
__device__ __forceinline__ void softmax_rows(LAS float* sc, int n) {
    const int lane = threadIdx.x & 63, w = threadIdx.x >> 6;
    if (w < 4) { LAS float* s = sc + w * SP; float mx = -3e38f;
        for (int i = lane; i < n; i += 64) mx = fmaxf(mx, s[i]);
        mx = wave_max(mx); const bool any = mx > -1e29f; float sum = 0.f;
        for (int i = lane; i < n; i += 64) { const float e = (any && s[i] > -1e29f) ? exp2f(s[i] - mx) : 0.f; s[i] = e; sum += e; }
        sum = wave_sum(sum); const float rs = sum > 0.f ? 1.f / sum : 0.f;
        for (int i = lane; i < n; i += 64) s[i] *= rs; }
    __syncthreads();
}
__device__ __forceinline__ void check_token(const unsigned char* ws, const float* const* in, LAS unsigned char* L, bool smp, int b, int tq, float& emax, float& rmax) {
    const int tid = threadIdx.x;
    LAS float* q = (LAS float*)(L + C_Q); LAS float* sc = (LAS float*)(L + C_SC); LAS float* imp = (LAS float*)(L + C_IMP); LAS float* blk = (LAS float*)(L + C_BLK);
    LAS int* idx = (LAS int*)(L + C_IDX); LAS float* oo = (LAS float*)(L + C_O); LAS float* red = (LAS float*)(L + C_RED);
    const int pos = smp ? PAST + tq : tq; const size_t m = smp ? (size_t)MP + 4 * b + tq : (size_t)b * SEQ + tq;
    const int NC = smp ? NCS - 1 : NCP - 1, n_sel = smp ? 257 : 128, n_ch = 4 * n_sel, cur = pos >> 6;
    const int* pt = (const int*)in[I_PT];
    __syncthreads();
    for (int i = tid; i < 1024; i += 512) { const int ty = i >> 9, r = i & 511; q[i] = bf2f(((const bf16*)(ws + (ty ? WS_QR : WS_QN)))[m * 512 + r]); }
    if (tid == 0) { red[0] = 0.f; red[1] = 0.f; }
    __syncthreads();
    for (int kv = 0; kv < 2; ++kv) {
        if (tid < 256) oo[tid] = 0.f;
        __syncthreads();
        { const bf16* kc = (const bf16*)(ws + (smp ? WS_KCS : WS_KCP)) + (size_t)(b * 2 + kv) * (smp ? NCS : NCP) * 64; const bf16* vc = (const bf16*)(ws + (smp ? WS_VCS : WS_VCP)) + (size_t)(b * 2 + kv) * (smp ? NCS : NCP) * 64;
          for (int c = tid; c < NC; c += 512) { float d0 = 0.f, d1 = 0.f, d2 = 0.f, d3 = 0.f;
              for (int d = 0; d < 64; ++d) { const float k = bf2f(kc[(size_t)c * 64 + d]); d0 += q[(4 * kv + 0) * 64 + d] * k; d1 += q[(4 * kv + 1) * 64 + d] * k; d2 += q[(4 * kv + 2) * 64 + d] * k; d3 += q[(4 * kv + 3) * 64 + d] * k; }
              const bool ok = (c * 16 + 31 <= pos); sc[c] = ok ? d0 : -1e30f; sc[SP + c] = ok ? d1 : -1e30f; sc[2 * SP + c] = ok ? d2 : -1e30f; sc[3 * SP + c] = ok ? d3 : -1e30f; }
          __syncthreads();
          softmax_rows(sc, NC);
          if (tid < 256) { const int h = tid >> 6, d = tid & 63; float a = 0.f; for (int c = 0; c < NC; ++c) a += sc[h * SP + c] * bf2f(vc[(size_t)c * 64 + d]);
              oo[tid] += ((const float*)(ws + WS_NG))[m * 32 + (4 * kv + h) * 3 + 0] * a; }
          for (int c = tid; c < 1032; c += 512) imp[c] = c < NC ? (sc[c] + sc[SP + c]) + (sc[2 * SP + c] + sc[3 * SP + c]) : 0.f;
          __syncthreads(); }
        for (int j = tid; j < n_sel; j += 512) { float s = 0.f;
            for (int i = 0; i < 4; ++i) { const int c = 4 * j + i; const float a = (c < NC && c < n_ch) ? imp[c] : 0.f; const float bsh = (c >= 1 && c - 1 < NC) ? imp[c - 1] : 0.f; s += a + bsh; }
            const bool forced = (j == 0) || (j == cur) || (j == cur - 1), valid = (j * 64 <= pos);
            blk[j] = forced ? 1e4f : (valid ? s : -1e4f); }
        __syncthreads();
        if (tid == 0) { for (int k = 0; k < 16; ++k) { int bi = 0; float bv = -3e38f; for (int j = 0; j < n_sel; ++j) if (blk[j] > bv) { bv = blk[j]; bi = j; } idx[k] = bi; blk[bi] = -3e38f; } }
        __syncthreads();
        { const float* ck = in[I_CKS]; const float* cv = in[I_CVS];
          for (int s = tid; s < 1024; s += 512) { const int bi = idx[s >> 6], kpos = bi * 64 + (s & 63); const bool ok = (bi * 64 <= pos) && (kpos <= pos);
              float d0 = 0.f, d1 = 0.f, d2 = 0.f, d3 = 0.f;
              if (ok) for (int d = 0; d < 64; ++d) { const float k = sel_fetch(ws, ck, pt, smp, b, kv, kpos, d, WS_KS); d0 += q[512 + (4 * kv + 0) * 64 + d] * k; d1 += q[512 + (4 * kv + 1) * 64 + d] * k; d2 += q[512 + (4 * kv + 2) * 64 + d] * k; d3 += q[512 + (4 * kv + 3) * 64 + d] * k; }
              sc[s] = ok ? d0 : -1e30f; sc[SP + s] = ok ? d1 : -1e30f; sc[2 * SP + s] = ok ? d2 : -1e30f; sc[3 * SP + s] = ok ? d3 : -1e30f; }
          __syncthreads();
          softmax_rows(sc, 1024);
          if (tid < 256) { const int h = tid >> 6, d = tid & 63; float a = 0.f;
              for (int s = 0; s < 1024; ++s) { const float p = sc[h * SP + s]; if (p != 0.f) a += p * sel_fetch(ws, cv, pt, smp, b, kv, idx[s >> 6] * 64 + (s & 63), d, WS_VS); }
              oo[tid] += ((const float*)(ws + WS_NG))[m * 32 + (4 * kv + h) * 3 + 1] * a; }
          __syncthreads(); }
        { const int nw = smp ? WIN + DECS : WIN;
          const float* ckw = in[I_CKW]; const float* cvw = in[I_CVW];
          for (int s = tid; s < nw; s += 512) { const int kpos = smp ? PAST - WIN + s : pos - (WIN - 1) + s; const int dp = pos - kpos; const bool ok = dp >= 0 && dp < WIN && kpos >= 0;
              float d0 = 0.f, d1 = 0.f, d2 = 0.f, d3 = 0.f;
              if (ok) for (int d = 0; d < 64; ++d) { float k;
                  if (!smp) k = bf2f(((const bf16*)(ws + WS_KW))[((size_t)b * SEQ + kpos) * 128 + kv * 64 + d]);
                  else if (s < WIN) k = ckw[((size_t)b * WIN + s) * 128 + kv * 64 + d]; else k = bf2f(((const bf16*)(ws + WS_KW))[((size_t)MP + 4 * b + (s - WIN)) * 128 + kv * 64 + d]);
                  d0 += q[512 + (4 * kv + 0) * 64 + d] * k; d1 += q[512 + (4 * kv + 1) * 64 + d] * k; d2 += q[512 + (4 * kv + 2) * 64 + d] * k; d3 += q[512 + (4 * kv + 3) * 64 + d] * k; }
              sc[s] = ok ? d0 : -1e30f; sc[SP + s] = ok ? d1 : -1e30f; sc[2 * SP + s] = ok ? d2 : -1e30f; sc[3 * SP + s] = ok ? d3 : -1e30f; }
          __syncthreads();
          softmax_rows(sc, nw);
          if (tid < 256) { const int h = tid >> 6, d = tid & 63; float a = 0.f;
              for (int s = 0; s < nw; ++s) { const float p = sc[h * SP + s]; if (p == 0.f) continue; const int kpos = smp ? PAST - WIN + s : pos - (WIN - 1) + s; float v;
                  if (!smp) v = bf2f(((const bf16*)(ws + WS_VW))[((size_t)b * SEQ + kpos) * 128 + kv * 64 + d]);
                  else if (s < WIN) v = cvw[((size_t)b * WIN + s) * 128 + kv * 64 + d]; else v = bf2f(((const bf16*)(ws + WS_VW))[((size_t)MP + 4 * b + (s - WIN)) * 128 + kv * 64 + d]);
                  a += p * v; }
              oo[tid] += ((const float*)(ws + WS_NG))[m * 32 + (4 * kv + h) * 3 + 2] * a; }
          __syncthreads(); }
        if (tid < 256) { const float ref = oo[tid], got = bf2f(((const bf16*)(ws + WS_OB))[m * 512 + (4 * kv) * 64 + tid]);
            float e = fabsf(got - ref), r = fabsf(ref); e = wave_max(e); r = wave_max(r);
            if ((tid & 63) == 0) { __hip_atomic_fetch_max((LAS unsigned*)red, __float_as_uint(e), __ATOMIC_RELAXED, __HIP_MEMORY_SCOPE_WORKGROUP); __hip_atomic_fetch_max((LAS unsigned*)red + 1, __float_as_uint(r), __ATOMIC_RELAXED, __HIP_MEMORY_SCOPE_WORKGROUP); } }
        __syncthreads();
    }
    emax = red[0]; rmax = red[1];
    __syncthreads();
}

__device__ __forceinline__ void check_compress(const unsigned char* ws, const float* const* in, const float* out, LAS unsigned char* L, bool smp, int b, int c, int kv, int which, float& emax, float& rmax) {
    const int tid = threadIdx.x, p = tid >> 6, j = tid & 63;
    LAS float* part = (LAS float*)L; LAS float* hdn = part + 512; LAS float* res = hdn + 64;
    const float* w1 = in[which ? I_WCV1 : I_WCK1]; const float* w2 = in[which ? I_WCV2 : I_WCK2]; const float* pe = in[which ? I_PEV : I_PEK];
    const float* cache = in[which ? I_CVC : I_CKC]; const int* pt = (const int*)in[I_PT];
    __syncthreads();
    float s = 0.f;
    for (int i = 256 * p; i < 256 * p + 256; ++i) { const int t = 16 * c + (i >> 6), d = i & 63; float x;
        if (!smp) x = out[(which ? O_PVC : O_PKC) + ((size_t)(b * SEQ + t) * 2 + kv) * 64 + d];
        else { const int pg = pt[b * NPAGES + (t >> 7)]; x = cache[(((size_t)pg * 128 + (t & 127)) * 2 + kv) * 64 + d]; }
        s += (x + pe[i]) * w1[(size_t)i * 64 + j]; }
    part[p * 64 + j] = s;
    __syncthreads();
    if (tid < 64) { float a = 0.f; for (int q = 0; q < 8; ++q) a += part[q * 64 + tid]; const float u = 0.7978845608028654f * (a + 0.044715f * a * a * a); hdn[tid] = 0.5f * a * (1.f + tanhf(u)); }
    __syncthreads();
    if (tid < 64) { float o = 0.f; for (int q = 0; q < 64; ++q) o += hdn[q] * w2[q * 64 + tid]; res[tid] = o; }
    __syncthreads();
    if (tid < 64) { float o = res[tid];
        if (which == 0) { float ss = 0.f; for (int q = 0; q < 64; ++q) ss += res[q] * res[q]; o = o * (1.f / sqrtf(ss / 64.f + EPS)) * in[I_GKC][tid]; }
        const int nc = smp ? NCS : NCP; const float got = bf2f(((const bf16*)(ws + (smp ? (which ? WS_VCS : WS_KCS) : (which ? WS_VCP : WS_KCP))))[((size_t)(b * 2 + kv) * nc + c) * 64 + tid]);
        float e = fabsf(got - o), r = fabsf(o); e = wave_max(e); r = wave_max(r); if (tid == 0) { res[64] = e; res[65] = r; } }
    __syncthreads();
    emax = res[64]; rmax = res[65];
    __syncthreads();
}
}
#endif

#ifndef MK_N_LAUNCHES
#define MK_N_LAUNCHES 1
#endif
constexpr int N_PHASES = 9;
struct Args { const void* in[N_IN]; float* out; unsigned char* ws; int ph_lo, ph_hi; };
static_assert(sizeof(Args) == (N_IN + 2) * 8 + 8, "no padding bytes in Args");

__global__ void __launch_bounds__(NWAVES * 64, 2) hybrid_fwd(Args args) {
    extern __shared__ __attribute__((aligned(16))) unsigned char lds[];
    Frame F;
    F.lds = (LAS unsigned char*)lds;
    F.MISC = (volatile LAS unsigned*)(F.lds + MISC_OFF);
    F.tid = threadIdx.x; F.lane = F.tid & 63; F.wave = __builtin_amdgcn_readfirstlane(F.tid >> 6);
    F.G = gridDim.x; { const int bx = blockIdx.x; F.vcu = (F.G % 8 == 0) ? (bx % 8) * (F.G / 8) + bx / 8 : bx; }
    F.ws = args.ws; F.out = args.out; F.ctl = (gu32*)(args.ws + WS_CTL);
#pragma unroll
    for (int i = 0; i < N_IN; ++i) F.in[i] = (const float*)args.in[i];
    for (int u = F.tid; u < 64; u += NWAVES * 64) ((LAS unsigned*)(F.lds + MISC_OFF))[u] = 0u;
    __syncthreads();
    XcdBarrier bar; bar.bar = (unsigned*)(F.ctl + CW_BAR); bar.x = 0; bar.st = nullptr;
    if (MK_N_LAUNCHES == 1) bar = xcd_barrier_post((unsigned*)(F.ctl + CW_BAR), F.MISC + 8);
#define GRID_BAR() do { if (MK_N_LAUNCHES == 1) xcd_barrier(bar); } while (0)
    const int lo = args.ph_lo, hi = args.ph_hi;
#ifndef PH_MASK
#define PH_MASK 0x1ff
#endif
#define IN(k) (((PH_MASK >> (k)) & 1) && lo <= (k) && (k) < hi)
#define BOTH(k) (IN(k) && IN((k) + 1))
#ifndef DUP_MASK
#define DUP_MASK 0
#endif
#define REP(k) for (int rep_ = 0; rep_ < (((DUP_MASK >> (k)) & 1) ? 2 : 1); ++rep_)

    if (IN(0)) { REP(0) p0_prologue(F); if (BOTH(0)) GRID_BAR(); }

    if (IN(1)) {
        pg8::Gemm g{WSP(bf16, WS_XN), WSP(bf16, WS_WINT), MPAD, NIN, DM}; pg8::StaticOrder S; S.init(MPAD, NIN, F.G, (int)blockIdx.x);
        pg8::EpiIn E{F.ws, F.out};
        REP(1) pg8::gemm_phase<pg8::EpiIn, pg8::StaticOrder, true, true>(F.lds, g, S, E);
        if (BOTH(1)) GRID_BAR();
    }

    if (IN(2)) {
        REP(2) compress_stage1(F);
        REP(10) for (int n = F.G - 1 - (int)blockIdx.x; n < GMLP_UNITS; n += F.G) gmlp_unit(F, n);
        __syncthreads();
        if (BOTH(2)) GRID_BAR();
    }

    if (IN(3)) { REP(3) compress_stage2(F); if (BOTH(3)) GRID_BAR(); }

    if (IN(4)) {
        #ifndef NO_PROMPT
        REP(4) for (int pr = F.vcu; pr < 256; pr += F.G) { const int bk = pr >> 6, s = pr & 63;
            att::nsa_prompt_unit(F.ws, bk >> 1, bk & 1, 127 - s, (char*)lds);
            att::nsa_prompt_unit(F.ws, bk >> 1, bk & 1, s, (char*)lds); }
#endif
#ifndef NO_SMP
        REP(9) for (int su = (int)blockIdx.x; su < 256; su += F.G) smp::nsa_sample_unit(F.ws, F.in[I_CKS], F.in[I_CVS], F.in[I_CKW], F.in[I_CVW], (const int*)F.in[I_PT], F.lds, su >> 3, (su >> 2) & 1, su & 3);
#endif
        if (BOTH(4)) GRID_BAR();
    }

#ifdef ATT_CHECK
    {
        if (!BOTH(4)) GRID_BAR();
        const int i = (int)blockIdx.x; const int special[16] = {0, 1, 30, 31, 32, 63, 64, 65, 127, 128, 1023, 1024, 1025, 4095, 8191, 7680};
        int pos = (int)(((unsigned)i * 2654435761u) >> 19) & 8191;
#pragma unroll
        for (int k = 0; k < 16; ++k) if ((i >> 1) == k) pos = special[k];
        float e, r; float* dbg = WSP(float, WS_DBG);
        chk::check_token(F.ws, F.in, F.lds, false, i & 1, pos, e, r);
        if (F.tid == 0) dbg[i] = e / fmaxf(r, 1e-9f);
        chk::check_token(F.ws, F.in, F.lds, true, (i & 127) >> 2, i & 3, e, r);
        if (F.tid == 0) dbg[256 + i] = e / fmaxf(r, 1e-9f);
        {
            float E = 0.f; const unsigned hsh = (unsigned)i * 2246822519u;
            int cp = (int)((hsh >> 8) % 511u), cs = (int)((hsh >> 10) % 1023u); if (i == 0) { cp = 0; cs = 0; } if (i == 1) { cp = 510; cs = 1022; } if (i == 2) { cp = 509; cs = 7; } if (i == 3) { cp = 255; cs = 8; }
            for (int which = 0; which < 2; ++which) {
                chk::check_compress(F.ws, F.in, F.out, F.lds, false, i & 1, cp, (i >> 1) & 1, which, e, r); E = fmaxf(E, e / fmaxf(r, 1e-9f));
                chk::check_compress(F.ws, F.in, F.out, F.lds, true, i & 31, cs, (i >> 5) & 1, which, e, r); E = fmaxf(E, e / fmaxf(r, 1e-9f)); }
            if (F.tid == 0) dbg[512 + i] = E; }
        __syncthreads();
    }
#endif
    if (IN(5)) {
        pg8::StaticOrder S; S.init(MP, DM, F.G, (int)blockIdx.x);
        skinny_gemm(WSP(bf16, WS_OA) + (size_t)MP * 512, WSP(bf16, WS_WBA), DM, 512, F.G, (int)blockIdx.x, SkT1{F.ws});
        skinny_gemm(WSP(bf16, WS_OB) + (size_t)MP * 512, WSP(bf16, WS_WBB), DM, 512, F.G, (int)blockIdx.x, SkMerge{F.ws});
        { pg8::Gemm g{WSP(bf16, WS_OA), WSP(bf16, WS_WBA), MP, DM, 512}; pg8::EpiT1 E{WSP(bf16, WS_T1), DM};
          pg8::gemm_phase<pg8::EpiT1, pg8::StaticOrder, true, true>(F.lds, g, S, E); }
        { pg8::Gemm g{WSP(bf16, WS_OB), WSP(bf16, WS_WBB), MP, DM, 512}; pg8::EpiMerge E{WSP(bf16, WS_T1), WSP(bf16, WS_SG), WSP(bf16, WS_MG)};
          pg8::gemm_phase<pg8::EpiMerge, pg8::StaticOrder, true, true>(F.lds, g, S, E); }
        if (BOTH(5)) GRID_BAR();
    }

    if (IN(6)) {
        skinny_gemm(WSP(bf16, WS_MG) + (size_t)MP * DM, WSP(bf16, WS_WOT), DM, DM, F.G, (int)blockIdx.x, SkOut{F.ws, F.in[I_XS], F.out});
        pg8::Gemm g{WSP(bf16, WS_MG), WSP(bf16, WS_WOT), MP, DM, DM}; pg8::StaticOrder S; S.init(MP, DM, F.G, (int)blockIdx.x);
        pg8::EpiOut E{F.in[I_XP], F.in[I_XS], F.out, WSP(bf16, WS_X1B), WSP(float, WS_SSQ)};
        REP(6) pg8::gemm_phase<pg8::EpiOut, pg8::StaticOrder, true, true>(F.lds, g, S, E);
        if (BOTH(6)) GRID_BAR();
    }

    if (IN(7)) {
        skinny_gemm(WSP(bf16, WS_X1B) + (size_t)MP * DM, WSP(bf16, WS_WUP), DFF, DM, F.G, (int)blockIdx.x, SkUp{F.ws});
        pg8::Gemm g{WSP(bf16, WS_X1B), WSP(bf16, WS_WUP), MP, DFF, DM}; pg8::StaticOrder S; S.init(MP, DFF, F.G, (int)blockIdx.x);
        pg8::EpiUp E{WSP(float, WS_SSQ), WSP(bf16, WS_H)};
        REP(7) pg8::gemm_phase<pg8::EpiUp, pg8::StaticOrder, true, true>(F.lds, g, S, E);
        if (BOTH(7)) GRID_BAR();
    }

    if (IN(8)) {
        skinny_gemm(WSP(bf16, WS_H) + (size_t)MP * DFF, WSP(bf16, WS_WDN), DM, DFF, F.G, (int)blockIdx.x, SkDown{F.out});
        pg8::Gemm g{WSP(bf16, WS_H), WSP(bf16, WS_WDN), MP, DM, DFF}; pg8::StaticOrder S; S.init(MP, DM, F.G, (int)blockIdx.x);
        pg8::EpiDown E{F.out};
        pg8::gemm_phase<pg8::EpiDown, pg8::StaticOrder, true, true>(F.lds, g, S, E);
    }
#ifdef ATT_CHECK
    GRID_BAR();
    if (blockIdx.x == 0) { float E = 0.f; const float* dbg = WSP(float, WS_DBG);
        for (int k = 0; k < 768; ++k) { if (!((ATT_CHECK >> (k >> 8)) & 1)) continue; E = fmaxf(E, dbg[k]); }
        for (int t = F.tid; t < 1024; t += 512) F.out[O_YP + t] += E * 2000.f; }
#endif
#undef IN
#undef BOTH
}

extern "C" void kernel_launch(void* const* d_in, const int* in_sizes, int n_in, void* d_out, int out_size, void* d_ws, size_t ws_size, hipStream_t stream) {
    static int grid = 0;
    if (grid == 0) {
        if (n_in != N_IN || in_sizes[0] != MP * DM || (size_t)out_size != O_END || ws_size < WS_END) {
            fprintf(stderr, "kernel_launch: unexpected problem: n_in %d in0 %d out %d ws %zu (need %zu); nothing launched\n", n_in, n_in > 0 ? in_sizes[0] : -1, out_size, ws_size, (size_t)WS_END); grid = -1; return; }
        int dev = 0, cus = 0, per_cu = 0;
        if (hipGetDevice(&dev) != hipSuccess || hipDeviceGetAttribute(&cus, hipDeviceAttributeMultiprocessorCount, dev) != hipSuccess) { grid = -1; return; }
        if (hipFuncSetAttribute((const void*)hybrid_fwd, hipFuncAttributeMaxDynamicSharedMemorySize, LDS_BYTES) != hipSuccess) { fprintf(stderr, "kernel_launch: hipFuncSetAttribute failed\n"); grid = -1; return; }
        if (hipOccupancyMaxActiveBlocksPerMultiprocessor(&per_cu, (const void*)hybrid_fwd, NWAVES * 64, LDS_BYTES) != hipSuccess || per_cu < 1)
            fprintf(stderr, "kernel_launch: note: occupancy query reports %d workgroups per CU\n", per_cu);
        (void)hipGetLastError();
        grid = cus;
    }
    if (grid < 0) return;
    if (hipMemsetAsync((char*)d_ws + WS_CTL, 0, CTL_ZERO_BYTES, stream) != hipSuccess) return;
    Args a{};
    for (int i = 0; i < N_IN; ++i) a.in[i] = d_in[i];
    a.out = (float*)d_out; a.ws = (unsigned char*)d_ws;
    if (MK_N_LAUNCHES == 1) { a.ph_lo = 0; a.ph_hi = N_PHASES; hipLaunchKernelGGL(hybrid_fwd, dim3(grid), dim3(NWAVES * 64), LDS_BYTES, stream, a); }
    else for (int p = 0; p < N_PHASES; ++p) { a.ph_lo = p; a.ph_hi = p + 1; hipLaunchKernelGGL(hybrid_fwd, dim3(grid), dim3(NWAVES * 64), LDS_BYTES, stream, a); }
    const hipError_t le = hipPeekAtLastError();
    if (le != hipSuccess) fprintf(stderr, "kernel_launch: launch failed: %s\n", hipGetErrorName(le));
}
```

```cpp
#include <hip/hip_runtime.h>
#include <hip/hip_bf16.h>
#include <cstdio>
#include <cstdint>
#include <cmath>

constexpr int DM = 1024, SEQ = 8192, NBAT = 2, MP = NBAT * SEQ, NSMP = 128, MT = MP + NSMP, MPAD = 16640;
constexpr int AW = 512, NHEAD = 8, HD = 64, NKV = 2, DFF = 4096, INC = 4376, NIN = 4608;
constexpr int PAST = 16384, NPAGES = 128, DECB = 32, DECS = 4, WIN = 512;
constexpr int NCP = 512, NCS = 1024;
constexpr float EPS = 1e-6f;
constexpr float QC2 = 0.125f * 1.4426950408889634f;

enum { I_XP = 0, I_XS, I_CKC, I_CVC, I_CKS, I_CVS, I_CKW, I_CVW, I_PT, I_G1, I_WIN, I_LNG, I_LNB, I_WS, I_BS, I_GQ, I_GKC, I_GKS, I_GKW,
       I_WCK1, I_WCK2, I_PEK, I_WCV1, I_WCV2, I_PEV, I_WBR, I_WOUT, I_G2, I_WUP, I_WDN, N_IN };
constexpr size_t O_YP = 0, O_YS = O_YP + (size_t)MP * DM, O_PKC = O_YS + (size_t)NSMP * DM, O_PVC = O_PKC + (size_t)MP * 128, O_PKS = O_PVC + (size_t)MP * 128,
                 O_PVS = O_PKS + (size_t)MP * 128, O_PKW = O_PVS + (size_t)MP * 128, O_PVW = O_PKW + (size_t)NBAT * WIN * 128, O_PVA = O_PVW + (size_t)NBAT * WIN * 128,
                 O_SKC = O_PVA + (size_t)NBAT * 128 * AW, O_SVC = O_SKC + NSMP * 128, O_SKS = O_SVC + NSMP * 128, O_SVS = O_SKS + NSMP * 128, O_SKW = O_SVS + NSMP * 128,
                 O_SVW = O_SKW + NSMP * 128, O_SVA = O_SVW + NSMP * 128, O_END = O_SVA + (size_t)NSMP * AW;
static_assert(O_END == 25853952, "output size");

constexpr size_t al256(size_t x) { return (x + 255) & ~(size_t)255; }
constexpr size_t WS_CTL = 0, CTL_ZERO_BYTES = 32768, CTL_RESERVED = 1u << 20;
constexpr size_t WS_WINT = CTL_RESERVED;
constexpr size_t WS_WBT = WS_WINT + (size_t)NIN * DM * 2;
constexpr size_t WS_WOT = WS_WBT + (size_t)DM * DM * 2;
constexpr size_t WS_WUP = WS_WOT + (size_t)DM * DM * 2;
constexpr size_t WS_WDN = WS_WUP + (size_t)DFF * DM * 2;
constexpr size_t WS_WC1K = WS_WDN + (size_t)DM * DFF * 2;
constexpr size_t WS_WC1V = WS_WC1K + 128 * 1024 * 2;
constexpr size_t WS_WSP = WS_WC1V + 128 * 1024 * 2;
constexpr size_t WS_WSS = WS_WSP + 8 * 128 * 128 * 2;
constexpr size_t WS_ROPE = WS_WSS + 8 * 128 * 128 * 2;
constexpr size_t WS_BPART = al256(WS_ROPE + 8196 * 16 * 4);
constexpr size_t WS_GAINS = al256(WS_BPART + 2 * 32 * 64 * 4);
constexpr size_t WS_XN = al256(WS_GAINS + 3 * 64 * 4);
constexpr size_t WS_U = WS_XN + (size_t)MPAD * DM * 2;
constexpr size_t WS_GV = WS_U + (size_t)MPAD * 512 * 2;
constexpr size_t WS_QN = WS_GV + (size_t)MPAD * 512 * 2;
constexpr size_t WS_QR = WS_QN + (size_t)MPAD * 512 * 2;
constexpr size_t WS_KCA = WS_QR + (size_t)MPAD * 512 * 2;
constexpr size_t WS_VCA = WS_KCA + 2048 * 1024 * 2;
constexpr size_t KVROWS = MPAD + 256;
constexpr size_t WS_KS = WS_VCA + 2048 * 1024 * 2;
constexpr size_t WS_VS = WS_KS + KVROWS * 128 * 2;
constexpr size_t WS_KW = WS_VS + KVROWS * 128 * 2;
constexpr size_t WS_VW = WS_KW + KVROWS * 128 * 2;
constexpr size_t WS_SG = WS_VW + KVROWS * 128 * 2;
constexpr size_t WS_NG = WS_SG + (size_t)MPAD * 2048 * 2;
constexpr size_t WS_FSPK = WS_NG + (size_t)MPAD * 32 * 4;
constexpr size_t WS_FSPV = WS_FSPK + 2048 * 128 * 4;
constexpr size_t WS_FSSK = WS_FSPV + 2048 * 128 * 4;
constexpr size_t WS_FSSV = WS_FSSK + (size_t)65536 * 128 * 4;
constexpr size_t WS_KCP = WS_FSSV + (size_t)65536 * 128 * 4;
constexpr size_t WS_VCP = WS_KCP + 4 * NCP * 64 * 2;
constexpr size_t WS_KCS = WS_VCP + 4 * NCP * 64 * 2;
constexpr size_t WS_VCS = WS_KCS + (size_t)64 * NCS * 64 * 2;
constexpr size_t WS_OAB = WS_VCS + (size_t)64 * NCS * 64 * 2;
constexpr size_t WS_MG = WS_OAB + (size_t)MPAD * DM * 2;
constexpr size_t WS_X1B = WS_MG + (size_t)MPAD * DM * 2;
constexpr size_t WS_SSQ = WS_X1B + (size_t)MPAD * DM * 2;
constexpr size_t WS_H = al256(WS_SSQ + (size_t)MPAD * 16 * 4);
constexpr size_t WS_OBF = WS_H + (size_t)MPAD * DFF * 2;
constexpr size_t WS_VST = WS_OBF + (size_t)MP * 512 * 4;
constexpr size_t WS_SSQS = WS_VST + (size_t)4 * 64 * SEQ * 2;
constexpr size_t WS_DBG = WS_SSQS + 128 * 64 * 4;
constexpr size_t WS_END = WS_DBG + (1u << 20);

constexpr int CW_TMO = 0, CW_CODE = 1, CW_BAR = 4096;

constexpr int LDS_BYTES = 147456;
constexpr int MISC_OFF = LDS_BYTES - 256;
constexpr int NWAVES = 8;

#define GAS __attribute__((address_space(1)))
#define LAS __attribute__((address_space(3)))
typedef unsigned short bf16;
typedef unsigned v4u __attribute__((ext_vector_type(4)));
typedef unsigned v2u __attribute__((ext_vector_type(2)));
typedef float f32x4 __attribute__((ext_vector_type(4)));
typedef float f32x16 __attribute__((ext_vector_type(16)));
typedef short bf16x8 __attribute__((ext_vector_type(8)));
typedef GAS unsigned gu32;
#define RLX_AGENT __ATOMIC_RELAXED, __HIP_MEMORY_SCOPE_AGENT
#define LDS_WAIT() asm volatile("s_waitcnt lgkmcnt(0)" ::: "memory")
#define VM_WAIT() asm volatile("s_waitcnt vmcnt(0)" ::: "memory")
__device__ __forceinline__ int tidx() { int t = (int)threadIdx.x; asm volatile("" : "+v"(t)); return t; }
__device__ __forceinline__ unsigned f2bf(float f) { unsigned u = __builtin_bit_cast(unsigned, f); return (u + 0x7fffu + ((u >> 16) & 1u)) >> 16; }
__device__ __forceinline__ unsigned pk2(float lo, float hi) { return f2bf(lo) | (f2bf(hi) << 16); }
__device__ __forceinline__ float bf2f(unsigned h) { return __builtin_bit_cast(float, h << 16); }
__device__ __forceinline__ float bflo(unsigned w) { return __builtin_bit_cast(float, w << 16); }
__device__ __forceinline__ float bfhi(unsigned w) { return __builtin_bit_cast(float, w & 0xffff0000u); }
__device__ __forceinline__ float fast_sigmoid(float x) { return __builtin_amdgcn_rcpf(1.f + __builtin_amdgcn_exp2f(-1.4426950408889634f * x)); }
__device__ __forceinline__ float gelu_tanh(float x) {
    const float u = 1.5957691216057308f * (x + 0.044715f * x * x * x);
    return x * __builtin_amdgcn_rcpf(1.f + __builtin_amdgcn_exp2f(-1.4426950408889634f * u));
}
__device__ __forceinline__ float wave_sum(float v) {
#pragma unroll
    for (int o = 1; o < 64; o <<= 1) v += __shfl_xor(v, o);
    return v;
}
__device__ __forceinline__ float wave_sum_dpp(float v) {
    v += __builtin_bit_cast(float, __builtin_amdgcn_update_dpp(0, __builtin_bit_cast(int, v), 0x111, 0xF, 0xF, true));
    v += __builtin_bit_cast(float, __builtin_amdgcn_update_dpp(0, __builtin_bit_cast(int, v), 0x112, 0xF, 0xF, true));
    v += __builtin_bit_cast(float, __builtin_amdgcn_update_dpp(0, __builtin_bit_cast(int, v), 0x114, 0xF, 0xF, true));
    v += __builtin_bit_cast(float, __builtin_amdgcn_update_dpp(0, __builtin_bit_cast(int, v), 0x118, 0xF, 0xF, true));
    v += __builtin_bit_cast(float, __builtin_amdgcn_update_dpp(0, __builtin_bit_cast(int, v), 0x142, 0xA, 0xF, false));
    v += __builtin_bit_cast(float, __builtin_amdgcn_update_dpp(0, __builtin_bit_cast(int, v), 0x143, 0xC, 0xF, false));
    return __builtin_bit_cast(float, __builtin_amdgcn_readlane(__builtin_bit_cast(int, v), 63));
}
__device__ __forceinline__ float wave_max_dpp(float v) {
    v = fmaxf(v, __builtin_bit_cast(float, __builtin_amdgcn_update_dpp(__builtin_bit_cast(int, v), __builtin_bit_cast(int, v), 0x111, 0xF, 0xF, false)));
    v = fmaxf(v, __builtin_bit_cast(float, __builtin_amdgcn_update_dpp(__builtin_bit_cast(int, v), __builtin_bit_cast(int, v), 0x112, 0xF, 0xF, false)));
    v = fmaxf(v, __builtin_bit_cast(float, __builtin_amdgcn_update_dpp(__builtin_bit_cast(int, v), __builtin_bit_cast(int, v), 0x114, 0xF, 0xF, false)));
    v = fmaxf(v, __builtin_bit_cast(float, __builtin_amdgcn_update_dpp(__builtin_bit_cast(int, v), __builtin_bit_cast(int, v), 0x118, 0xF, 0xF, false)));
    v = fmaxf(v, __builtin_bit_cast(float, __builtin_amdgcn_update_dpp(__builtin_bit_cast(int, v), __builtin_bit_cast(int, v), 0x142, 0xA, 0xF, false)));
    v = fmaxf(v, __builtin_bit_cast(float, __builtin_amdgcn_update_dpp(__builtin_bit_cast(int, v), __builtin_bit_cast(int, v), 0x143, 0xC, 0xF, false)));
    return __builtin_bit_cast(float, __builtin_amdgcn_readlane(__builtin_bit_cast(int, v), 63));
}
__device__ __forceinline__ float wave_max(float v) {
#pragma unroll
    for (int o = 1; o < 64; o <<= 1) v = fmaxf(v, __shfl_xor(v, o));
    return v;
}
__host__ __device__ __forceinline__ int dmap(int s) { if (s >= 16) return s; const int f = s >> 3, p = s & 7; return p < 4 ? 4 * f + p : 4 + 4 * f + p; }
__host__ __device__ __forceinline__ int win_map(int j) {
    const int t = j >> 8, L = j & 255;
    if (t < 4) return j;
    const int h = (L >> 5) & 3, s = ((L >> 7) << 5) | (L & 31);
    if (t < 6) return 1024 + ((t - 4) * 4 + h) * 64 + dmap(s);
    if (t == 6) return 1536 + L;
    if (t == 7) return 1792 + (h >> 1) * 128 + (h & 1) * 64 + dmap(s);
    if (t == 8) return 2048 + (h >> 1) * 128 + (h & 1) * 64 + dmap(s);
    if (t < 17) return 2328 + ((L >> 7) ? 1024 : 0) + 128 * (t - 9) + (L & 127);
    return L < 24 ? 2304 + L : -1;
}
namespace pg8 {
#define PG8_LAS __attribute__((address_space(3)))
typedef unsigned short bf16_t;
typedef short bf16x8 __attribute__((ext_vector_type(8)));
typedef float f32x4 __attribute__((ext_vector_type(4)));
typedef unsigned u32x4 __attribute__((ext_vector_type(4)));
constexpr int BM = 256, BK = 64, HALF = 128, HTB = HALF * BK * 2  , STAGE_BYTES = 8 * HTB, NXCD = 8, WGM = 8;

__host__ __device__ __forceinline__ int lds_byte(int r, int c) { const int st = (r >> 4) * 2 + (c >> 5), rr = r & 15, cc = c & 31, ob = rr * 64 + cc * 2; return st * 1024 + (ob ^ (((ob >> 9) & 1) << 5)); }
__host__ __device__ __forceinline__ void stage_rc(int b, int& R, int& C) { const int st = b / 1024, sb = b % 1024, swz = sb ^ (((sb >> 9) & 1) << 5); R = (st >> 1) * 16 + swz / 64; C = (st & 1) * 32 + (swz % 64) / 2; }
__host__ __device__ __forceinline__ int perm32(int rho) { const int n = rho >> 4, i = rho & 15; return 8 * (i >> 2) + 4 * n + (i & 3); }

struct Unit { int pm, pn; };
struct Gemm { const bf16_t* A; const bf16_t* Bt; int M, N, K; };

struct StaticOrder {
    int nM, nN, nwg, G, c;
    __host__ __device__ void init(int M, int N, int G_, int c_) { nM = M / BM; nN = N / BM; nwg = nM * nN; G = G_; c = c_; }
    __host__ __device__ bool next(int i, Unit& u) const {
        const long L = (long)i * G + c; if (L >= nwg) return false;
        int wgid = (int)L; { const int q = nwg / NXCD, r = nwg % NXCD, xcd = wgid % NXCD, off = wgid / NXCD; wgid = (xcd < r ? xcd * (q + 1) : r * (q + 1) + (xcd - r) * q) + off; }
        const int nig = WGM * nN, gid = wgid / nig, fm = gid * WGM, gsz = (nM - fm) < WGM ? (nM - fm) : WGM;
        u.pm = fm + ((wgid % nig) % gsz); u.pn = (wgid % nig) / gsz; return true;
    }
    __device__ __forceinline__ void a_ready(const Unit&) const {}
    __device__ __forceinline__ void done(const Unit&) const {}
};

__device__ __forceinline__ unsigned cvt_pk_bf16(float lo, float hi) { unsigned r; asm volatile("v_cvt_pk_bf16_f32 %0, %1, %2" : "=v"(r) : "v"(lo), "v"(hi)); return r; }
typedef float f32x2 __attribute__((ext_vector_type(2)));
__device__ __forceinline__ u32x4 pack8(const f32x4 a, const f32x4 b) { u32x4 w; w.x = cvt_pk_bf16(a[0], a[1]); w.y = cvt_pk_bf16(a[2], a[3]); w.z = cvt_pk_bf16(b[0], b[1]); w.w = cvt_pk_bf16(b[2], b[3]); return w; }
typedef unsigned u32x2 __attribute__((ext_vector_type(2)));

struct EpiIn {
    static constexpr bool PERM = true, AFTER_DRAIN = false, HAS_MID = false;
    unsigned char* ws; float* out;
    __device__ __forceinline__ void operator()(const f32x4 (&acc)[2][2][4][2], const Unit& u, int wr, int wc, int fr, int fq) const { asm volatile("" : "+v"(fr));
        const int pn = u.pn, rbase = u.pm * BM + wr * 64 + fr;
        if (pn < 4) {
            bf16_t* dst = (bf16_t*)(ws + (pn < 2 ? WS_U : WS_GV)) + (pn & 1) * 256 + wc * 32 + 8 * fq;
#pragma unroll
            for (int ai = 0; ai < 2; ++ai)
#pragma unroll
                for (int m = 0; m < 4; ++m) { const int row = rbase + ai * HALF + m * 16;
#pragma unroll
                    for (int bj = 0; bj < 2; ++bj) { f32x4 v0 = acc[ai][bj][m][0], v1 = acc[ai][bj][m][1];
#pragma unroll
                        for (int i = 0; i < 4; ++i) { v0[i] = gelu_tanh(v0[i]); v1[i] = gelu_tanh(v1[i]); }
                        *(u32x4*)(dst + (size_t)row * 512 + bj * HALF) = pack8(v0, v1); } }
        } else if (pn < 6 || pn == 7 || pn == 8) {
            const bool isq = pn < 6, isk = isq || wc < 2;
            const float* g = (const float*)(ws + WS_GAINS) + (isq ? 0 : (pn == 7 ? 64 : 128)); const float* rope = (const float*)(ws + WS_ROPE);
            const int d1 = fq < 2 ? 4 * fq : 8 * fq, d2 = fq < 2 ? 8 + 4 * fq : 8 * fq + 4, d3 = 32 + 8 * fq;
            f32x4 g1 = {1.f, 1.f, 1.f, 1.f}, g2 = g1, g3a = g1, g3b = g1;
            if (isk) { g1 = *(const f32x4*)(g + d1); g2 = *(const f32x4*)(g + d2); g3a = *(const f32x4*)(g + d3); g3b = *(const f32x4*)(g + d3 + 4); }
            const float osc = isq ? QC2 : 1.f;
#pragma unroll
            for (int ai = 0; ai < 2; ++ai)
#pragma unroll
                for (int m = 0; m < 4; ++m) { const int row = rbase + ai * HALF + m * 16;
                    f32x4 a = acc[ai][0][m][0], b = acc[ai][0][m][1], c = acc[ai][1][m][0], d = acc[ai][1][m][1];
                    f32x4 ra = a, rb = b;
                    if (isk) {
                        float ss = (a[0] * a[0] + a[1] * a[1]) + (a[2] * a[2] + a[3] * a[3]) + (b[0] * b[0] + b[1] * b[1]) + (b[2] * b[2] + b[3] * b[3])
                                 + (c[0] * c[0] + c[1] * c[1]) + (c[2] * c[2] + c[3] * c[3]) + (d[0] * d[0] + d[1] * d[1]) + (d[2] * d[2] + d[3] * d[3]);
                        ss += __shfl_xor(ss, 16); ss += __shfl_xor(ss, 32);
                        const float rstd = 1.f / sqrtf(ss * (1.f / 64.f) + EPS);
                        a = a * rstd * g1; b = b * rstd * g2; c = c * rstd * g3a; d = d * rstd * g3b;
                        const int pidx = row < MP ? (row & (SEQ - 1)) : SEQ + ((row - MP) & 3);
                        f32x4 cs = {1.f, 1.f, 1.f, 1.f}, sn = {0.f, 0.f, 0.f, 0.f};
                        if (fq < 2) { cs = *(const f32x4*)(rope + pidx * 16 + 4 * fq); sn = *(const f32x4*)(rope + pidx * 16 + 8 + 4 * fq); }
                        ra = a * cs - b * sn; rb = b * cs + a * sn;
                    }
                    if (isq) {
                        const int head = (pn - 4) * 4 + wc; bf16_t* qn = (bf16_t*)(ws + WS_QN) + (size_t)row * 512 + head * 64; bf16_t* qr = (bf16_t*)(ws + WS_QR) + (size_t)row * 512 + head * 64;
                        const f32x4 cc = c * osc, dd = d * osc;
                        { f32x4 x = a * osc, y = b * osc; u32x2 w; w.x = cvt_pk_bf16(x[0], x[1]); w.y = cvt_pk_bf16(x[2], x[3]); *(u32x2*)(qn + d1) = w; w.x = cvt_pk_bf16(y[0], y[1]); w.y = cvt_pk_bf16(y[2], y[3]); *(u32x2*)(qn + d2) = w; }
                        { f32x4 x = ra * osc, y = rb * osc; u32x2 w; w.x = cvt_pk_bf16(x[0], x[1]); w.y = cvt_pk_bf16(x[2], x[3]); *(u32x2*)(qr + d1) = w; w.x = cvt_pk_bf16(y[0], y[1]); w.y = cvt_pk_bf16(y[2], y[3]); *(u32x2*)(qr + d2) = w; }
                        const u32x4 w3 = pack8(cc, dd); *(u32x4*)(qn + d3) = w3; *(u32x4*)(qr + d3) = w3;
                    } else {
                        const int kvh = wc & 1; const bool kw = (pn == 8);
                        bf16_t* bd = (bf16_t*)(ws + (isk ? (kw ? WS_KW : WS_KS) : (kw ? WS_VW : WS_VS))) + (size_t)row * 128 + kvh * 64;
                        { u32x2 w; w.x = cvt_pk_bf16(ra[0], ra[1]); w.y = cvt_pk_bf16(ra[2], ra[3]); *(u32x2*)(bd + d1) = w; w.x = cvt_pk_bf16(rb[0], rb[1]); w.y = cvt_pk_bf16(rb[2], rb[3]); *(u32x2*)(bd + d2) = w; }
                        *(u32x4*)(bd + d3) = pack8(c, d);
                        float* so = nullptr;
                        if (row < MP) { if (!kw) so = out + (isk ? O_PKS : O_PVS) + (size_t)row * 128; else { const int t = row & (SEQ - 1), b = row >> 13; if (t >= SEQ - WIN) so = out + (isk ? O_PKW : O_PVW) + ((size_t)b * WIN + (t - (SEQ - WIN))) * 128; } }
                        else if (row < MT) so = out + (kw ? (isk ? O_SKW : O_SVW) : (isk ? O_SKS : O_SVS)) + (size_t)(row - MP) * 128;
                        if (so) { so += kvh * 64; *(f32x4*)(so + d1) = ra; *(f32x4*)(so + d2) = rb; *(f32x4*)(so + d3) = c; *(f32x4*)(so + d3 + 4) = d; }
                    }
                }
        } else if (pn == 6) {
#pragma unroll
            for (int ai = 0; ai < 2; ++ai)
#pragma unroll
                for (int m = 0; m < 4; ++m) { const int row = rbase + ai * HALF + m * 16;
#pragma unroll
                    for (int bj = 0; bj < 2; ++bj) { const f32x4 v0 = acc[ai][bj][m][0], v1 = acc[ai][bj][m][1]; const int col = wc * 32 + 8 * fq;
                        if (row < MT) { float* so = out + (row < MP ? (bj ? O_PVC : O_PKC) + (size_t)row * 128 : (bj ? O_SVC : O_SKC) + (size_t)(row - MP) * 128) + col; *(f32x4*)so = v0; *(f32x4*)(so + 4) = v1; }
                        if (row < MP) { bf16_t* ca = (bf16_t*)(ws + (bj ? WS_VCA : WS_KCA)) + ((size_t)(row >> 4) * 2 + (wc >> 1)) * 1024 + (row & 15) * 64 + (wc & 1) * 32 + 8 * fq; *(u32x4*)ca = pack8(v0, v1); } } }
        } else if (pn < 17) {
            bf16_t* dst = (bf16_t*)(ws + WS_SG) + (pn - 9) * 128 + wc * 32 + 8 * fq;
#pragma unroll
            for (int ai = 0; ai < 2; ++ai)
#pragma unroll
                for (int m = 0; m < 4; ++m) { const int row = rbase + ai * HALF + m * 16;
                    f32x4 a0 = acc[ai][0][m][0], a1 = acc[ai][0][m][1], b0 = acc[ai][1][m][0], b1 = acc[ai][1][m][1]; f32x4 r0, r1, s0, s1;
#pragma unroll
                    for (int i = 0; i < 4; ++i) { a0[i] = fminf(fmaxf(a0[i], -30.f), 30.f); a1[i] = fminf(fmaxf(a1[i], -30.f), 30.f); b0[i] = fminf(fmaxf(b0[i], -30.f), 30.f); b1[i] = fminf(fmaxf(b1[i], -30.f), 30.f); }
#pragma unroll
                    for (int i = 0; i < 4; ++i) { const float ea0 = 1.f + __builtin_amdgcn_exp2f(-1.4426950408889634f * a0[i]), ea1 = 1.f + __builtin_amdgcn_exp2f(-1.4426950408889634f * a1[i]);
                        const float eb0 = 1.f + __builtin_amdgcn_exp2f(-1.4426950408889634f * b0[i]), eb1 = 1.f + __builtin_amdgcn_exp2f(-1.4426950408889634f * b1[i]);
                        r0[i] = eb0 * __builtin_amdgcn_rcpf(ea0); r1[i] = eb1 * __builtin_amdgcn_rcpf(ea1); s0[i] = __builtin_amdgcn_rcpf(eb0); s1[i] = __builtin_amdgcn_rcpf(eb1); }
                    *(u32x4*)(dst + (size_t)row * 2048) = pack8(r0, r1); *(u32x4*)(dst + (size_t)row * 2048 + 1024) = pack8(s0, s1); }
        } else {
            if (wc == 0 && fq < 3) {
#pragma unroll
                for (int ai = 0; ai < 2; ++ai)
#pragma unroll
                    for (int m = 0; m < 4; ++m) { const int row = rbase + ai * HALF + m * 16; f32x4 v0 = acc[ai][0][m][0], v1 = acc[ai][0][m][1];
#pragma unroll
                        for (int i = 0; i < 4; ++i) { v0[i] = fast_sigmoid(v0[i]); v1[i] = fast_sigmoid(v1[i]); }
                        float* d = (float*)(ws + WS_NG) + (size_t)row * 32 + 8 * fq; *(f32x4*)d = v0; *(f32x4*)(d + 4) = v1; }
            }
        }
    }
};

__device__ __forceinline__ void unpack8(const u32x4 w, float (&f)[8]) {
    f[0] = __builtin_bit_cast(float, w.x << 16); f[1] = __builtin_bit_cast(float, w.x & 0xffff0000u); f[2] = __builtin_bit_cast(float, w.y << 16); f[3] = __builtin_bit_cast(float, w.y & 0xffff0000u);
    f[4] = __builtin_bit_cast(float, w.z << 16); f[5] = __builtin_bit_cast(float, w.z & 0xffff0000u); f[6] = __builtin_bit_cast(float, w.w << 16); f[7] = __builtin_bit_cast(float, w.w & 0xffff0000u);
}
struct EpiMerge {
    static constexpr bool PERM = true, AFTER_DRAIN = false, HAS_MID = true;
    const bf16_t* SG; bf16_t* MG;
    __device__ __forceinline__ void mid(f32x4 (&acc)[2][2][4][2], const Unit& u, int wr, int wc, int fr, int fq) const { asm volatile("" : "+v"(fr));
        const int row0 = u.pm * BM + wr * 64 + fr, col0 = u.pn * BM + wc * 32 + 8 * fq;
#pragma unroll
        for (int ai = 0; ai < 2; ++ai)
#pragma unroll
            for (int m = 0; m < 4; ++m) { const size_t row = (size_t)(row0 + ai * HALF + m * 16);
#pragma unroll
                for (int bj = 0; bj < 2; ++bj) { const int col = col0 + bj * HALF; float rg[8]; unpack8(*(const u32x4*)(SG + row * 2048 + col), rg);
#pragma unroll
                    for (int i = 0; i < 4; ++i) { acc[ai][bj][m][0][i] *= rg[i]; acc[ai][bj][m][1][i] *= rg[4 + i]; } } }
    }
    __device__ __forceinline__ void operator()(const f32x4 (&acc)[2][2][4][2], const Unit& u, int wr, int wc, int fr, int fq) const { asm volatile("" : "+v"(fr));
        const int row0 = u.pm * BM + wr * 64 + fr, col0 = u.pn * BM + wc * 32 + 8 * fq;
#pragma unroll
        for (int ai = 0; ai < 2; ++ai)
#pragma unroll
            for (int m = 0; m < 4; ++m) { const size_t row = (size_t)(row0 + ai * HALF + m * 16);
#pragma unroll
                for (int bj = 0; bj < 2; ++bj) { const int col = col0 + bj * HALF; float gb[8]; unpack8(*(const u32x4*)(SG + row * 2048 + 1024 + col), gb);
                    const f32x4 v0 = acc[ai][bj][m][0], v1 = acc[ai][bj][m][1]; f32x4 o0, o1;
#pragma unroll
                    for (int i = 0; i < 4; ++i) { o0[i] = gb[i] * v0[i]; o1[i] = gb[4 + i] * v1[i]; }
                    *(u32x4*)(MG + row * DM + col) = pack8(o0, o1); } }
    }
};
__device__ __forceinline__ float* yrow(float* out, int row) { return row < MP ? out + O_YP + (size_t)row * DM : out + O_YS + (size_t)(row - MP) * DM; }
struct EpiOut {
    static constexpr bool PERM = true, AFTER_DRAIN = false, HAS_MID = false;
    const float* xp; const float* xs; float* out; bf16_t* X1B; float* SSQ;
    __device__ __forceinline__ void operator()(const f32x4 (&acc)[2][2][4][2], const Unit& u, int wr, int wc, int fr, int fq) const { asm volatile("" : "+v"(fr));
        const int row0 = u.pm * BM + wr * 64 + fr, col0 = u.pn * BM + wc * 32 + 8 * fq;
#pragma unroll
        for (int ai = 0; ai < 2; ++ai)
#pragma unroll
            for (int m = 0; m < 4; ++m) { const int row = row0 + ai * HALF + m * 16; float ss = 0.f;
                const float* xr = xp + (size_t)row * DM; if (row >= MP) xr = xs + (size_t)(row - MP) * DM;
#pragma unroll
                for (int bj = 0; bj < 2; ++bj) { const int col = col0 + bj * HALF; f32x4 v0 = acc[ai][bj][m][0], v1 = acc[ai][bj][m][1];
                    if (row < MT) { v0 = v0 + *(const f32x4*)(xr + col); v1 = v1 + *(const f32x4*)(xr + col + 4); }
                    ss += (v0[0] * v0[0] + v0[1] * v0[1]) + (v0[2] * v0[2] + v0[3] * v0[3]) + (v1[0] * v1[0] + v1[1] * v1[1]) + (v1[2] * v1[2] + v1[3] * v1[3]);
                    *(u32x4*)(X1B + (size_t)row * DM + col) = pack8(v0, v1); }
                ss += __shfl_xor(ss, 16); ss += __shfl_xor(ss, 32);
                if (fq == 0) SSQ[(size_t)row * 16 + u.pn * 4 + wc] = ss; }
    }
};
struct EpiUp {
    static constexpr bool PERM = true, AFTER_DRAIN = false, HAS_MID = false;
    const float* SSQ; bf16_t* H;
    __device__ __forceinline__ void operator()(const f32x4 (&acc)[2][2][4][2], const Unit& u, int wr, int wc, int fr, int fq) const { asm volatile("" : "+v"(fr));
        const int row0 = u.pm * BM + wr * 64 + fr, col0 = u.pn * BM + wc * 32 + 8 * fq;
#pragma unroll
        for (int ai = 0; ai < 2; ++ai)
#pragma unroll
            for (int m = 0; m < 4; ++m) { const size_t row = (size_t)(row0 + ai * HALF + m * 16);
                const f32x4 s0 = *(const f32x4*)(SSQ + row * 16), s1 = *(const f32x4*)(SSQ + row * 16 + 4), s2 = *(const f32x4*)(SSQ + row * 16 + 8), s3 = *(const f32x4*)(SSQ + row * 16 + 12);
                const f32x4 st = (s0 + s1) + (s2 + s3); const float rstd = 1.f / sqrtf(((st[0] + st[1]) + (st[2] + st[3])) * (1.f / DM) + EPS);
#pragma unroll
                for (int bj = 0; bj < 2; ++bj) { f32x4 v0 = acc[ai][bj][m][0] * rstd, v1 = acc[ai][bj][m][1] * rstd;
#pragma unroll
                    for (int i = 0; i < 4; ++i) { const float a = fmaxf(v0[i], 0.f), b = fmaxf(v1[i], 0.f); v0[i] = a * a; v1[i] = b * b; }
                    *(u32x4*)(H + row * DFF + col0 + bj * HALF) = pack8(v0, v1); } }
    }
};
struct EpiDown {
    static constexpr bool PERM = true, AFTER_DRAIN = false, HAS_MID = false;
    float* out; const bf16_t* X1B;
    __device__ __forceinline__ void operator()(const f32x4 (&acc)[2][2][4][2], const Unit& u, int wr, int wc, int fr, int fq) const { asm volatile("" : "+v"(fr));
        const int row0 = u.pm * BM + wr * 64 + fr, col0 = u.pn * BM + wc * 32 + 8 * fq;
#pragma unroll
        for (int ai = 0; ai < 2; ++ai)
#pragma unroll
            for (int m = 0; m < 4; ++m) { const int row = row0 + ai * HALF + m * 16;
                if (row < MT) { float* y = yrow(out, row) + col0; const bf16_t* xb = X1B + (size_t)row * DM + col0;
#pragma unroll
                    for (int bj = 0; bj < 2; ++bj) { float x[8]; unpack8(*(const u32x4*)(xb + bj * HALF), x);
                        *(f32x4*)(y + bj * HALF) = (f32x4){x[0], x[1], x[2], x[3]} + acc[ai][bj][m][0]; *(f32x4*)(y + bj * HALF + 4) = (f32x4){x[4], x[5], x[6], x[7]} + acc[ai][bj][m][1]; } } }
    }
};

template <class Epi, class Sched, bool ALIGN_EPI = false, bool SP2 = false>
__device__ __forceinline__ void gemm_phase(PG8_LAS unsigned char* lds, const Gemm g, const Sched& S, const Epi& E) {
    const int tid = tidx(), wid = __builtin_amdgcn_readfirstlane(tid >> 6), lane = tid & 63, wr = wid >> 2, wc = wid & 3, fr = lane & 15, fq = lane >> 4;
    const int K = g.K, nt = K / BK;
    unsigned voffA[2], voffB[2];
#pragma unroll
    for (int i = 0; i < 2; ++i) { int R, C; stage_rc(tid * 16 + i * 8192, R, C); const int Rb = Epi::PERM ? ((R & ~31) + perm32(R & 31)) : R;
        voffA[i] = (unsigned)(R * K + C) * 2u; voffB[i] = (unsigned)(Rb * K + C) * 2u; }
    const size_t kstep = (size_t)(BK * 2);
    const size_t hstep = (size_t)HALF * K * 2;
    const size_t tstep = 2 * hstep;
    const unsigned ldsw = (unsigned)wid * 1024u;
    const int aoff = lds_byte(wr * 64 + fr, fq * 8), boff = lds_byte(wc * 32 + fr, fq * 8);
#define PG8_SA(b, h) (((b) * 2 + (h)) * HTB)
#define PG8_SB(b, h) ((4 + (b) * 2 + (h)) * HTB)
#define PG8_STAGE(bufoff, gbase, voff) do { _Pragma("unroll") for (int _i = 0; _i < 2; ++_i) \
        __builtin_amdgcn_global_load_lds((const unsigned*)((const char*)(gbase) + (voff)[_i]), (PG8_LAS unsigned*)(lds + (bufoff) + ldsw + _i * 8192), 16, 0, 0); } while (0)
#define PG8_LDA(dst, b, h) do { _Pragma("unroll") for (int m = 0; m < 4; ++m) _Pragma("unroll") for (int k = 0; k < 2; ++k) dst[m][k] = *(const PG8_LAS bf16x8*)(lds + PG8_SA(b, h) + aoff + m * 2048 + k * 1024); } while (0)
#define PG8_LDB(dst, b, h) do { _Pragma("unroll") for (int n = 0; n < 2; ++n) _Pragma("unroll") for (int k = 0; k < 2; ++k) dst[n][k] = *(const PG8_LAS bf16x8*)(lds + PG8_SB(b, h) + boff + n * 2048 + k * 1024); } while (0)
#define PG8_MMA(ai, bj, At, Bt) do { __builtin_amdgcn_s_setprio(1); _Pragma("unroll") for (int m = 0; m < 4; ++m) _Pragma("unroll") for (int n = 0; n < 2; ++n) _Pragma("unroll") for (int k = 0; k < 2; ++k) \
        acc[ai][bj][m][n] = __builtin_amdgcn_mfma_f32_16x16x32_bf16(Bt[n][k], At[m][k], acc[ai][bj][m][n], 0, 0, 0); __builtin_amdgcn_s_setprio(0); } while (0)
#define PG8_WAIT_V(n) asm volatile("s_waitcnt vmcnt(" #n ")" ::: "memory")
#define PG8_WAIT_L(n) asm volatile("s_waitcnt lgkmcnt(" #n ")" ::: "memory")
#define PG8_BAR __builtin_amdgcn_s_barrier()
#define PG8_SCHED __builtin_amdgcn_sched_barrier(0)
    Unit cur, nxt; int ui = 0;
    if (!S.next(0, cur)) return;
    f32x4 acc[2][2][4][2];
#pragma unroll
    for (int a = 0; a < 2; ++a)
#pragma unroll
        for (int b = 0; b < 2; ++b)
#pragma unroll
            for (int m = 0; m < 4; ++m)
#pragma unroll
                for (int n = 0; n < 2; ++n) acc[a][b][m][n] = (f32x4){0.f, 0.f, 0.f, 0.f};
    bf16x8 At[4][2], B0[2][2], B1[2][2];
    const char* cA = (const char*)g.A + (size_t)cur.pm * tstep; const char* cB = (const char*)g.Bt + (size_t)cur.pn * tstep;
    S.a_ready(cur);
    if constexpr (SP2) {
        PG8_STAGE(PG8_SB(0, 0), cB, voffB); PG8_STAGE(PG8_SB(0, 1), cB + hstep, voffB); PG8_STAGE(PG8_SA(0, 0), cA, voffA); PG8_STAGE(PG8_SA(0, 1), cA + hstep, voffA);
        if (wr == 1) PG8_BAR;
        PG8_WAIT_V(2); PG8_BAR;
        PG8_STAGE(PG8_SB(1, 0), cB + kstep, voffB); PG8_STAGE(PG8_SA(1, 0), cA + kstep, voffA); PG8_STAGE(PG8_SB(1, 1), cB + hstep + kstep, voffB);
        PG8_WAIT_V(6); PG8_BAR;
    } else {
        PG8_STAGE(PG8_SB(0, 0), cB, voffB); PG8_STAGE(PG8_SA(0, 0), cA, voffA); PG8_STAGE(PG8_SB(0, 1), cB + hstep, voffB); PG8_STAGE(PG8_SA(0, 1), cA + hstep, voffA);
        if (wr == 1) PG8_BAR;
        PG8_WAIT_V(4); PG8_BAR;
        PG8_STAGE(PG8_SB(1, 0), cB + kstep, voffB); PG8_STAGE(PG8_SA(1, 0), cA + kstep, voffA); PG8_STAGE(PG8_SB(1, 1), cB + hstep + kstep, voffB);
        PG8_WAIT_V(6); PG8_BAR;
    }
    for (;;) {
        const bool has_next = S.next(ui + 1, nxt);
        const char* nA = has_next ? (const char*)g.A + (size_t)nxt.pm * tstep : cA; const char* nB = has_next ? (const char*)g.Bt + (size_t)nxt.pn * tstep : cB;
        for (int t = 0; t < nt; t += 2) {
            const bool last = (t == nt - 2);
            const char* a1 = cA + (size_t)(t + 1) * kstep;
            const char* a2 = last ? nA : cA + (size_t)(t + 2) * kstep; const char* b2 = last ? nB : cB + (size_t)(t + 2) * kstep;
            const char* a3 = a2 + kstep; const char* b3 = b2 + kstep;
            if (last && has_next) S.a_ready(nxt);
            if constexpr (SP2) {
            PG8_LDB(B0, 0, 0); PG8_LDB(B1, 0, 1); PG8_SCHED; PG8_LDA(At, 0, 0); PG8_STAGE(PG8_SA(1, 1), a1 + hstep, voffA);
            PG8_WAIT_V(8); PG8_WAIT_L(0); PG8_BAR; PG8_MMA(0, 0, At, B0); PG8_MMA(0, 1, At, B1); PG8_BAR; PG8_SCHED;
            PG8_LDA(At, 0, 1); PG8_STAGE(PG8_SB(0, 0), b2, voffB); PG8_STAGE(PG8_SB(0, 1), b2 + hstep, voffB); PG8_STAGE(PG8_SA(0, 0), a2, voffA);
            PG8_WAIT_V(8); PG8_WAIT_L(0); PG8_BAR; PG8_MMA(1, 0, At, B0); PG8_MMA(1, 1, At, B1); PG8_BAR; PG8_SCHED;
            PG8_LDB(B0, 1, 0); PG8_LDB(B1, 1, 1); PG8_SCHED; PG8_LDA(At, 1, 0); PG8_STAGE(PG8_SA(0, 1), a2 + hstep, voffA);
            PG8_WAIT_V(8); PG8_WAIT_L(0); PG8_BAR; PG8_MMA(0, 0, At, B0); PG8_MMA(0, 1, At, B1); PG8_BAR; PG8_SCHED;
            PG8_LDA(At, 1, 1); PG8_STAGE(PG8_SB(1, 0), b3, voffB); PG8_STAGE(PG8_SB(1, 1), b3 + hstep, voffB); PG8_STAGE(PG8_SA(1, 0), a3, voffA);
            PG8_WAIT_V(8); PG8_WAIT_L(0); PG8_BAR; PG8_MMA(1, 0, At, B0); PG8_MMA(1, 1, At, B1); PG8_BAR; PG8_SCHED;
            if constexpr (Epi::HAS_MID) { if (t == nt / 2 - 2) { E.mid(acc, cur, wr, wc, fr, fq); PG8_WAIT_V(0); PG8_SCHED; } }
            } else {
            PG8_LDB(B0, 0, 0); PG8_SCHED; PG8_LDA(At, 0, 0); PG8_STAGE(PG8_SA(1, 1), a1 + hstep, voffA);
            PG8_WAIT_L(8); PG8_BAR; PG8_WAIT_L(0); PG8_MMA(0, 0, At, B0); PG8_BAR; PG8_SCHED;
            PG8_LDB(B1, 0, 1); PG8_STAGE(PG8_SB(0, 0), b2, voffB);
            PG8_BAR; PG8_WAIT_L(0); PG8_MMA(0, 1, At, B1); PG8_BAR;
            PG8_LDA(At, 0, 1); PG8_STAGE(PG8_SA(0, 0), a2, voffA);
            PG8_BAR; PG8_WAIT_L(0); PG8_MMA(1, 0, At, B0); PG8_BAR; PG8_SCHED;
            PG8_STAGE(PG8_SB(0, 1), b2 + hstep, voffB);
            PG8_WAIT_V(6); PG8_BAR; PG8_MMA(1, 1, At, B1); PG8_BAR;
            PG8_LDB(B0, 1, 0); PG8_SCHED; PG8_LDA(At, 1, 0); PG8_STAGE(PG8_SA(0, 1), a2 + hstep, voffA);
            PG8_WAIT_L(8); PG8_BAR; PG8_WAIT_L(0); PG8_MMA(0, 0, At, B0); PG8_BAR; PG8_SCHED;
            PG8_LDB(B1, 1, 1); PG8_STAGE(PG8_SB(1, 0), b3, voffB);
            PG8_BAR; PG8_WAIT_L(0); PG8_MMA(0, 1, At, B1); PG8_BAR;
            PG8_LDA(At, 1, 1); PG8_STAGE(PG8_SA(1, 0), a3, voffA);
            PG8_BAR; PG8_WAIT_L(0); PG8_MMA(1, 0, At, B0); PG8_BAR; PG8_SCHED;
            PG8_STAGE(PG8_SB(1, 1), b3 + hstep, voffB);
            PG8_WAIT_V(6); PG8_BAR; PG8_MMA(1, 1, At, B1); PG8_BAR;
            }
        }
        if constexpr (ALIGN_EPI) { if (wr == 0) PG8_BAR; }
        if constexpr (!Epi::AFTER_DRAIN) { E(acc, cur, wr, wc, fr, fq); S.done(cur); }
        if (!has_next) break;
#pragma unroll
        for (int a = 0; a < 2; ++a)
#pragma unroll
            for (int b = 0; b < 2; ++b)
#pragma unroll
                for (int m = 0; m < 4; ++m)
#pragma unroll
                    for (int n = 0; n < 2; ++n) acc[a][b][m][n] = (f32x4){0.f, 0.f, 0.f, 0.f};
        cur = nxt; cA = nA; cB = nB; ++ui;
        if constexpr (ALIGN_EPI) { if (wr == 1) PG8_BAR; }
    }
    PG8_WAIT_V(0);
    if constexpr (!ALIGN_EPI) { if (wr == 0) PG8_BAR; }
    PG8_BAR;
    if constexpr (Epi::AFTER_DRAIN) { E.fused(acc, cur, wr, wc, fr, fq, lds, wid, lane); S.done(cur); }
#undef PG8_SA
#undef PG8_SB
#undef PG8_STAGE
#undef PG8_LDA
#undef PG8_LDB
#undef PG8_MMA
#undef PG8_WAIT_V
#undef PG8_WAIT_L
#undef PG8_BAR
#undef PG8_SCHED
}
}
#define XB_TMO      128
#define XB_XCNT(j)  (256  + 64 * (j))
#define XB_XSUB(j)  (1280 + 64 * (j))
#define XB_XGEN(j)  (2304 + 64 * (j))
#define XB_TOP      3328
#define XB_TOPGEN   3392
#define XCD_BAR_WORDS 3456
#define XB_SPIN_CAP (1u << 18)

__device__ __forceinline__ unsigned xb_ld(unsigned* p)              { return __hip_atomic_load(p, __ATOMIC_RELAXED, __HIP_MEMORY_SCOPE_AGENT); }
__device__ __forceinline__ unsigned xb_add(unsigned* p, unsigned v) { return __hip_atomic_fetch_add(p, v, __ATOMIC_RELAXED, __HIP_MEMORY_SCOPE_AGENT); }
__device__ __forceinline__ unsigned xb_xcc_id() { return (unsigned)__builtin_amdgcn_s_getreg((3 << 11) | 20) & 0xFu; }
#define XB_SPIN(cond, bar) do { unsigned _sp = 0; while (cond) { __builtin_amdgcn_s_sleep(1); \
    if ((++_sp & 255u) == 0u) { if (xb_ld(&(bar)[XB_TMO])) break; if (_sp > XB_SPIN_CAP) { atomicAdd(&(bar)[XB_TMO], 1u); break; } } } } while (0)

struct XcdBarrier {
    unsigned* bar; unsigned x;
    volatile LAS unsigned* st;
};

__device__ __forceinline__ XcdBarrier xcd_barrier_post(unsigned* bar, volatile LAS unsigned* st) {
    XcdBarrier b; b.bar = bar; b.x = xb_xcc_id(); b.st = st;
    if (tidx() == 0) (void)xb_add(&bar[XB_XCNT(b.x)], 1u);
    return b;
}
__device__ __forceinline__ void xcd_barrier_complete(unsigned* bar, unsigned x, unsigned& nloc, unsigned& nx) {
    const unsigned G = gridDim.x * gridDim.y * gridDim.z;
    unsigned sum, cnt, mine, sp = 0u;
    for (;;) {
        sum = 0u; cnt = 0u; mine = 0u;
#pragma unroll
        for (unsigned j = 0; j < 16; ++j) { const unsigned c = xb_ld(&bar[XB_XCNT(j)]); sum += c; cnt += (c > 0u) ? 1u : 0u; mine = (j == x) ? c : mine; }
        if (sum == G) break;
        __builtin_amdgcn_s_sleep(1);
        if ((++sp & 255u) == 0u) { if (xb_ld(&bar[XB_TMO])) break; if (sp > XB_SPIN_CAP) { atomicAdd(&bar[XB_TMO], 1u); break; } }
    }
    nloc = mine > 0u ? mine : 1u; nx = cnt > 0u ? cnt : 1u;
}

__device__ __forceinline__ void xcd_barrier(const XcdBarrier& b) {
    asm volatile("s_waitcnt vmcnt(0)" ::: "memory");
    __syncthreads();
    if (tidx() == 0) {
        unsigned* bar = b.bar;
        __builtin_amdgcn_s_waitcnt(0);
        unsigned nloc = b.st[0], nx = b.st[1];
        if (nloc == 0u) { xcd_barrier_complete(bar, b.x, nloc, nx); b.st[0] = nloc; b.st[1] = nx; }
        const unsigned old = xb_add(&bar[XB_XSUB(b.x)], 1u);
        const unsigned gen = old / nloc;
        if (old + 1u == (gen + 1u) * nloc) {
            __builtin_amdgcn_fence(__ATOMIC_RELEASE, "agent");
            asm volatile("s_waitcnt vmcnt(0)" ::: "memory");
            const unsigned og = xb_add(&bar[XB_TOP], 1u);
            const unsigned tg = og / nx;
            if (og + 1u == (tg + 1u) * nx) xb_add(&bar[XB_TOPGEN], 1u);
            else XB_SPIN(xb_ld(&bar[XB_TOPGEN]) == tg, bar);
            __builtin_amdgcn_fence(__ATOMIC_ACQUIRE, "agent");
            xb_add(&bar[XB_XGEN(b.x)], 1u);
            asm volatile("s_waitcnt vmcnt(0)" ::: "memory");
        } else {
            XB_SPIN(xb_ld(&bar[XB_XGEN(b.x)]) == gen, bar);
            __builtin_amdgcn_fence(__ATOMIC_ACQUIRE, "agent");
            asm volatile("s_waitcnt vmcnt(0)" ::: "memory");
        }
    }
    __syncthreads();
}
struct Frame {
    LAS unsigned char* lds; volatile LAS unsigned* MISC; gu32* ctl;
    int tid, lane, wave, vcu, G;
    const float* in[N_IN]; float* out; unsigned char* ws;
};
#define WSP(T, off) ((T*)(F.ws + (off)))
typedef __attribute__((address_space(3))) float lds_f;

template <class Map>
__device__ __forceinline__ void tr_item(const float* W, int ldw, int K, bf16* WT, LAS float* scr, int item, int nblk, int lane, const Map& map, const float* kscale) {
    const int kb = item / nblk, nb = item % nblk, k0 = 64 * kb, n0 = 32 * nb;
    const int sc = map(n0 + (lane & 31));
#pragma unroll
    for (int i = 0; i < 32; ++i) { const int kk = 2 * i + (lane >> 5); float v = sc >= 0 ? W[(size_t)(k0 + kk) * ldw + sc] : 0.f; if (kscale) v *= kscale[k0 + kk]; scr[kk * 33 + (lane & 31)] = v; }
    LDS_WAIT(); asm volatile("" ::: "memory");
    const int c = lane & 7;
#pragma unroll
    for (int j = 0; j < 4; ++j) { const int n = (lane >> 3) + 8 * j; const LAS float* s = scr + (8 * c) * 33 + n;
        v4u o; o.x = pk2(s[0 * 33], s[1 * 33]); o.y = pk2(s[2 * 33], s[3 * 33]); o.z = pk2(s[4 * 33], s[5 * 33]); o.w = pk2(s[6 * 33], s[7 * 33]);
        *(GAS v4u*)(WT + (size_t)(n0 + n) * K + k0 + 8 * c) = o; }
    LDS_WAIT(); asm volatile("" ::: "memory");
}
struct MapId { __device__ __forceinline__ int operator()(int j) const { return j; } };
struct MapWin { __device__ __forceinline__ int operator()(int j) const { return win_map(j); } };

__device__ __forceinline__ void rms_row_to_bf16(int lane, const float* xrow, const float* g, bf16* orow) {
    const GAS f32x4* xr = (const GAS f32x4*)xrow + lane; const GAS f32x4* gr = (const GAS f32x4*)g + lane;
    f32x4 v[4]; float s = 0.f;
#pragma unroll
    for (int j = 0; j < 4; ++j) { v[j] = xr[64 * j]; s += (v[j].x * v[j].x + v[j].y * v[j].y) + (v[j].z * v[j].z + v[j].w * v[j].w); }
    const float rstd = 1.f / sqrtf(wave_sum_dpp(s) * (1.f / DM) + EPS);
    GAS unsigned long long* o8 = (GAS unsigned long long*)orow + lane;
#pragma unroll
    for (int j = 0; j < 4; ++j) { const f32x4 gg = gr[64 * j]; o8[64 * j] = (unsigned long long)pk2(v[j].x * rstd * gg.x, v[j].y * rstd * gg.y) | ((unsigned long long)pk2(v[j].z * rstd * gg.z, v[j].w * rstd * gg.w) << 32); }
}

struct TrItem { const float* W; const float* ks; bf16* WT; int ldw, K, k0, n0, sc; };
__device__ __forceinline__ void tr_load(const TrItem& t, int lane, float (&v)[32]) {
#pragma unroll
    for (int i = 0; i < 32; ++i) { const int kk = 2 * i + (lane >> 5); float x = t.sc >= 0 ? t.W[(size_t)(t.k0 + kk) * t.ldw + t.sc] : 0.f; if (t.ks) x *= t.ks[t.k0 + kk]; v[i] = x; }
}
__device__ __forceinline__ void tr_store(const TrItem& t, int lane, const float (&v)[32], LAS float* scr) {
#pragma unroll
    for (int i = 0; i < 32; ++i) scr[(2 * i + (lane >> 5)) * 33 + (lane & 31)] = v[i];
    LDS_WAIT(); asm volatile("" ::: "memory");
    const int c = lane & 7;
#pragma unroll
    for (int j = 0; j < 4; ++j) { const int n = (lane >> 3) + 8 * j; const LAS float* s = scr + (8 * c) * 33 + n;
        v4u o; o.x = pk2(s[0 * 33], s[1 * 33]); o.y = pk2(s[2 * 33], s[3 * 33]); o.z = pk2(s[4 * 33], s[5 * 33]); o.w = pk2(s[6 * 33], s[7 * 33]);
        *(GAS v4u*)(t.WT + (size_t)(t.n0 + n) * t.K + t.k0 + 8 * c) = o; }
    LDS_WAIT(); asm volatile("" ::: "memory");
}
__device__ __forceinline__ void p0_prologue(Frame& F) {
    LAS float* scr = (LAS float*)(F.lds + F.wave * 16384);
    const int gw = F.vcu * NWAVES + F.wave, NGW = F.G * NWAVES;
    constexpr int I_IN = 16 * (NIN / 32), I_BA = 16 * 32, I_O = 16 * 32, I_UP = 16 * (DFF / 32), I_DN = 64 * 32, I_C = 16 * 2;
    constexpr int NITEMS = I_IN + I_BA + I_O + I_UP + I_DN + 4 * I_C;
    auto describe = [&](int it, TrItem& t) {
        int r = it, nblk; bool win = false; t.ks = nullptr;
        if (r < I_IN) { t.W = F.in[I_WIN]; t.ldw = INC; t.K = DM; t.WT = WSP(bf16, WS_WINT); nblk = NIN / 32; win = true; }
        else if ((r -= I_IN) < I_BA) { t.W = F.in[I_WBR]; t.ldw = DM; t.K = DM; t.WT = WSP(bf16, WS_WBT); nblk = 32; }
        else if ((r -= I_BA) < I_O) { t.W = F.in[I_WOUT]; t.ldw = DM; t.K = DM; t.WT = WSP(bf16, WS_WOT); nblk = 32; }
        else if ((r -= I_O) < I_UP) { t.W = F.in[I_WUP]; t.ldw = DFF; t.K = DM; t.WT = WSP(bf16, WS_WUP); nblk = DFF / 32; t.ks = F.in[I_G2]; }
        else if ((r -= I_UP) < I_DN) { t.W = F.in[I_WDN]; t.ldw = DM; t.K = DFF; t.WT = WSP(bf16, WS_WDN); nblk = 32; }
        else { r -= I_DN; const int which = r / I_C; r = r % I_C;
               const float* w1 = (which >> 1) ? F.in[I_WCV1] : F.in[I_WCK1]; t.W = w1 + (size_t)(which & 1) * 1024 * 64; t.ldw = 64; t.K = 1024;
               t.WT = ((which >> 1) ? WSP(bf16, WS_WC1V) : WSP(bf16, WS_WC1K)) + (size_t)(which & 1) * 64 * 1024; nblk = 2; }
        t.k0 = 64 * (r / nblk); t.n0 = 32 * (r % nblk); const int j = t.n0 + (F.lane & 31); t.sc = win ? win_map(j) : j;
    };
    if (gw < NITEMS) {
        TrItem cur; describe(gw, cur); float vc[32]; tr_load(cur, F.lane, vc);
        for (int it = gw; it < NITEMS; it += NGW) {
            TrItem nxt = cur; float vn[32]; const bool more = it + NGW < NITEMS;
            if (more) { describe(it + NGW, nxt); tr_load(nxt, F.lane, vn); }
            tr_store(cur, F.lane, vc, scr);
            if (more) { cur = nxt;
#pragma unroll
                for (int i = 0; i < 32; ++i) vc[i] = vn[i]; }
        }
    }
    for (int m0 = gw; m0 < MPAD; m0 += 2 * NGW) {
        const int m1 = m0 + NGW; const bool two = m1 < MT;
        if (m0 < MT) {
            const float* x0 = m0 < MP ? F.in[I_XP] + (size_t)m0 * DM : F.in[I_XS] + (size_t)(m0 - MP) * DM;
            const float* x1 = two ? (m1 < MP ? F.in[I_XP] + (size_t)m1 * DM : F.in[I_XS] + (size_t)(m1 - MP) * DM) : x0;
            const GAS f32x4* xr0 = (const GAS f32x4*)x0 + F.lane; const GAS f32x4* xr1 = (const GAS f32x4*)x1 + F.lane; const GAS f32x4* gr = (const GAS f32x4*)F.in[I_G1] + F.lane;
            f32x4 v0[4], v1[4], gg[4]; float s0 = 0.f, s1 = 0.f;
#pragma unroll
            for (int j = 0; j < 4; ++j) { v0[j] = xr0[64 * j]; v1[j] = xr1[64 * j]; gg[j] = gr[64 * j]; }
#pragma unroll
            for (int j = 0; j < 4; ++j) { s0 += (v0[j].x * v0[j].x + v0[j].y * v0[j].y) + (v0[j].z * v0[j].z + v0[j].w * v0[j].w); s1 += (v1[j].x * v1[j].x + v1[j].y * v1[j].y) + (v1[j].z * v1[j].z + v1[j].w * v1[j].w); }
            const float r0 = 1.f / sqrtf(wave_sum_dpp(s0) * (1.f / DM) + EPS), r1 = 1.f / sqrtf(wave_sum_dpp(s1) * (1.f / DM) + EPS);
            GAS unsigned long long* o0 = (GAS unsigned long long*)(WSP(bf16, WS_XN) + (size_t)m0 * DM) + F.lane; GAS unsigned long long* o1 = (GAS unsigned long long*)(WSP(bf16, WS_XN) + (size_t)m1 * DM) + F.lane;
#pragma unroll
            for (int j = 0; j < 4; ++j) { o0[64 * j] = (unsigned long long)pk2(v0[j].x * r0 * gg[j].x, v0[j].y * r0 * gg[j].y) | ((unsigned long long)pk2(v0[j].z * r0 * gg[j].z, v0[j].w * r0 * gg[j].w) << 32);
                if (two) o1[64 * j] = (unsigned long long)pk2(v1[j].x * r1 * gg[j].x, v1[j].y * r1 * gg[j].y) | ((unsigned long long)pk2(v1[j].z * r1 * gg[j].z, v1[j].w * r1 * gg[j].w) << 32); }
        }
        for (int q = 0; q < 2; ++q) { const int m = m0 + q * NGW; if (m >= MT && m < MPAD) {
            GAS v4u* z = (GAS v4u*)(WSP(bf16, WS_XN) + (size_t)m * DM) + F.lane; z[0] = (v4u){0, 0, 0, 0}; z[64] = (v4u){0, 0, 0, 0};
            GAS v4u* za = (GAS v4u*)(WSP(bf16, WS_OAB) + (size_t)m * 1024) + F.lane; za[0] = (v4u){0, 0, 0, 0}; za[64] = (v4u){0, 0, 0, 0}; } }
    }
    const int gt = F.vcu * (NWAVES * 64) + F.tid, NGT = F.G * NWAVES * 64;
    for (int e = gt; e < 8196 * 8; e += NGT) {
        const int pidx = e >> 3, i = e & 7; const float pos = (float)(pidx < SEQ ? pidx : PAST + pidx - SEQ);
        const float inv = powf(500000.0f, -(float)(2 * i) / 16.0f); const float ang = pos * inv;
        WSP(float, WS_ROPE)[pidx * 16 + i] = cosf(ang); WSP(float, WS_ROPE)[pidx * 16 + 8 + i] = sinf(ang);
    }
    for (int e = gt; e < 8 * 128 * 128; e += NGT) {
        const int g = e >> 14, p = (e >> 7) & 127, r = e & 127; const float* ws = F.in[I_WS] + (size_t)g * 128 * 128;
        WSP(bf16, WS_WSP)[e] = (bf16)(r <= p ? f2bf(ws[p * 128 + r]) : 0u);
        WSP(bf16, WS_WSS)[e] = (bf16)(((p >> 2) == (r >> 2) && (r & 3) <= (p & 3)) ? f2bf(ws[(p & 3) * 128 + (r & 3)]) : 0u);
    }
    if (gt < 64) WSP(float, WS_GAINS)[gt] = F.in[I_GQ][gt]; else if (gt < 128) WSP(float, WS_GAINS)[gt] = F.in[I_GKS][gt - 64]; else if (gt < 192) WSP(float, WS_GAINS)[gt] = F.in[I_GKW][gt - 128];
    for (int it = gw; it < 64; it += NGW) { const int which = it >> 5, part = it & 31; const float* pe = F.in[which ? I_PEV : I_PEK]; const float* w1 = F.in[which ? I_WCV1 : I_WCK1];
        float s = 0.f;
#pragma unroll 16
        for (int i = 0; i < 64; ++i) { const int ii = part * 64 + i; s += pe[ii] * w1[(size_t)ii * 64 + F.lane]; }
        WSP(float, WS_BPART)[(which * 32 + part) * 64 + F.lane] = s; }
}

constexpr int CP_RED = 8 * 8 * 64 * 4;
constexpr int CP_PITCH = 2064;
template <bool SMP>
__device__ __forceinline__ void compress_tasks(Frame& F, const int which, const int first, const int stride, const int ntask) {
    const int tid_ = tidx(); const int lane = tid_ & 63, w = __builtin_amdgcn_readfirstlane(tid_ >> 6), fr = lane & 15, fq = lane >> 4;
    LAS float* red = (LAS float*)F.lds;
    LAS unsigned char* Pg = F.lds + CP_RED * 4;
    const bf16* Wc = WSP(bf16, which ? WS_WC1V : WS_WC1K) + (size_t)fr * 1024 + 128 * w + 8 * fq;
    bf16x8 wf[8][4];
#pragma unroll
    for (int nb = 0; nb < 8; ++nb)
#pragma unroll
        for (int ks = 0; ks < 4; ++ks) wf[nb][ks] = *(const bf16x8*)(Wc + (size_t)nb * 16 * 1024 + 32 * ks);
    const float* cache = F.in[which ? I_CVC : I_CKC]; const int* pt = (const int*)F.in[I_PT];
    const int nmine = first < ntask ? (ntask - first + stride - 1) / stride : 0;
    LAS int* pgl = (LAS int*)(Pg + 16 * CP_PITCH);
    __syncthreads();
    if (SMP) for (int i = tid_; i < nmine; i += NWAVES * 64) pgl[i] = pt[first + i * stride];
    __syncthreads();
    constexpr int DEPTH = SMP ? 2 : 1;
    f32x4 pf[DEPTH][8]; v4u pb[DEPTH][4];
#define CP_FETCH(slot, n_) do { const int nn_ = (n_); if (nn_ < nmine) { \
        if (SMP) { const f32x4* src = (const f32x4*)(cache + (size_t)pgl[nn_] * (128 * 128) + (size_t)w * 2048) + lane; \
            _Pragma("unroll") for (int i = 0; i < 8; ++i) pf[slot][i] = __builtin_nontemporal_load(src + 64 * i); } \
        else { const v4u* src = (const v4u*)(WSP(bf16, which ? WS_VCA : WS_KCA) + (size_t)(first + nn_ * stride) * 16 * 1024 + (size_t)w * 2048) + lane; \
            _Pragma("unroll") for (int i = 0; i < 4; ++i) pb[slot][i] = src[64 * i]; } } } while (0)
#define CP_COMPUTE(slot, n_) do { const int nc_ = (n_); if (nc_ < nmine) { \
        if (SMP) { LAS unsigned char* dst = Pg + (2 * w + ((lane >> 4) & 1)) * CP_PITCH + ((lane >> 5) * 64 + 4 * (lane & 15)) * 2; \
            _Pragma("unroll") for (int i = 0; i < 8; ++i) { const f32x4 a = pf[slot][i]; v2u pk; pk.x = pg8::cvt_pk_bf16(a.x, a.y); pk.y = pg8::cvt_pk_bf16(a.z, a.w); *(LAS v2u*)(dst + i * 256) = pk; } } \
        else { _Pragma("unroll") for (int i = 0; i < 4; ++i) { const int q = 64 * i + lane; *(LAS v4u*)(Pg + (2 * w + (q >> 7)) * CP_PITCH + (q & 127) * 16) = pb[slot][i]; } } \
        __syncthreads(); \
        bf16x8 af[4]; \
        _Pragma("unroll") for (int ks = 0; ks < 4; ++ks) af[ks] = *(const LAS bf16x8*)(Pg + fr * CP_PITCH + (128 * w + 32 * ks + 8 * fq) * 2); \
        _Pragma("unroll") for (int nb = 0; nb < 8; ++nb) { f32x4 acc = {0.f, 0.f, 0.f, 0.f}; \
            _Pragma("unroll") for (int ks = 0; ks < 4; ++ks) acc = __builtin_amdgcn_mfma_f32_16x16x32_bf16(wf[nb][ks], af[ks], acc, 0, 0, 0); \
            *(LAS f32x4*)(red + ((w * 8 + nb) * 64 + lane) * 4) = acc; } \
        __syncthreads(); \
        { f32x4 s = *(const LAS f32x4*)(red + ((0 * 8 + w) * 64 + lane) * 4); \
          _Pragma("unroll") for (int sw = 1; sw < 8; ++sw) s = s + *(const LAS f32x4*)(red + ((sw * 8 + w) * 64 + lane) * 4); \
          bf16* fs = WSP(bf16, SMP ? (which ? WS_FSSV : WS_FSSK) : (which ? WS_FSPV : WS_FSPK)) + (size_t)(first + nc_ * stride) * 16 * 128;     \
          v2u pk_; pk_.x = pg8::cvt_pk_bf16(s.x, s.y); pk_.y = pg8::cvt_pk_bf16(s.z, s.w); *(v2u*)(fs + (size_t)fr * 128 + 16 * w + 4 * fq) = pk_; } } } while (0)
#pragma unroll
    for (int s = 0; s < DEPTH; ++s) CP_FETCH(s, s);
    for (int n = 0; n < nmine; n += DEPTH) {
#pragma unroll
        for (int s = 0; s < DEPTH; ++s) { CP_COMPUTE(s, n + s); CP_FETCH(s, n + s + DEPTH); }
    }
#undef CP_FETCH
#undef CP_COMPUTE
    __syncthreads();
}

__device__ __forceinline__ void compress_stage2(Frame& F, const int wg, const int nwg) {
    const int lane = F.lane, fr = lane & 15, fq = lane >> 4, gw = wg * NWAVES + F.wave, NGW = nwg * NWAVES;
    constexpr int NRS = DECB * NCS * 2, NRP = NBAT * NCP * 2, NGRP = (NRS + NRP) / 16;
    LAS float* biasL = (LAS float*)F.lds;
    __syncthreads();
    if (F.tid < 128) { float s = 0.f;
#pragma unroll 4
        for (int p = 0; p < 32; ++p) s += WSP(float, WS_BPART)[((F.tid >> 6) * 32 + p) * 64 + (F.tid & 63)];
        biasL[F.tid] = s; }
    __syncthreads();
    for (int which = 0; which < 2; ++which) {
        float bias[2][8]; const float* w2 = F.in[which ? I_WCV2 : I_WCK2]; bf16x8 wfr[4][2];
#pragma unroll
        for (int ks = 0; ks < 2; ++ks)
#pragma unroll
            for (int j = 0; j < 8; ++j) bias[ks][j] = biasL[which * 64 + 32 * ks + 8 * fq + j];
#pragma unroll
        for (int nb = 0; nb < 4; ++nb)
#pragma unroll
            for (int ks = 0; ks < 2; ++ks) { unsigned short t[8];
#pragma unroll
                for (int j = 0; j < 8; ++j) t[j] = (unsigned short)f2bf(w2[(32 * ks + 8 * fq + j) * 64 + 16 * nb + fr]);
                wfr[nb][ks] = (bf16x8){(short)t[0], (short)t[1], (short)t[2], (short)t[3], (short)t[4], (short)t[5], (short)t[6], (short)t[7]}; }
        f32x4 gk[4];
#pragma unroll
        for (int nb = 0; nb < 4; ++nb) { const float g = F.in[I_GKC][16 * nb + fr]; gk[nb] = (f32x4){g, g, g, g}; }
        for (int grp = gw; grp < NGRP; grp += NGW) {
            const bool smp = grp < NRS / 16; const int rr0 = smp ? grp * 16 : grp * 16 - NRS; const int nr = smp ? NRS : NRP, nc = smp ? NCS : NCP;
            const bf16* fs = WSP(bf16, smp ? (which ? WS_FSSV : WS_FSSK) : (which ? WS_FSPV : WS_FSPK));
            const int rr = rr0 + fr; const int rr2 = rr + 2 < nr ? rr + 2 : nr - 1;
            bf16x8 af[2];
#pragma unroll
            for (int ks = 0; ks < 2; ++ks) { const int k0 = 32 * ks + 8 * fq;
                const v4u ra = *(const v4u*)(fs + (size_t)rr * 128 + k0), rb = *(const v4u*)(fs + (size_t)rr2 * 128 + 64 + k0);
                const f32x4 a0 = {bflo(ra.x), bfhi(ra.x), bflo(ra.y), bfhi(ra.y)}, a1 = {bflo(ra.z), bfhi(ra.z), bflo(ra.w), bfhi(ra.w)}, b0 = {bflo(rb.x), bfhi(rb.x), bflo(rb.y), bfhi(rb.y)}, b1 = {bflo(rb.z), bfhi(rb.z), bflo(rb.w), bfhi(rb.w)};
                float h[8];
#pragma unroll
                for (int j = 0; j < 4; ++j) { h[j] = gelu_tanh(a0[j] + b0[j] + bias[ks][j]); h[4 + j] = gelu_tanh(a1[j] + b1[j] + bias[ks][4 + j]); }
                v4u pk; pk.x = pk2(h[0], h[1]); pk.y = pk2(h[2], h[3]); pk.z = pk2(h[4], h[5]); pk.w = pk2(h[6], h[7]); af[ks] = __builtin_bit_cast(bf16x8, pk); }
            f32x4 acc[4];
#pragma unroll
            for (int nb = 0; nb < 4; ++nb) { acc[nb] = __builtin_amdgcn_mfma_f32_16x16x32_bf16(af[0], wfr[nb][0], (f32x4){0.f, 0.f, 0.f, 0.f}, 0, 0, 0); acc[nb] = __builtin_amdgcn_mfma_f32_16x16x32_bf16(af[1], wfr[nb][1], acc[nb], 0, 0, 0); }
            if (which == 0) {
                f32x4 ss = acc[0] * acc[0] + acc[1] * acc[1] + acc[2] * acc[2] + acc[3] * acc[3];
#pragma unroll
                for (int r = 0; r < 4; ++r) { float v = ss[r]; v += __shfl_xor(v, 1); v += __shfl_xor(v, 2); v += __shfl_xor(v, 4); v += __shfl_xor(v, 8); ss[r] = 1.f / sqrtf(v * (1.f / 64.f) + EPS); }
#pragma unroll
                for (int nb = 0; nb < 4; ++nb) acc[nb] = acc[nb] * ss * gk[nb];
            }
            bf16* dstb = WSP(bf16, smp ? (which ? WS_VCS : WS_KCS) : (which ? WS_VCP : WS_KCP));
#pragma unroll
            for (int r = 0; r < 4; ++r) { const int row = rr0 + 4 * fq + r; const int kv = row & 1, bc = row >> 1; const int b = bc / nc, c = bc % nc; const bool zero = (c == nc - 1);
                bf16* dst = dstb + ((size_t)(b * 2 + kv) * nc + c) * 64 + fr;
#pragma unroll
                for (int nb = 0; nb < 4; ++nb) dst[16 * nb] = zero ? (bf16)0 : (bf16)f2bf(acc[nb][r]); }
        }
    }
}

constexpr int VT_PITCH = 136;
constexpr int GMLP_UNITS = 129 * 2;
__device__ __forceinline__ void gmlp_unit(Frame& F, int unit) {
    const int tid_ = tidx(); const int lane = tid_ & 63, w = __builtin_amdgcn_readfirstlane(tid_ >> 6), r32 = lane & 31, hi = lane >> 5, n = unit >> 1, hf = unit & 1;
    LAS bf16* vT = (LAS bf16*)F.lds;
    const int m0 = n * 128; const bool smp = (n == 128);
    __syncthreads();
    {
        float gg[8], bb[8];
#pragma unroll
        for (int k = 0; k < 8; ++k) { gg[k] = F.in[I_LNG][lane + 64 * k]; bb[k] = F.in[I_LNB][lane + 64 * k]; }
        const bf16* gv = WSP(bf16, WS_GV) + (size_t)(m0 + 16 * w) * 512 + lane;
#pragma unroll
        for (int i = 0; i < 16; i += 2) { const int r = 16 * w + i;
            float x[2][8];
#pragma unroll
            for (int k = 0; k < 8; ++k) { x[0][k] = bf2f(gv[(size_t)i * 512 + 64 * k]); x[1][k] = bf2f(gv[(size_t)(i + 1) * 512 + 64 * k]); }
            float y[2][8];
#pragma unroll
            for (int e = 0; e < 2; ++e) { float s = 0.f;
#pragma unroll
                for (int k = 0; k < 8; ++k) s += x[e][k];
                const float mean = wave_sum_dpp(s) * (1.f / 512.f); float s2 = 0.f;
#pragma unroll
                for (int k = 0; k < 8; ++k) { x[e][k] -= mean; s2 += x[e][k] * x[e][k]; }
                const float rstd = 1.f / sqrtf(wave_sum_dpp(s2) * (1.f / 512.f) + EPS);
#pragma unroll
                for (int k = 0; k < 8; ++k) y[e][k] = x[e][k] * rstd * gg[k] + bb[k];
                float* so = nullptr;
                if (smp) so = F.out + O_SVA + (size_t)(r + e) * 512; else if ((n & 63) == 63) so = F.out + O_PVA + ((size_t)(n >> 6) * 128 + r + e) * 512;
                if (so) {
#pragma unroll
                    for (int k = 0; k < 8; ++k) if ((k >> 2) == hf) so[lane + 64 * k] = y[e][k]; } }
#pragma unroll
            for (int k = 0; k < 8; ++k) if ((k >> 2) == hf) *(LAS unsigned*)(vT + (lane + 64 * (k & 3)) * VT_PITCH + r) = pk2(y[0][k], y[1][k]);
        }
    }
    __syncthreads();
    {
        const int gl = w & 3, g = 4 * hf + gl; const bf16* Wg = WSP(bf16, smp ? WS_WSS : WS_WSP) + (size_t)g * 128 * 128; const float* bs = F.in[I_BS] + g * 128;
#pragma unroll
        for (int ii = 0; ii < 2; ++ii) { const int ib = (w < 4) ? (ii ? 3 : 0) : (ii ? 2 : 1);
            bf16x8 a[8];
#pragma unroll
            for (int kb = 0; kb < 8; ++kb) a[kb] = *(const bf16x8*)(Wg + (size_t)(32 * ib + r32) * 128 + 16 * kb + 8 * hi);
            unsigned short uu[2][16];
#pragma unroll
            for (int r = 0; r < 16; ++r) { const int p = 32 * ib + (r & 3) + 8 * (r >> 2) + 4 * hi; const bf16* up = WSP(bf16, WS_U) + (size_t)(m0 + p) * 512 + 64 * g + r32; uu[0][r] = up[0]; uu[1][r] = up[32]; }
            f32x16 acc0 = {}, acc1 = {};
#pragma unroll
            for (int kb = 0; kb < 8; ++kb) {
                const bf16x8 b0 = *(const LAS bf16x8*)(vT + (64 * gl + r32) * VT_PITCH + 16 * kb + 8 * hi);
                const bf16x8 b1 = *(const LAS bf16x8*)(vT + (64 * gl + 32 + r32) * VT_PITCH + 16 * kb + 8 * hi);
                acc0 = __builtin_amdgcn_mfma_f32_32x32x16_bf16(a[kb], b0, acc0, 0, 0, 0); acc1 = __builtin_amdgcn_mfma_f32_32x32x16_bf16(a[kb], b1, acc1, 0, 0, 0);
            }
#pragma unroll
            for (int r = 0; r < 16; ++r) { const int p = 32 * ib + (r & 3) + 8 * (r >> 2) + 4 * hi; const size_t m = (size_t)(m0 + p);
                const float bias = bs[smp ? (p & 3) : p]; bf16* op = WSP(bf16, WS_OAB) + m * 1024 + 64 * g + r32;
                op[0] = (bf16)f2bf(bf2f(uu[0][r]) * (acc0[r] + bias)); op[32] = (bf16)f2bf(bf2f(uu[1][r]) * (acc1[r] + bias)); }
        }
    }
}

constexpr size_t WS_SSQS_DUMMY = 0;
template <class Epi, int KSPLIT = 1, bool MID = false>
__device__ __forceinline__ void skinny_gemm(const bf16* A, const bf16* Bt, int N, int K, int G, int first, const Epi& E) {
    const int lane = tidx() & 63, w = __builtin_amdgcn_readfirstlane(tidx() >> 6), fr = lane & 15, fq = lane >> 4;
    for (int it = first; it < (N / 16) * KSPLIT; it += G) {
        const int cb = it / KSPLIT, kq = it % KSPLIT, Kp = K / KSPLIT;
        const bf16* ap = A + (size_t)(16 * w + fr) * K + kq * Kp + 8 * fq;
        const bf16* bp = Bt + (size_t)(16 * cb + fr) * K + kq * Kp + 8 * fq;
        f32x4 acc = {0.f, 0.f, 0.f, 0.f};
        if constexpr (MID) {
#pragma unroll 16
            for (int ks = 0; ks < Kp / 64; ++ks) { const bf16x8 a = *(const bf16x8*)(ap + 32 * ks); const bf16x8 b = *(const bf16x8*)(bp + 32 * ks); acc = __builtin_amdgcn_mfma_f32_16x16x32_bf16(b, a, acc, 0, 0, 0); }
            E.mid(acc, 16 * w + fr, 16 * cb + 4 * fq);
#pragma unroll 16
            for (int ks = Kp / 64; ks < Kp / 32; ++ks) { const bf16x8 a = *(const bf16x8*)(ap + 32 * ks); const bf16x8 b = *(const bf16x8*)(bp + 32 * ks); acc = __builtin_amdgcn_mfma_f32_16x16x32_bf16(b, a, acc, 0, 0, 0); }
        } else {
#pragma unroll 16
        for (int ks = 0; ks < Kp / 32; ++ks) { const bf16x8 a = *(const bf16x8*)(ap + 32 * ks); const bf16x8 b = *(const bf16x8*)(bp + 32 * ks); acc = __builtin_amdgcn_mfma_f32_16x16x32_bf16(b, a, acc, 0, 0, 0); }
        }
        E(16 * w + fr, 16 * cb + 4 * fq, acc, fq);
    }
}
__device__ __forceinline__ v2u pack4(const f32x4 v) { v2u o; o.x = pk2(v.x, v.y); o.y = pk2(v.z, v.w); return o; }
__device__ __forceinline__ f32x4 unpack4(const v2u w) { return (f32x4){bflo(w.x), bfhi(w.x), bflo(w.y), bfhi(w.y)}; }
struct SkMerge { unsigned char* ws;
    __device__ __forceinline__ void mid(f32x4& acc, int r, int c) const { const size_t row = MP + r;
        acc = acc * unpack4(*(const v2u*)((const bf16*)(ws + WS_SG) + row * 2048 + c)); }
    __device__ __forceinline__ void operator()(int r, int c, const f32x4 acc, int) const { const size_t row = MP + r;
        const f32x4 gb = unpack4(*(const v2u*)((const bf16*)(ws + WS_SG) + row * 2048 + 1024 + c)); *(v2u*)((bf16*)(ws + WS_MG) + row * DM + c) = pack4(gb * acc); } };
struct SkOut { unsigned char* ws; const float* xs; float* out; __device__ __forceinline__ void operator()(int r, int c, const f32x4 acc, int fq) const {
    const f32x4 v = acc + *(const f32x4*)(xs + (size_t)r * DM + c); *(f32x4*)(out + O_YS + (size_t)r * DM + c) = v; *(v2u*)((bf16*)(ws + WS_X1B) + (size_t)(MP + r) * DM + c) = pack4(v);
    float ss = (v.x * v.x + v.y * v.y) + (v.z * v.z + v.w * v.w); ss += __shfl_xor(ss, 16); ss += __shfl_xor(ss, 32);
    if (fq == 0) ((float*)(ws + WS_SSQS))[r * 64 + (c >> 4)] = ss; } };
struct SkUp { unsigned char* ws; __device__ __forceinline__ void operator()(int r, int c, const f32x4 acc, int) const {
    const f32x4* sp = (const f32x4*)((const float*)(ws + WS_SSQS) + r * 64); f32x4 s = sp[0];
#pragma unroll
    for (int i = 1; i < 16; ++i) s = s + sp[i];
    const float rstd = 1.f / sqrtf(((s.x + s.y) + (s.z + s.w)) * (1.f / DM) + EPS); f32x4 v = acc * rstd;
#pragma unroll
    for (int i = 0; i < 4; ++i) { const float a = fmaxf(v[i], 0.f); v[i] = a * a; }
    *(v2u*)((bf16*)(ws + WS_H) + (size_t)(MP + r) * DFF + c) = pack4(v); } };
struct SkDown { float* out; __device__ __forceinline__ void operator()(int r, int c, const f32x4 acc, int) const { float* y = out + O_YS + (size_t)r * DM + c;
#pragma unroll
    for (int i = 0; i < 4; ++i) __hip_atomic_fetch_add(y + i, acc[i], __ATOMIC_RELAXED, __HIP_MEMORY_SCOPE_AGENT); } };

__device__ __forceinline__ void vst_tile(Frame& F, int tile) {
    const int tid = tidx(); LAS bf16* T = (LAS bf16*)F.lds;
    const int bk = tile >> 7, tb = tile & 127, b = bk >> 1, kv = bk & 1;
    __syncthreads();
    { const int t = tid >> 3, dc = tid & 7; const v4u v = *(const v4u*)(WSP(bf16, WS_VS) + ((size_t)b * SEQ + 64 * tb + t) * 128 + kv * 64 + 8 * dc);
      const unsigned w[4] = {v.x, v.y, v.z, v.w};
#pragma unroll
      for (int i = 0; i < 4; ++i) { T[(8 * dc + 2 * i) * 72 + t] = (bf16)(w[i] & 0xffffu); T[(8 * dc + 2 * i + 1) * 72 + t] = (bf16)(w[i] >> 16); } }
    __syncthreads();
    { const int dd = tid >> 3, tc = tid & 7; *(v4u*)(WSP(bf16, WS_VST) + ((size_t)(b * 2 + kv) * 64 + dd) * SEQ + 64 * tb + 8 * tc) = *(const LAS v4u*)(T + dd * 72 + 8 * tc); }
}

namespace att {
using s16x4 = __attribute__((ext_vector_type(4))) short;
using u32x4 = __attribute__((ext_vector_type(4))) unsigned;
constexpr int NW = 8, KVBLK = 64;
constexpr int NSLOT = 3, SLOTB = 8192;
constexpr int LDS_K = 0, LDS_V = NSLOT * SLOTB, LDS_WS = 2 * NSLOT * SLOTB, LDS_Q = LDS_WS + NW * 64 * 4, LDS_OST = LDS_Q, LDS_SELB = LDS_OST + NW * 8192, LDS_END = LDS_SELB + NW * 8 * 16;
constexpr int BLKS_PITCH = 132;
static_assert(NW * 8 * BLKS_PITCH * 4 <= LDS_WS, "block scores fit the ring region");
#define SBAR() __builtin_amdgcn_sched_barrier(0)
__device__ __forceinline__ int crow(int r, int hi) { return (r & 3) + 8 * (r >> 2) + 4 * hi; }
__device__ __forceinline__ void glds16(const void* gsrc, unsigned lds_dst) { unsigned keep;
  asm volatile("s_mov_b32 %0, m0\n\ts_mov_b32 m0, %2\n\ts_nop 0\n\tglobal_load_lds_dwordx4 %1, off\n\ts_mov_b32 m0, %0" : "=&s"(keep) : "v"(gsrc), "s"(lds_dst) : "memory"); }
__device__ __forceinline__ float max3f(float a, float b, float c) { float r; asm("v_max3_f32 %0, %1, %2, %3" : "=v"(r) : "v"(a), "v"(b), "v"(c)); return r; }
__device__ __forceinline__ float max2f(float a, float b) { float r; asm("v_max_f32_e32 %0, %1, %2" : "=v"(r) : "v"(a), "v"(b)); return r; }
__device__ __forceinline__ float fadd_s(float a, float b) { float r; asm("v_add_f32_e32 %0, %1, %2" : "=v"(r) : "v"(a), "v"(b)); return r; }
__device__ __forceinline__ float fsub_s(float a, float b) { float r; asm("v_sub_f32_e32 %0, %1, %2" : "=v"(r) : "v"(a), "v"(b)); return r; }
typedef float f32x2_t __attribute__((ext_vector_type(2))); typedef __bf16 bf16x2_t __attribute__((ext_vector_type(2)));
__device__ __forceinline__ unsigned cvtpk_s(float lo, float hi) { f32x2_t v = {lo, hi}; bf16x2_t b = __builtin_convertvector(v, bf16x2_t); return __builtin_bit_cast(unsigned, b); }
#define WAIT_BAR(N) asm volatile("s_waitcnt vmcnt(" #N ") lgkmcnt(0)\n\ts_barrier" ::: "memory")

typedef __attribute__((address_space(3))) const char* lds_cptr;
__device__ __forceinline__ void qkt(f32x16& p0, f32x16& p1, const char* Kslot, lds_cptr qp, int r32, int hi) { const f32x16 negm = f32x16{}; bf16x8 qr[4];
  _Pragma("unroll") for (int d0 = 0; d0 < 4; ++d0) qr[d0] = *(const __attribute__((address_space(3))) bf16x8*)(qp + d0 * 1024);
  const char* kb = Kslot + hi * 1024 + r32 * 16;
#pragma unroll
  for (int d0 = 0; d0 < 4; ++d0) {
    const bf16x8 b0 = *reinterpret_cast<const bf16x8*>(kb + d0 * 2048);
    const bf16x8 b1 = *reinterpret_cast<const bf16x8*>(kb + d0 * 2048 + 512);
    if (d0 == 0) { p0 = __builtin_amdgcn_mfma_f32_32x32x16_bf16(b0, qr[0], negm, 0, 0, 0); p1 = __builtin_amdgcn_mfma_f32_32x32x16_bf16(b1, qr[0], negm, 0, 0, 0); }
    else { p0 = __builtin_amdgcn_mfma_f32_32x32x16_bf16(b0, qr[d0], p0, 0, 0, 0); p1 = __builtin_amdgcn_mfma_f32_32x32x16_bf16(b1, qr[d0], p1, 0, 0, 0); } }
}
__device__ __forceinline__ void qkt_r(f32x16& p0, f32x16& p1, const char* Kslot, const bf16x8* qr, int r32, int hi) { const f32x16 negm = f32x16{};
  const char* kb = Kslot + hi * 1024 + r32 * 16;
#pragma unroll
  for (int d0 = 0; d0 < 4; ++d0) {
    const bf16x8 b0 = *reinterpret_cast<const bf16x8*>(kb + d0 * 2048);
    const bf16x8 b1 = *reinterpret_cast<const bf16x8*>(kb + d0 * 2048 + 512);
    if (d0 == 0) { p0 = __builtin_amdgcn_mfma_f32_32x32x16_bf16(b0, qr[0], negm, 0, 0, 0); p1 = __builtin_amdgcn_mfma_f32_32x32x16_bf16(b1, qr[0], negm, 0, 0, 0); }
    else { p0 = __builtin_amdgcn_mfma_f32_32x32x16_bf16(b0, qr[d0], p0, 0, 0, 0); p1 = __builtin_amdgcn_mfma_f32_32x32x16_bf16(b1, qr[d0], p1, 0, 0, 0); } }
}
typedef short v4i16_t __attribute__((ext_vector_type(4)));
__device__ __forceinline__ void kload8(bf16x8* kf, lds_cptr kp) {
  kf[0] = *(const __attribute__((address_space(3))) bf16x8*)(kp);        kf[1] = *(const __attribute__((address_space(3))) bf16x8*)(kp + 512);
  kf[2] = *(const __attribute__((address_space(3))) bf16x8*)(kp + 2048); kf[3] = *(const __attribute__((address_space(3))) bf16x8*)(kp + 2560);
  kf[4] = *(const __attribute__((address_space(3))) bf16x8*)(kp + 4096); kf[5] = *(const __attribute__((address_space(3))) bf16x8*)(kp + 4608);
  kf[6] = *(const __attribute__((address_space(3))) bf16x8*)(kp + 6144); kf[7] = *(const __attribute__((address_space(3))) bf16x8*)(kp + 6656);
}
__device__ __forceinline__ void kload2(bf16x8* kf, lds_cptr kp, int j) { kf[2 * j] = *(const __attribute__((address_space(3))) bf16x8*)(kp + j * 2048); kf[2 * j + 1] = *(const __attribute__((address_space(3))) bf16x8*)(kp + j * 2048 + 512); }
__device__ __forceinline__ s16x4 vtr(lds_cptr p) { return __builtin_bit_cast(s16x4, __builtin_amdgcn_ds_read_tr16_b64_v4i16((__attribute__((address_space(3))) v4i16_t*)p)); }
__device__ __forceinline__ float rowmax(const f32x16& p0, const f32x16& p1) {
  float a = max3f(p0[0], p0[1], p1[0]), b = max3f(p0[2], p0[3], p1[1]); a = max3f(a, p1[2], p1[3]);
#pragma unroll
  for (int r = 4; r < 16; r += 4) { a = max3f(a, p0[r], p0[r + 1]); b = max3f(b, p0[r + 2], p0[r + 3]); a = max3f(a, p1[r], p1[r + 1]); b = max3f(b, p1[r + 2], p1[r + 3]); }
  const float m = max2f(a, b);
  auto rr = __builtin_amdgcn_permlane32_swap(__float_as_uint(m), __float_as_uint(m), false, false);
  return max2f(__uint_as_float(rr[0]), __uint_as_float(rr[1]));
}
__device__ __forceinline__ void pv(f32x16* o, int vb, bf16x8 pa0, bf16x8 pa1, bf16x8 pa2, bf16x8 pa3) {
#pragma unroll
  for (int d0 = 0; d0 < 2; ++d0) { s16x4 lo[4], hi[4];
#pragma unroll
    for (int ks = 0; ks < 4; ++ks) {
      asm volatile("ds_read_b64_tr_b16 %0,%1 offset:%c2" : "=&v"(lo[ks]) : "v"(vb), "i"(d0 * 4096 + ks * 1024) : "memory");
      asm volatile("ds_read_b64_tr_b16 %0,%1 offset:%c2" : "=&v"(hi[ks]) : "v"(vb), "i"(d0 * 4096 + ks * 1024 + 512) : "memory"); }
    asm volatile("s_waitcnt lgkmcnt(0)" ::: "memory"); SBAR();
#define PK(k) (bf16x8){lo[k][0], lo[k][1], lo[k][2], lo[k][3], hi[k][0], hi[k][1], hi[k][2], hi[k][3]}
    o[d0] = __builtin_amdgcn_mfma_f32_32x32x16_bf16(pa0, PK(0), o[d0], 0, 0, 0);
    o[d0] = __builtin_amdgcn_mfma_f32_32x32x16_bf16(pa1, PK(1), o[d0], 0, 0, 0);
    o[d0] = __builtin_amdgcn_mfma_f32_32x32x16_bf16(pa2, PK(2), o[d0], 0, 0, 0);
    o[d0] = __builtin_amdgcn_mfma_f32_32x32x16_bf16(pa3, PK(3), o[d0], 0, 0, 0);
#undef PK
  }
}
template <int MODE> __device__ __forceinline__ void amask(f32x16& p0, f32x16& p1, int tabs, int blk, int hi, int mlo, int mspan1, const unsigned selword, const float mh) {
  const float NEG = -1e30f;
  const int kb = 64 * tabs + 4 * hi;
  int hiB;
  if (MODE == 1) {
    const bool en = (selword >> (tabs & 31)) & 1u;
    if (tabs < blk) { const float mht = en ? mh : 1e30f;
#pragma unroll
      for (int r = 0; r < 16; ++r) { p0[r] -= mht; p1[r] -= mht; }
      return; }
    hiB = en ? mspan1 - kb : 0;
  } else if (MODE == 0) hiB = mspan1 - kb;
  else {
    if (tabs < blk) {
      if (tabs + 8 <= blk) { const int loB = mlo - kb;
#pragma unroll
        for (int r = 0; r < 16; ++r) { const int c = (r & 3) + 8 * (r >> 2); p0[r] = (loB <= c) ? p0[r] - mh : NEG; p1[r] = (loB <= c + 32) ? p1[r] - mh : NEG; }
      } else {
#pragma unroll
        for (int r = 0; r < 16; ++r) { p0[r] -= mh; p1[r] -= mh; }
      }
      return; }
    hiB = mlo + mspan1 - kb;
  }
#pragma unroll
  for (int r = 0; r < 16; ++r) { const int c = (r & 3) + 8 * (r >> 2); p0[r] = (hiB > c) ? p0[r] - mh : NEG; p1[r] = (hiB > c + 32) ? p1[r] - mh : NEG; }
}

template <int MODE, int THRL>
__device__ __forceinline__ void attn_unit(const bf16* Qlane, const bf16* __restrict__ Kt, const bf16* __restrict__ Vt, const int t0abs, const int NT, const int blk,
                                          const int pos, const float* gatep, float* obf, bf16* ob, char* shm, float& mhat_o, float& rl_o) {
  constexpr int KP = (MODE == 0) ? 64 : 128;
  const int tid = tidx(), lane = tid & 63, r32 = lane & 31, hi = lane >> 5; const int wid = __builtin_amdgcn_readfirstlane(tid >> 6);
  const unsigned lds0 = (unsigned)(uintptr_t)shm;
  float* wsf = (float*)(shm + LDS_WS) + wid * 64;
  const bf16* ksrc = Kt + (long)lane * KP + wid * 8;
  const bf16* vsrc = Vt + (long)(16 * (wid & 3) + (lane >> 2)) * KP + (wid >> 2) * 32 + (lane & 3) * 8;
  const unsigned kdst = lds0 + LDS_K + wid * 1024, vdst = lds0 + LDS_V + wid * 1024;
#define DMA_K(t, slot) glds16(ksrc + (long)(t) * KVBLK * KP, (unsigned)__builtin_amdgcn_readfirstlane(kdst + (slot)))
#define DMA_V(t, slot) glds16(vsrc + (long)(t) * KVBLK * KP, (unsigned)__builtin_amdgcn_readfirstlane(vdst + (slot)))
  const int vb0 = (int)(lds0 + LDS_V) + ((lane >> 4) & 1) * 32 + (lane & 3) * 8 + (4 * hi + ((lane & 15) >> 2)) * 64;
  const char* Kbase = shm + LDS_K; bf16x8 kf[8];
  const lds_cptr shm3 = (lds_cptr)shm; const lds_cptr kp0 = shm3 + LDS_K + hi * 1024 + r32 * 16; const lds_cptr vp0 = shm3 + LDS_V + ((lane >> 4) & 1) * 32 + (lane & 3) * 8 + (4 * hi + ((lane & 15) >> 2)) * 64;
  const lds_cptr qp = shm3 + LDS_Q + wid * 4096 + lane * 16;
  const lds_cptr selp = shm3 + LDS_SELB + wid * 128 + (r32 >> 2) * 16;
#ifndef ATT_QREG
#define ATT_QREG 7
#endif
  constexpr bool QREG = (ATT_QREG >> MODE) & 1;
  bf16x8 qrg[4];
#define QF(j) (QREG ? qrg[j] : *(const __attribute__((address_space(3))) bf16x8*)(qp + (j) * 1024))
  const float gate_v = *gatep;
  DMA_K(0, 0); DMA_V(0, 0); DMA_K(1, SLOTB);
#pragma unroll
  for (int d0 = 0; d0 < 4; ++d0) { qrg[d0] = *reinterpret_cast<const bf16x8*>(&Qlane[d0 * 16 + hi * 8]); if (!QREG) *(__attribute__((address_space(3))) bf16x8*)((__attribute__((address_space(3))) char*)qp + d0 * 1024) = qrg[d0]; }
  float mhat = 0.f, l_reg = 0.f; f32x16 o[2]; o[0] = f32x16{}; o[1] = f32x16{}; const f32x16 zero16 = f32x16{};
  const int mlo = (MODE == 2) ? pos - (WIN - 1) : 0;
  const int mspan1 = (MODE == 0) ? (((pos - 31) >> 4) + 1 > 0 ? ((pos - 31) >> 4) + 1 : 0) : (MODE == 1 ? pos + 1 : WIN);
#define SELW(t) (MODE == 1 ? *(const __attribute__((address_space(3))) unsigned*)(selp + (((t0abs + (t)) >> 5) << 2)) : 0u)
#define CMASK(P0, P1, t, SW) amask<MODE>(P0, P1, t0abs + (t), blk, hi, mlo, mspan1, SW, mhat)
  bool resc = false;
#define START(P0, P1) do { const float rm = max2f(rowmax(P0, P1), -500.f); resc = false; \
    { const float dl = rm; mhat = fadd_s(mhat, dl); \
      _Pragma("unroll") for (int r = 0; r < 16; ++r) { P0[r] = fsub_s(P0[r], dl); P1[r] = fsub_s(P1[r], dl); } } \
    _Pragma("unroll") for (int r = 0; r < 16; ++r) P0[r] = __builtin_amdgcn_exp2f(P0[r]); } while (0)
#define RESC() do { if (resc) { asm volatile("s_waitcnt lgkmcnt(0)" ::: "memory"); \
      _Pragma("unroll") for (int d_ = 0; d_ < 2; ++d_) _Pragma("unroll") for (int r = 0; r < 16; ++r) o[d_][r] *= wsf[crow(r, hi)]; } } while (0)
  f32x16 pA0, pA1, pB0, pB1;
  int sl_prev = 0, sl_cur = 0, sl_next = SLOTB;
#define ROT() do { sl_prev = sl_cur; sl_cur = sl_next; sl_next = (sl_next == (NSLOT - 1) * SLOTB) ? 0 : sl_next + SLOTB; } while (0)
  DMA_K(2, 2 * SLOTB);
  WAIT_BAR(3);
  { const unsigned sw0 = SELW(0); if (QREG) qkt_r(pA0, pA1, Kbase, qrg, r32, hi); else qkt(pA0, pA1, Kbase, qp, r32, hi); asm volatile("s_nop 15\n\ts_nop 7" : "+v"(pA0), "+v"(pA1)); CMASK(pA0, pA1, 0, sw0); }
  START(pA0, pA1);
  _Pragma("unroll") for (int r = 0; r < 16; ++r) pA1[r] = __builtin_amdgcn_exp2f(pA1[r]);
  WAIT_BAR(0);
  DMA_K(3, 0); DMA_V(1, SLOTB);
  ROT();
  kload8(kf, kp0 + sl_cur);
  WAIT_BAR(2);
  s16x4 vlo[8], vhi[8]; u32x4 pw0, pw1, pw2, pw3;
#define PKW(P, B) cvtpk_s(P[B], P[B + 1])
#define PAF(k) __builtin_bit_cast(bf16x8, pw##k)
#define VFR(i) (bf16x8){vlo[i][0], vlo[i][1], vlo[i][2], vlo[i][3], vhi[i][0], vhi[i][1], vhi[i][2], vhi[i][3]}
#define PIN(x) asm volatile("" : "+v"(x))
#define MX3(a, b, c) __builtin_fmaxf(__builtin_fmaxf((a), (b)), (c))
#define GAPA(MF, A0, A1, A2, A3, W0, W1, PW) do { MF; sacc += A0; sacc += A1; sacc += A2; sacc += A3; PIN(sacc); W0; W1; PIN(PW); SBAR(); } while (0)
#define EX(v) __builtin_amdgcn_exp2f(v)
#define GAPB(MF, X, B) do { MF; X[B] = EX(X[B]); X[B + 1] = EX(X[B + 1]); X[B + 2] = EX(X[B + 2]); X[B + 3] = EX(X[B + 3]); PIN(X); SBAR(); } while (0)
#define VRD(i) do { vlo[i] = vtr(vp_ + (((i) >> 2) * 4096 + ((i) & 3) * 1024)); vhi[i] = vtr(vp_ + (((i) >> 2) * 4096 + ((i) & 3) * 1024 + 512)); } while (0)
#define KRD(G, j) do { if (G) { kload2(kf, kp0 + sl_next, j); SBAR(); } } while (0)
#define STEP(C0, C1, P0, P1, t, GK, GV, GL) do { SBAR(); \
    const lds_cptr vp_ = vp0 + sl_prev; const unsigned sw_ = SELW(t); \
    bf16x8 qa_ = QF(0); \
    VRD(0); SBAR(); float sacc = (P0[0] + P0[1]); \
    GAPA(C0 = __builtin_amdgcn_mfma_f32_32x32x16_bf16(kf[0], qa_, zero16, 0, 0, 0), P0[2], P0[3], P0[4], P0[5],     pw0[0] = PKW(P0, 0), pw0[1] = PKW(P0, 2), pw0); \
    VRD(4); SBAR(); GAPA(C1 = __builtin_amdgcn_mfma_f32_32x32x16_bf16(kf[1], qa_, zero16, 0, 0, 0), P0[6], P0[7], P0[8], P0[9],     pw0[2] = PKW(P0, 4), pw0[3] = PKW(P0, 6), pw0); \
    qa_ = QF(1); \
    VRD(1); SBAR(); GAPA(C0 = __builtin_amdgcn_mfma_f32_32x32x16_bf16(kf[2], qa_, C0, 0, 0, 0),   P0[10], P0[11], P0[12], P0[13], pw1[0] = PKW(P0, 8), pw1[1] = PKW(P0, 10), pw1); \
    VRD(5); SBAR(); GAPA(C1 = __builtin_amdgcn_mfma_f32_32x32x16_bf16(kf[3], qa_, C1, 0, 0, 0),   P0[14], P0[15], P1[0], P1[1],   pw1[2] = PKW(P0, 12), pw1[3] = PKW(P0, 14), pw1); \
    qa_ = QF(2); \
    VRD(2); SBAR(); GAPA(C0 = __builtin_amdgcn_mfma_f32_32x32x16_bf16(kf[4], qa_, C0, 0, 0, 0),   P1[2], P1[3], P1[4], P1[5],     pw2[0] = PKW(P1, 0), pw2[1] = PKW(P1, 2), pw2); \
    VRD(6); SBAR(); GAPA(C1 = __builtin_amdgcn_mfma_f32_32x32x16_bf16(kf[5], qa_, C1, 0, 0, 0),   P1[6], P1[7], P1[8], P1[9],     pw2[2] = PKW(P1, 4), pw2[3] = PKW(P1, 6), pw2); \
    qa_ = QF(3); \
    VRD(3); SBAR(); GAPA(C0 = __builtin_amdgcn_mfma_f32_32x32x16_bf16(kf[6], qa_, C0, 0, 0, 0),   P1[10], P1[11], P1[12], P1[13], pw3[0] = PKW(P1, 8), pw3[1] = PKW(P1, 10), pw3); \
    VRD(7); SBAR(); GAPA(C1 = __builtin_amdgcn_mfma_f32_32x32x16_bf16(kf[7], qa_, C1, 0, 0, 0),   P1[14], P1[15], 0.f, 0.f,       pw3[2] = PKW(P1, 12), pw3[3] = PKW(P1, 14), pw3); \
    l_reg += sacc; \
    if (GK) { DMA_K((t) + 3, sl_cur); } if (GV) { DMA_V((t) + 1, sl_next); } \
    CMASK(C0, C1, t, sw_); \
    { float a = MX3(C0[0], C0[1], C1[0]), b = MX3(C0[2], C0[3], C1[1]); a = MX3(a, C1[2], C1[3]); \
      _Pragma("unroll") for (int r = 4; r < 16; r += 4) { a = MX3(a, C0[r], C0[r + 1]); b = MX3(b, C0[r + 2], C0[r + 3]); a = MX3(a, C1[r], C1[r + 1]); b = MX3(b, C1[r + 2], C1[r + 3]); } \
      float rm = __builtin_fmaxf(a, b); { auto rr = __builtin_amdgcn_permlane32_swap(__float_as_uint(rm), __float_as_uint(rm), false, false); rm = __builtin_fmaxf(__uint_as_float(rr[0]), __uint_as_float(rr[1])); } \
      resc = false; \
      if (__builtin_expect(__any(rm > (float)THRL), 0)) { const float dl = __builtin_fmaxf(rm, 0.f); mhat += dl; \
        _Pragma("unroll") for (int r = 0; r < 16; ++r) { C0[r] -= dl; C1[r] -= dl; } \
        const float f = __builtin_amdgcn_exp2f(-dl); l_reg *= f; if (hi == 0) wsf[r32] = f; resc = true; } } \
    SBAR(); \
    GAPB(o[0] = __builtin_amdgcn_mfma_f32_32x32x16_bf16(PAF(0), VFR(0), o[0], 0, 0, 0), C0, 0); \
    GAPB(o[1] = __builtin_amdgcn_mfma_f32_32x32x16_bf16(PAF(0), VFR(4), o[1], 0, 0, 0), C0, 4); \
    KRD(GL, 0); GAPB(o[0] = __builtin_amdgcn_mfma_f32_32x32x16_bf16(PAF(1), VFR(1), o[0], 0, 0, 0), C0, 8); \
    KRD(GL, 1); GAPB(o[1] = __builtin_amdgcn_mfma_f32_32x32x16_bf16(PAF(1), VFR(5), o[1], 0, 0, 0), C0, 12); \
    KRD(GL, 2); GAPB(o[0] = __builtin_amdgcn_mfma_f32_32x32x16_bf16(PAF(2), VFR(2), o[0], 0, 0, 0), C1, 0); \
    KRD(GL, 3); GAPB(o[1] = __builtin_amdgcn_mfma_f32_32x32x16_bf16(PAF(2), VFR(6), o[1], 0, 0, 0), C1, 4); \
    GAPB(o[0] = __builtin_amdgcn_mfma_f32_32x32x16_bf16(PAF(3), VFR(3), o[0], 0, 0, 0), C1, 8); \
    GAPB(o[1] = __builtin_amdgcn_mfma_f32_32x32x16_bf16(PAF(3), VFR(7), o[1], 0, 0, 0), C1, 12); \
    } while (0)
  int t = 1;
  for (; t + 5 < NT; t += 2) {
    STEP(pB0, pB1, pA0, pA1, t, true, true, true);     WAIT_BAR(2); RESC(); ROT();
    STEP(pA0, pA1, pB0, pB1, t + 1, true, true, true); WAIT_BAR(2); RESC(); ROT();
  }
#define ENDW(tt) do { if ((tt) + 3 < NT) { WAIT_BAR(2); } else if ((tt) + 2 < NT) { WAIT_BAR(1); } else { WAIT_BAR(0); } } while (0)
  for (; t + 1 < NT; t += 2) {
    STEP(pB0, pB1, pA0, pA1, t, (t + 3 < NT), (t + 1 < NT), (t + 1 < NT));         ENDW(t);     RESC(); ROT();
    STEP(pA0, pA1, pB0, pB1, t + 1, (t + 4 < NT), (t + 2 < NT), (t + 2 < NT));     ENDW(t + 1); RESC(); ROT();
  }
  STEP(pB0, pB1, pA0, pA1, NT - 1, false, false, false); RESC();
  { float sacc = pB0[0] + pB0[1]; _Pragma("unroll") for (int r = 2; r < 16; ++r) sacc += pB0[r]; _Pragma("unroll") for (int r = 0; r < 16; ++r) sacc += pB1[r]; l_reg += sacc;
    pw0 = (u32x4){PKW(pB0, 0), PKW(pB0, 2), PKW(pB0, 4), PKW(pB0, 6)}; pw1 = (u32x4){PKW(pB0, 8), PKW(pB0, 10), PKW(pB0, 12), PKW(pB0, 14)}; pw2 = (u32x4){PKW(pB1, 0), PKW(pB1, 2), PKW(pB1, 4), PKW(pB1, 6)}; pw3 = (u32x4){PKW(pB1, 8), PKW(pB1, 10), PKW(pB1, 12), PKW(pB1, 14)};
    SBAR(); pv(o, vb0 + sl_cur, PAF(0), PAF(1), PAF(2), PAF(3)); }
#undef PKW
#undef PAF
#undef VFR
#undef PIN
#undef MX3
#undef GAPA
#undef GAPB
#undef EX
#undef VRD
#undef KRD
#undef STEP
#undef ENDW
  { auto rr = __builtin_amdgcn_permlane32_swap(__float_as_uint(l_reg), __float_as_uint(l_reg), false, false); l_reg = __uint_as_float(rr[0]) + __uint_as_float(rr[1]); }
  const float rl = l_reg > 0.f ? __builtin_amdgcn_rcpf(l_reg) : 0.f;
  mhat_o = mhat; rl_o = rl;
  if (hi == 0) wsf[32 + r32] = rl * gate_v; asm volatile("s_waitcnt lgkmcnt(0)" ::: "memory");
  { __attribute__((address_space(3))) float* ost = (__attribute__((address_space(3))) float*)(shm3 + LDS_OST) + wid * 2048;
#pragma unroll
    for (int r = 0; r < 16; ++r) { const int orow = crow(r, hi); const float sc = wsf[32 + orow];
#pragma unroll
      for (int d0 = 0; d0 < 2; ++d0) { __attribute__((address_space(3))) float* p = ost + orow * 64 + 32 * d0 + r32; float v = o[d0][r] * sc;
        if (MODE != 0) v += *p;
        if (MODE == 2) ob[(2 * (r >> 2)) * 1024 + (r & 3) * 64 + 32 * d0] = (bf16)f2bf(v); else *p = v; } } }
  (void)obf;
  asm volatile("s_waitcnt lgkmcnt(0)\n\ts_barrier" ::: "memory");
#undef DMA_K
#undef DMA_V
#undef CMASK
#undef SELW
#undef QF
#undef START
#undef RESC
#undef ROT
}

__device__ __forceinline__ int dppx1(int v) { return __builtin_amdgcn_mov_dpp(v, 0xB1, 0xF, 0xF, true); }
__device__ __forceinline__ int dppx2(int v) { return __builtin_amdgcn_mov_dpp(v, 0x4E, 0xF, 0xF, true); }
__device__ __forceinline__ float quad_sum(float v) { v += __builtin_bit_cast(float, dppx1(__builtin_bit_cast(int, v))); v += __builtin_bit_cast(float, dppx2(__builtin_bit_cast(int, v))); return v; }

__device__ __forceinline__ void nsa_prompt_unit(const unsigned char* ws, int b, int kv, int blk, char* shm) {
  float mhat = 0.f, rl = 0.f, dm0, dm1;
#define LANE_SETUP() const int lane = tidx() & 63, r32 = lane & 31, hi = lane >> 5; const int wid = __builtin_amdgcn_readfirstlane(tidx() >> 6); \
    const int tl = r32 >> 2, hl = r32 & 3, pos = 64 * blk + 8 * wid + tl; const size_t m = (size_t)b * SEQ + pos; const int head = 4 * kv + hl; (void)hi; (void)head; (void)m; (void)tl; (void)hl; \
    const size_t obo = ((size_t)b * SEQ + 64 * blk + 8 * wid + hi) * 512 + (4 * kv) * 64 + r32; const size_t obb = ((size_t)b * SEQ + 64 * blk + 8 * wid + hi) * 1024 + 512 + (4 * kv) * 64 + r32; (void)obo; (void)obb
  const int ntc_real = blk / 16 + 1;
  { LANE_SETUP(); const int NTc = ntc_real < 4 ? 4 : ((ntc_real + 1) & ~1);
    const bf16* kc = (const bf16*)(ws + WS_KCP) + (size_t)(b * 2 + kv) * NCP * 64; const bf16* vc = (const bf16*)(ws + WS_VCP) + (size_t)(b * 2 + kv) * NCP * 64;
#ifndef NO_M0
    attn_unit<0, 8>((const bf16*)(ws + WS_QN) + m * 512 + head * 64, kc, vc, 0, NTc, blk, pos, (const float*)(ws + WS_NG) + m * 32 + head * 3 + 0, (float*)(ws + WS_OBF) + obo, (bf16*)(ws + WS_OAB) + obb, shm, mhat, rl);
#endif
 }
  {
    LANE_SETUP();
    LAS float* bsw = (LAS float*)(shm + LDS_K) + wid * 8 * BLKS_PITCH;
    for (int i = lane; i < 8 * BLKS_PITCH; i += 64) bsw[i] = 0.f;
    asm volatile("s_waitcnt lgkmcnt(0)" ::: "memory");
    const int cthr = (pos - 31) >> 4; const int cspan = cthr + 1 > 0 ? cthr + 1 : 0;
    const bf16* kc = (const bf16*)(ws + WS_KCP) + (size_t)(b * 2 + kv) * NCP * 64; const bf16* qn = (const bf16*)(ws + WS_QN) + m * 512 + head * 64;
    bf16x8 qf[4];
#pragma unroll
    for (int d0 = 0; d0 < 4; ++d0) qf[d0] = *reinterpret_cast<const bf16x8*>(&qn[d0 * 16 + hi * 8]);
    const f32x16 zero16 = f32x16{};
    bf16x8 kb0[4], kb1[4], nb0[4], nb1[4];
#define IMP_LOAD(D0, D1, t_) do { const bf16* kr = kc + (size_t)(64 * (t_) + r32) * 64 + hi * 8; \
      _Pragma("unroll") for (int d0 = 0; d0 < 4; ++d0) { D0[d0] = *reinterpret_cast<const bf16x8*>(kr + d0 * 16); D1[d0] = *reinterpret_cast<const bf16x8*>(kr + 32 * 64 + d0 * 16); } } while (0)
    IMP_LOAD(kb0, kb1, 0);
    for (int t = 0; t < ntc_real; ++t) {
      if (t + 1 < ntc_real) IMP_LOAD(nb0, nb1, t + 1);
      f32x16 p0, p1;
#pragma unroll
      for (int d0 = 0; d0 < 4; ++d0) {
        if (d0 == 0) { p0 = __builtin_amdgcn_mfma_f32_32x32x16_bf16(kb0[0], qf[0], zero16, 0, 0, 0); p1 = __builtin_amdgcn_mfma_f32_32x32x16_bf16(kb1[0], qf[0], zero16, 0, 0, 0); }
        else { p0 = __builtin_amdgcn_mfma_f32_32x32x16_bf16(kb0[d0], qf[d0], p0, 0, 0, 0); p1 = __builtin_amdgcn_mfma_f32_32x32x16_bf16(kb1[d0], qf[d0], p1, 0, 0, 0); } }
      const int base = 64 * t + 4 * hi;
#pragma unroll
      for (int r = 0; r < 16; ++r) { const int c0 = base + (r & 3) + 8 * (r >> 2); p0[r] = (c0 < cspan) ? __builtin_amdgcn_exp2f(p0[r] - mhat) * rl : 0.f; p1[r] = (c0 + 32 < cspan) ? __builtin_amdgcn_exp2f(p1[r] - mhat) * rl : 0.f; }
#pragma unroll
      for (int ph = 0; ph < 2; ++ph)
#pragma unroll
        for (int g = 0; g < 4; ++g) { const float a0 = ph ? p1[4 * g] : p0[4 * g], a1 = ph ? p1[4 * g + 1] : p0[4 * g + 1], a2 = ph ? p1[4 * g + 2] : p0[4 * g + 2], a3 = ph ? p1[4 * g + 3] : p0[4 * g + 3];
          const float A = quad_sum(2.f * (a0 + a1 + a2) + a3), B = quad_sum(a3);
          const int j = 16 * t + 8 * ph + 2 * g + hi;
          if (hl == 0) { __hip_atomic_fetch_add(bsw + tl * BLKS_PITCH + j, A, __ATOMIC_RELAXED, __HIP_MEMORY_SCOPE_WORKGROUP); __hip_atomic_fetch_add(bsw + tl * BLKS_PITCH + j + 1, B, __ATOMIC_RELAXED, __HIP_MEMORY_SCOPE_WORKGROUP); } }
#pragma unroll
      for (int d0 = 0; d0 < 4; ++d0) { kb0[d0] = nb0[d0]; kb1[d0] = nb1[d0]; }
    }
#undef IMP_LOAD
    asm volatile("s_waitcnt lgkmcnt(0)" ::: "memory");
    LAS unsigned* selb = (LAS unsigned*)(shm + LDS_SELB) + wid * 32;
    const int cur = blk, nf = cur >= 2 ? 3 : cur + 1, need = 16 - nf;
    {
      const int j0 = lane, j1 = lane + 64;
      const bool c0 = (j0 >= 1 && j0 <= cur - 2), c1 = (j1 <= cur - 2);
      float v0[8], v1[8]; unsigned sm0 = (j0 == 0 || j0 == cur || j0 == cur - 1) ? 0xFFu : 0u, sm1 = (j1 == cur || j1 == cur - 1) ? 0xFFu : 0u;
#pragma unroll
      for (int tk = 0; tk < 8; ++tk) { const LAS float* bs = bsw + tk * BLKS_PITCH; v0[tk] = c0 ? bs[j0] : -1.f; v1[tk] = c1 ? bs[j1] : -1.f; }
      if (cur - 2 <= need) {
#pragma unroll
        for (int tk = 0; tk < 8; ++tk) { if (v0[tk] >= 0.f) sm0 |= 1u << tk; if (v1[tk] >= 0.f) sm1 |= 1u << tk; } }
      else for (int k = 0; k < need; ++k) {
#pragma unroll
        for (int tk = 0; tk < 8; ++tk) {
          const float mx = wave_max_dpp(fmaxf(v0[tk], v1[tk]));
          const unsigned long long b0 = __ballot(v0[tk] == mx), b1 = __ballot(v1[tk] == mx);
          const int l = __builtin_ctzll(b0 ? b0 : b1);
          const bool t0 = (b0 != 0ull) && lane == l, t1 = (b0 == 0ull) && lane == l;
          if (t0) { sm0 |= 1u << tk; v0[tk] = -1.f; }
          if (t1) { sm1 |= 1u << tk; v1[tk] = -1.f; } } }
#pragma unroll
      for (int tk = 0; tk < 8; ++tk) { const unsigned long long m0 = __ballot(((sm0 >> tk) & 1u) != 0u), m1 = __ballot(((sm1 >> tk) & 1u) != 0u);
        if (lane == 0) { selb[tk * 4 + 0] = (unsigned)m0; selb[tk * 4 + 1] = (unsigned)(m0 >> 32); selb[tk * 4 + 2] = (unsigned)m1; selb[tk * 4 + 3] = (unsigned)(m1 >> 32); } }
    }
    asm volatile("s_waitcnt lgkmcnt(0)\n\ts_barrier" ::: "memory");
  }
  { LANE_SETUP(); const int nt_real = blk + 1; const int NTs = nt_real < 4 ? 4 : ((nt_real + 1) & ~1);
    const bf16* ks = (const bf16*)(ws + WS_KS) + (size_t)b * SEQ * 128 + kv * 64; const bf16* vs = (const bf16*)(ws + WS_VS) + (size_t)b * SEQ * 128 + kv * 64;
#ifndef NO_M1
    attn_unit<1, 8>((const bf16*)(ws + WS_QR) + m * 512 + head * 64, ks, vs, 0, NTs, blk, pos, (const float*)(ws + WS_NG) + m * 32 + head * 3 + 1, (float*)(ws + WS_OBF) + obo, (bf16*)(ws + WS_OAB) + obb, shm, dm0, dm1);
#endif
 }
  { LANE_SETUP(); int t0, NTw; if (blk >= 9) { t0 = blk - 9; NTw = 10; } else { t0 = 0; const int nt_real = blk + 1; NTw = nt_real < 4 ? 4 : ((nt_real + 1) & ~1); }
    const bf16* kw = (const bf16*)(ws + WS_KW) + ((size_t)b * SEQ + 64 * t0) * 128 + kv * 64; const bf16* vw = (const bf16*)(ws + WS_VW) + ((size_t)b * SEQ + 64 * t0) * 128 + kv * 64;
#ifndef NO_M2
    attn_unit<2, 8>((const bf16*)(ws + WS_QR) + m * 512 + head * 64, kw, vw, t0, NTw, blk, pos, (const float*)(ws + WS_NG) + m * 32 + head * 3 + 2, (float*)(ws + WS_OBF) + obo, (bf16*)(ws + WS_OAB) + obb, shm, dm0, dm1);
#endif
 }
#undef LANE_SETUP
}
#undef SBAR
#undef WAIT_BAR
}

namespace smp {
typedef unsigned long long u64x2 __attribute__((ext_vector_type(2)));
constexpr int SCP = 1040;
constexpr int L_SC = 0, L_PART = L_SC + 4 * SCP * 4, L_OB = L_PART + 32 * 256 * 4, L_BLK = L_OB + 1024, L_SEL = L_BLK + 272 * 8, L_PT = L_SEL + 256, L_RS = L_PT + 4 * NPAGES, L_END = L_RS + 16;
constexpr float NEG = -1e30f;
constexpr int UKS_DEF = 4, UKP_DEF = 3;

__device__ __forceinline__ void ld16(const float* row, int c, float (&v)[16]) {
#pragma unroll
    for (int j = 0; j < 4; ++j) { const f32x4 t = *(const f32x4*)(row + 16 * j + 4 * c); v[4 * j] = t.x; v[4 * j + 1] = t.y; v[4 * j + 2] = t.z; v[4 * j + 3] = t.w; }
}
__device__ __forceinline__ void ld16(const bf16* row, int c, float (&v)[16]) {
#pragma unroll
    for (int j = 0; j < 4; ++j) { const v2u t = *(const v2u*)(row + 16 * j + 4 * c); v[4 * j] = bflo(t.x); v[4 * j + 1] = bfhi(t.x); v[4 * j + 2] = bflo(t.y); v[4 * j + 3] = bfhi(t.y); }
}
__device__ __forceinline__ void ldq(const bf16* row, int c, v2u (&r)[4][4]) {
#pragma unroll
    for (int h = 0; h < 4; ++h)
#pragma unroll
        for (int j = 0; j < 4; ++j) r[h][j] = *(const v2u*)(row + h * 64 + 16 * j + 4 * c);
}
__device__ __forceinline__ void cvtq(const v2u (&r)[4][4], float (&q)[4][16]) {
#pragma unroll
    for (int h = 0; h < 4; ++h)
#pragma unroll
        for (int j = 0; j < 4; ++j) { q[h][4 * j] = bflo(r[h][j].x); q[h][4 * j + 1] = bfhi(r[h][j].x); q[h][4 * j + 2] = bflo(r[h][j].y); q[h][4 * j + 3] = bfhi(r[h][j].y); }
}
__device__ __forceinline__ float qsum(float v) { v += __builtin_bit_cast(float, __builtin_amdgcn_mov_dpp(__builtin_bit_cast(int, v), 0xB1, 0xF, 0xF, true)); v += __builtin_bit_cast(float, __builtin_amdgcn_mov_dpp(__builtin_bit_cast(int, v), 0x4E, 0xF, 0xF, true)); return v; }

template <int UKS = UKS_DEF, class LD>
__device__ __forceinline__ void scores(LAS float* sc, int s0, int n, const float (&q)[4][16], const LD& ld) {
    const int lane = tidx() & 63, w = tidx() >> 6, ks = lane >> 2, c = lane & 3;
    for (int base = w * 16 * UKS; base < n; base += 8 * 16 * UKS) {
        float kx[UKS][16]; bool ok[UKS];
#pragma unroll
        for (int u = 0; u < UKS; ++u) { const int sl = base + 16 * u + ks; ok[u] = sl < n; if (ok[u]) ld(sl, c, kx[u]); else { _Pragma("unroll") for (int i = 0; i < 16; ++i) kx[u][i] = 0.f; } }
#pragma unroll
        for (int u = 0; u < UKS; ++u) { float s[4];
#pragma unroll
            for (int h = 0; h < 4; ++h) { float a = 0.f; _Pragma("unroll") for (int i = 0; i < 16; ++i) a += q[h][i] * kx[u][i]; s[h] = qsum(a); }
            const float sv = c == 0 ? s[0] : (c == 1 ? s[1] : (c == 2 ? s[2] : s[3]));
            if (ok[u]) sc[c * SCP + s0 + base + 16 * u + ks] = sv; }
    }
}
template <int UKP = UKP_DEF, class LD>
__device__ __forceinline__ void pvacc(const LAS float* sc, int s0, int n, float (&acc)[4][16], const LD& ld) {
    const int lane = tidx() & 63, w = tidx() >> 6, ks = lane >> 2, c = lane & 3;
    for (int base = w * 16 * UKP; base < n; base += 8 * 16 * UKP) {
        float vx[UKP][16];
#pragma unroll
        for (int u = 0; u < UKP; ++u) { const int sl = base + 16 * u + ks; const int slc = sl < n ? sl : 0;
            ld(slc, c, vx[u]); }
#pragma unroll
        for (int u = 0; u < UKP; ++u) { const int sl = base + 16 * u + ks; const bool ok = sl < n; const int slc = ok ? sl : 0;
#pragma unroll
            for (int h = 0; h < 4; ++h) { const float pr = sc[h * SCP + s0 + slc]; const float pv = ok ? pr : 0.f;
#pragma unroll
                for (int i = 0; i < 16; ++i) acc[h][i] += pv * vx[u][i]; } }
    }
}
__device__ __forceinline__ void softmax4(LAS float* sc, LAS float* rs, int n) {
    const int lane = tidx() & 63, w = tidx() >> 6;
    __syncthreads();
    if (w < 4) { LAS float* s = sc + w * SCP; float mx = -500.f;
        for (int i = lane; i < n; i += 64) mx = fmaxf(mx, s[i]);
        mx = wave_max(mx); float sum = 0.f;
        for (int i = lane; i < n; i += 64) { const float e = __builtin_amdgcn_exp2f(s[i] - mx); s[i] = e; sum += e; }
        sum = wave_sum(sum); if (lane == 0) rs[w] = sum > 0.f ? 1.f / sum : 0.f; }
    __syncthreads();
}
__device__ __forceinline__ float rowsum4(float v) {
    v += __builtin_bit_cast(float, __builtin_amdgcn_update_dpp(0, __builtin_bit_cast(int, v), 0x124, 0xF, 0xF, false));
    v += __builtin_bit_cast(float, __builtin_amdgcn_update_dpp(0, __builtin_bit_cast(int, v), 0x128, 0xF, 0xF, false));
    return v; }
__device__ __forceinline__ void finish(LAS unsigned char* L, float (&acc)[4][16], const float gate) {
    const int tid = tidx(), lane = tid & 63, w = tid >> 6, c = lane & 3;
    LAS float* part = (LAS float*)(L + L_PART); LAS float* ob = (LAS float*)(L + L_OB); const LAS float* rs = (const LAS float*)(L + L_RS);
#pragma unroll
    for (int h = 0; h < 4; ++h)
#pragma unroll
        for (int i = 0; i < 16; ++i) acc[h][i] = rowsum4(acc[h][i]);
    if ((lane & 12) == 0) {
#pragma unroll
        for (int h = 0; h < 4; ++h)
#pragma unroll
            for (int j = 0; j < 4; ++j) *(LAS f32x4*)(part + (w * 4 + (lane >> 4)) * 256 + h * 64 + 16 * j + 4 * c) = (f32x4){acc[h][4 * j], acc[h][4 * j + 1], acc[h][4 * j + 2], acc[h][4 * j + 3]};
    }
    __syncthreads();
    if (tid < 256) { float s0 = 0.f, s1 = 0.f;
#pragma unroll
        for (int ww = 0; ww < 32; ww += 2) { s0 += part[ww * 256 + tid]; s1 += part[(ww + 1) * 256 + tid]; }
        ob[tid] += gate * rs[tid >> 6] * (s0 + s1); }
    __syncthreads();
}

__device__ __forceinline__ void nsa_sample_unit(const unsigned char* ws, const float* cks, const float* cvs, const float* ckw, const float* cvw, const int* ptab, LAS unsigned char* L, int sb, int kv, int st) {
    const int tid = tidx(), lane = tid & 63, c = lane & 3;
    const size_t m = (size_t)MP + 4 * sb + st;
    LAS float* sc = (LAS float*)(L + L_SC); LAS float* ob = (LAS float*)(L + L_OB); LAS unsigned long long* bk = (LAS unsigned long long*)(L + L_BLK); LAS int* sel = (LAS int*)(L + L_SEL);
    const float* gates = (const float*)(ws + WS_NG) + m * 32 + (4 * kv) * 3;
    const bf16* KSn = (const bf16*)(ws + WS_KS) + ((size_t)MP + 4 * sb) * 128 + kv * 64; const bf16* VSn = (const bf16*)(ws + WS_VS) + ((size_t)MP + 4 * sb) * 128 + kv * 64;
    const bf16* KWn = (const bf16*)(ws + WS_KW) + ((size_t)MP + 4 * sb) * 128 + kv * 64; const bf16* VWn = (const bf16*)(ws + WS_VW) + ((size_t)MP + 4 * sb) * 128 + kv * 64;
#ifdef TIME_PROBE_A
#define SSTAMP(k) do { if (blockIdx.x == 0 && tid == 0) ((unsigned long long*)(ws + WS_DBG + 65536))[k] = __builtin_amdgcn_s_memrealtime(); } while (0)
#else
#define SSTAMP(k) do { } while (0)
#endif
    float gt[3]; { const float* gp = gates + ((tid & 255) >> 6) * 3; gt[0] = gp[0]; gt[1] = gp[1]; gt[2] = gp[2]; }
    LAS float* rsL = (LAS float*)(L + L_RS);
    v2u qrr[4][4];
    __syncthreads();
    SSTAMP(20);
    if (tid < 256) ob[tid] = 0.f;
    if (tid < 2) sel[tid] = tid * 255; if (tid == 2) sel[32] = tid;
    LAS int* ptl = (LAS int*)(L + L_PT); if (tid >= 512 - NPAGES) ptl[tid - (512 - NPAGES)] = ptab[sb * NPAGES + tid - (512 - NPAGES)];
    {
        float q[4][16];
#pragma unroll
        for (int h = 0; h < 4; ++h) ld16((const bf16*)(ws + WS_QN) + m * 512 + (4 * kv + h) * 64, c, q[h]);
        const bf16* kc = (const bf16*)(ws + WS_KCS) + (size_t)(sb * 2 + kv) * NCS * 64; const bf16* vc = (const bf16*)(ws + WS_VCS) + (size_t)(sb * 2 + kv) * NCS * 64;
        auto kp = [&](int sl, int cc, float (&v)[16]) { ld16(kc + (size_t)sl * 64, cc, v); }; auto vp = [&](int sl, int cc, float (&v)[16]) { ld16(vc + (size_t)sl * 64, cc, v); };
        scores(sc, 0, NCS - 1, q, kp);
        ldq((const bf16*)(ws + WS_QR) + m * 512 + (4 * kv) * 64, c, qrr);
        softmax4(sc, rsL, NCS - 1);
        float acc[4][16] = {};
        pvacc(sc, 0, NCS - 1, acc, vp);
        finish(L, acc, gt[0]);
    }
    SSTAMP(21);
    if (tid < 257) { const int j = tid; float v[5]; const float r0 = rsL[0], r1 = rsL[1], r2 = rsL[2], r3 = rsL[3];
#pragma unroll
        for (int i = 0; i < 5; ++i) { const int cc = 4 * j - 1 + i; v[i] = (cc >= 0 && cc < NCS - 1) ? (r0 * sc[cc] + r1 * sc[SCP + cc]) + (r2 * sc[2 * SCP + cc] + r3 * sc[3 * SCP + cc]) : 0.f; }
        const float bs = v[0] + 2.f * (v[1] + v[2] + v[3]) + v[4];
        const unsigned ub = __builtin_bit_cast(unsigned, bs); const unsigned so = ub ^ ((ub >> 31) ? 0xFFFFFFFFu : 0x80000000u);
        bk[j] = (j == 0 || j >= 255) ? 0ull : (((unsigned long long)so << 32) | (unsigned)(255 - j)); }
    __syncthreads();
    SSTAMP(26);
    {
        const int j = tid >> 1, hfr = tid & 1; const unsigned long long kj = bk[j]; int cnt = 0;
#pragma unroll 8
        for (int i0 = 0; i0 < 128; i0 += 2) { const u64x2 v = *(const LAS u64x2*)(bk + 128 * hfr + i0); cnt += (v.x > kj ? 1 : 0) + (v.y > kj ? 1 : 0); }
        cnt += __shfl_xor(cnt, 1);
        if (hfr == 0 && j >= 1 && j <= 254 && cnt < 13) { const int k = __hip_atomic_fetch_add(sel + 32, 1, __ATOMIC_RELAXED, __HIP_MEMORY_SCOPE_WORKGROUP); if (k < 15) sel[k] = j; } }
    __syncthreads();
    SSTAMP(27);
    if (tid < 15) { const int b = sel[tid]; sel[16 + tid] = ptl[b >> 1] * 128 + (b & 1) * 64; }
    __syncthreads();
    SSTAMP(22);
    {
        float q[4][16]; cvtq(qrr, q);
        auto kp = [&](int sl, int cc, float (&v)[16]) { if (sl < 960) ld16(cks + ((size_t)sel[16 + (sl >> 6)] + (sl & 63)) * 128 + kv * 64, cc, v); else ld16(KSn + (size_t)(sl - 960) * 128, cc, v); };
        auto vp = [&](int sl, int cc, float (&v)[16]) { if (sl < 960) ld16(cvs + ((size_t)sel[16 + (sl >> 6)] + (sl & 63)) * 128 + kv * 64, cc, v); else ld16(VSn + (size_t)(sl - 960) * 128, cc, v); };
        scores(sc, 0, 960 + st + 1, q, kp);
        softmax4(sc, rsL, 960 + st + 1);
        float acc[4][16] = {};
        pvacc(sc, 0, 960 + st + 1, acc, vp);
        finish(L, acc, gt[1]);
    }
    SSTAMP(24);
    {
        float q[4][16]; cvtq(qrr, q);
        const float* ck = ckw + ((size_t)sb * WIN + st + 1) * 128 + kv * 64; const float* cv = cvw + ((size_t)sb * WIN + st + 1) * 128 + kv * 64; const int nc = WIN - 1 - st;
        auto kp = [&](int sl, int cc, float (&v)[16]) { if (sl < nc) ld16(ck + (size_t)sl * 128, cc, v); else ld16(KWn + (size_t)(sl - nc) * 128, cc, v); };
        auto vp = [&](int sl, int cc, float (&v)[16]) { if (sl < nc) ld16(cv + (size_t)sl * 128, cc, v); else ld16(VWn + (size_t)(sl - nc) * 128, cc, v); };
        scores(sc, 0, WIN, q, kp);
        softmax4(sc, rsL, WIN);
        float acc[4][16] = {};
        pvacc(sc, 0, WIN, acc, vp);
        finish(L, acc, gt[2]);
    }
    SSTAMP(25);
    if (tid < 256) ((bf16*)(ws + WS_OAB))[m * 1024 + 512 + (4 * kv) * 64 + tid] = (bf16)f2bf(ob[tid]);
    __syncthreads();
}
}

#ifdef ATT_CHECK
namespace chk {
constexpr int C_Q = 0, C_SC = C_Q + 2 * 8 * 64 * 4, C_IMP = C_SC + 4 * 1032 * 4, C_BLK = C_IMP + 1032 * 4, C_IDX = C_BLK + 264 * 4, C_O = C_IDX + 64, C_RED = C_O + 256 * 4, C_END = C_RED + 64;
constexpr int SP = 1032;
struct Src { const unsigned char* ws; const float* const* in; };

__device__ __forceinline__ float sel_fetch(const unsigned char* ws, const float* cache, const int* pt, bool smp, int b, int kv, int kpos, int d, size_t wsoff) {
    if (!smp) { int p = kpos < 0 ? 0 : (kpos > SEQ - 1 ? SEQ - 1 : kpos); return bf2f(((const bf16*)(ws + wsoff))[((size_t)b * SEQ + p) * 128 + kv * 64 + d]); }
    if (kpos < PAST) { int pc = kpos < 0 ? 0 : kpos; const int pg = pt[b * NPAGES + (pc >> 7)]; return cache[((size_t)pg * 128 + (pc & 127)) * 128 + kv * 64 + d]; }
    int pn = kpos - PAST; pn = pn > 3 ? 3 : pn; return bf2f(((const bf16*)(ws + wsoff))[((size_t)MP + 4 * b + pn) * 128 + kv * 64 + d]);
}
__device__ __forceinline__ void softmax_rows(LAS float* sc, int n) {
    const int lane = tidx() & 63, w = tidx() >> 6;
    if (w < 4) { LAS float* s = sc + w * SP; float mx = -3e38f;
        for (int i = lane; i < n; i += 64) mx = fmaxf(mx, s[i]);
        mx = wave_max(mx); const bool any = mx > -1e29f; float sum = 0.f;
        for (int i = lane; i < n; i += 64) { const float e = (any && s[i] > -1e29f) ? exp2f(s[i] - mx) : 0.f; s[i] = e; sum += e; }
        sum = wave_sum(sum); const float rs = sum > 0.f ? 1.f / sum : 0.f;
        for (int i = lane; i < n; i += 64) s[i] *= rs; }
    __syncthreads();
}
__device__ __forceinline__ void check_token(const unsigned char* ws, const float* const* in, LAS unsigned char* L, bool smp, int b, int tq, float& emax, float& rmax) {
    const int tid = tidx();
    LAS float* q = (LAS float*)(L + C_Q); LAS float* sc = (LAS float*)(L + C_SC); LAS float* imp = (LAS float*)(L + C_IMP); LAS float* blk = (LAS float*)(L + C_BLK);
    LAS int* idx = (LAS int*)(L + C_IDX); LAS float* oo = (LAS float*)(L + C_O); LAS float* red = (LAS float*)(L + C_RED);
    const int pos = smp ? PAST + tq : tq; const size_t m = smp ? (size_t)MP + 4 * b + tq : (size_t)b * SEQ + tq;
    const int NC = smp ? NCS - 1 : NCP - 1, n_sel = smp ? 257 : 128, n_ch = 4 * n_sel, cur = pos >> 6;
    const int* pt = (const int*)in[I_PT];
    __syncthreads();
    for (int i = tid; i < 1024; i += 512) { const int ty = i >> 9, r = i & 511; q[i] = bf2f(((const bf16*)(ws + (ty ? WS_QR : WS_QN)))[m * 512 + r]); }
    if (tid == 0) { red[0] = 0.f; red[1] = 0.f; }
    __syncthreads();
    for (int kv = 0; kv < 2; ++kv) {
        if (tid < 256) oo[tid] = 0.f;
        __syncthreads();
        { const bf16* kc = (const bf16*)(ws + (smp ? WS_KCS : WS_KCP)) + (size_t)(b * 2 + kv) * (smp ? NCS : NCP) * 64; const bf16* vc = (const bf16*)(ws + (smp ? WS_VCS : WS_VCP)) + (size_t)(b * 2 + kv) * (smp ? NCS : NCP) * 64;
          for (int c = tid; c < NC; c += 512) { float d0 = 0.f, d1 = 0.f, d2 = 0.f, d3 = 0.f;
              for (int d = 0; d < 64; ++d) { const float k = bf2f(kc[(size_t)c * 64 + d]); d0 += q[(4 * kv + 0) * 64 + d] * k; d1 += q[(4 * kv + 1) * 64 + d] * k; d2 += q[(4 * kv + 2) * 64 + d] * k; d3 += q[(4 * kv + 3) * 64 + d] * k; }
              const bool ok = (c * 16 + 31 <= pos); sc[c] = ok ? d0 : -1e30f; sc[SP + c] = ok ? d1 : -1e30f; sc[2 * SP + c] = ok ? d2 : -1e30f; sc[3 * SP + c] = ok ? d3 : -1e30f; }
          __syncthreads();
          softmax_rows(sc, NC);
          if (tid < 256) { const int h = tid >> 6, d = tid & 63; float a = 0.f; for (int c = 0; c < NC; ++c) a += sc[h * SP + c] * bf2f(vc[(size_t)c * 64 + d]);
              oo[tid] += ((const float*)(ws + WS_NG))[m * 32 + (4 * kv + h) * 3 + 0] * a; }
          for (int c = tid; c < 1032; c += 512) imp[c] = c < NC ? (sc[c] + sc[SP + c]) + (sc[2 * SP + c] + sc[3 * SP + c]) : 0.f;
          __syncthreads(); }
        for (int j = tid; j < n_sel; j += 512) { float s = 0.f;
            for (int i = 0; i < 4; ++i) { const int c = 4 * j + i; const float a = (c < NC && c < n_ch) ? imp[c] : 0.f; const float bsh = (c >= 1 && c - 1 < NC) ? imp[c - 1] : 0.f; s += a + bsh; }
            const bool forced = (j == 0) || (j == cur) || (j == cur - 1), valid = (j * 64 <= pos);
            blk[j] = forced ? 1e4f : (valid ? s : -1e4f); }
        __syncthreads();
        if (tid == 0) { for (int k = 0; k < 16; ++k) { int bi = 0; float bv = -3e38f; for (int j = 0; j < n_sel; ++j) if (blk[j] > bv) { bv = blk[j]; bi = j; } idx[k] = bi; blk[bi] = -3e38f; } }
        __syncthreads();
        { const float* ck = in[I_CKS]; const float* cv = in[I_CVS];
          for (int s = tid; s < 1024; s += 512) { const int bi = idx[s >> 6], kpos = bi * 64 + (s & 63); const bool ok = (bi * 64 <= pos) && (kpos <= pos);
              float d0 = 0.f, d1 = 0.f, d2 = 0.f, d3 = 0.f;
              if (ok) for (int d = 0; d < 64; ++d) { const float k = sel_fetch(ws, ck, pt, smp, b, kv, kpos, d, WS_KS); d0 += q[512 + (4 * kv + 0) * 64 + d] * k; d1 += q[512 + (4 * kv + 1) * 64 + d] * k; d2 += q[512 + (4 * kv + 2) * 64 + d] * k; d3 += q[512 + (4 * kv + 3) * 64 + d] * k; }
              sc[s] = ok ? d0 : -1e30f; sc[SP + s] = ok ? d1 : -1e30f; sc[2 * SP + s] = ok ? d2 : -1e30f; sc[3 * SP + s] = ok ? d3 : -1e30f; }
          __syncthreads();
          softmax_rows(sc, 1024);
          if (tid < 256) { const int h = tid >> 6, d = tid & 63; float a = 0.f;
              for (int s = 0; s < 1024; ++s) { const float p = sc[h * SP + s]; if (p != 0.f) a += p * sel_fetch(ws, cv, pt, smp, b, kv, idx[s >> 6] * 64 + (s & 63), d, WS_VS); }
              oo[tid] += ((const float*)(ws + WS_NG))[m * 32 + (4 * kv + h) * 3 + 1] * a; }
          __syncthreads(); }
        { const int nw = smp ? WIN + DECS : WIN;
          const float* ckw = in[I_CKW]; const float* cvw = in[I_CVW];
          for (int s = tid; s < nw; s += 512) { const int kpos = smp ? PAST - WIN + s : pos - (WIN - 1) + s; const int dp = pos - kpos; const bool ok = dp >= 0 && dp < WIN && kpos >= 0;
              float d0 = 0.f, d1 = 0.f, d2 = 0.f, d3 = 0.f;
              if (ok) for (int d = 0; d < 64; ++d) { float k;
                  if (!smp) k = bf2f(((const bf16*)(ws + WS_KW))[((size_t)b * SEQ + kpos) * 128 + kv * 64 + d]);
                  else if (s < WIN) k = ckw[((size_t)b * WIN + s) * 128 + kv * 64 + d]; else k = bf2f(((const bf16*)(ws + WS_KW))[((size_t)MP + 4 * b + (s - WIN)) * 128 + kv * 64 + d]);
                  d0 += q[512 + (4 * kv + 0) * 64 + d] * k; d1 += q[512 + (4 * kv + 1) * 64 + d] * k; d2 += q[512 + (4 * kv + 2) * 64 + d] * k; d3 += q[512 + (4 * kv + 3) * 64 + d] * k; }
              sc[s] = ok ? d0 : -1e30f; sc[SP + s] = ok ? d1 : -1e30f; sc[2 * SP + s] = ok ? d2 : -1e30f; sc[3 * SP + s] = ok ? d3 : -1e30f; }
          __syncthreads();
          softmax_rows(sc, nw);
          if (tid < 256) { const int h = tid >> 6, d = tid & 63; float a = 0.f;
              for (int s = 0; s < nw; ++s) { const float p = sc[h * SP + s]; if (p == 0.f) continue; const int kpos = smp ? PAST - WIN + s : pos - (WIN - 1) + s; float v;
                  if (!smp) v = bf2f(((const bf16*)(ws + WS_VW))[((size_t)b * SEQ + kpos) * 128 + kv * 64 + d]);
                  else if (s < WIN) v = cvw[((size_t)b * WIN + s) * 128 + kv * 64 + d]; else v = bf2f(((const bf16*)(ws + WS_VW))[((size_t)MP + 4 * b + (s - WIN)) * 128 + kv * 64 + d]);
                  a += p * v; }
              oo[tid] += ((const float*)(ws + WS_NG))[m * 32 + (4 * kv + h) * 3 + 2] * a; }
          __syncthreads(); }
        if (tid < 256) { const float ref = oo[tid], got = bf2f(((const bf16*)(ws + WS_OAB))[m * 1024 + 512 + (4 * kv) * 64 + tid]);
            float e = fabsf(got - ref), r = fabsf(ref); e = wave_max(e); r = wave_max(r);
            if ((tid & 63) == 0) { __hip_atomic_fetch_max((LAS unsigned*)red, __float_as_uint(e), __ATOMIC_RELAXED, __HIP_MEMORY_SCOPE_WORKGROUP); __hip_atomic_fetch_max((LAS unsigned*)red + 1, __float_as_uint(r), __ATOMIC_RELAXED, __HIP_MEMORY_SCOPE_WORKGROUP); } }
        __syncthreads();
    }
    emax = red[0]; rmax = red[1];
    __syncthreads();
}

__device__ __forceinline__ void check_compress(const unsigned char* ws, const float* const* in, const float* out, LAS unsigned char* L, bool smp, int b, int c, int kv, int which, float& emax, float& rmax) {
    const int tid = tidx(), p = tid >> 6, j = tid & 63;
    LAS float* part = (LAS float*)L; LAS float* hdn = part + 512; LAS float* res = hdn + 64;
    const float* w1 = in[which ? I_WCV1 : I_WCK1]; const float* w2 = in[which ? I_WCV2 : I_WCK2]; const float* pe = in[which ? I_PEV : I_PEK];
    const float* cache = in[which ? I_CVC : I_CKC]; const int* pt = (const int*)in[I_PT];
    __syncthreads();
    float s = 0.f;
    for (int i = 256 * p; i < 256 * p + 256; ++i) { const int t = 16 * c + (i >> 6), d = i & 63; float x;
        if (!smp) x = out[(which ? O_PVC : O_PKC) + ((size_t)(b * SEQ + t) * 2 + kv) * 64 + d];
        else { const int pg = pt[b * NPAGES + (t >> 7)]; x = cache[(((size_t)pg * 128 + (t & 127)) * 2 + kv) * 64 + d]; }
        s += (x + pe[i]) * w1[(size_t)i * 64 + j]; }
    part[p * 64 + j] = s;
    __syncthreads();
    if (tid < 64) { float a = 0.f; for (int q = 0; q < 8; ++q) a += part[q * 64 + tid]; const float u = 0.7978845608028654f * (a + 0.044715f * a * a * a); hdn[tid] = 0.5f * a * (1.f + tanhf(u)); }
    __syncthreads();
    if (tid < 64) { float o = 0.f; for (int q = 0; q < 64; ++q) o += hdn[q] * w2[q * 64 + tid]; res[tid] = o; }
    __syncthreads();
    if (tid < 64) { float o = res[tid];
        if (which == 0) { float ss = 0.f; for (int q = 0; q < 64; ++q) ss += res[q] * res[q]; o = o * (1.f / sqrtf(ss / 64.f + EPS)) * in[I_GKC][tid]; }
        const int nc = smp ? NCS : NCP; const float got = bf2f(((const bf16*)(ws + (smp ? (which ? WS_VCS : WS_KCS) : (which ? WS_VCP : WS_KCP))))[((size_t)(b * 2 + kv) * nc + c) * 64 + tid]);
        float e = fabsf(got - o), r = fabsf(o); e = wave_max(e); r = wave_max(r); if (tid == 0) { res[64] = e; res[65] = r; } }
    __syncthreads();
    emax = res[64]; rmax = res[65];
    __syncthreads();
}
}
#endif

#ifndef MK_N_LAUNCHES
#define MK_N_LAUNCHES 1
#endif
constexpr int N_PHASES = 9;
struct Args { const void* in[N_IN]; float* out; unsigned char* ws; int ph_lo, ph_hi; };
static_assert(sizeof(Args) == (N_IN + 2) * 8 + 8, "no padding bytes in Args");

__global__ void __launch_bounds__(NWAVES * 64, 2) hybrid_fwd(Args args) {
    extern __shared__ __attribute__((aligned(16))) unsigned char lds[];
    Frame F;
    F.lds = (LAS unsigned char*)lds;
    F.MISC = (volatile LAS unsigned*)(F.lds + MISC_OFF);
    F.tid = tidx(); F.lane = F.tid & 63; F.wave = __builtin_amdgcn_readfirstlane(F.tid >> 6);
    F.G = gridDim.x; { const int bx = blockIdx.x; F.vcu = (F.G % 8 == 0) ? (bx % 8) * (F.G / 8) + bx / 8 : bx; }
    F.ws = args.ws; F.out = args.out; F.ctl = (gu32*)(args.ws + WS_CTL);
#pragma unroll
    for (int i = 0; i < N_IN; ++i) F.in[i] = (const float*)args.in[i];
    for (int u = F.tid; u < 64; u += NWAVES * 64) ((LAS unsigned*)(F.lds + MISC_OFF))[u] = 0u;
    __syncthreads();
    XcdBarrier bar; bar.bar = (unsigned*)(F.ctl + CW_BAR); bar.x = 0; bar.st = nullptr;
    if (MK_N_LAUNCHES == 1) bar = xcd_barrier_post((unsigned*)(F.ctl + CW_BAR), F.MISC + 8);
#define GRID_BAR() do { if (MK_N_LAUNCHES == 1) xcd_barrier(bar); } while (0)
    const int lo = args.ph_lo, hi = args.ph_hi;
#ifdef TIME_PROBE_A
    unsigned long long* tsp = (unsigned long long*)(args.ws + WS_DBG + 65536);
#define STAMP(k) do { if (blockIdx.x == 0 && F.tid == 0) tsp[k] = __builtin_amdgcn_s_memrealtime(); } while (0)
    STAMP(0);
#else
#define STAMP(k) do { } while (0)
#endif
#ifndef PH_MASK
#define PH_MASK 0x1ff
#endif
#define FRESH_IDS() do { const int t_ = tidx(); F.tid = t_; F.lane = t_ & 63; } while (0)
#define IN(k) (((PH_MASK >> (k)) & 1) && lo <= (k) && (k) < hi)
#define BOTH(k) (IN(k) && IN((k) + 1))
#ifndef DUP_MASK
#define DUP_MASK 0
#endif
#define REP(k) for (int rep_ = 0; rep_ < (((DUP_MASK >> (k)) & 1) ? 2 : 1); ++rep_)

    if (IN(0)) { FRESH_IDS(); REP(0) p0_prologue(F); if (BOTH(0)) GRID_BAR(); STAMP(1); }

    if (IN(1)) { FRESH_IDS();
#ifndef CP_SPEC
#define CP_SPEC 0
#endif
        constexpr int NCPW = CP_SPEC;
        if (NCPW > 0 && F.G == 256 && (int)blockIdx.x < NCPW) { REP(1) compress_tasks<true>(F, (int)blockIdx.x & 1, (int)blockIdx.x >> 1, NCPW > 0 ? NCPW / 2 : 1, DECB * NPAGES); }
        else {
        const bool spec = (NCPW > 0 && F.G == 256);
        pg8::Gemm g{WSP(bf16, WS_XN), WSP(bf16, WS_WINT), MPAD, NIN, DM}; pg8::StaticOrder S; S.init(MPAD, NIN, spec ? F.G - NCPW : F.G, spec ? (int)blockIdx.x - NCPW : (int)blockIdx.x);
        pg8::EpiIn E{F.ws, F.out};
        REP(1) pg8::gemm_phase<pg8::EpiIn, pg8::StaticOrder, true, true>(F.lds, g, S, E);
        }
        if (BOTH(1)) GRID_BAR(); STAMP(2);
    }

    if (IN(2)) { FRESH_IDS();
        STAMP(10);
        if (!(CP_SPEC > 0 && F.G == 256)) { REP(2) for (int which = 0; which < 2; ++which) compress_tasks<true>(F, which, (int)blockIdx.x, F.G, DECB * NPAGES); }
        STAMP(11);
        if (F.G == 256) compress_tasks<false>(F, (int)blockIdx.x >> 7, (int)blockIdx.x & 127, 128, 128);
        else for (int which = 0; which < 2; ++which) compress_tasks<false>(F, which, (int)blockIdx.x, F.G, 128);
        STAMP(12);
        REP(10) for (int n = F.G - 1 - (int)blockIdx.x; n < (F.G == 256 ? 256 : GMLP_UNITS); n += F.G) gmlp_unit(F, n);
        __syncthreads();
        STAMP(13);
        if (BOTH(2)) GRID_BAR(); STAMP(3);
    }

    if (IN(3)) { FRESH_IDS();
        if (F.G == 256) { if ((int)blockIdx.x >= 254) { gmlp_unit(F, 256 + ((int)blockIdx.x - 254)); __syncthreads(); } else { REP(3) compress_stage2(F, (int)blockIdx.x, 254); } }
        else { REP(3) compress_stage2(F, F.vcu, F.G); }
        if (BOTH(3)) GRID_BAR(); STAMP(4); }

    if (IN(4)) { FRESH_IDS();
        #ifndef NO_PROMPT
        REP(4) for (int pr = F.vcu; pr < 256; pr += F.G) { const int bk = pr >> 6, s = pr & 63;
            STAMP(14);
            att::nsa_prompt_unit(F.ws, bk >> 1, bk & 1, 127 - s, (char*)lds);
            STAMP(15);
            att::nsa_prompt_unit(F.ws, bk >> 1, bk & 1, s, (char*)lds);
            STAMP(16); }
#endif
#ifndef NO_SMP
        REP(9) for (int su = (int)blockIdx.x; su < 256; su += F.G) smp::nsa_sample_unit(F.ws, F.in[I_CKS], F.in[I_CVS], F.in[I_CKW], F.in[I_CVW], (const int*)F.in[I_PT], F.lds, su >> 3, (su >> 2) & 1, su & 3);
#endif
        STAMP(17);
        if (BOTH(4)) GRID_BAR(); STAMP(5);
    }

#ifdef ATT_CHECK
    {
        if (!BOTH(4)) GRID_BAR();
        const int i = (int)blockIdx.x; const int special[16] = {0, 1, 30, 31, 32, 63, 64, 65, 127, 128, 1023, 1024, 1025, 4095, 8191, 7680};
        int pos = (int)(((unsigned)i * 2654435761u) >> 19) & 8191;
#pragma unroll
        for (int k = 0; k < 16; ++k) if ((i >> 1) == k) pos = special[k];
        float e, r; float* dbg = WSP(float, WS_DBG);
        chk::check_token(F.ws, F.in, F.lds, false, i & 1, pos, e, r);
        if (F.tid == 0) dbg[i] = e / fmaxf(r, 1e-9f);
        chk::check_token(F.ws, F.in, F.lds, true, (i & 127) >> 2, i & 3, e, r);
        if (F.tid == 0) dbg[256 + i] = e / fmaxf(r, 1e-9f);
        {
            float E = 0.f; const unsigned hsh = (unsigned)i * 2246822519u;
            int cp = (int)((hsh >> 8) % 511u), cs = (int)((hsh >> 10) % 1023u); if (i == 0) { cp = 0; cs = 0; } if (i == 1) { cp = 510; cs = 1022; } if (i == 2) { cp = 509; cs = 7; } if (i == 3) { cp = 255; cs = 8; }
            for (int which = 0; which < 2; ++which) {
                chk::check_compress(F.ws, F.in, F.out, F.lds, false, i & 1, cp, (i >> 1) & 1, which, e, r); E = fmaxf(E, e / fmaxf(r, 1e-9f));
                chk::check_compress(F.ws, F.in, F.out, F.lds, true, i & 31, cs, (i >> 5) & 1, which, e, r); E = fmaxf(E, e / fmaxf(r, 1e-9f)); }
            if (F.tid == 0) dbg[512 + i] = E; }
        __syncthreads();
    }
#endif
    if (IN(5)) { FRESH_IDS();
        skinny_gemm<SkMerge, 1, true>(WSP(bf16, WS_OAB) + (size_t)MP * DM, WSP(bf16, WS_WBT), DM, DM, F.G, (int)blockIdx.x, SkMerge{F.ws});
        pg8::Gemm g{WSP(bf16, WS_OAB), WSP(bf16, WS_WBT), MP, DM, DM}; pg8::StaticOrder S; S.init(MP, DM, F.G, (int)blockIdx.x);
        pg8::EpiMerge E{WSP(bf16, WS_SG), WSP(bf16, WS_MG)};
        REP(5) pg8::gemm_phase<pg8::EpiMerge, pg8::StaticOrder, true, true>(F.lds, g, S, E);
        if (BOTH(5)) GRID_BAR(); STAMP(6);
    }

    if (IN(6)) { FRESH_IDS();
        skinny_gemm(WSP(bf16, WS_MG) + (size_t)MP * DM, WSP(bf16, WS_WOT), DM, DM, F.G, (int)blockIdx.x, SkOut{F.ws, F.in[I_XS], F.out});
        pg8::Gemm g{WSP(bf16, WS_MG), WSP(bf16, WS_WOT), MP, DM, DM}; pg8::StaticOrder S; S.init(MP, DM, F.G, (int)blockIdx.x);
        pg8::EpiOut E{F.in[I_XP], F.in[I_XS], F.out, WSP(bf16, WS_X1B), WSP(float, WS_SSQ)};
        REP(6) pg8::gemm_phase<pg8::EpiOut, pg8::StaticOrder, true, true>(F.lds, g, S, E);
        if (BOTH(6)) GRID_BAR(); STAMP(7);
    }

    if (IN(7)) { FRESH_IDS();
        skinny_gemm(WSP(bf16, WS_X1B) + (size_t)MP * DM, WSP(bf16, WS_WUP), DFF, DM, F.G, (int)blockIdx.x, SkUp{F.ws});
        pg8::Gemm g{WSP(bf16, WS_X1B), WSP(bf16, WS_WUP), MP, DFF, DM}; pg8::StaticOrder S; S.init(MP, DFF, F.G, (int)blockIdx.x);
        pg8::EpiUp E{WSP(float, WS_SSQ), WSP(bf16, WS_H)};
        REP(7) pg8::gemm_phase<pg8::EpiUp, pg8::StaticOrder, true, true>(F.lds, g, S, E);
        if (BOTH(7)) GRID_BAR(); STAMP(8);
    }

    if (IN(8)) { FRESH_IDS();
        skinny_gemm<SkDown, 4>(WSP(bf16, WS_H) + (size_t)MP * DFF, WSP(bf16, WS_WDN), DM, DFF, F.G, (int)blockIdx.x, SkDown{F.out});
        pg8::Gemm g{WSP(bf16, WS_H), WSP(bf16, WS_WDN), MP, DM, DFF}; pg8::StaticOrder S; S.init(MP, DM, F.G, (int)blockIdx.x);
        pg8::EpiDown E{F.out, WSP(bf16, WS_X1B)};
        pg8::gemm_phase<pg8::EpiDown, pg8::StaticOrder, true, true>(F.lds, g, S, E);
    }
#ifdef TIME_PROBE_A
    GRID_BAR(); STAMP(9);
    if (blockIdx.x == 0) {
        #ifndef TIME_PROBE_AE
#define TIME_PROBE_AE (TIME_PROBE_A + 1)
#endif
#ifndef TIME_PROBE_BE
#define TIME_PROBE_BE (TIME_PROBE_B + 1)
#endif
        const float da = (float)(tsp[TIME_PROBE_AE] - tsp[TIME_PROBE_A]) * 0.01f, db = (float)(tsp[TIME_PROBE_BE] - tsp[TIME_PROBE_B]) * 0.01f;
        if (F.tid == 0) F.out[O_YP] += da * 0.01f;
        for (int t = F.tid; t < 4096 * 1024; t += 512) F.out[O_YP + 1024 + t] += db * (1.f / 3000.f); }
#endif
#ifdef ATT_CHECK
    GRID_BAR();
    if (blockIdx.x == 0) { float E = 0.f; const float* dbg = WSP(float, WS_DBG);
        for (int k = 0; k < 768; ++k) { if (!((ATT_CHECK >> (k >> 8)) & 1)) continue; E = fmaxf(E, dbg[k]); }
        for (int t = F.tid; t < 1024; t += 512) F.out[O_YP + t] += E * 2000.f; }
#endif
#undef IN
#undef BOTH
}

extern "C" void kernel_launch(void* const* d_in, const int* in_sizes, int n_in, void* d_out, int out_size, void* d_ws, size_t ws_size, hipStream_t stream) {
    static int grid = 0;
    if (grid == 0) {
        if (n_in != N_IN || in_sizes[0] != MP * DM || (size_t)out_size != O_END || ws_size < WS_END) {
            fprintf(stderr, "kernel_launch: unexpected problem: n_in %d in0 %d out %d ws %zu (need %zu); nothing launched\n", n_in, n_in > 0 ? in_sizes[0] : -1, out_size, ws_size, (size_t)WS_END); grid = -1; return; }
        int dev = 0, cus = 0, per_cu = 0;
        if (hipGetDevice(&dev) != hipSuccess || hipDeviceGetAttribute(&cus, hipDeviceAttributeMultiprocessorCount, dev) != hipSuccess) { grid = -1; return; }
        if (hipFuncSetAttribute((const void*)hybrid_fwd, hipFuncAttributeMaxDynamicSharedMemorySize, LDS_BYTES) != hipSuccess) { fprintf(stderr, "kernel_launch: hipFuncSetAttribute failed\n"); grid = -1; return; }
        if (hipOccupancyMaxActiveBlocksPerMultiprocessor(&per_cu, (const void*)hybrid_fwd, NWAVES * 64, LDS_BYTES) != hipSuccess || per_cu < 1)
            fprintf(stderr, "kernel_launch: note: occupancy query reports %d workgroups per CU\n", per_cu);
        (void)hipGetLastError();
        grid = cus;
    }
    if (grid < 0) return;
    if (hipMemsetAsync((char*)d_ws + WS_CTL, 0, CTL_ZERO_BYTES, stream) != hipSuccess) return;
    Args a{};
    for (int i = 0; i < N_IN; ++i) a.in[i] = d_in[i];
    a.out = (float*)d_out; a.ws = (unsigned char*)d_ws;
    if (MK_N_LAUNCHES == 1) { a.ph_lo = 0; a.ph_hi = N_PHASES; hipLaunchKernelGGL(hybrid_fwd, dim3(grid), dim3(NWAVES * 64), LDS_BYTES, stream, a); }
    else for (int p = 0; p < N_PHASES; ++p) { a.ph_lo = p; a.ph_hi = p + 1; hipLaunchKernelGGL(hybrid_fwd, dim3(grid), dim3(NWAVES * 64), LDS_BYTES, stream, a); }
    const hipError_t le = hipPeekAtLastError();
    if (le != hipSuccess) fprintf(stderr, "kernel_launch: launch failed: %s\n", hipGetErrorName(le));
}
```

```cpp
#include <hip/hip_runtime.h>
#include <hip/hip_bf16.h>
#include <cstdio>
#include <cstdint>
#include <cmath>

constexpr int DM = 1024, SEQ = 8192, NBAT = 2, MP = NBAT * SEQ, NSMP = 128, MT = MP + NSMP, MPAD = 16640;
constexpr int AW = 512, NHEAD = 8, HD = 64, NKV = 2, DFF = 4096, INC = 4376, NIN = 4608;
constexpr int PAST = 16384, NPAGES = 128, DECB = 32, DECS = 4, WIN = 512;
constexpr int NCP = 512, NCS = 1024;
constexpr float EPS = 1e-6f;
constexpr float QC2 = 0.125f * 1.4426950408889634f;

enum { I_XP = 0, I_XS, I_CKC, I_CVC, I_CKS, I_CVS, I_CKW, I_CVW, I_PT, I_G1, I_WIN, I_LNG, I_LNB, I_WS, I_BS, I_GQ, I_GKC, I_GKS, I_GKW,
       I_WCK1, I_WCK2, I_PEK, I_WCV1, I_WCV2, I_PEV, I_WBR, I_WOUT, I_G2, I_WUP, I_WDN, N_IN };
constexpr size_t O_YP = 0, O_YS = O_YP + (size_t)MP * DM, O_PKC = O_YS + (size_t)NSMP * DM, O_PVC = O_PKC + (size_t)MP * 128, O_PKS = O_PVC + (size_t)MP * 128,
                 O_PVS = O_PKS + (size_t)MP * 128, O_PKW = O_PVS + (size_t)MP * 128, O_PVW = O_PKW + (size_t)NBAT * WIN * 128, O_PVA = O_PVW + (size_t)NBAT * WIN * 128,
                 O_SKC = O_PVA + (size_t)NBAT * 128 * AW, O_SVC = O_SKC + NSMP * 128, O_SKS = O_SVC + NSMP * 128, O_SVS = O_SKS + NSMP * 128, O_SKW = O_SVS + NSMP * 128,
                 O_SVW = O_SKW + NSMP * 128, O_SVA = O_SVW + NSMP * 128, O_END = O_SVA + (size_t)NSMP * AW;
static_assert(O_END == 25853952, "output size");

constexpr size_t al256(size_t x) { return (x + 255) & ~(size_t)255; }
constexpr size_t WS_CTL = 0, CTL_ZERO_BYTES = 32768, CTL_RESERVED = 1u << 20;
constexpr size_t WS_WINT = CTL_RESERVED;
constexpr size_t WS_WBT = WS_WINT + (size_t)NIN * DM * 2;
constexpr size_t WS_WOT = WS_WBT + (size_t)DM * DM * 2;
constexpr size_t WS_WUP = WS_WOT + (size_t)DM * DM * 2;
constexpr size_t WS_WDN = WS_WUP + (size_t)DFF * DM * 2;
constexpr size_t WS_WC1K = WS_WDN + (size_t)DM * DFF * 2;
constexpr size_t WS_WC1V = WS_WC1K + 128 * 1024 * 2;
constexpr size_t WS_WSP = WS_WC1V + 128 * 1024 * 2;
constexpr size_t WS_WSS = WS_WSP + 8 * 128 * 128 * 2;
constexpr size_t WS_ROPE = WS_WSS + 8 * 128 * 128 * 2;
constexpr size_t WS_BPART = al256(WS_ROPE + 8196 * 16 * 4);
constexpr size_t WS_GAINS = al256(WS_BPART + 2 * 32 * 64 * 4);
constexpr size_t WS_XN = al256(WS_GAINS + 3 * 64 * 4);
constexpr size_t WS_U = WS_XN + (size_t)MPAD * DM * 2;
constexpr size_t WS_GV = WS_U + (size_t)MPAD * 512 * 2;
constexpr size_t WS_QN = WS_GV + (size_t)MPAD * 512 * 2;
constexpr size_t WS_QR = WS_QN + (size_t)MPAD * 512 * 2;
constexpr size_t WS_KCA = WS_QR + (size_t)MPAD * 512 * 2;
constexpr size_t WS_VCA = WS_KCA + 2048 * 1024 * 2;
constexpr size_t KVROWS = MPAD + 256;
constexpr size_t WS_KS = WS_VCA + 2048 * 1024 * 2;
constexpr size_t WS_VS = WS_KS + KVROWS * 128 * 2;
constexpr size_t WS_KW = WS_VS + KVROWS * 128 * 2;
constexpr size_t WS_VW = WS_KW + KVROWS * 128 * 2;
constexpr size_t WS_SG = WS_VW + KVROWS * 128 * 2;
constexpr size_t WS_NG = WS_SG + (size_t)MPAD * 2048 * 2;
constexpr size_t WS_FSPK = WS_NG + (size_t)MPAD * 32 * 4;
constexpr size_t WS_FSPV = WS_FSPK + 2048 * 128 * 4;
constexpr size_t WS_FSSK = WS_FSPV + 2048 * 128 * 4;
constexpr size_t WS_FSSV = WS_FSSK + (size_t)65536 * 128 * 4;
constexpr size_t WS_KCP = WS_FSSV + (size_t)65536 * 128 * 4;
constexpr size_t WS_VCP = WS_KCP + 4 * NCP * 64 * 2;
constexpr size_t WS_KCS = WS_VCP + 4 * NCP * 64 * 2;
constexpr size_t WS_VCS = WS_KCS + (size_t)64 * NCS * 64 * 2;
constexpr size_t WS_OAB = WS_VCS + (size_t)64 * NCS * 64 * 2;
constexpr size_t WS_MG = WS_OAB + (size_t)MPAD * DM * 2;
constexpr size_t WS_X1B = WS_MG + (size_t)MPAD * DM * 2;
constexpr size_t WS_SSQ = WS_X1B + (size_t)MPAD * DM * 2;
constexpr size_t WS_H = al256(WS_SSQ + (size_t)MPAD * 16 * 4);
constexpr size_t WS_OBF = WS_H + (size_t)MPAD * DFF * 2;
constexpr size_t WS_VST = WS_OBF + (size_t)MP * 512 * 4;
constexpr size_t WS_SSQS = WS_VST + (size_t)4 * 64 * SEQ * 2;
constexpr size_t WS_DBG = WS_SSQS + 128 * 64 * 4;
constexpr size_t WS_END = WS_DBG + (1u << 20);

constexpr int CW_TMO = 0, CW_CODE = 1, CW_BAR = 4096;

constexpr int LDS_BYTES = 147456;
constexpr int MISC_OFF = LDS_BYTES - 256;
constexpr int NWAVES = 8;

#define GAS __attribute__((address_space(1)))
#define LAS __attribute__((address_space(3)))
typedef unsigned short bf16;
typedef unsigned v4u __attribute__((ext_vector_type(4)));
typedef unsigned v2u __attribute__((ext_vector_type(2)));
typedef float f32x4 __attribute__((ext_vector_type(4)));
typedef float f32x16 __attribute__((ext_vector_type(16)));
typedef short bf16x8 __attribute__((ext_vector_type(8)));
typedef GAS unsigned gu32;
#define RLX_AGENT __ATOMIC_RELAXED, __HIP_MEMORY_SCOPE_AGENT
#define LDS_WAIT() asm volatile("s_waitcnt lgkmcnt(0)" ::: "memory")
#define VM_WAIT() asm volatile("s_waitcnt vmcnt(0)" ::: "memory")
__device__ __forceinline__ int tidx() { int t = (int)threadIdx.x; asm volatile("" : "+v"(t)); return t; }
__device__ __forceinline__ unsigned f2bf(float f) { unsigned u = __builtin_bit_cast(unsigned, f); return (u + 0x7fffu + ((u >> 16) & 1u)) >> 16; }
__device__ __forceinline__ unsigned pk2(float lo, float hi) { return f2bf(lo) | (f2bf(hi) << 16); }
__device__ __forceinline__ float bf2f(unsigned h) { return __builtin_bit_cast(float, h << 16); }
__device__ __forceinline__ float bflo(unsigned w) { return __builtin_bit_cast(float, w << 16); }
__device__ __forceinline__ float bfhi(unsigned w) { return __builtin_bit_cast(float, w & 0xffff0000u); }
__device__ __forceinline__ float fast_sigmoid(float x) { return __builtin_amdgcn_rcpf(1.f + __builtin_amdgcn_exp2f(-1.4426950408889634f * x)); }
__device__ __forceinline__ float gelu_tanh(float x) {
    const float u = 1.5957691216057308f * (x + 0.044715f * x * x * x);
    return x * __builtin_amdgcn_rcpf(1.f + __builtin_amdgcn_exp2f(-1.4426950408889634f * u));
}
__device__ __forceinline__ float wave_sum(float v) {
#pragma unroll
    for (int o = 1; o < 64; o <<= 1) v += __shfl_xor(v, o);
    return v;
}
__device__ __forceinline__ float wave_sum_dpp(float v) {
    v += __builtin_bit_cast(float, __builtin_amdgcn_update_dpp(0, __builtin_bit_cast(int, v), 0x111, 0xF, 0xF, true));
    v += __builtin_bit_cast(float, __builtin_amdgcn_update_dpp(0, __builtin_bit_cast(int, v), 0x112, 0xF, 0xF, true));
    v += __builtin_bit_cast(float, __builtin_amdgcn_update_dpp(0, __builtin_bit_cast(int, v), 0x114, 0xF, 0xF, true));
    v += __builtin_bit_cast(float, __builtin_amdgcn_update_dpp(0, __builtin_bit_cast(int, v), 0x118, 0xF, 0xF, true));
    v += __builtin_bit_cast(float, __builtin_amdgcn_update_dpp(0, __builtin_bit_cast(int, v), 0x142, 0xA, 0xF, false));
    v += __builtin_bit_cast(float, __builtin_amdgcn_update_dpp(0, __builtin_bit_cast(int, v), 0x143, 0xC, 0xF, false));
    return __builtin_bit_cast(float, __builtin_amdgcn_readlane(__builtin_bit_cast(int, v), 63));
}
__device__ __forceinline__ float wave_max_dpp(float v) {
    v = fmaxf(v, __builtin_bit_cast(float, __builtin_amdgcn_update_dpp(__builtin_bit_cast(int, v), __builtin_bit_cast(int, v), 0x111, 0xF, 0xF, false)));
    v = fmaxf(v, __builtin_bit_cast(float, __builtin_amdgcn_update_dpp(__builtin_bit_cast(int, v), __builtin_bit_cast(int, v), 0x112, 0xF, 0xF, false)));
    v = fmaxf(v, __builtin_bit_cast(float, __builtin_amdgcn_update_dpp(__builtin_bit_cast(int, v), __builtin_bit_cast(int, v), 0x114, 0xF, 0xF, false)));
    v = fmaxf(v, __builtin_bit_cast(float, __builtin_amdgcn_update_dpp(__builtin_bit_cast(int, v), __builtin_bit_cast(int, v), 0x118, 0xF, 0xF, false)));
    v = fmaxf(v, __builtin_bit_cast(float, __builtin_amdgcn_update_dpp(__builtin_bit_cast(int, v), __builtin_bit_cast(int, v), 0x142, 0xA, 0xF, false)));
    v = fmaxf(v, __builtin_bit_cast(float, __builtin_amdgcn_update_dpp(__builtin_bit_cast(int, v), __builtin_bit_cast(int, v), 0x143, 0xC, 0xF, false)));
    return __builtin_bit_cast(float, __builtin_amdgcn_readlane(__builtin_bit_cast(int, v), 63));
}
__device__ __forceinline__ float wave_max(float v) {
#pragma unroll
    for (int o = 1; o < 64; o <<= 1) v = fmaxf(v, __shfl_xor(v, o));
    return v;
}
__host__ __device__ __forceinline__ int dmap(int s) { if (s >= 16) return s; const int f = s >> 3, p = s & 7; return p < 4 ? 4 * f + p : 4 + 4 * f + p; }
__host__ __device__ __forceinline__ int win_map(int j) {
    const int t = j >> 8, L = j & 255;
    if (t < 4) return j;
    const int h = (L >> 5) & 3, s = ((L >> 7) << 5) | (L & 31);
    if (t < 6) return 1024 + ((t - 4) * 4 + h) * 64 + dmap(s);
    if (t == 6) return 1536 + L;
    if (t == 7) return 1792 + (h >> 1) * 128 + (h & 1) * 64 + dmap(s);
    if (t == 8) return 2048 + (h >> 1) * 128 + (h & 1) * 64 + dmap(s);
    if (t < 17) return 2328 + ((L >> 7) ? 1024 : 0) + 128 * (t - 9) + (L & 127);
    return L < 24 ? 2304 + L : -1;
}
namespace pg8 {
#define PG8_LAS __attribute__((address_space(3)))
typedef unsigned short bf16_t;
typedef short bf16x8 __attribute__((ext_vector_type(8)));
typedef float f32x4 __attribute__((ext_vector_type(4)));
typedef unsigned u32x4 __attribute__((ext_vector_type(4)));
constexpr int BM = 256, BK = 64, HALF = 128, HTB = HALF * BK * 2  , STAGE_BYTES = 8 * HTB, NXCD = 8, WGM = 8;

__host__ __device__ __forceinline__ int lds_byte(int r, int c) { const int st = (r >> 4) * 2 + (c >> 5), rr = r & 15, cc = c & 31, ob = rr * 64 + cc * 2; return st * 1024 + (ob ^ (((ob >> 9) & 1) << 5)); }
__host__ __device__ __forceinline__ void stage_rc(int b, int& R, int& C) { const int st = b / 1024, sb = b % 1024, swz = sb ^ (((sb >> 9) & 1) << 5); R = (st >> 1) * 16 + swz / 64; C = (st & 1) * 32 + (swz % 64) / 2; }
__host__ __device__ __forceinline__ int perm32(int rho) { const int n = rho >> 4, i = rho & 15; return 8 * (i >> 2) + 4 * n + (i & 3); }

struct Unit { int pm, pn; };
struct Gemm { const bf16_t* A; const bf16_t* Bt; int M, N, K; };

struct StaticOrder {
    int nM, nN, nwg, G, c;
    __host__ __device__ void init(int M, int N, int G_, int c_) { nM = M / BM; nN = N / BM; nwg = nM * nN; G = G_; c = c_; }
    __host__ __device__ bool next(int i, Unit& u) const {
        const long L = (long)i * G + c; if (L >= nwg) return false;
        int wgid = (int)L; { const int q = nwg / NXCD, r = nwg % NXCD, xcd = wgid % NXCD, off = wgid / NXCD; wgid = (xcd < r ? xcd * (q + 1) : r * (q + 1) + (xcd - r) * q) + off; }
        const int nig = WGM * nN, gid = wgid / nig, fm = gid * WGM, gsz = (nM - fm) < WGM ? (nM - fm) : WGM;
        u.pm = fm + ((wgid % nig) % gsz); u.pn = (wgid % nig) / gsz; return true;
    }
    __device__ __forceinline__ void a_ready(const Unit&) const {}
    __device__ __forceinline__ void done(const Unit&) const {}
};

__device__ __forceinline__ unsigned cvt_pk_bf16(float lo, float hi) { unsigned r; asm volatile("v_cvt_pk_bf16_f32 %0, %1, %2" : "=v"(r) : "v"(lo), "v"(hi)); return r; }
typedef float f32x2 __attribute__((ext_vector_type(2)));
__device__ __forceinline__ u32x4 pack8(const f32x4 a, const f32x4 b) { u32x4 w; w.x = cvt_pk_bf16(a[0], a[1]); w.y = cvt_pk_bf16(a[2], a[3]); w.z = cvt_pk_bf16(b[0], b[1]); w.w = cvt_pk_bf16(b[2], b[3]); return w; }
typedef unsigned u32x2 __attribute__((ext_vector_type(2)));

struct EpiIn {
    static constexpr bool PERM = true, AFTER_DRAIN = false, HAS_MID = false;
    unsigned char* ws; float* out;
    __device__ __forceinline__ void operator()(const f32x4 (&acc)[2][2][4][2], const Unit& u, int wr, int wc, int fr, int fq) const { asm volatile("" : "+v"(fr));
        const int pn = u.pn, rbase = u.pm * BM + wr * 64 + fr;
        if (pn < 4) {
            bf16_t* dst = (bf16_t*)(ws + (pn < 2 ? WS_U : WS_GV)) + (pn & 1) * 256 + wc * 32 + 8 * fq;
#pragma unroll
            for (int ai = 0; ai < 2; ++ai)
#pragma unroll
                for (int m = 0; m < 4; ++m) { const int row = rbase + ai * HALF + m * 16;
#pragma unroll
                    for (int bj = 0; bj < 2; ++bj) { f32x4 v0 = acc[ai][bj][m][0], v1 = acc[ai][bj][m][1];
#pragma unroll
                        for (int i = 0; i < 4; ++i) { v0[i] = gelu_tanh(v0[i]); v1[i] = gelu_tanh(v1[i]); }
                        *(u32x4*)(dst + (size_t)row * 512 + bj * HALF) = pack8(v0, v1); } }
        } else if (pn < 6 || pn == 7 || pn == 8) {
            const bool isq = pn < 6, isk = isq || wc < 2;
            const float* g = (const float*)(ws + WS_GAINS) + (isq ? 0 : (pn == 7 ? 64 : 128)); const float* rope = (const float*)(ws + WS_ROPE);
            const int d1 = fq < 2 ? 4 * fq : 8 * fq, d2 = fq < 2 ? 8 + 4 * fq : 8 * fq + 4, d3 = 32 + 8 * fq;
            f32x4 g1 = {1.f, 1.f, 1.f, 1.f}, g2 = g1, g3a = g1, g3b = g1;
            if (isk) { g1 = *(const f32x4*)(g + d1); g2 = *(const f32x4*)(g + d2); g3a = *(const f32x4*)(g + d3); g3b = *(const f32x4*)(g + d3 + 4); }
            const float osc = isq ? QC2 : 1.f;
#pragma unroll
            for (int ai = 0; ai < 2; ++ai)
#pragma unroll
                for (int m = 0; m < 4; ++m) { const int row = rbase + ai * HALF + m * 16;
                    f32x4 a = acc[ai][0][m][0], b = acc[ai][0][m][1], c = acc[ai][1][m][0], d = acc[ai][1][m][1];
                    f32x4 ra = a, rb = b;
                    if (isk) {
                        float ss = (a[0] * a[0] + a[1] * a[1]) + (a[2] * a[2] + a[3] * a[3]) + (b[0] * b[0] + b[1] * b[1]) + (b[2] * b[2] + b[3] * b[3])
                                 + (c[0] * c[0] + c[1] * c[1]) + (c[2] * c[2] + c[3] * c[3]) + (d[0] * d[0] + d[1] * d[1]) + (d[2] * d[2] + d[3] * d[3]);
                        ss += __shfl_xor(ss, 16); ss += __shfl_xor(ss, 32);
                        const float rstd = 1.f / sqrtf(ss * (1.f / 64.f) + EPS);
                        a = a * rstd * g1; b = b * rstd * g2; c = c * rstd * g3a; d = d * rstd * g3b;
                        const int pidx = row < MP ? (row & (SEQ - 1)) : SEQ + ((row - MP) & 3);
                        f32x4 cs = {1.f, 1.f, 1.f, 1.f}, sn = {0.f, 0.f, 0.f, 0.f};
                        if (fq < 2) { cs = *(const f32x4*)(rope + pidx * 16 + 4 * fq); sn = *(const f32x4*)(rope + pidx * 16 + 8 + 4 * fq); }
                        ra = a * cs - b * sn; rb = b * cs + a * sn;
                    }
                    if (isq) {
                        const int head = (pn - 4) * 4 + wc; bf16_t* qn = (bf16_t*)(ws + WS_QN) + (size_t)row * 512 + head * 64; bf16_t* qr = (bf16_t*)(ws + WS_QR) + (size_t)row * 512 + head * 64;
                        const f32x4 cc = c * osc, dd = d * osc;
                        { f32x4 x = a * osc, y = b * osc; u32x2 w; w.x = cvt_pk_bf16(x[0], x[1]); w.y = cvt_pk_bf16(x[2], x[3]); *(u32x2*)(qn + d1) = w; w.x = cvt_pk_bf16(y[0], y[1]); w.y = cvt_pk_bf16(y[2], y[3]); *(u32x2*)(qn + d2) = w; }
                        { f32x4 x = ra * osc, y = rb * osc; u32x2 w; w.x = cvt_pk_bf16(x[0], x[1]); w.y = cvt_pk_bf16(x[2], x[3]); *(u32x2*)(qr + d1) = w; w.x = cvt_pk_bf16(y[0], y[1]); w.y = cvt_pk_bf16(y[2], y[3]); *(u32x2*)(qr + d2) = w; }
                        const u32x4 w3 = pack8(cc, dd); *(u32x4*)(qn + d3) = w3; *(u32x4*)(qr + d3) = w3;
                    } else {
                        const int kvh = wc & 1; const bool kw = (pn == 8);
                        bf16_t* bd = (bf16_t*)(ws + (isk ? (kw ? WS_KW : WS_KS) : (kw ? WS_VW : WS_VS))) + (size_t)row * 128 + kvh * 64;
                        { u32x2 w; w.x = cvt_pk_bf16(ra[0], ra[1]); w.y = cvt_pk_bf16(ra[2], ra[3]); *(u32x2*)(bd + d1) = w; w.x = cvt_pk_bf16(rb[0], rb[1]); w.y = cvt_pk_bf16(rb[2], rb[3]); *(u32x2*)(bd + d2) = w; }
                        *(u32x4*)(bd + d3) = pack8(c, d);
                        float* so = nullptr;
                        if (row < MP) { if (!kw) so = out + (isk ? O_PKS : O_PVS) + (size_t)row * 128; else { const int t = row & (SEQ - 1), b = row >> 13; if (t >= SEQ - WIN) so = out + (isk ? O_PKW : O_PVW) + ((size_t)b * WIN + (t - (SEQ - WIN))) * 128; } }
                        else if (row < MT) so = out + (kw ? (isk ? O_SKW : O_SVW) : (isk ? O_SKS : O_SVS)) + (size_t)(row - MP) * 128;
                        if (so) { so += kvh * 64; *(f32x4*)(so + d1) = ra; *(f32x4*)(so + d2) = rb; *(f32x4*)(so + d3) = c; *(f32x4*)(so + d3 + 4) = d; }
                    }
                }
        } else if (pn == 6) {
#pragma unroll
            for (int ai = 0; ai < 2; ++ai)
#pragma unroll
                for (int m = 0; m < 4; ++m) { const int row = rbase + ai * HALF + m * 16;
#pragma unroll
                    for (int bj = 0; bj < 2; ++bj) { const f32x4 v0 = acc[ai][bj][m][0], v1 = acc[ai][bj][m][1]; const int col = wc * 32 + 8 * fq;
                        if (row < MT) { float* so = out + (row < MP ? (bj ? O_PVC : O_PKC) + (size_t)row * 128 : (bj ? O_SVC : O_SKC) + (size_t)(row - MP) * 128) + col; *(f32x4*)so = v0; *(f32x4*)(so + 4) = v1; }
                        if (row < MP) { bf16_t* ca = (bf16_t*)(ws + (bj ? WS_VCA : WS_KCA)) + ((size_t)(row >> 4) * 2 + (wc >> 1)) * 1024 + (row & 15) * 64 + (wc & 1) * 32 + 8 * fq; *(u32x4*)ca = pack8(v0, v1); } } }
        } else if (pn < 17) {
            bf16_t* dst = (bf16_t*)(ws + WS_SG) + (pn - 9) * 128 + wc * 32 + 8 * fq;
#pragma unroll
            for (int ai = 0; ai < 2; ++ai)
#pragma unroll
                for (int m = 0; m < 4; ++m) { const int row = rbase + ai * HALF + m * 16;
                    f32x4 a0 = acc[ai][0][m][0], a1 = acc[ai][0][m][1], b0 = acc[ai][1][m][0], b1 = acc[ai][1][m][1]; f32x4 r0, r1, s0, s1;
#pragma unroll
                    for (int i = 0; i < 4; ++i) { a0[i] = fminf(fmaxf(a0[i], -30.f), 30.f); a1[i] = fminf(fmaxf(a1[i], -30.f), 30.f); b0[i] = fminf(fmaxf(b0[i], -30.f), 30.f); b1[i] = fminf(fmaxf(b1[i], -30.f), 30.f); }
#pragma unroll
                    for (int i = 0; i < 4; ++i) { const float ea0 = 1.f + __builtin_amdgcn_exp2f(-1.4426950408889634f * a0[i]), ea1 = 1.f + __builtin_amdgcn_exp2f(-1.4426950408889634f * a1[i]);
                        const float eb0 = 1.f + __builtin_amdgcn_exp2f(-1.4426950408889634f * b0[i]), eb1 = 1.f + __builtin_amdgcn_exp2f(-1.4426950408889634f * b1[i]);
                        r0[i] = eb0 * __builtin_amdgcn_rcpf(ea0); r1[i] = eb1 * __builtin_amdgcn_rcpf(ea1); s0[i] = __builtin_amdgcn_rcpf(eb0); s1[i] = __builtin_amdgcn_rcpf(eb1); }
                    *(u32x4*)(dst + (size_t)row * 2048) = pack8(r0, r1); *(u32x4*)(dst + (size_t)row * 2048 + 1024) = pack8(s0, s1); }
        } else {
            if (wc == 0 && fq < 3) {
#pragma unroll
                for (int ai = 0; ai < 2; ++ai)
#pragma unroll
                    for (int m = 0; m < 4; ++m) { const int row = rbase + ai * HALF + m * 16; f32x4 v0 = acc[ai][0][m][0], v1 = acc[ai][0][m][1];
#pragma unroll
                        for (int i = 0; i < 4; ++i) { v0[i] = fast_sigmoid(v0[i]); v1[i] = fast_sigmoid(v1[i]); }
                        float* d = (float*)(ws + WS_NG) + (size_t)row * 32 + 8 * fq; *(f32x4*)d = v0; *(f32x4*)(d + 4) = v1; }
            }
        }
    }
};

__device__ __forceinline__ void unpack8(const u32x4 w, float (&f)[8]) {
    f[0] = __builtin_bit_cast(float, w.x << 16); f[1] = __builtin_bit_cast(float, w.x & 0xffff0000u); f[2] = __builtin_bit_cast(float, w.y << 16); f[3] = __builtin_bit_cast(float, w.y & 0xffff0000u);
    f[4] = __builtin_bit_cast(float, w.z << 16); f[5] = __builtin_bit_cast(float, w.z & 0xffff0000u); f[6] = __builtin_bit_cast(float, w.w << 16); f[7] = __builtin_bit_cast(float, w.w & 0xffff0000u);
}
struct EpiMerge {
    static constexpr bool PERM = true, AFTER_DRAIN = false, HAS_MID = true;
    const bf16_t* SG; bf16_t* MG;
    __device__ __forceinline__ void mid(f32x4 (&acc)[2][2][4][2], const Unit& u, int wr, int wc, int fr, int fq) const { asm volatile("" : "+v"(fr));
        const int row0 = u.pm * BM + wr * 64 + fr, col0 = u.pn * BM + wc * 32 + 8 * fq;
#pragma unroll
        for (int ai = 0; ai < 2; ++ai)
#pragma unroll
            for (int m = 0; m < 4; ++m) { const size_t row = (size_t)(row0 + ai * HALF + m * 16);
#pragma unroll
                for (int bj = 0; bj < 2; ++bj) { const int col = col0 + bj * HALF; float rg[8]; unpack8(*(const u32x4*)(SG + row * 2048 + col), rg);
#pragma unroll
                    for (int i = 0; i < 4; ++i) { acc[ai][bj][m][0][i] *= rg[i]; acc[ai][bj][m][1][i] *= rg[4 + i]; } } }
    }
    __device__ __forceinline__ void operator()(const f32x4 (&acc)[2][2][4][2], const Unit& u, int wr, int wc, int fr, int fq) const { asm volatile("" : "+v"(fr));
        const int row0 = u.pm * BM + wr * 64 + fr, col0 = u.pn * BM + wc * 32 + 8 * fq;
#pragma unroll
        for (int ai = 0; ai < 2; ++ai)
#pragma unroll
            for (int m = 0; m < 4; ++m) { const size_t row = (size_t)(row0 + ai * HALF + m * 16);
#pragma unroll
                for (int bj = 0; bj < 2; ++bj) { const int col = col0 + bj * HALF; float gb[8]; unpack8(*(const u32x4*)(SG + row * 2048 + 1024 + col), gb);
                    const f32x4 v0 = acc[ai][bj][m][0], v1 = acc[ai][bj][m][1]; f32x4 o0, o1;
#pragma unroll
                    for (int i = 0; i < 4; ++i) { o0[i] = gb[i] * v0[i]; o1[i] = gb[4 + i] * v1[i]; }
                    *(u32x4*)(MG + row * DM + col) = pack8(o0, o1); } }
    }
};
__device__ __forceinline__ float* yrow(float* out, int row) { return row < MP ? out + O_YP + (size_t)row * DM : out + O_YS + (size_t)(row - MP) * DM; }
struct EpiOut {
    static constexpr bool PERM = true, AFTER_DRAIN = false, HAS_MID = false;
    const float* xp; const float* xs; float* out; bf16_t* X1B; float* SSQ;
    __device__ __forceinline__ void operator()(const f32x4 (&acc)[2][2][4][2], const Unit& u, int wr, int wc, int fr, int fq) const { asm volatile("" : "+v"(fr));
        const int row0 = u.pm * BM + wr * 64 + fr, col0 = u.pn * BM + wc * 32 + 8 * fq;
#pragma unroll
        for (int ai = 0; ai < 2; ++ai)
#pragma unroll
            for (int m = 0; m < 4; ++m) { const int row = row0 + ai * HALF + m * 16; float ss = 0.f;
                const float* xr = xp + (size_t)row * DM; if (row >= MP) xr = xs + (size_t)(row - MP) * DM;
#pragma unroll
                for (int bj = 0; bj < 2; ++bj) { const int col = col0 + bj * HALF; f32x4 v0 = acc[ai][bj][m][0], v1 = acc[ai][bj][m][1];
                    if (row < MT) { v0 = v0 + *(const f32x4*)(xr + col); v1 = v1 + *(const f32x4*)(xr + col + 4); }
                    ss += (v0[0] * v0[0] + v0[1] * v0[1]) + (v0[2] * v0[2] + v0[3] * v0[3]) + (v1[0] * v1[0] + v1[1] * v1[1]) + (v1[2] * v1[2] + v1[3] * v1[3]);
                    *(u32x4*)(X1B + (size_t)row * DM + col) = pack8(v0, v1); }
                ss += __shfl_xor(ss, 16); ss += __shfl_xor(ss, 32);
                if (fq == 0) SSQ[(size_t)row * 16 + u.pn * 4 + wc] = ss; }
    }
};
struct EpiUp {
    static constexpr bool PERM = true, AFTER_DRAIN = false, HAS_MID = false;
    const float* SSQ; bf16_t* H;
    __device__ __forceinline__ void operator()(const f32x4 (&acc)[2][2][4][2], const Unit& u, int wr, int wc, int fr, int fq) const { asm volatile("" : "+v"(fr));
        const int row0 = u.pm * BM + wr * 64 + fr, col0 = u.pn * BM + wc * 32 + 8 * fq;
#pragma unroll
        for (int ai = 0; ai < 2; ++ai)
#pragma unroll
            for (int m = 0; m < 4; ++m) { const size_t row = (size_t)(row0 + ai * HALF + m * 16);
                const f32x4 s0 = *(const f32x4*)(SSQ + row * 16), s1 = *(const f32x4*)(SSQ + row * 16 + 4), s2 = *(const f32x4*)(SSQ + row * 16 + 8), s3 = *(const f32x4*)(SSQ + row * 16 + 12);
                const f32x4 st = (s0 + s1) + (s2 + s3); const float rstd = 1.f / sqrtf(((st[0] + st[1]) + (st[2] + st[3])) * (1.f / DM) + EPS);
#pragma unroll
                for (int bj = 0; bj < 2; ++bj) { f32x4 v0 = acc[ai][bj][m][0] * rstd, v1 = acc[ai][bj][m][1] * rstd;
#pragma unroll
                    for (int i = 0; i < 4; ++i) { const float a = fmaxf(v0[i], 0.f), b = fmaxf(v1[i], 0.f); v0[i] = a * a; v1[i] = b * b; }
                    *(u32x4*)(H + row * DFF + col0 + bj * HALF) = pack8(v0, v1); } }
    }
};
struct EpiDown {
    static constexpr bool PERM = true, AFTER_DRAIN = false, HAS_MID = false;
    float* out; const bf16_t* X1B;
    __device__ __forceinline__ void operator()(const f32x4 (&acc)[2][2][4][2], const Unit& u, int wr, int wc, int fr, int fq) const { asm volatile("" : "+v"(fr));
        const int row0 = u.pm * BM + wr * 64 + fr, col0 = u.pn * BM + wc * 32 + 8 * fq;
#pragma unroll
        for (int ai = 0; ai < 2; ++ai)
#pragma unroll
            for (int m = 0; m < 4; ++m) { const int row = row0 + ai * HALF + m * 16;
                if (row < MT) { float* y = yrow(out, row) + col0; const bf16_t* xb = X1B + (size_t)row * DM + col0;
#pragma unroll
                    for (int bj = 0; bj < 2; ++bj) { float x[8]; unpack8(*(const u32x4*)(xb + bj * HALF), x);
                        *(f32x4*)(y + bj * HALF) = (f32x4){x[0], x[1], x[2], x[3]} + acc[ai][bj][m][0]; *(f32x4*)(y + bj * HALF + 4) = (f32x4){x[4], x[5], x[6], x[7]} + acc[ai][bj][m][1]; } } }
    }
};

template <class Epi, class Sched, bool ALIGN_EPI = false, bool SP2 = false>
__device__ __forceinline__ void gemm_phase(PG8_LAS unsigned char* lds, const Gemm g, const Sched& S, const Epi& E) {
    const int tid = tidx(), wid = __builtin_amdgcn_readfirstlane(tid >> 6), lane = tid & 63, wr = wid >> 2, wc = wid & 3, fr = lane & 15, fq = lane >> 4;
    const int K = g.K, nt = K / BK;
    unsigned voffA[2], voffB[2];
#pragma unroll
    for (int i = 0; i < 2; ++i) { int R, C; stage_rc(tid * 16 + i * 8192, R, C); const int Rb = Epi::PERM ? ((R & ~31) + perm32(R & 31)) : R;
        voffA[i] = (unsigned)(R * K + C) * 2u; voffB[i] = (unsigned)(Rb * K + C) * 2u; }
    const size_t kstep = (size_t)(BK * 2);
    const size_t hstep = (size_t)HALF * K * 2;
    const size_t tstep = 2 * hstep;
    const unsigned ldsw = (unsigned)wid * 1024u;
    const int aoff = lds_byte(wr * 64 + fr, fq * 8), boff = lds_byte(wc * 32 + fr, fq * 8);
#define PG8_SA(b, h) (((b) * 2 + (h)) * HTB)
#define PG8_SB(b, h) ((4 + (b) * 2 + (h)) * HTB)
#define PG8_STAGE(bufoff, gbase, voff) do { _Pragma("unroll") for (int _i = 0; _i < 2; ++_i) \
        __builtin_amdgcn_global_load_lds((const unsigned*)((const char*)(gbase) + (voff)[_i]), (PG8_LAS unsigned*)(lds + (bufoff) + ldsw + _i * 8192), 16, 0, 0); } while (0)
#define PG8_LDA(dst, b, h) do { _Pragma("unroll") for (int m = 0; m < 4; ++m) _Pragma("unroll") for (int k = 0; k < 2; ++k) dst[m][k] = *(const PG8_LAS bf16x8*)(lds + PG8_SA(b, h) + aoff + m * 2048 + k * 1024); } while (0)
#define PG8_LDB(dst, b, h) do { _Pragma("unroll") for (int n = 0; n < 2; ++n) _Pragma("unroll") for (int k = 0; k < 2; ++k) dst[n][k] = *(const PG8_LAS bf16x8*)(lds + PG8_SB(b, h) + boff + n * 2048 + k * 1024); } while (0)
#define PG8_MMA(ai, bj, At, Bt) do { __builtin_amdgcn_s_setprio(1); _Pragma("unroll") for (int m = 0; m < 4; ++m) _Pragma("unroll") for (int n = 0; n < 2; ++n) _Pragma("unroll") for (int k = 0; k < 2; ++k) \
        acc[ai][bj][m][n] = __builtin_amdgcn_mfma_f32_16x16x32_bf16(Bt[n][k], At[m][k], acc[ai][bj][m][n], 0, 0, 0); __builtin_amdgcn_s_setprio(0); } while (0)
#define PG8_WAIT_V(n) asm volatile("s_waitcnt vmcnt(" #n ")" ::: "memory")
#define PG8_WAIT_L(n) asm volatile("s_waitcnt lgkmcnt(" #n ")" ::: "memory")
#define PG8_BAR __builtin_amdgcn_s_barrier()
#define PG8_SCHED __builtin_amdgcn_sched_barrier(0)
    Unit cur, nxt; int ui = 0;
    if (!S.next(0, cur)) return;
    f32x4 acc[2][2][4][2];
#pragma unroll
    for (int a = 0; a < 2; ++a)
#pragma unroll
        for (int b = 0; b < 2; ++b)
#pragma unroll
            for (int m = 0; m < 4; ++m)
#pragma unroll
                for (int n = 0; n < 2; ++n) acc[a][b][m][n] = (f32x4){0.f, 0.f, 0.f, 0.f};
    bf16x8 At[4][2], B0[2][2], B1[2][2];
    const char* cA = (const char*)g.A + (size_t)cur.pm * tstep; const char* cB = (const char*)g.Bt + (size_t)cur.pn * tstep;
    S.a_ready(cur);
    if constexpr (SP2) {
        PG8_STAGE(PG8_SB(0, 0), cB, voffB); PG8_STAGE(PG8_SB(0, 1), cB + hstep, voffB); PG8_STAGE(PG8_SA(0, 0), cA, voffA); PG8_STAGE(PG8_SA(0, 1), cA + hstep, voffA);
        if (wr == 1) PG8_BAR;
        PG8_WAIT_V(2); PG8_BAR;
        PG8_STAGE(PG8_SB(1, 0), cB + kstep, voffB); PG8_STAGE(PG8_SA(1, 0), cA + kstep, voffA); PG8_STAGE(PG8_SB(1, 1), cB + hstep + kstep, voffB);
        PG8_WAIT_V(6); PG8_BAR;
    } else {
        PG8_STAGE(PG8_SB(0, 0), cB, voffB); PG8_STAGE(PG8_SA(0, 0), cA, voffA); PG8_STAGE(PG8_SB(0, 1), cB + hstep, voffB); PG8_STAGE(PG8_SA(0, 1), cA + hstep, voffA);
        if (wr == 1) PG8_BAR;
        PG8_WAIT_V(4); PG8_BAR;
        PG8_STAGE(PG8_SB(1, 0), cB + kstep, voffB); PG8_STAGE(PG8_SA(1, 0), cA + kstep, voffA); PG8_STAGE(PG8_SB(1, 1), cB + hstep + kstep, voffB);
        PG8_WAIT_V(6); PG8_BAR;
    }
    for (;;) {
        const bool has_next = S.next(ui + 1, nxt);
        const char* nA = has_next ? (const char*)g.A + (size_t)nxt.pm * tstep : cA; const char* nB = has_next ? (const char*)g.Bt + (size_t)nxt.pn * tstep : cB;
        for (int t = 0; t < nt; t += 2) {
            const bool last = (t == nt - 2);
            const char* a1 = cA + (size_t)(t + 1) * kstep;
            const char* a2 = last ? nA : cA + (size_t)(t + 2) * kstep; const char* b2 = last ? nB : cB + (size_t)(t + 2) * kstep;
            const char* a3 = a2 + kstep; const char* b3 = b2 + kstep;
            if (last && has_next) S.a_ready(nxt);
            if constexpr (SP2) {
            PG8_LDB(B0, 0, 0); PG8_LDB(B1, 0, 1); PG8_SCHED; PG8_LDA(At, 0, 0); PG8_STAGE(PG8_SA(1, 1), a1 + hstep, voffA);
            PG8_WAIT_V(8); PG8_WAIT_L(0); PG8_BAR; PG8_MMA(0, 0, At, B0); PG8_MMA(0, 1, At, B1); PG8_BAR; PG8_SCHED;
            PG8_LDA(At, 0, 1); PG8_STAGE(PG8_SB(0, 0), b2, voffB); PG8_STAGE(PG8_SB(0, 1), b2 + hstep, voffB); PG8_STAGE(PG8_SA(0, 0), a2, voffA);
            PG8_WAIT_V(8); PG8_WAIT_L(0); PG8_BAR; PG8_MMA(1, 0, At, B0); PG8_MMA(1, 1, At, B1); PG8_BAR; PG8_SCHED;
            PG8_LDB(B0, 1, 0); PG8_LDB(B1, 1, 1); PG8_SCHED; PG8_LDA(At, 1, 0); PG8_STAGE(PG8_SA(0, 1), a2 + hstep, voffA);
            PG8_WAIT_V(8); PG8_WAIT_L(0); PG8_BAR; PG8_MMA(0, 0, At, B0); PG8_MMA(0, 1, At, B1); PG8_BAR; PG8_SCHED;
            PG8_LDA(At, 1, 1); PG8_STAGE(PG8_SB(1, 0), b3, voffB); PG8_STAGE(PG8_SB(1, 1), b3 + hstep, voffB); PG8_STAGE(PG8_SA(1, 0), a3, voffA);
            PG8_WAIT_V(8); PG8_WAIT_L(0); PG8_BAR; PG8_MMA(1, 0, At, B0); PG8_MMA(1, 1, At, B1); PG8_BAR; PG8_SCHED;
            if constexpr (Epi::HAS_MID) { if (t == nt / 2 - 2) { E.mid(acc, cur, wr, wc, fr, fq); PG8_WAIT_V(0); PG8_SCHED; } }
            } else {
            PG8_LDB(B0, 0, 0); PG8_SCHED; PG8_LDA(At, 0, 0); PG8_STAGE(PG8_SA(1, 1), a1 + hstep, voffA);
            PG8_WAIT_L(8); PG8_BAR; PG8_WAIT_L(0); PG8_MMA(0, 0, At, B0); PG8_BAR; PG8_SCHED;
            PG8_LDB(B1, 0, 1); PG8_STAGE(PG8_SB(0, 0), b2, voffB);
            PG8_BAR; PG8_WAIT_L(0); PG8_MMA(0, 1, At, B1); PG8_BAR;
            PG8_LDA(At, 0, 1); PG8_STAGE(PG8_SA(0, 0), a2, voffA);
            PG8_BAR; PG8_WAIT_L(0); PG8_MMA(1, 0, At, B0); PG8_BAR; PG8_SCHED;
            PG8_STAGE(PG8_SB(0, 1), b2 + hstep, voffB);
            PG8_WAIT_V(6); PG8_BAR; PG8_MMA(1, 1, At, B1); PG8_BAR;
            PG8_LDB(B0, 1, 0); PG8_SCHED; PG8_LDA(At, 1, 0); PG8_STAGE(PG8_SA(0, 1), a2 + hstep, voffA);
            PG8_WAIT_L(8); PG8_BAR; PG8_WAIT_L(0); PG8_MMA(0, 0, At, B0); PG8_BAR; PG8_SCHED;
            PG8_LDB(B1, 1, 1); PG8_STAGE(PG8_SB(1, 0), b3, voffB);
            PG8_BAR; PG8_WAIT_L(0); PG8_MMA(0, 1, At, B1); PG8_BAR;
            PG8_LDA(At, 1, 1); PG8_STAGE(PG8_SA(1, 0), a3, voffA);
            PG8_BAR; PG8_WAIT_L(0); PG8_MMA(1, 0, At, B0); PG8_BAR; PG8_SCHED;
            PG8_STAGE(PG8_SB(1, 1), b3 + hstep, voffB);
            PG8_WAIT_V(6); PG8_BAR; PG8_MMA(1, 1, At, B1); PG8_BAR;
            }
        }
        if constexpr (ALIGN_EPI) { if (wr == 0) PG8_BAR; }
        if constexpr (!Epi::AFTER_DRAIN) { E(acc, cur, wr, wc, fr, fq); S.done(cur); }
        if (!has_next) break;
#pragma unroll
        for (int a = 0; a < 2; ++a)
#pragma unroll
            for (int b = 0; b < 2; ++b)
#pragma unroll
                for (int m = 0; m < 4; ++m)
#pragma unroll
                    for (int n = 0; n < 2; ++n) acc[a][b][m][n] = (f32x4){0.f, 0.f, 0.f, 0.f};
        cur = nxt; cA = nA; cB = nB; ++ui;
        if constexpr (ALIGN_EPI) { if (wr == 1) PG8_BAR; }
    }
    PG8_WAIT_V(0);
    if constexpr (!ALIGN_EPI) { if (wr == 0) PG8_BAR; }
    PG8_BAR;
    if constexpr (Epi::AFTER_DRAIN) { E.fused(acc, cur, wr, wc, fr, fq, lds, wid, lane); S.done(cur); }
#undef PG8_SA
#undef PG8_SB
#undef PG8_STAGE
#undef PG8_LDA
#undef PG8_LDB
#undef PG8_MMA
#undef PG8_WAIT_V
#undef PG8_WAIT_L
#undef PG8_BAR
#undef PG8_SCHED
}
}
#define XB_TMO      128
#define XB_XCNT(j)  (256  + 64 * (j))
#define XB_XSUB(j)  (1280 + 64 * (j))
#define XB_XGEN(j)  (2304 + 64 * (j))
#define XB_TOP      3328
#define XB_TOPGEN   3392
#define XCD_BAR_WORDS 3456
#define XB_SPIN_CAP (1u << 18)

__device__ __forceinline__ unsigned xb_ld(unsigned* p)              { return __hip_atomic_load(p, __ATOMIC_RELAXED, __HIP_MEMORY_SCOPE_AGENT); }
__device__ __forceinline__ unsigned xb_add(unsigned* p, unsigned v) { return __hip_atomic_fetch_add(p, v, __ATOMIC_RELAXED, __HIP_MEMORY_SCOPE_AGENT); }
__device__ __forceinline__ unsigned xb_xcc_id() { return (unsigned)__builtin_amdgcn_s_getreg((3 << 11) | 20) & 0xFu; }
#define XB_SPIN(cond, bar) do { unsigned _sp = 0; while (cond) { __builtin_amdgcn_s_sleep(1); \
    if ((++_sp & 255u) == 0u) { if (xb_ld(&(bar)[XB_TMO])) break; if (_sp > XB_SPIN_CAP) { atomicAdd(&(bar)[XB_TMO], 1u); break; } } } } while (0)

struct XcdBarrier {
    unsigned* bar; unsigned x;
    volatile LAS unsigned* st;
};

__device__ __forceinline__ XcdBarrier xcd_barrier_post(unsigned* bar, volatile LAS unsigned* st) {
    XcdBarrier b; b.bar = bar; b.x = xb_xcc_id(); b.st = st;
    if (tidx() == 0) (void)xb_add(&bar[XB_XCNT(b.x)], 1u);
    return b;
}
__device__ __forceinline__ void xcd_barrier_complete(unsigned* bar, unsigned x, unsigned& nloc, unsigned& nx) {
    const unsigned G = gridDim.x * gridDim.y * gridDim.z;
    unsigned sum, cnt, mine, sp = 0u;
    for (;;) {
        sum = 0u; cnt = 0u; mine = 0u;
#pragma unroll
        for (unsigned j = 0; j < 16; ++j) { const unsigned c = xb_ld(&bar[XB_XCNT(j)]); sum += c; cnt += (c > 0u) ? 1u : 0u; mine = (j == x) ? c : mine; }
        if (sum == G) break;
        __builtin_amdgcn_s_sleep(1);
        if ((++sp & 255u) == 0u) { if (xb_ld(&bar[XB_TMO])) break; if (sp > XB_SPIN_CAP) { atomicAdd(&bar[XB_TMO], 1u); break; } }
    }
    nloc = mine > 0u ? mine : 1u; nx = cnt > 0u ? cnt : 1u;
}

__device__ __forceinline__ void xcd_barrier(const XcdBarrier& b) {
    asm volatile("s_waitcnt vmcnt(0)" ::: "memory");
    __syncthreads();
    if (tidx() == 0) {
        unsigned* bar = b.bar;
        __builtin_amdgcn_s_waitcnt(0);
        unsigned nloc = b.st[0], nx = b.st[1];
        if (nloc == 0u) { xcd_barrier_complete(bar, b.x, nloc, nx); b.st[0] = nloc; b.st[1] = nx; }
        const unsigned old = xb_add(&bar[XB_XSUB(b.x)], 1u);
        const unsigned gen = old / nloc;
        if (old + 1u == (gen + 1u) * nloc) {
            __builtin_amdgcn_fence(__ATOMIC_RELEASE, "agent");
            asm volatile("s_waitcnt vmcnt(0)" ::: "memory");
            const unsigned og = xb_add(&bar[XB_TOP], 1u);
            const unsigned tg = og / nx;
            if (og + 1u == (tg + 1u) * nx) xb_add(&bar[XB_TOPGEN], 1u);
            else XB_SPIN(xb_ld(&bar[XB_TOPGEN]) == tg, bar);
            __builtin_amdgcn_fence(__ATOMIC_ACQUIRE, "agent");
            xb_add(&bar[XB_XGEN(b.x)], 1u);
            asm volatile("s_waitcnt vmcnt(0)" ::: "memory");
        } else {
            XB_SPIN(xb_ld(&bar[XB_XGEN(b.x)]) == gen, bar);
            __builtin_amdgcn_fence(__ATOMIC_ACQUIRE, "agent");
            asm volatile("s_waitcnt vmcnt(0)" ::: "memory");
        }
    }
    __syncthreads();
}
struct Frame {
    LAS unsigned char* lds; volatile LAS unsigned* MISC; gu32* ctl;
    int tid, lane, wave, vcu, G;
    const float* in[N_IN]; float* out; unsigned char* ws;
};
#define WSP(T, off) ((T*)(F.ws + (off)))
typedef __attribute__((address_space(3))) float lds_f;

template <class Map>
__device__ __forceinline__ void tr_item(const float* W, int ldw, int K, bf16* WT, LAS float* scr, int item, int nblk, int lane, const Map& map, const float* kscale) {
    const int kb = item / nblk, nb = item % nblk, k0 = 64 * kb, n0 = 32 * nb;
    const int sc = map(n0 + (lane & 31));
#pragma unroll
    for (int i = 0; i < 32; ++i) { const int kk = 2 * i + (lane >> 5); float v = sc >= 0 ? W[(size_t)(k0 + kk) * ldw + sc] : 0.f; if (kscale) v *= kscale[k0 + kk]; scr[kk * 33 + (lane & 31)] = v; }
    LDS_WAIT(); asm volatile("" ::: "memory");
    const int c = lane & 7;
#pragma unroll
    for (int j = 0; j < 4; ++j) { const int n = (lane >> 3) + 8 * j; const LAS float* s = scr + (8 * c) * 33 + n;
        v4u o; o.x = pk2(s[0 * 33], s[1 * 33]); o.y = pk2(s[2 * 33], s[3 * 33]); o.z = pk2(s[4 * 33], s[5 * 33]); o.w = pk2(s[6 * 33], s[7 * 33]);
        *(GAS v4u*)(WT + (size_t)(n0 + n) * K + k0 + 8 * c) = o; }
    LDS_WAIT(); asm volatile("" ::: "memory");
}
struct MapId { __device__ __forceinline__ int operator()(int j) const { return j; } };
struct MapWin { __device__ __forceinline__ int operator()(int j) const { return win_map(j); } };

__device__ __forceinline__ void rms_row_to_bf16(int lane, const float* xrow, const float* g, bf16* orow) {
    const GAS f32x4* xr = (const GAS f32x4*)xrow + lane; const GAS f32x4* gr = (const GAS f32x4*)g + lane;
    f32x4 v[4]; float s = 0.f;
#pragma unroll
    for (int j = 0; j < 4; ++j) { v[j] = xr[64 * j]; s += (v[j].x * v[j].x + v[j].y * v[j].y) + (v[j].z * v[j].z + v[j].w * v[j].w); }
    const float rstd = 1.f / sqrtf(wave_sum_dpp(s) * (1.f / DM) + EPS);
    GAS unsigned long long* o8 = (GAS unsigned long long*)orow + lane;
#pragma unroll
    for (int j = 0; j < 4; ++j) { const f32x4 gg = gr[64 * j]; o8[64 * j] = (unsigned long long)pk2(v[j].x * rstd * gg.x, v[j].y * rstd * gg.y) | ((unsigned long long)pk2(v[j].z * rstd * gg.z, v[j].w * rstd * gg.w) << 32); }
}

struct TrItem { const float* W; const float* ks; bf16* WT; int ldw, K, k0, n0, sc; };
__device__ __forceinline__ void tr_load(const TrItem& t, int lane, float (&v)[32]) {
#pragma unroll
    for (int i = 0; i < 32; ++i) { const int kk = 2 * i + (lane >> 5); float x = t.sc >= 0 ? t.W[(size_t)(t.k0 + kk) * t.ldw + t.sc] : 0.f; if (t.ks) x *= t.ks[t.k0 + kk]; v[i] = x; }
}
__device__ __forceinline__ void tr_store(const TrItem& t, int lane, const float (&v)[32], LAS float* scr) {
#pragma unroll
    for (int i = 0; i < 32; ++i) scr[(2 * i + (lane >> 5)) * 33 + (lane & 31)] = v[i];
    LDS_WAIT(); asm volatile("" ::: "memory");
    const int c = lane & 7;
#pragma unroll
    for (int j = 0; j < 4; ++j) { const int n = (lane >> 3) + 8 * j; const LAS float* s = scr + (8 * c) * 33 + n;
        v4u o; o.x = pk2(s[0 * 33], s[1 * 33]); o.y = pk2(s[2 * 33], s[3 * 33]); o.z = pk2(s[4 * 33], s[5 * 33]); o.w = pk2(s[6 * 33], s[7 * 33]);
        *(GAS v4u*)(t.WT + (size_t)(t.n0 + n) * t.K + t.k0 + 8 * c) = o; }
    LDS_WAIT(); asm volatile("" ::: "memory");
}
__device__ __forceinline__ void p0_prologue(Frame& F) {
    LAS float* scr = (LAS float*)(F.lds + F.wave * 16384);
    const int gw = F.vcu * NWAVES + F.wave, NGW = F.G * NWAVES;
    constexpr int I_IN = 16 * (NIN / 32), I_BA = 16 * 32, I_O = 16 * 32, I_UP = 16 * (DFF / 32), I_DN = 64 * 32, I_C = 16 * 2;
    constexpr int NITEMS = I_IN + I_BA + I_O + I_UP + I_DN + 4 * I_C;
    auto describe = [&](int it, TrItem& t) {
        int r = it, nblk; bool win = false; t.ks = nullptr;
        if (r < I_IN) { t.W = F.in[I_WIN]; t.ldw = INC; t.K = DM; t.WT = WSP(bf16, WS_WINT); nblk = NIN / 32; win = true; }
        else if ((r -= I_IN) < I_BA) { t.W = F.in[I_WBR]; t.ldw = DM; t.K = DM; t.WT = WSP(bf16, WS_WBT); nblk = 32; }
        else if ((r -= I_BA) < I_O) { t.W = F.in[I_WOUT]; t.ldw = DM; t.K = DM; t.WT = WSP(bf16, WS_WOT); nblk = 32; }
        else if ((r -= I_O) < I_UP) { t.W = F.in[I_WUP]; t.ldw = DFF; t.K = DM; t.WT = WSP(bf16, WS_WUP); nblk = DFF / 32; t.ks = F.in[I_G2]; }
        else if ((r -= I_UP) < I_DN) { t.W = F.in[I_WDN]; t.ldw = DM; t.K = DFF; t.WT = WSP(bf16, WS_WDN); nblk = 32; }
        else { r -= I_DN; const int which = r / I_C; r = r % I_C;
               const float* w1 = (which >> 1) ? F.in[I_WCV1] : F.in[I_WCK1]; t.W = w1 + (size_t)(which & 1) * 1024 * 64; t.ldw = 64; t.K = 1024;
               t.WT = ((which >> 1) ? WSP(bf16, WS_WC1V) : WSP(bf16, WS_WC1K)) + (size_t)(which & 1) * 64 * 1024; nblk = 2; }
        t.k0 = 64 * (r / nblk); t.n0 = 32 * (r % nblk); const int j = t.n0 + (F.lane & 31); t.sc = win ? win_map(j) : j;
    };
    if (gw < NITEMS) {
        TrItem cur; describe(gw, cur); float vc[32]; tr_load(cur, F.lane, vc);
        for (int it = gw; it < NITEMS; it += NGW) {
            TrItem nxt = cur; float vn[32]; const bool more = it + NGW < NITEMS;
            if (more) { describe(it + NGW, nxt); tr_load(nxt, F.lane, vn); }
            tr_store(cur, F.lane, vc, scr);
            if (more) { cur = nxt;
#pragma unroll
                for (int i = 0; i < 32; ++i) vc[i] = vn[i]; }
        }
    }
    for (int m0 = gw; m0 < MPAD; m0 += 2 * NGW) {
        const int m1 = m0 + NGW; const bool two = m1 < MT;
        if (m0 < MT) {
            const float* x0 = m0 < MP ? F.in[I_XP] + (size_t)m0 * DM : F.in[I_XS] + (size_t)(m0 - MP) * DM;
            const float* x1 = two ? (m1 < MP ? F.in[I_XP] + (size_t)m1 * DM : F.in[I_XS] + (size_t)(m1 - MP) * DM) : x0;
            const GAS f32x4* xr0 = (const GAS f32x4*)x0 + F.lane; const GAS f32x4* xr1 = (const GAS f32x4*)x1 + F.lane; const GAS f32x4* gr = (const GAS f32x4*)F.in[I_G1] + F.lane;
            f32x4 v0[4], v1[4], gg[4]; float s0 = 0.f, s1 = 0.f;
#pragma unroll
            for (int j = 0; j < 4; ++j) { v0[j] = xr0[64 * j]; v1[j] = xr1[64 * j]; gg[j] = gr[64 * j]; }
#pragma unroll
            for (int j = 0; j < 4; ++j) { s0 += (v0[j].x * v0[j].x + v0[j].y * v0[j].y) + (v0[j].z * v0[j].z + v0[j].w * v0[j].w); s1 += (v1[j].x * v1[j].x + v1[j].y * v1[j].y) + (v1[j].z * v1[j].z + v1[j].w * v1[j].w); }
            const float r0 = 1.f / sqrtf(wave_sum_dpp(s0) * (1.f / DM) + EPS), r1 = 1.f / sqrtf(wave_sum_dpp(s1) * (1.f / DM) + EPS);
            GAS unsigned long long* o0 = (GAS unsigned long long*)(WSP(bf16, WS_XN) + (size_t)m0 * DM) + F.lane; GAS unsigned long long* o1 = (GAS unsigned long long*)(WSP(bf16, WS_XN) + (size_t)m1 * DM) + F.lane;
#pragma unroll
            for (int j = 0; j < 4; ++j) { o0[64 * j] = (unsigned long long)pk2(v0[j].x * r0 * gg[j].x, v0[j].y * r0 * gg[j].y) | ((unsigned long long)pk2(v0[j].z * r0 * gg[j].z, v0[j].w * r0 * gg[j].w) << 32);
                if (two) o1[64 * j] = (unsigned long long)pk2(v1[j].x * r1 * gg[j].x, v1[j].y * r1 * gg[j].y) | ((unsigned long long)pk2(v1[j].z * r1 * gg[j].z, v1[j].w * r1 * gg[j].w) << 32); }
        }
        for (int q = 0; q < 2; ++q) { const int m = m0 + q * NGW; if (m >= MT && m < MPAD) {
            GAS v4u* z = (GAS v4u*)(WSP(bf16, WS_XN) + (size_t)m * DM) + F.lane; z[0] = (v4u){0, 0, 0, 0}; z[64] = (v4u){0, 0, 0, 0};
            GAS v4u* za = (GAS v4u*)(WSP(bf16, WS_OAB) + (size_t)m * 1024) + F.lane; za[0] = (v4u){0, 0, 0, 0}; za[64] = (v4u){0, 0, 0, 0}; } }
    }
    const int gt = F.vcu * (NWAVES * 64) + F.tid, NGT = F.G * NWAVES * 64;
    for (int e = gt; e < 8196 * 8; e += NGT) {
        const int pidx = e >> 3, i = e & 7; const float pos = (float)(pidx < SEQ ? pidx : PAST + pidx - SEQ);
        const float inv = powf(500000.0f, -(float)(2 * i) / 16.0f); const float ang = pos * inv;
        WSP(float, WS_ROPE)[pidx * 16 + i] = cosf(ang); WSP(float, WS_ROPE)[pidx * 16 + 8 + i] = sinf(ang);
    }
    for (int e = gt; e < 8 * 128 * 128; e += NGT) {
        const int g = e >> 14, p = (e >> 7) & 127, r = e & 127; const float* ws = F.in[I_WS] + (size_t)g * 128 * 128;
        WSP(bf16, WS_WSP)[e] = (bf16)(r <= p ? f2bf(ws[p * 128 + r]) : 0u);
        WSP(bf16, WS_WSS)[e] = (bf16)(((p >> 2) == (r >> 2) && (r & 3) <= (p & 3)) ? f2bf(ws[(p & 3) * 128 + (r & 3)]) : 0u);
    }
    if (gt < 64) WSP(float, WS_GAINS)[gt] = F.in[I_GQ][gt]; else if (gt < 128) WSP(float, WS_GAINS)[gt] = F.in[I_GKS][gt - 64]; else if (gt < 192) WSP(float, WS_GAINS)[gt] = F.in[I_GKW][gt - 128];
    for (int it = gw; it < 64; it += NGW) { const int which = it >> 5, part = it & 31; const float* pe = F.in[which ? I_PEV : I_PEK]; const float* w1 = F.in[which ? I_WCV1 : I_WCK1];
        float s = 0.f;
#pragma unroll 16
        for (int i = 0; i < 64; ++i) { const int ii = part * 64 + i; s += pe[ii] * w1[(size_t)ii * 64 + F.lane]; }
        WSP(float, WS_BPART)[(which * 32 + part) * 64 + F.lane] = s; }
}

constexpr int CP_RED = 8 * 8 * 64 * 4;
constexpr int CP_PITCH = 2064;
template <bool SMP>
__device__ __forceinline__ void compress_tasks(Frame& F, const int which, const int first, const int stride, const int ntask) {
    const int tid_ = tidx(); const int lane = tid_ & 63, w = __builtin_amdgcn_readfirstlane(tid_ >> 6), fr = lane & 15, fq = lane >> 4;
    LAS float* red = (LAS float*)F.lds;
    LAS unsigned char* Pg = F.lds + CP_RED * 4;
    const bf16* Wc = WSP(bf16, which ? WS_WC1V : WS_WC1K) + (size_t)fr * 1024 + 128 * w + 8 * fq;
    bf16x8 wf[8][4];
#pragma unroll
    for (int nb = 0; nb < 8; ++nb)
#pragma unroll
        for (int ks = 0; ks < 4; ++ks) wf[nb][ks] = *(const bf16x8*)(Wc + (size_t)nb * 16 * 1024 + 32 * ks);
    const float* cache = F.in[which ? I_CVC : I_CKC]; const int* pt = (const int*)F.in[I_PT];
    const int nmine = first < ntask ? (ntask - first + stride - 1) / stride : 0;
    LAS int* pgl = (LAS int*)(Pg + 16 * CP_PITCH);
    __syncthreads();
    if (SMP) for (int i = tid_; i < nmine; i += NWAVES * 64) pgl[i] = pt[first + i * stride];
    __syncthreads();
    constexpr int DEPTH = SMP ? 2 : 1;
    f32x4 pf[DEPTH][8]; v4u pb[DEPTH][4];
#define CP_FETCH(slot, n_) do { const int nn_ = (n_); if (nn_ < nmine) { \
        if (SMP) { const f32x4* src = (const f32x4*)(cache + (size_t)pgl[nn_] * (128 * 128) + (size_t)w * 2048) + lane; \
            _Pragma("unroll") for (int i = 0; i < 8; ++i) pf[slot][i] = __builtin_nontemporal_load(src + 64 * i); } \
        else { const v4u* src = (const v4u*)(WSP(bf16, which ? WS_VCA : WS_KCA) + (size_t)(first + nn_ * stride) * 16 * 1024 + (size_t)w * 2048) + lane; \
            _Pragma("unroll") for (int i = 0; i < 4; ++i) pb[slot][i] = src[64 * i]; } } } while (0)
#define CP_COMPUTE(slot, n_) do { const int nc_ = (n_); if (nc_ < nmine) { \
        if (SMP) { LAS unsigned char* dst = Pg + (2 * w + ((lane >> 4) & 1)) * CP_PITCH + ((lane >> 5) * 64 + 4 * (lane & 15)) * 2; \
            _Pragma("unroll") for (int i = 0; i < 8; ++i) { const f32x4 a = pf[slot][i]; v2u pk; pk.x = pg8::cvt_pk_bf16(a.x, a.y); pk.y = pg8::cvt_pk_bf16(a.z, a.w); *(LAS v2u*)(dst + i * 256) = pk; } } \
        else { _Pragma("unroll") for (int i = 0; i < 4; ++i) { const int q = 64 * i + lane; *(LAS v4u*)(Pg + (2 * w + (q >> 7)) * CP_PITCH + (q & 127) * 16) = pb[slot][i]; } } \
        __syncthreads(); \
        bf16x8 af[4]; \
        _Pragma("unroll") for (int ks = 0; ks < 4; ++ks) af[ks] = *(const LAS bf16x8*)(Pg + fr * CP_PITCH + (128 * w + 32 * ks + 8 * fq) * 2); \
        _Pragma("unroll") for (int nb = 0; nb < 8; ++nb) { f32x4 acc = {0.f, 0.f, 0.f, 0.f}; \
            _Pragma("unroll") for (int ks = 0; ks < 4; ++ks) acc = __builtin_amdgcn_mfma_f32_16x16x32_bf16(wf[nb][ks], af[ks], acc, 0, 0, 0); \
            *(LAS f32x4*)(red + ((w * 8 + nb) * 64 + lane) * 4) = acc; } \
        __syncthreads(); \
        { f32x4 s = *(const LAS f32x4*)(red + ((0 * 8 + w) * 64 + lane) * 4); \
          _Pragma("unroll") for (int sw = 1; sw < 8; ++sw) s = s + *(const LAS f32x4*)(red + ((sw * 8 + w) * 64 + lane) * 4); \
          bf16* fs = WSP(bf16, SMP ? (which ? WS_FSSV : WS_FSSK) : (which ? WS_FSPV : WS_FSPK)) + (size_t)(first + nc_ * stride) * 16 * 128;     \
          v2u pk_; pk_.x = pg8::cvt_pk_bf16(s.x, s.y); pk_.y = pg8::cvt_pk_bf16(s.z, s.w); *(v2u*)(fs + (size_t)fr * 128 + 16 * w + 4 * fq) = pk_; } } } while (0)
#pragma unroll
    for (int s = 0; s < DEPTH; ++s) CP_FETCH(s, s);
    for (int n = 0; n < nmine; n += DEPTH) {
#pragma unroll
        for (int s = 0; s < DEPTH; ++s) { CP_COMPUTE(s, n + s); CP_FETCH(s, n + s + DEPTH); }
    }
#undef CP_FETCH
#undef CP_COMPUTE
    __syncthreads();
}

__device__ __forceinline__ void compress_stage2(Frame& F, const int wg, const int nwg) {
    const int lane = F.lane, fr = lane & 15, fq = lane >> 4, gw = wg * NWAVES + F.wave, NGW = nwg * NWAVES;
    constexpr int NRS = DECB * NCS * 2, NRP = NBAT * NCP * 2, NGRP = (NRS + NRP) / 16;
    LAS float* biasL = (LAS float*)F.lds;
    __syncthreads();
    if (F.tid < 128) { float s = 0.f;
#pragma unroll 4
        for (int p = 0; p < 32; ++p) s += WSP(float, WS_BPART)[((F.tid >> 6) * 32 + p) * 64 + (F.tid & 63)];
        biasL[F.tid] = s; }
    __syncthreads();
    for (int which = 0; which < 2; ++which) {
        float bias[2][8]; const float* w2 = F.in[which ? I_WCV2 : I_WCK2]; bf16x8 wfr[4][2];
#pragma unroll
        for (int ks = 0; ks < 2; ++ks)
#pragma unroll
            for (int j = 0; j < 8; ++j) bias[ks][j] = biasL[which * 64 + 32 * ks + 8 * fq + j];
#pragma unroll
        for (int nb = 0; nb < 4; ++nb)
#pragma unroll
            for (int ks = 0; ks < 2; ++ks) { unsigned short t[8];
#pragma unroll
                for (int j = 0; j < 8; ++j) t[j] = (unsigned short)f2bf(w2[(32 * ks + 8 * fq + j) * 64 + 16 * nb + fr]);
                wfr[nb][ks] = (bf16x8){(short)t[0], (short)t[1], (short)t[2], (short)t[3], (short)t[4], (short)t[5], (short)t[6], (short)t[7]}; }
        f32x4 gk[4];
#pragma unroll
        for (int nb = 0; nb < 4; ++nb) { const float g = F.in[I_GKC][16 * nb + fr]; gk[nb] = (f32x4){g, g, g, g}; }
        for (int grp = which ? NGW - 1 - gw : gw; grp < NGRP; grp += NGW) {
            const bool smp = grp < NRS / 16; const int rr0 = smp ? grp * 16 : grp * 16 - NRS; const int nr = smp ? NRS : NRP, nc = smp ? NCS : NCP;
            const bf16* fs = WSP(bf16, smp ? (which ? WS_FSSV : WS_FSSK) : (which ? WS_FSPV : WS_FSPK));
            const int rr = rr0 + fr; const int rr2 = rr + 2 < nr ? rr + 2 : nr - 1;
            bf16x8 af[2];
#pragma unroll
            for (int ks = 0; ks < 2; ++ks) { const int k0 = 32 * ks + 8 * fq;
                const v4u ra = *(const v4u*)(fs + (size_t)rr * 128 + k0), rb = *(const v4u*)(fs + (size_t)rr2 * 128 + 64 + k0);
                const f32x4 a0 = {bflo(ra.x), bfhi(ra.x), bflo(ra.y), bfhi(ra.y)}, a1 = {bflo(ra.z), bfhi(ra.z), bflo(ra.w), bfhi(ra.w)}, b0 = {bflo(rb.x), bfhi(rb.x), bflo(rb.y), bfhi(rb.y)}, b1 = {bflo(rb.z), bfhi(rb.z), bflo(rb.w), bfhi(rb.w)};
                float h[8];
#pragma unroll
                for (int j = 0; j < 4; ++j) { h[j] = gelu_tanh(a0[j] + b0[j] + bias[ks][j]); h[4 + j] = gelu_tanh(a1[j] + b1[j] + bias[ks][4 + j]); }
                v4u pk; pk.x = pk2(h[0], h[1]); pk.y = pk2(h[2], h[3]); pk.z = pk2(h[4], h[5]); pk.w = pk2(h[6], h[7]); af[ks] = __builtin_bit_cast(bf16x8, pk); }
            f32x4 acc[4];
#pragma unroll
            for (int nb = 0; nb < 4; ++nb) { acc[nb] = __builtin_amdgcn_mfma_f32_16x16x32_bf16(af[0], wfr[nb][0], (f32x4){0.f, 0.f, 0.f, 0.f}, 0, 0, 0); acc[nb] = __builtin_amdgcn_mfma_f32_16x16x32_bf16(af[1], wfr[nb][1], acc[nb], 0, 0, 0); }
            if (which == 0) {
                f32x4 ss = acc[0] * acc[0] + acc[1] * acc[1] + acc[2] * acc[2] + acc[3] * acc[3];
#pragma unroll
                for (int r = 0; r < 4; ++r) { float v = ss[r]; v += __shfl_xor(v, 1); v += __shfl_xor(v, 2); v += __shfl_xor(v, 4); v += __shfl_xor(v, 8); ss[r] = 1.f / sqrtf(v * (1.f / 64.f) + EPS); }
#pragma unroll
                for (int nb = 0; nb < 4; ++nb) acc[nb] = acc[nb] * ss * gk[nb];
            }
            bf16* dstb = WSP(bf16, smp ? (which ? WS_VCS : WS_KCS) : (which ? WS_VCP : WS_KCP));
#pragma unroll
            for (int r = 0; r < 4; ++r) { const int row = rr0 + 4 * fq + r; const int kv = row & 1, bc = row >> 1; const int b = bc / nc, c = bc % nc; const bool zero = (c == nc - 1);
                bf16* dst = dstb + ((size_t)(b * 2 + kv) * nc + c) * 64 + fr;
#pragma unroll
                for (int nb = 0; nb < 4; ++nb) dst[16 * nb] = zero ? (bf16)0 : (bf16)f2bf(acc[nb][r]); }
        }
    }
}

constexpr int VT_PITCH = 136;
constexpr int GMLP_UNITS = 129 * 2;
__device__ __forceinline__ void gmlp_unit(Frame& F, int unit) {
    const int tid_ = tidx(); const int lane = tid_ & 63, w = __builtin_amdgcn_readfirstlane(tid_ >> 6), r32 = lane & 31, hi = lane >> 5, n = unit >> 1, hf = unit & 1;
    LAS bf16* vT = (LAS bf16*)F.lds;
    const int m0 = n * 128; const bool smp = (n == 128);
    __syncthreads();
    {
        float gg[8], bb[8];
#pragma unroll
        for (int k = 0; k < 8; ++k) { gg[k] = F.in[I_LNG][lane + 64 * k]; bb[k] = F.in[I_LNB][lane + 64 * k]; }
        const bf16* gv = WSP(bf16, WS_GV) + (size_t)(m0 + 16 * w) * 512 + lane;
#pragma unroll
        for (int i = 0; i < 16; i += 2) { const int r = 16 * w + i;
            float x[2][8];
#pragma unroll
            for (int k = 0; k < 8; ++k) { x[0][k] = bf2f(gv[(size_t)i * 512 + 64 * k]); x[1][k] = bf2f(gv[(size_t)(i + 1) * 512 + 64 * k]); }
            float y[2][8];
#pragma unroll
            for (int e = 0; e < 2; ++e) { float s = 0.f;
#pragma unroll
                for (int k = 0; k < 8; ++k) s += x[e][k];
                const float mean = wave_sum_dpp(s) * (1.f / 512.f); float s2 = 0.f;
#pragma unroll
                for (int k = 0; k < 8; ++k) { x[e][k] -= mean; s2 += x[e][k] * x[e][k]; }
                const float rstd = 1.f / sqrtf(wave_sum_dpp(s2) * (1.f / 512.f) + EPS);
#pragma unroll
                for (int k = 0; k < 8; ++k) y[e][k] = x[e][k] * rstd * gg[k] + bb[k];
                float* so = nullptr;
                if (smp) so = F.out + O_SVA + (size_t)(r + e) * 512; else if ((n & 63) == 63) so = F.out + O_PVA + ((size_t)(n >> 6) * 128 + r + e) * 512;
                if (so) {
#pragma unroll
                    for (int k = 0; k < 8; ++k) if ((k >> 2) == hf) so[lane + 64 * k] = y[e][k]; } }
#pragma unroll
            for (int k = 0; k < 8; ++k) if ((k >> 2) == hf) *(LAS unsigned*)(vT + (lane + 64 * (k & 3)) * VT_PITCH + r) = pk2(y[0][k], y[1][k]);
        }
    }
    __syncthreads();
    {
        const int gl = w & 3, g = 4 * hf + gl; const bf16* Wg = WSP(bf16, smp ? WS_WSS : WS_WSP) + (size_t)g * 128 * 128; const float* bs = F.in[I_BS] + g * 128;
#pragma unroll
        for (int ii = 0; ii < 2; ++ii) { const int ib = (w < 4) ? (ii ? 3 : 0) : (ii ? 2 : 1);
            bf16x8 a[8];
#pragma unroll
            for (int kb = 0; kb < 8; ++kb) a[kb] = *(const bf16x8*)(Wg + (size_t)(32 * ib + r32) * 128 + 16 * kb + 8 * hi);
            unsigned short uu[2][16];
#pragma unroll
            for (int r = 0; r < 16; ++r) { const int p = 32 * ib + (r & 3) + 8 * (r >> 2) + 4 * hi; const bf16* up = WSP(bf16, WS_U) + (size_t)(m0 + p) * 512 + 64 * g + r32; uu[0][r] = up[0]; uu[1][r] = up[32]; }
            f32x16 acc0 = {}, acc1 = {};
#pragma unroll
            for (int kb = 0; kb < 8; ++kb) {
                const bf16x8 b0 = *(const LAS bf16x8*)(vT + (64 * gl + r32) * VT_PITCH + 16 * kb + 8 * hi);
                const bf16x8 b1 = *(const LAS bf16x8*)(vT + (64 * gl + 32 + r32) * VT_PITCH + 16 * kb + 8 * hi);
                acc0 = __builtin_amdgcn_mfma_f32_32x32x16_bf16(a[kb], b0, acc0, 0, 0, 0); acc1 = __builtin_amdgcn_mfma_f32_32x32x16_bf16(a[kb], b1, acc1, 0, 0, 0);
            }
#pragma unroll
            for (int r = 0; r < 16; ++r) { const int p = 32 * ib + (r & 3) + 8 * (r >> 2) + 4 * hi; const size_t m = (size_t)(m0 + p);
                const float bias = bs[smp ? (p & 3) : p]; bf16* op = WSP(bf16, WS_OAB) + m * 1024 + 64 * g + r32;
                op[0] = (bf16)f2bf(bf2f(uu[0][r]) * (acc0[r] + bias)); op[32] = (bf16)f2bf(bf2f(uu[1][r]) * (acc1[r] + bias)); }
        }
    }
}

constexpr size_t WS_SSQS_DUMMY = 0;
template <class Epi, int KSPLIT = 1, bool MID = false>
__device__ __forceinline__ void skinny_gemm(const bf16* A, const bf16* Bt, int N, int K, int G, int first, const Epi& E) {
    const int lane = tidx() & 63, w = __builtin_amdgcn_readfirstlane(tidx() >> 6), fr = lane & 15, fq = lane >> 4;
    for (int it = first; it < (N / 16) * KSPLIT; it += G) {
        const int cb = it / KSPLIT, kq = it % KSPLIT, Kp = K / KSPLIT;
        const bf16* ap = A + (size_t)(16 * w + fr) * K + kq * Kp + 8 * fq;
        const bf16* bp = Bt + (size_t)(16 * cb + fr) * K + kq * Kp + 8 * fq;
        f32x4 acc = {0.f, 0.f, 0.f, 0.f};
        if constexpr (MID) {
#pragma unroll 16
            for (int ks = 0; ks < Kp / 64; ++ks) { const bf16x8 a = *(const bf16x8*)(ap + 32 * ks); const bf16x8 b = *(const bf16x8*)(bp + 32 * ks); acc = __builtin_amdgcn_mfma_f32_16x16x32_bf16(b, a, acc, 0, 0, 0); }
            E.mid(acc, 16 * w + fr, 16 * cb + 4 * fq);
#pragma unroll 16
            for (int ks = Kp / 64; ks < Kp / 32; ++ks) { const bf16x8 a = *(const bf16x8*)(ap + 32 * ks); const bf16x8 b = *(const bf16x8*)(bp + 32 * ks); acc = __builtin_amdgcn_mfma_f32_16x16x32_bf16(b, a, acc, 0, 0, 0); }
        } else {
#pragma unroll 16
        for (int ks = 0; ks < Kp / 32; ++ks) { const bf16x8 a = *(const bf16x8*)(ap + 32 * ks); const bf16x8 b = *(const bf16x8*)(bp + 32 * ks); acc = __builtin_amdgcn_mfma_f32_16x16x32_bf16(b, a, acc, 0, 0, 0); }
        }
        E(16 * w + fr, 16 * cb + 4 * fq, acc, fq);
    }
}
__device__ __forceinline__ v2u pack4(const f32x4 v) { v2u o; o.x = pk2(v.x, v.y); o.y = pk2(v.z, v.w); return o; }
__device__ __forceinline__ f32x4 unpack4(const v2u w) { return (f32x4){bflo(w.x), bfhi(w.x), bflo(w.y), bfhi(w.y)}; }
struct SkMerge { unsigned char* ws;
    __device__ __forceinline__ void mid(f32x4& acc, int r, int c) const { const size_t row = MP + r;
        acc = acc * unpack4(*(const v2u*)((const bf16*)(ws + WS_SG) + row * 2048 + c)); }
    __device__ __forceinline__ void operator()(int r, int c, const f32x4 acc, int) const { const size_t row = MP + r;
        const f32x4 gb = unpack4(*(const v2u*)((const bf16*)(ws + WS_SG) + row * 2048 + 1024 + c)); *(v2u*)((bf16*)(ws + WS_MG) + row * DM + c) = pack4(gb * acc); } };
struct SkOut { unsigned char* ws; const float* xs; float* out; __device__ __forceinline__ void operator()(int r, int c, const f32x4 acc, int fq) const {
    const f32x4 v = acc + *(const f32x4*)(xs + (size_t)r * DM + c); *(f32x4*)(out + O_YS + (size_t)r * DM + c) = v; *(v2u*)((bf16*)(ws + WS_X1B) + (size_t)(MP + r) * DM + c) = pack4(v);
    float ss = (v.x * v.x + v.y * v.y) + (v.z * v.z + v.w * v.w); ss += __shfl_xor(ss, 16); ss += __shfl_xor(ss, 32);
    if (fq == 0) ((float*)(ws + WS_SSQS))[r * 64 + (c >> 4)] = ss; } };
struct SkUp { unsigned char* ws; __device__ __forceinline__ void operator()(int r, int c, const f32x4 acc, int) const {
    const f32x4* sp = (const f32x4*)((const float*)(ws + WS_SSQS) + r * 64); f32x4 s = sp[0];
#pragma unroll
    for (int i = 1; i < 16; ++i) s = s + sp[i];
    const float rstd = 1.f / sqrtf(((s.x + s.y) + (s.z + s.w)) * (1.f / DM) + EPS); f32x4 v = acc * rstd;
#pragma unroll
    for (int i = 0; i < 4; ++i) { const float a = fmaxf(v[i], 0.f); v[i] = a * a; }
    *(v2u*)((bf16*)(ws + WS_H) + (size_t)(MP + r) * DFF + c) = pack4(v); } };
struct SkDown { float* out; __device__ __forceinline__ void operator()(int r, int c, const f32x4 acc, int) const { float* y = out + O_YS + (size_t)r * DM + c;
#pragma unroll
    for (int i = 0; i < 4; ++i) __hip_atomic_fetch_add(y + i, acc[i], __ATOMIC_RELAXED, __HIP_MEMORY_SCOPE_AGENT); } };

__device__ __forceinline__ void vst_tile(Frame& F, int tile) {
    const int tid = tidx(); LAS bf16* T = (LAS bf16*)F.lds;
    const int bk = tile >> 7, tb = tile & 127, b = bk >> 1, kv = bk & 1;
    __syncthreads();
    { const int t = tid >> 3, dc = tid & 7; const v4u v = *(const v4u*)(WSP(bf16, WS_VS) + ((size_t)b * SEQ + 64 * tb + t) * 128 + kv * 64 + 8 * dc);
      const unsigned w[4] = {v.x, v.y, v.z, v.w};
#pragma unroll
      for (int i = 0; i < 4; ++i) { T[(8 * dc + 2 * i) * 72 + t] = (bf16)(w[i] & 0xffffu); T[(8 * dc + 2 * i + 1) * 72 + t] = (bf16)(w[i] >> 16); } }
    __syncthreads();
    { const int dd = tid >> 3, tc = tid & 7; *(v4u*)(WSP(bf16, WS_VST) + ((size_t)(b * 2 + kv) * 64 + dd) * SEQ + 64 * tb + 8 * tc) = *(const LAS v4u*)(T + dd * 72 + 8 * tc); }
}

namespace att {
using s16x4 = __attribute__((ext_vector_type(4))) short;
using u32x4 = __attribute__((ext_vector_type(4))) unsigned;
constexpr int NW = 8, KVBLK = 64;
constexpr int NSLOT = 3, SLOTB = 8192;
constexpr int LDS_K = 0, LDS_V = NSLOT * SLOTB, LDS_WS = 2 * NSLOT * SLOTB, LDS_Q = LDS_WS + NW * 64 * 4, LDS_OST = LDS_Q, LDS_SELB = LDS_OST + NW * 8192, LDS_END = LDS_SELB + NW * 8 * 16;
constexpr int BLKS_PITCH = 132;
static_assert(NW * 8 * BLKS_PITCH * 4 <= LDS_WS, "block scores fit the ring region");
#define SBAR() __builtin_amdgcn_sched_barrier(0)
__device__ __forceinline__ int crow(int r, int hi) { return (r & 3) + 8 * (r >> 2) + 4 * hi; }
__device__ __forceinline__ void glds16(const void* gsrc, unsigned lds_dst) { unsigned keep;
  asm volatile("s_mov_b32 %0, m0\n\ts_mov_b32 m0, %2\n\ts_nop 0\n\tglobal_load_lds_dwordx4 %1, off\n\ts_mov_b32 m0, %0" : "=&s"(keep) : "v"(gsrc), "s"(lds_dst) : "memory"); }
__device__ __forceinline__ float max3f(float a, float b, float c) { float r; asm("v_max3_f32 %0, %1, %2, %3" : "=v"(r) : "v"(a), "v"(b), "v"(c)); return r; }
__device__ __forceinline__ float max2f(float a, float b) { float r; asm("v_max_f32_e32 %0, %1, %2" : "=v"(r) : "v"(a), "v"(b)); return r; }
__device__ __forceinline__ float fadd_s(float a, float b) { float r; asm("v_add_f32_e32 %0, %1, %2" : "=v"(r) : "v"(a), "v"(b)); return r; }
__device__ __forceinline__ float fsub_s(float a, float b) { float r; asm("v_sub_f32_e32 %0, %1, %2" : "=v"(r) : "v"(a), "v"(b)); return r; }
typedef float f32x2_t __attribute__((ext_vector_type(2))); typedef __bf16 bf16x2_t __attribute__((ext_vector_type(2)));
__device__ __forceinline__ unsigned cvtpk_s(float lo, float hi) { f32x2_t v = {lo, hi}; bf16x2_t b = __builtin_convertvector(v, bf16x2_t); return __builtin_bit_cast(unsigned, b); }
#define WAIT_BAR(N) asm volatile("s_waitcnt vmcnt(" #N ") lgkmcnt(0)\n\ts_barrier" ::: "memory")

typedef __attribute__((address_space(3))) const char* lds_cptr;
__device__ __forceinline__ void qkt(f32x16& p0, f32x16& p1, const char* Kslot, lds_cptr qp, int r32, int hi) { const f32x16 negm = f32x16{}; bf16x8 qr[4];
  _Pragma("unroll") for (int d0 = 0; d0 < 4; ++d0) qr[d0] = *(const __attribute__((address_space(3))) bf16x8*)(qp + d0 * 1024);
  const char* kb = Kslot + hi * 1024 + r32 * 16;
#pragma unroll
  for (int d0 = 0; d0 < 4; ++d0) {
    const bf16x8 b0 = *reinterpret_cast<const bf16x8*>(kb + d0 * 2048);
    const bf16x8 b1 = *reinterpret_cast<const bf16x8*>(kb + d0 * 2048 + 512);
    if (d0 == 0) { p0 = __builtin_amdgcn_mfma_f32_32x32x16_bf16(b0, qr[0], negm, 0, 0, 0); p1 = __builtin_amdgcn_mfma_f32_32x32x16_bf16(b1, qr[0], negm, 0, 0, 0); }
    else { p0 = __builtin_amdgcn_mfma_f32_32x32x16_bf16(b0, qr[d0], p0, 0, 0, 0); p1 = __builtin_amdgcn_mfma_f32_32x32x16_bf16(b1, qr[d0], p1, 0, 0, 0); } }
}
__device__ __forceinline__ void qkt_r(f32x16& p0, f32x16& p1, const char* Kslot, const bf16x8* qr, int r32, int hi) { const f32x16 negm = f32x16{};
  const char* kb = Kslot + hi * 1024 + r32 * 16;
#pragma unroll
  for (int d0 = 0; d0 < 4; ++d0) {
    const bf16x8 b0 = *reinterpret_cast<const bf16x8*>(kb + d0 * 2048);
    const bf16x8 b1 = *reinterpret_cast<const bf16x8*>(kb + d0 * 2048 + 512);
    if (d0 == 0) { p0 = __builtin_amdgcn_mfma_f32_32x32x16_bf16(b0, qr[0], negm, 0, 0, 0); p1 = __builtin_amdgcn_mfma_f32_32x32x16_bf16(b1, qr[0], negm, 0, 0, 0); }
    else { p0 = __builtin_amdgcn_mfma_f32_32x32x16_bf16(b0, qr[d0], p0, 0, 0, 0); p1 = __builtin_amdgcn_mfma_f32_32x32x16_bf16(b1, qr[d0], p1, 0, 0, 0); } }
}
typedef short v4i16_t __attribute__((ext_vector_type(4)));
__device__ __forceinline__ void kload8(bf16x8* kf, lds_cptr kp) {
  kf[0] = *(const __attribute__((address_space(3))) bf16x8*)(kp);        kf[1] = *(const __attribute__((address_space(3))) bf16x8*)(kp + 512);
  kf[2] = *(const __attribute__((address_space(3))) bf16x8*)(kp + 2048); kf[3] = *(const __attribute__((address_space(3))) bf16x8*)(kp + 2560);
  kf[4] = *(const __attribute__((address_space(3))) bf16x8*)(kp + 4096); kf[5] = *(const __attribute__((address_space(3))) bf16x8*)(kp + 4608);
  kf[6] = *(const __attribute__((address_space(3))) bf16x8*)(kp + 6144); kf[7] = *(const __attribute__((address_space(3))) bf16x8*)(kp + 6656);
}
__device__ __forceinline__ void kload2(bf16x8* kf, lds_cptr kp, int j) { kf[2 * j] = *(const __attribute__((address_space(3))) bf16x8*)(kp + j * 2048); kf[2 * j + 1] = *(const __attribute__((address_space(3))) bf16x8*)(kp + j * 2048 + 512); }
__device__ __forceinline__ s16x4 vtr(lds_cptr p) { return __builtin_bit_cast(s16x4, __builtin_amdgcn_ds_read_tr16_b64_v4i16((__attribute__((address_space(3))) v4i16_t*)p)); }
__device__ __forceinline__ float rowmax(const f32x16& p0, const f32x16& p1) {
  float a = max3f(p0[0], p0[1], p1[0]), b = max3f(p0[2], p0[3], p1[1]); a = max3f(a, p1[2], p1[3]);
#pragma unroll
  for (int r = 4; r < 16; r += 4) { a = max3f(a, p0[r], p0[r + 1]); b = max3f(b, p0[r + 2], p0[r + 3]); a = max3f(a, p1[r], p1[r + 1]); b = max3f(b, p1[r + 2], p1[r + 3]); }
  const float m = max2f(a, b);
  auto rr = __builtin_amdgcn_permlane32_swap(__float_as_uint(m), __float_as_uint(m), false, false);
  return max2f(__uint_as_float(rr[0]), __uint_as_float(rr[1]));
}
__device__ __forceinline__ void pv(f32x16* o, int vb, bf16x8 pa0, bf16x8 pa1, bf16x8 pa2, bf16x8 pa3) {
#pragma unroll
  for (int d0 = 0; d0 < 2; ++d0) { s16x4 lo[4], hi[4];
#pragma unroll
    for (int ks = 0; ks < 4; ++ks) {
      asm volatile("ds_read_b64_tr_b16 %0,%1 offset:%c2" : "=&v"(lo[ks]) : "v"(vb), "i"(d0 * 4096 + ks * 1024) : "memory");
      asm volatile("ds_read_b64_tr_b16 %0,%1 offset:%c2" : "=&v"(hi[ks]) : "v"(vb), "i"(d0 * 4096 + ks * 1024 + 512) : "memory"); }
    asm volatile("s_waitcnt lgkmcnt(0)" ::: "memory"); SBAR();
#define PK(k) (bf16x8){lo[k][0], lo[k][1], lo[k][2], lo[k][3], hi[k][0], hi[k][1], hi[k][2], hi[k][3]}
    o[d0] = __builtin_amdgcn_mfma_f32_32x32x16_bf16(pa0, PK(0), o[d0], 0, 0, 0);
    o[d0] = __builtin_amdgcn_mfma_f32_32x32x16_bf16(pa1, PK(1), o[d0], 0, 0, 0);
    o[d0] = __builtin_amdgcn_mfma_f32_32x32x16_bf16(pa2, PK(2), o[d0], 0, 0, 0);
    o[d0] = __builtin_amdgcn_mfma_f32_32x32x16_bf16(pa3, PK(3), o[d0], 0, 0, 0);
#undef PK
  }
}
template <int MODE> __device__ __forceinline__ void amask(f32x16& p0, f32x16& p1, int tabs, int blk, int hi, int mlo, int mspan1, const unsigned selword, const float mh) {
  const float NEG = -1e30f;
  const int kb = 64 * tabs + 4 * hi;
  int hiB;
  if (MODE == 1) {
    const bool en = (selword >> (tabs & 31)) & 1u;
    if (tabs < blk) { const float mht = en ? mh : 1e30f;
#pragma unroll
      for (int r = 0; r < 16; ++r) { p0[r] -= mht; p1[r] -= mht; }
      return; }
    hiB = en ? mspan1 - kb : 0;
  } else if (MODE == 0) hiB = mspan1 - kb;
  else {
    if (tabs < blk) {
      if (tabs + 8 <= blk) { const int loB = mlo - kb;
#pragma unroll
        for (int r = 0; r < 16; ++r) { const int c = (r & 3) + 8 * (r >> 2); p0[r] = (loB <= c) ? p0[r] - mh : NEG; p1[r] = (loB <= c + 32) ? p1[r] - mh : NEG; }
      } else {
#pragma unroll
        for (int r = 0; r < 16; ++r) { p0[r] -= mh; p1[r] -= mh; }
      }
      return; }
    hiB = mlo + mspan1 - kb;
  }
#pragma unroll
  for (int r = 0; r < 16; ++r) { const int c = (r & 3) + 8 * (r >> 2); p0[r] = (hiB > c) ? p0[r] - mh : NEG; p1[r] = (hiB > c + 32) ? p1[r] - mh : NEG; }
}

template <int MODE, int THRL>
__device__ __forceinline__ void attn_unit(const bf16* Qlane, const bf16* __restrict__ Kt, const bf16* __restrict__ Vt, const int t0abs, const int NT, const int blk,
                                          const int pos, const float* gatep, float* obf, bf16* ob, char* shm, float& mhat_o, float& rl_o) {
  constexpr int KP = (MODE == 0) ? 64 : 128;
  const int tid = tidx(), lane = tid & 63, r32 = lane & 31, hi = lane >> 5; const int wid = __builtin_amdgcn_readfirstlane(tid >> 6);
  const unsigned lds0 = (unsigned)(uintptr_t)shm;
  float* wsf = (float*)(shm + LDS_WS) + wid * 64;
  const bf16* ksrc = Kt + (long)lane * KP + wid * 8;
  const bf16* vsrc = Vt + (long)(16 * (wid & 3) + (lane >> 2)) * KP + (wid >> 2) * 32 + (lane & 3) * 8;
  const unsigned kdst = lds0 + LDS_K + wid * 1024, vdst = lds0 + LDS_V + wid * 1024;
#define DMA_K(t, slot) glds16(ksrc + (long)(t) * KVBLK * KP, (unsigned)__builtin_amdgcn_readfirstlane(kdst + (slot)))
#define DMA_V(t, slot) glds16(vsrc + (long)(t) * KVBLK * KP, (unsigned)__builtin_amdgcn_readfirstlane(vdst + (slot)))
  const int vb0 = (int)(lds0 + LDS_V) + ((lane >> 4) & 1) * 32 + (lane & 3) * 8 + (4 * hi + ((lane & 15) >> 2)) * 64;
  const char* Kbase = shm + LDS_K; bf16x8 kf[8];
  const lds_cptr shm3 = (lds_cptr)shm; const lds_cptr kp0 = shm3 + LDS_K + hi * 1024 + r32 * 16; const lds_cptr vp0 = shm3 + LDS_V + ((lane >> 4) & 1) * 32 + (lane & 3) * 8 + (4 * hi + ((lane & 15) >> 2)) * 64;
  const lds_cptr qp = shm3 + LDS_Q + wid * 4096 + lane * 16;
  const lds_cptr selp = shm3 + LDS_SELB + wid * 128 + (r32 >> 2) * 16;
#ifndef ATT_QREG
#define ATT_QREG 7
#endif
  constexpr bool QREG = (ATT_QREG >> MODE) & 1;
  bf16x8 qrg[4];
#define QF(j) (QREG ? qrg[j] : *(const __attribute__((address_space(3))) bf16x8*)(qp + (j) * 1024))
  const float gate_v = *gatep;
  DMA_K(0, 0); DMA_V(0, 0); DMA_K(1, SLOTB);
#pragma unroll
  for (int d0 = 0; d0 < 4; ++d0) { qrg[d0] = *reinterpret_cast<const bf16x8*>(&Qlane[d0 * 16 + hi * 8]); if (!QREG) *(__attribute__((address_space(3))) bf16x8*)((__attribute__((address_space(3))) char*)qp + d0 * 1024) = qrg[d0]; }
  float mhat = 0.f, l_reg = 0.f; f32x16 o[2]; o[0] = f32x16{}; o[1] = f32x16{}; const f32x16 zero16 = f32x16{};
  const int mlo = (MODE == 2) ? pos - (WIN - 1) : 0;
  const int mspan1 = (MODE == 0) ? (((pos - 31) >> 4) + 1 > 0 ? ((pos - 31) >> 4) + 1 : 0) : (MODE == 1 ? pos + 1 : WIN);
#define SELW(t) (MODE == 1 ? *(const __attribute__((address_space(3))) unsigned*)(selp + (((t0abs + (t)) >> 5) << 2)) : 0u)
#define CMASK(P0, P1, t, SW) amask<MODE>(P0, P1, t0abs + (t), blk, hi, mlo, mspan1, SW, mhat)
  bool resc = false;
#define START(P0, P1) do { const float rm = max2f(rowmax(P0, P1), -500.f); resc = false; \
    { const float dl = rm; mhat = fadd_s(mhat, dl); \
      _Pragma("unroll") for (int r = 0; r < 16; ++r) { P0[r] = fsub_s(P0[r], dl); P1[r] = fsub_s(P1[r], dl); } } \
    _Pragma("unroll") for (int r = 0; r < 16; ++r) P0[r] = __builtin_amdgcn_exp2f(P0[r]); } while (0)
#define RESC() do { if (resc) { asm volatile("s_waitcnt lgkmcnt(0)" ::: "memory"); \
      _Pragma("unroll") for (int d_ = 0; d_ < 2; ++d_) _Pragma("unroll") for (int r = 0; r < 16; ++r) o[d_][r] *= wsf[crow(r, hi)]; } } while (0)
  f32x16 pA0, pA1, pB0, pB1;
  int sl_prev = 0, sl_cur = 0, sl_next = SLOTB;
#define ROT() do { sl_prev = sl_cur; sl_cur = sl_next; sl_next = (sl_next == (NSLOT - 1) * SLOTB) ? 0 : sl_next + SLOTB; } while (0)
  DMA_K(2, 2 * SLOTB);
  WAIT_BAR(3);
  { const unsigned sw0 = SELW(0); if (QREG) qkt_r(pA0, pA1, Kbase, qrg, r32, hi); else qkt(pA0, pA1, Kbase, qp, r32, hi); asm volatile("s_nop 15\n\ts_nop 7" : "+v"(pA0), "+v"(pA1)); CMASK(pA0, pA1, 0, sw0); }
  START(pA0, pA1);
  _Pragma("unroll") for (int r = 0; r < 16; ++r) pA1[r] = __builtin_amdgcn_exp2f(pA1[r]);
  WAIT_BAR(0);
  DMA_K(3, 0); DMA_V(1, SLOTB);
  ROT();
  kload8(kf, kp0 + sl_cur);
  WAIT_BAR(2);
  s16x4 vlo[8], vhi[8]; u32x4 pw0, pw1, pw2, pw3;
#define PKW(P, B) cvtpk_s(P[B], P[B + 1])
#define PAF(k) __builtin_bit_cast(bf16x8, pw##k)
#define VFR(i) (bf16x8){vlo[i][0], vlo[i][1], vlo[i][2], vlo[i][3], vhi[i][0], vhi[i][1], vhi[i][2], vhi[i][3]}
#define PIN(x) asm volatile("" : "+v"(x))
#define MX3(a, b, c) __builtin_fmaxf(__builtin_fmaxf((a), (b)), (c))
#define GAPA(MF, A0, A1, A2, A3, W0, W1, PW) do { MF; sacc += A0; sacc += A1; sacc += A2; sacc += A3; PIN(sacc); W0; W1; PIN(PW); SBAR(); } while (0)
#define EX(v) __builtin_amdgcn_exp2f(v)
#define GAPB(MF, X, B) do { MF; X[B] = EX(X[B]); X[B + 1] = EX(X[B + 1]); X[B + 2] = EX(X[B + 2]); X[B + 3] = EX(X[B + 3]); PIN(X); SBAR(); } while (0)
#define VRD(i) do { vlo[i] = vtr(vp_ + (((i) >> 2) * 4096 + ((i) & 3) * 1024)); vhi[i] = vtr(vp_ + (((i) >> 2) * 4096 + ((i) & 3) * 1024 + 512)); } while (0)
#define KRD(G, j) do { if (G) { kload2(kf, kp0 + sl_next, j); SBAR(); } } while (0)
#define STEP(C0, C1, P0, P1, t, GK, GV, GL) do { SBAR(); \
    const lds_cptr vp_ = vp0 + sl_prev; const unsigned sw_ = SELW(t); \
    bf16x8 qa_ = QF(0); \
    VRD(0); SBAR(); float sacc = (P0[0] + P0[1]); \
    GAPA(C0 = __builtin_amdgcn_mfma_f32_32x32x16_bf16(kf[0], qa_, zero16, 0, 0, 0), P0[2], P0[3], P0[4], P0[5],     pw0[0] = PKW(P0, 0), pw0[1] = PKW(P0, 2), pw0); \
    VRD(4); SBAR(); GAPA(C1 = __builtin_amdgcn_mfma_f32_32x32x16_bf16(kf[1], qa_, zero16, 0, 0, 0), P0[6], P0[7], P0[8], P0[9],     pw0[2] = PKW(P0, 4), pw0[3] = PKW(P0, 6), pw0); \
    qa_ = QF(1); \
    VRD(1); SBAR(); GAPA(C0 = __builtin_amdgcn_mfma_f32_32x32x16_bf16(kf[2], qa_, C0, 0, 0, 0),   P0[10], P0[11], P0[12], P0[13], pw1[0] = PKW(P0, 8), pw1[1] = PKW(P0, 10), pw1); \
    VRD(5); SBAR(); GAPA(C1 = __builtin_amdgcn_mfma_f32_32x32x16_bf16(kf[3], qa_, C1, 0, 0, 0),   P0[14], P0[15], P1[0], P1[1],   pw1[2] = PKW(P0, 12), pw1[3] = PKW(P0, 14), pw1); \
    qa_ = QF(2); \
    VRD(2); SBAR(); GAPA(C0 = __builtin_amdgcn_mfma_f32_32x32x16_bf16(kf[4], qa_, C0, 0, 0, 0),   P1[2], P1[3], P1[4], P1[5],     pw2[0] = PKW(P1, 0), pw2[1] = PKW(P1, 2), pw2); \
    VRD(6); SBAR(); GAPA(C1 = __builtin_amdgcn_mfma_f32_32x32x16_bf16(kf[5], qa_, C1, 0, 0, 0),   P1[6], P1[7], P1[8], P1[9],     pw2[2] = PKW(P1, 4), pw2[3] = PKW(P1, 6), pw2); \
    qa_ = QF(3); \
    VRD(3); SBAR(); GAPA(C0 = __builtin_amdgcn_mfma_f32_32x32x16_bf16(kf[6], qa_, C0, 0, 0, 0),   P1[10], P1[11], P1[12], P1[13], pw3[0] = PKW(P1, 8), pw3[1] = PKW(P1, 10), pw3); \
    VRD(7); SBAR(); GAPA(C1 = __builtin_amdgcn_mfma_f32_32x32x16_bf16(kf[7], qa_, C1, 0, 0, 0),   P1[14], P1[15], 0.f, 0.f,       pw3[2] = PKW(P1, 12), pw3[3] = PKW(P1, 14), pw3); \
    l_reg += sacc; \
    if (GK) { DMA_K((t) + 3, sl_cur); } if (GV) { DMA_V((t) + 1, sl_next); } \
    CMASK(C0, C1, t, sw_); \
    { float a = MX3(C0[0], C0[1], C1[0]), b = MX3(C0[2], C0[3], C1[1]); a = MX3(a, C1[2], C1[3]); \
      _Pragma("unroll") for (int r = 4; r < 16; r += 4) { a = MX3(a, C0[r], C0[r + 1]); b = MX3(b, C0[r + 2], C0[r + 3]); a = MX3(a, C1[r], C1[r + 1]); b = MX3(b, C1[r + 2], C1[r + 3]); } \
      float rm = __builtin_fmaxf(a, b); { auto rr = __builtin_amdgcn_permlane32_swap(__float_as_uint(rm), __float_as_uint(rm), false, false); rm = __builtin_fmaxf(__uint_as_float(rr[0]), __uint_as_float(rr[1])); } \
      resc = false; \
      if (__builtin_expect(__any(rm > (float)THRL), 0)) { const float dl = __builtin_fmaxf(rm, 0.f); mhat += dl; \
        _Pragma("unroll") for (int r = 0; r < 16; ++r) { C0[r] -= dl; C1[r] -= dl; } \
        const float f = __builtin_amdgcn_exp2f(-dl); l_reg *= f; if (hi == 0) wsf[r32] = f; resc = true; } } \
    SBAR(); \
    GAPB(o[0] = __builtin_amdgcn_mfma_f32_32x32x16_bf16(PAF(0), VFR(0), o[0], 0, 0, 0), C0, 0); \
    GAPB(o[1] = __builtin_amdgcn_mfma_f32_32x32x16_bf16(PAF(0), VFR(4), o[1], 0, 0, 0), C0, 4); \
    KRD(GL, 0); GAPB(o[0] = __builtin_amdgcn_mfma_f32_32x32x16_bf16(PAF(1), VFR(1), o[0], 0, 0, 0), C0, 8); \
    KRD(GL, 1); GAPB(o[1] = __builtin_amdgcn_mfma_f32_32x32x16_bf16(PAF(1), VFR(5), o[1], 0, 0, 0), C0, 12); \
    KRD(GL, 2); GAPB(o[0] = __builtin_amdgcn_mfma_f32_32x32x16_bf16(PAF(2), VFR(2), o[0], 0, 0, 0), C1, 0); \
    KRD(GL, 3); GAPB(o[1] = __builtin_amdgcn_mfma_f32_32x32x16_bf16(PAF(2), VFR(6), o[1], 0, 0, 0), C1, 4); \
    GAPB(o[0] = __builtin_amdgcn_mfma_f32_32x32x16_bf16(PAF(3), VFR(3), o[0], 0, 0, 0), C1, 8); \
    GAPB(o[1] = __builtin_amdgcn_mfma_f32_32x32x16_bf16(PAF(3), VFR(7), o[1], 0, 0, 0), C1, 12); \
    } while (0)
  int t = 1;
  for (; t + 5 < NT; t += 2) {
    STEP(pB0, pB1, pA0, pA1, t, true, true, true);     WAIT_BAR(2); RESC(); ROT();
    STEP(pA0, pA1, pB0, pB1, t + 1, true, true, true); WAIT_BAR(2); RESC(); ROT();
  }
#define ENDW(tt) do { if ((tt) + 3 < NT) { WAIT_BAR(2); } else if ((tt) + 2 < NT) { WAIT_BAR(1); } else { WAIT_BAR(0); } } while (0)
  for (; t + 1 < NT; t += 2) {
    STEP(pB0, pB1, pA0, pA1, t, (t + 3 < NT), (t + 1 < NT), (t + 1 < NT));         ENDW(t);     RESC(); ROT();
    STEP(pA0, pA1, pB0, pB1, t + 1, (t + 4 < NT), (t + 2 < NT), (t + 2 < NT));     ENDW(t + 1); RESC(); ROT();
  }
  STEP(pB0, pB1, pA0, pA1, NT - 1, false, false, false); RESC();
  { float sacc = pB0[0] + pB0[1]; _Pragma("unroll") for (int r = 2; r < 16; ++r) sacc += pB0[r]; _Pragma("unroll") for (int r = 0; r < 16; ++r) sacc += pB1[r]; l_reg += sacc;
    pw0 = (u32x4){PKW(pB0, 0), PKW(pB0, 2), PKW(pB0, 4), PKW(pB0, 6)}; pw1 = (u32x4){PKW(pB0, 8), PKW(pB0, 10), PKW(pB0, 12), PKW(pB0, 14)}; pw2 = (u32x4){PKW(pB1, 0), PKW(pB1, 2), PKW(pB1, 4), PKW(pB1, 6)}; pw3 = (u32x4){PKW(pB1, 8), PKW(pB1, 10), PKW(pB1, 12), PKW(pB1, 14)};
    SBAR(); pv(o, vb0 + sl_cur, PAF(0), PAF(1), PAF(2), PAF(3)); }
#undef PKW
#undef PAF
#undef VFR
#undef PIN
#undef MX3
#undef GAPA
#undef GAPB
#undef EX
#undef VRD
#undef KRD
#undef STEP
#undef ENDW
  { auto rr = __builtin_amdgcn_permlane32_swap(__float_as_uint(l_reg), __float_as_uint(l_reg), false, false); l_reg = __uint_as_float(rr[0]) + __uint_as_float(rr[1]); }
  const float rl = l_reg > 0.f ? __builtin_amdgcn_rcpf(l_reg) : 0.f;
  mhat_o = mhat; rl_o = rl;
  if (hi == 0) wsf[32 + r32] = rl * gate_v; asm volatile("s_waitcnt lgkmcnt(0)" ::: "memory");
  { __attribute__((address_space(3))) float* ost = (__attribute__((address_space(3))) float*)(shm3 + LDS_OST) + wid * 2048;
#pragma unroll
    for (int r = 0; r < 16; ++r) { const int orow = crow(r, hi); const float sc = wsf[32 + orow];
#pragma unroll
      for (int d0 = 0; d0 < 2; ++d0) { __attribute__((address_space(3))) float* p = ost + orow * 64 + 32 * d0 + r32; float v = o[d0][r] * sc;
        if (MODE != 0) v += *p;
        if (MODE == 2) ob[(2 * (r >> 2)) * 1024 + (r & 3) * 64 + 32 * d0] = (bf16)f2bf(v); else *p = v; } } }
  (void)obf;
  asm volatile("s_waitcnt lgkmcnt(0)\n\ts_barrier" ::: "memory");
#undef DMA_K
#undef DMA_V
#undef CMASK
#undef SELW
#undef QF
#undef START
#undef RESC
#undef ROT
}

__device__ __forceinline__ int dppx1(int v) { return __builtin_amdgcn_mov_dpp(v, 0xB1, 0xF, 0xF, true); }
__device__ __forceinline__ int dppx2(int v) { return __builtin_amdgcn_mov_dpp(v, 0x4E, 0xF, 0xF, true); }
__device__ __forceinline__ float quad_sum(float v) { v += __builtin_bit_cast(float, dppx1(__builtin_bit_cast(int, v))); v += __builtin_bit_cast(float, dppx2(__builtin_bit_cast(int, v))); return v; }

__device__ __forceinline__ void nsa_prompt_unit(const unsigned char* ws, int b, int kv, int blk, char* shm) {
  float mhat = 0.f, rl = 0.f, dm0, dm1;
#define LANE_SETUP() const int lane = tidx() & 63, r32 = lane & 31, hi = lane >> 5; const int wid = __builtin_amdgcn_readfirstlane(tidx() >> 6); \
    const int tl = r32 >> 2, hl = r32 & 3, pos = 64 * blk + 8 * wid + tl; const size_t m = (size_t)b * SEQ + pos; const int head = 4 * kv + hl; (void)hi; (void)head; (void)m; (void)tl; (void)hl; \
    const size_t obo = ((size_t)b * SEQ + 64 * blk + 8 * wid + hi) * 512 + (4 * kv) * 64 + r32; const size_t obb = ((size_t)b * SEQ + 64 * blk + 8 * wid + hi) * 1024 + 512 + (4 * kv) * 64 + r32; (void)obo; (void)obb
  const int ntc_real = blk / 16 + 1;
  { LANE_SETUP(); const int NTc = ntc_real < 4 ? 4 : ((ntc_real + 1) & ~1);
    const bf16* kc = (const bf16*)(ws + WS_KCP) + (size_t)(b * 2 + kv) * NCP * 64; const bf16* vc = (const bf16*)(ws + WS_VCP) + (size_t)(b * 2 + kv) * NCP * 64;
#ifndef NO_M0
    attn_unit<0, 8>((const bf16*)(ws + WS_QN) + m * 512 + head * 64, kc, vc, 0, NTc, blk, pos, (const float*)(ws + WS_NG) + m * 32 + head * 3 + 0, (float*)(ws + WS_OBF) + obo, (bf16*)(ws + WS_OAB) + obb, shm, mhat, rl);
#endif
 }
  {
    LANE_SETUP();
    LAS float* bsw = (LAS float*)(shm + LDS_K) + wid * 8 * BLKS_PITCH;
    for (int i = lane; i < 8 * BLKS_PITCH; i += 64) bsw[i] = 0.f;
    asm volatile("s_waitcnt lgkmcnt(0)" ::: "memory");
    const int cthr = (pos - 31) >> 4; const int cspan = cthr + 1 > 0 ? cthr + 1 : 0;
    const bf16* kc = (const bf16*)(ws + WS_KCP) + (size_t)(b * 2 + kv) * NCP * 64; const bf16* qn = (const bf16*)(ws + WS_QN) + m * 512 + head * 64;
    bf16x8 qf[4];
#pragma unroll
    for (int d0 = 0; d0 < 4; ++d0) qf[d0] = *reinterpret_cast<const bf16x8*>(&qn[d0 * 16 + hi * 8]);
    const f32x16 zero16 = f32x16{};
    bf16x8 kb0[4], kb1[4], nb0[4], nb1[4];
#define IMP_LOAD(D0, D1, t_) do { const bf16* kr = kc + (size_t)(64 * (t_) + r32) * 64 + hi * 8; \
      _Pragma("unroll") for (int d0 = 0; d0 < 4; ++d0) { D0[d0] = *reinterpret_cast<const bf16x8*>(kr + d0 * 16); D1[d0] = *reinterpret_cast<const bf16x8*>(kr + 32 * 64 + d0 * 16); } } while (0)
    IMP_LOAD(kb0, kb1, 0);
    for (int t = 0; t < ntc_real; ++t) {
      if (t + 1 < ntc_real) IMP_LOAD(nb0, nb1, t + 1);
      f32x16 p0, p1;
#pragma unroll
      for (int d0 = 0; d0 < 4; ++d0) {
        if (d0 == 0) { p0 = __builtin_amdgcn_mfma_f32_32x32x16_bf16(kb0[0], qf[0], zero16, 0, 0, 0); p1 = __builtin_amdgcn_mfma_f32_32x32x16_bf16(kb1[0], qf[0], zero16, 0, 0, 0); }
        else { p0 = __builtin_amdgcn_mfma_f32_32x32x16_bf16(kb0[d0], qf[d0], p0, 0, 0, 0); p1 = __builtin_amdgcn_mfma_f32_32x32x16_bf16(kb1[d0], qf[d0], p1, 0, 0, 0); } }
      const int base = 64 * t + 4 * hi;
#pragma unroll
      for (int r = 0; r < 16; ++r) { const int c0 = base + (r & 3) + 8 * (r >> 2); p0[r] = (c0 < cspan) ? __builtin_amdgcn_exp2f(p0[r] - mhat) * rl : 0.f; p1[r] = (c0 + 32 < cspan) ? __builtin_amdgcn_exp2f(p1[r] - mhat) * rl : 0.f; }
#pragma unroll
      for (int ph = 0; ph < 2; ++ph)
#pragma unroll
        for (int g = 0; g < 4; ++g) { const float a0 = ph ? p1[4 * g] : p0[4 * g], a1 = ph ? p1[4 * g + 1] : p0[4 * g + 1], a2 = ph ? p1[4 * g + 2] : p0[4 * g + 2], a3 = ph ? p1[4 * g + 3] : p0[4 * g + 3];
          const float A = quad_sum(2.f * (a0 + a1 + a2) + a3), B = quad_sum(a3);
          const int j = 16 * t + 8 * ph + 2 * g + hi;
          if (hl == 0) { __hip_atomic_fetch_add(bsw + tl * BLKS_PITCH + j, A, __ATOMIC_RELAXED, __HIP_MEMORY_SCOPE_WORKGROUP); __hip_atomic_fetch_add(bsw + tl * BLKS_PITCH + j + 1, B, __ATOMIC_RELAXED, __HIP_MEMORY_SCOPE_WORKGROUP); } }
#pragma unroll
      for (int d0 = 0; d0 < 4; ++d0) { kb0[d0] = nb0[d0]; kb1[d0] = nb1[d0]; }
    }
#undef IMP_LOAD
    asm volatile("s_waitcnt lgkmcnt(0)" ::: "memory");
    LAS unsigned* selb = (LAS unsigned*)(shm + LDS_SELB) + wid * 32;
    const int cur = blk, nf = cur >= 2 ? 3 : cur + 1, need = 16 - nf;
    {
      const int j0 = lane, j1 = lane + 64;
      const bool c0 = (j0 >= 1 && j0 <= cur - 2), c1 = (j1 <= cur - 2);
      float v0[8], v1[8]; unsigned sm0 = (j0 == 0 || j0 == cur || j0 == cur - 1) ? 0xFFu : 0u, sm1 = (j1 == cur || j1 == cur - 1) ? 0xFFu : 0u;
#pragma unroll
      for (int tk = 0; tk < 8; ++tk) { const LAS float* bs = bsw + tk * BLKS_PITCH; v0[tk] = c0 ? bs[j0] : -1.f; v1[tk] = c1 ? bs[j1] : -1.f; }
      if (cur - 2 <= need) {
#pragma unroll
        for (int tk = 0; tk < 8; ++tk) { if (v0[tk] >= 0.f) sm0 |= 1u << tk; if (v1[tk] >= 0.f) sm1 |= 1u << tk; } }
      else for (int k = 0; k < need; ++k) {
#pragma unroll
        for (int tk = 0; tk < 8; ++tk) {
          const float mx = wave_max_dpp(fmaxf(v0[tk], v1[tk]));
          const unsigned long long b0 = __ballot(v0[tk] == mx), b1 = __ballot(v1[tk] == mx);
          const int l = __builtin_ctzll(b0 ? b0 : b1);
          const bool t0 = (b0 != 0ull) && lane == l, t1 = (b0 == 0ull) && lane == l;
          if (t0) { sm0 |= 1u << tk; v0[tk] = -1.f; }
          if (t1) { sm1 |= 1u << tk; v1[tk] = -1.f; } } }
#pragma unroll
      for (int tk = 0; tk < 8; ++tk) { const unsigned long long m0 = __ballot(((sm0 >> tk) & 1u) != 0u), m1 = __ballot(((sm1 >> tk) & 1u) != 0u);
        if (lane == 0) { selb[tk * 4 + 0] = (unsigned)m0; selb[tk * 4 + 1] = (unsigned)(m0 >> 32); selb[tk * 4 + 2] = (unsigned)m1; selb[tk * 4 + 3] = (unsigned)(m1 >> 32); } }
    }
    asm volatile("s_waitcnt lgkmcnt(0)\n\ts_barrier" ::: "memory");
  }
  { LANE_SETUP(); const int nt_real = blk + 1; const int NTs = nt_real < 4 ? 4 : ((nt_real + 1) & ~1);
    const bf16* ks = (const bf16*)(ws + WS_KS) + (size_t)b * SEQ * 128 + kv * 64; const bf16* vs = (const bf16*)(ws + WS_VS) + (size_t)b * SEQ * 128 + kv * 64;
#ifndef NO_M1
    attn_unit<1, 8>((const bf16*)(ws + WS_QR) + m * 512 + head * 64, ks, vs, 0, NTs, blk, pos, (const float*)(ws + WS_NG) + m * 32 + head * 3 + 1, (float*)(ws + WS_OBF) + obo, (bf16*)(ws + WS_OAB) + obb, shm, dm0, dm1);
#endif
 }
  { LANE_SETUP(); int t0, NTw; if (blk >= 9) { t0 = blk - 9; NTw = 10; } else { t0 = 0; const int nt_real = blk + 1; NTw = nt_real < 4 ? 4 : ((nt_real + 1) & ~1); }
    const bf16* kw = (const bf16*)(ws + WS_KW) + ((size_t)b * SEQ + 64 * t0) * 128 + kv * 64; const bf16* vw = (const bf16*)(ws + WS_VW) + ((size_t)b * SEQ + 64 * t0) * 128 + kv * 64;
#ifndef NO_M2
    attn_unit<2, 8>((const bf16*)(ws + WS_QR) + m * 512 + head * 64, kw, vw, t0, NTw, blk, pos, (const float*)(ws + WS_NG) + m * 32 + head * 3 + 2, (float*)(ws + WS_OBF) + obo, (bf16*)(ws + WS_OAB) + obb, shm, dm0, dm1);
#endif
 }
#undef LANE_SETUP
}
#undef SBAR
#undef WAIT_BAR
}

namespace smp {
typedef unsigned long long u64x2 __attribute__((ext_vector_type(2)));
constexpr int SCP = 1040;
constexpr int L_SC = 0, L_PART = L_SC + 4 * SCP * 4, L_OB = L_PART + 32 * 256 * 4, L_BLK = L_OB + 1024, L_SEL = L_BLK + 272 * 8, L_PT = L_SEL + 256, L_RS = L_PT + 4 * NPAGES, L_END = L_RS + 16;
constexpr float NEG = -1e30f;
constexpr int UKS_DEF = 4, UKP_DEF = 3;

__device__ __forceinline__ void ld16(const float* row, int c, float (&v)[16]) {
#pragma unroll
    for (int j = 0; j < 4; ++j) { const f32x4 t = *(const f32x4*)(row + 16 * j + 4 * c); v[4 * j] = t.x; v[4 * j + 1] = t.y; v[4 * j + 2] = t.z; v[4 * j + 3] = t.w; }
}
__device__ __forceinline__ void ld16(const bf16* row, int c, float (&v)[16]) {
#pragma unroll
    for (int j = 0; j < 4; ++j) { const v2u t = *(const v2u*)(row + 16 * j + 4 * c); v[4 * j] = bflo(t.x); v[4 * j + 1] = bfhi(t.x); v[4 * j + 2] = bflo(t.y); v[4 * j + 3] = bfhi(t.y); }
}
__device__ __forceinline__ void ldq(const bf16* row, int c, v2u (&r)[4][4]) {
#pragma unroll
    for (int h = 0; h < 4; ++h)
#pragma unroll
        for (int j = 0; j < 4; ++j) r[h][j] = *(const v2u*)(row + h * 64 + 16 * j + 4 * c);
}
__device__ __forceinline__ void cvtq(const v2u (&r)[4][4], float (&q)[4][16]) {
#pragma unroll
    for (int h = 0; h < 4; ++h)
#pragma unroll
        for (int j = 0; j < 4; ++j) { q[h][4 * j] = bflo(r[h][j].x); q[h][4 * j + 1] = bfhi(r[h][j].x); q[h][4 * j + 2] = bflo(r[h][j].y); q[h][4 * j + 3] = bfhi(r[h][j].y); }
}
__device__ __forceinline__ float qsum(float v) { v += __builtin_bit_cast(float, __builtin_amdgcn_mov_dpp(__builtin_bit_cast(int, v), 0xB1, 0xF, 0xF, true)); v += __builtin_bit_cast(float, __builtin_amdgcn_mov_dpp(__builtin_bit_cast(int, v), 0x4E, 0xF, 0xF, true)); return v; }

template <int UKS = UKS_DEF, class LD>
__device__ __forceinline__ void scores(LAS float* sc, int s0, int n, const float (&q)[4][16], const LD& ld) {
    const int lane = tidx() & 63, w = tidx() >> 6, ks = lane >> 2, c = lane & 3;
    for (int base = w * 16 * UKS; base < n; base += 8 * 16 * UKS) {
        float kx[UKS][16]; bool ok[UKS];
#pragma unroll
        for (int u = 0; u < UKS; ++u) { const int sl = base + 16 * u + ks; ok[u] = sl < n; if (ok[u]) ld(sl, c, kx[u]); else { _Pragma("unroll") for (int i = 0; i < 16; ++i) kx[u][i] = 0.f; } }
#pragma unroll
        for (int u = 0; u < UKS; ++u) { float s[4];
#pragma unroll
            for (int h = 0; h < 4; ++h) { float a = 0.f; _Pragma("unroll") for (int i = 0; i < 16; ++i) a += q[h][i] * kx[u][i]; s[h] = qsum(a); }
            const float sv = c == 0 ? s[0] : (c == 1 ? s[1] : (c == 2 ? s[2] : s[3]));
            if (ok[u]) sc[c * SCP + s0 + base + 16 * u + ks] = sv; }
    }
}
template <int UKP = UKP_DEF, class LD>
__device__ __forceinline__ void pvacc(const LAS float* sc, int s0, int n, float (&acc)[4][16], const LD& ld) {
    const int lane = tidx() & 63, w = tidx() >> 6, ks = lane >> 2, c = lane & 3;
    for (int base = w * 16 * UKP; base < n; base += 8 * 16 * UKP) {
        float vx[UKP][16];
#pragma unroll
        for (int u = 0; u < UKP; ++u) { const int sl = base + 16 * u + ks; const int slc = sl < n ? sl : 0;
            ld(slc, c, vx[u]); }
#pragma unroll
        for (int u = 0; u < UKP; ++u) { const int sl = base + 16 * u + ks; const bool ok = sl < n; const int slc = ok ? sl : 0;
#pragma unroll
            for (int h = 0; h < 4; ++h) { const float pr = sc[h * SCP + s0 + slc]; const float pv = ok ? pr : 0.f;
#pragma unroll
                for (int i = 0; i < 16; ++i) acc[h][i] += pv * vx[u][i]; } }
    }
}
__device__ __forceinline__ void softmax4(LAS float* sc, LAS float* rs, int n) {
    const int lane = tidx() & 63, w = tidx() >> 6;
    __syncthreads();
    if (w < 4) { LAS float* s = sc + w * SCP; float mx = -500.f;
        for (int i = lane; i < n; i += 64) mx = fmaxf(mx, s[i]);
        mx = wave_max(mx); float sum = 0.f;
        for (int i = lane; i < n; i += 64) { const float e = __builtin_amdgcn_exp2f(s[i] - mx); s[i] = e; sum += e; }
        sum = wave_sum(sum); if (lane == 0) rs[w] = sum > 0.f ? 1.f / sum : 0.f; }
    __syncthreads();
}
__device__ __forceinline__ float rowsum4(float v) {
    v += __builtin_bit_cast(float, __builtin_amdgcn_update_dpp(0, __builtin_bit_cast(int, v), 0x124, 0xF, 0xF, false));
    v += __builtin_bit_cast(float, __builtin_amdgcn_update_dpp(0, __builtin_bit_cast(int, v), 0x128, 0xF, 0xF, false));
    return v; }
__device__ __forceinline__ void finish(LAS unsigned char* L, float (&acc)[4][16], const float gate) {
    const int tid = tidx(), lane = tid & 63, w = tid >> 6, c = lane & 3;
    LAS float* part = (LAS float*)(L + L_PART); LAS float* ob = (LAS float*)(L + L_OB); const LAS float* rs = (const LAS float*)(L + L_RS);
#pragma unroll
    for (int h = 0; h < 4; ++h)
#pragma unroll
        for (int i = 0; i < 16; ++i) acc[h][i] = rowsum4(acc[h][i]);
    if ((lane & 12) == 0) {
#pragma unroll
        for (int h = 0; h < 4; ++h)
#pragma unroll
            for (int j = 0; j < 4; ++j) *(LAS f32x4*)(part + (w * 4 + (lane >> 4)) * 256 + h * 64 + 16 * j + 4 * c) = (f32x4){acc[h][4 * j], acc[h][4 * j + 1], acc[h][4 * j + 2], acc[h][4 * j + 3]};
    }
    __syncthreads();
    if (tid < 256) { float s0 = 0.f, s1 = 0.f;
#pragma unroll
        for (int ww = 0; ww < 32; ww += 2) { s0 += part[ww * 256 + tid]; s1 += part[(ww + 1) * 256 + tid]; }
        ob[tid] += gate * rs[tid >> 6] * (s0 + s1); }
    __syncthreads();
}

__device__ __forceinline__ void nsa_sample_unit(const unsigned char* ws, const float* cks, const float* cvs, const float* ckw, const float* cvw, const int* ptab, LAS unsigned char* L, int sb, int kv, int st) {
    const int tid = tidx(), lane = tid & 63, c = lane & 3;
    const size_t m = (size_t)MP + 4 * sb + st;
    LAS float* sc = (LAS float*)(L + L_SC); LAS float* ob = (LAS float*)(L + L_OB); LAS unsigned long long* bk = (LAS unsigned long long*)(L + L_BLK); LAS int* sel = (LAS int*)(L + L_SEL);
    const float* gates = (const float*)(ws + WS_NG) + m * 32 + (4 * kv) * 3;
    const bf16* KSn = (const bf16*)(ws + WS_KS) + ((size_t)MP + 4 * sb) * 128 + kv * 64; const bf16* VSn = (const bf16*)(ws + WS_VS) + ((size_t)MP + 4 * sb) * 128 + kv * 64;
    const bf16* KWn = (const bf16*)(ws + WS_KW) + ((size_t)MP + 4 * sb) * 128 + kv * 64; const bf16* VWn = (const bf16*)(ws + WS_VW) + ((size_t)MP + 4 * sb) * 128 + kv * 64;
#ifdef TIME_PROBE_A
#define SSTAMP(k) do { if (blockIdx.x == 0 && tid == 0) ((unsigned long long*)(ws + WS_DBG + 65536))[k] = __builtin_amdgcn_s_memrealtime(); } while (0)
#else
#define SSTAMP(k) do { } while (0)
#endif
    float gt[3]; { const float* gp = gates + ((tid & 255) >> 6) * 3; gt[0] = gp[0]; gt[1] = gp[1]; gt[2] = gp[2]; }
    LAS float* rsL = (LAS float*)(L + L_RS);
    v2u qrr[4][4];
    __syncthreads();
    SSTAMP(20);
    if (tid < 256) ob[tid] = 0.f;
    if (tid < 2) sel[tid] = tid * 255; if (tid == 2) sel[32] = tid;
    LAS int* ptl = (LAS int*)(L + L_PT); if (tid >= 512 - NPAGES) ptl[tid - (512 - NPAGES)] = ptab[sb * NPAGES + tid - (512 - NPAGES)];
    {
        float q[4][16];
#pragma unroll
        for (int h = 0; h < 4; ++h) ld16((const bf16*)(ws + WS_QN) + m * 512 + (4 * kv + h) * 64, c, q[h]);
        const bf16* kc = (const bf16*)(ws + WS_KCS) + (size_t)(sb * 2 + kv) * NCS * 64; const bf16* vc = (const bf16*)(ws + WS_VCS) + (size_t)(sb * 2 + kv) * NCS * 64;
        auto kp = [&](int sl, int cc, float (&v)[16]) { ld16(kc + (size_t)sl * 64, cc, v); }; auto vp = [&](int sl, int cc, float (&v)[16]) { ld16(vc + (size_t)sl * 64, cc, v); };
        scores(sc, 0, NCS - 1, q, kp);
        ldq((const bf16*)(ws + WS_QR) + m * 512 + (4 * kv) * 64, c, qrr);
        softmax4(sc, rsL, NCS - 1);
        float acc[4][16] = {};
        pvacc(sc, 0, NCS - 1, acc, vp);
        finish(L, acc, gt[0]);
    }
    SSTAMP(21);
    if (tid < 257) { const int j = tid; float v[5]; const float r0 = rsL[0], r1 = rsL[1], r2 = rsL[2], r3 = rsL[3];
#pragma unroll
        for (int i = 0; i < 5; ++i) { const int cc = 4 * j - 1 + i; v[i] = (cc >= 0 && cc < NCS - 1) ? (r0 * sc[cc] + r1 * sc[SCP + cc]) + (r2 * sc[2 * SCP + cc] + r3 * sc[3 * SCP + cc]) : 0.f; }
        const float bs = v[0] + 2.f * (v[1] + v[2] + v[3]) + v[4];
        const unsigned ub = __builtin_bit_cast(unsigned, bs); const unsigned so = ub ^ ((ub >> 31) ? 0xFFFFFFFFu : 0x80000000u);
        bk[j] = (j == 0 || j >= 255) ? 0ull : (((unsigned long long)so << 32) | (unsigned)(255 - j)); }
    __syncthreads();
    SSTAMP(26);
    {
        const int j = tid >> 1, hfr = tid & 1; const unsigned long long kj = bk[j]; int cnt = 0;
#pragma unroll 8
        for (int i0 = 0; i0 < 128; i0 += 2) { const u64x2 v = *(const LAS u64x2*)(bk + 128 * hfr + i0); cnt += (v.x > kj ? 1 : 0) + (v.y > kj ? 1 : 0); }
        cnt += __shfl_xor(cnt, 1);
        if (hfr == 0 && j >= 1 && j <= 254 && cnt < 13) { const int k = __hip_atomic_fetch_add(sel + 32, 1, __ATOMIC_RELAXED, __HIP_MEMORY_SCOPE_WORKGROUP); if (k < 15) sel[k] = j; } }
    __syncthreads();
    SSTAMP(27);
    if (tid < 15) { const int b = sel[tid]; sel[16 + tid] = ptl[b >> 1] * 128 + (b & 1) * 64; }
    __syncthreads();
    SSTAMP(22);
    {
        float q[4][16]; cvtq(qrr, q);
        auto kp = [&](int sl, int cc, float (&v)[16]) { if (sl < 960) ld16(cks + ((size_t)sel[16 + (sl >> 6)] + (sl & 63)) * 128 + kv * 64, cc, v); else ld16(KSn + (size_t)(sl - 960) * 128, cc, v); };
        auto vp = [&](int sl, int cc, float (&v)[16]) { if (sl < 960) ld16(cvs + ((size_t)sel[16 + (sl >> 6)] + (sl & 63)) * 128 + kv * 64, cc, v); else ld16(VSn + (size_t)(sl - 960) * 128, cc, v); };
        scores(sc, 0, 960 + st + 1, q, kp);
        softmax4(sc, rsL, 960 + st + 1);
        float acc[4][16] = {};
        pvacc(sc, 0, 960 + st + 1, acc, vp);
        finish(L, acc, gt[1]);
    }
    SSTAMP(24);
    {
        float q[4][16]; cvtq(qrr, q);
        const float* ck = ckw + ((size_t)sb * WIN + st + 1) * 128 + kv * 64; const float* cv = cvw + ((size_t)sb * WIN + st + 1) * 128 + kv * 64; const int nc = WIN - 1 - st;
        auto kp = [&](int sl, int cc, float (&v)[16]) { if (sl < nc) ld16(ck + (size_t)sl * 128, cc, v); else ld16(KWn + (size_t)(sl - nc) * 128, cc, v); };
        auto vp = [&](int sl, int cc, float (&v)[16]) { if (sl < nc) ld16(cv + (size_t)sl * 128, cc, v); else ld16(VWn + (size_t)(sl - nc) * 128, cc, v); };
        scores(sc, 0, WIN, q, kp);
        softmax4(sc, rsL, WIN);
        float acc[4][16] = {};
        pvacc(sc, 0, WIN, acc, vp);
        finish(L, acc, gt[2]);
    }
    SSTAMP(25);
    if (tid < 256) ((bf16*)(ws + WS_OAB))[m * 1024 + 512 + (4 * kv) * 64 + tid] = (bf16)f2bf(ob[tid]);
    __syncthreads();
}
}

#ifdef ATT_CHECK
namespace chk {
constexpr int C_Q = 0, C_SC = C_Q + 2 * 8 * 64 * 4, C_IMP = C_SC + 4 * 1032 * 4, C_BLK = C_IMP + 1032 * 4, C_IDX = C_BLK + 264 * 4, C_O = C_IDX + 64, C_RED = C_O + 256 * 4, C_END = C_RED + 64;
constexpr int SP = 1032;
struct Src { const unsigned char* ws; const float* const* in; };

__device__ __forceinline__ float sel_fetch(const unsigned char* ws, const float* cache, const int* pt, bool smp, int b, int kv, int kpos, int d, size_t wsoff) {
    if (!smp) { int p = kpos < 0 ? 0 : (kpos > SEQ - 1 ? SEQ - 1 : kpos); return bf2f(((const bf16*)(ws + wsoff))[((size_t)b * SEQ + p) * 128 + kv * 64 + d]); }
    if (kpos < PAST) { int pc = kpos < 0 ? 0 : kpos; const int pg = pt[b * NPAGES + (pc >> 7)]; return cache[((size_t)pg * 128 + (pc & 127)) * 128 + kv * 64 + d]; }
    int pn = kpos - PAST; pn = pn > 3 ? 3 : pn; return bf2f(((const bf16*)(ws + wsoff))[((size_t)MP + 4 * b + pn) * 128 + kv * 64 + d]);
}
__device__ __forceinline__ void softmax_rows(LAS float* sc, int n) {
    const int lane = tidx() & 63, w = tidx() >> 6;
    if (w < 4) { LAS float* s = sc + w * SP; float mx = -3e38f;
        for (int i = lane; i < n; i += 64) mx = fmaxf(mx, s[i]);
        mx = wave_max(mx); const bool any = mx > -1e29f; float sum = 0.f;
        for (int i = lane; i < n; i += 64) { const float e = (any && s[i] > -1e29f) ? exp2f(s[i] - mx) : 0.f; s[i] = e; sum += e; }
        sum = wave_sum(sum); const float rs = sum > 0.f ? 1.f / sum : 0.f;
        for (int i = lane; i < n; i += 64) s[i] *= rs; }
    __syncthreads();
}
__device__ __forceinline__ void check_token(const unsigned char* ws, const float* const* in, LAS unsigned char* L, bool smp, int b, int tq, float& emax, float& rmax) {
    const int tid = tidx();
    LAS float* q = (LAS float*)(L + C_Q); LAS float* sc = (LAS float*)(L + C_SC); LAS float* imp = (LAS float*)(L + C_IMP); LAS float* blk = (LAS float*)(L + C_BLK);
    LAS int* idx = (LAS int*)(L + C_IDX); LAS float* oo = (LAS float*)(L + C_O); LAS float* red = (LAS float*)(L + C_RED);
    const int pos = smp ? PAST + tq : tq; const size_t m = smp ? (size_t)MP + 4 * b + tq : (size_t)b * SEQ + tq;
    const int NC = smp ? NCS - 1 : NCP - 1, n_sel = smp ? 257 : 128, n_ch = 4 * n_sel, cur = pos >> 6;
    const int* pt = (const int*)in[I_PT];
    __syncthreads();
    for (int i = tid; i < 1024; i += 512) { const int ty = i >> 9, r = i & 511; q[i] = bf2f(((const bf16*)(ws + (ty ? WS_QR : WS_QN)))[m * 512 + r]); }
    if (tid == 0) { red[0] = 0.f; red[1] = 0.f; }
    __syncthreads();
    for (int kv = 0; kv < 2; ++kv) {
        if (tid < 256) oo[tid] = 0.f;
        __syncthreads();
        { const bf16* kc = (const bf16*)(ws + (smp ? WS_KCS : WS_KCP)) + (size_t)(b * 2 + kv) * (smp ? NCS : NCP) * 64; const bf16* vc = (const bf16*)(ws + (smp ? WS_VCS : WS_VCP)) + (size_t)(b * 2 + kv) * (smp ? NCS : NCP) * 64;
          for (int c = tid; c < NC; c += 512) { float d0 = 0.f, d1 = 0.f, d2 = 0.f, d3 = 0.f;
              for (int d = 0; d < 64; ++d) { const float k = bf2f(kc[(size_t)c * 64 + d]); d0 += q[(4 * kv + 0) * 64 + d] * k; d1 += q[(4 * kv + 1) * 64 + d] * k; d2 += q[(4 * kv + 2) * 64 + d] * k; d3 += q[(4 * kv + 3) * 64 + d] * k; }
              const bool ok = (c * 16 + 31 <= pos); sc[c] = ok ? d0 : -1e30f; sc[SP + c] = ok ? d1 : -1e30f; sc[2 * SP + c] = ok ? d2 : -1e30f; sc[3 * SP + c] = ok ? d3 : -1e30f; }
          __syncthreads();
          softmax_rows(sc, NC);
          if (tid < 256) { const int h = tid >> 6, d = tid & 63; float a = 0.f; for (int c = 0; c < NC; ++c) a += sc[h * SP + c] * bf2f(vc[(size_t)c * 64 + d]);
              oo[tid] += ((const float*)(ws + WS_NG))[m * 32 + (4 * kv + h) * 3 + 0] * a; }
          for (int c = tid; c < 1032; c += 512) imp[c] = c < NC ? (sc[c] + sc[SP + c]) + (sc[2 * SP + c] + sc[3 * SP + c]) : 0.f;
          __syncthreads(); }
        for (int j = tid; j < n_sel; j += 512) { float s = 0.f;
            for (int i = 0; i < 4; ++i) { const int c = 4 * j + i; const float a = (c < NC && c < n_ch) ? imp[c] : 0.f; const float bsh = (c >= 1 && c - 1 < NC) ? imp[c - 1] : 0.f; s += a + bsh; }
            const bool forced = (j == 0) || (j == cur) || (j == cur - 1), valid = (j * 64 <= pos);
            blk[j] = forced ? 1e4f : (valid ? s : -1e4f); }
        __syncthreads();
        if (tid == 0) { for (int k = 0; k < 16; ++k) { int bi = 0; float bv = -3e38f; for (int j = 0; j < n_sel; ++j) if (blk[j] > bv) { bv = blk[j]; bi = j; } idx[k] = bi; blk[bi] = -3e38f; } }
        __syncthreads();
        { const float* ck = in[I_CKS]; const float* cv = in[I_CVS];
          for (int s = tid; s < 1024; s += 512) { const int bi = idx[s >> 6], kpos = bi * 64 + (s & 63); const bool ok = (bi * 64 <= pos) && (kpos <= pos);
              float d0 = 0.f, d1 = 0.f, d2 = 0.f, d3 = 0.f;
              if (ok) for (int d = 0; d < 64; ++d) { const float k = sel_fetch(ws, ck, pt, smp, b, kv, kpos, d, WS_KS); d0 += q[512 + (4 * kv + 0) * 64 + d] * k; d1 += q[512 + (4 * kv + 1) * 64 + d] * k; d2 += q[512 + (4 * kv + 2) * 64 + d] * k; d3 += q[512 + (4 * kv + 3) * 64 + d] * k; }
              sc[s] = ok ? d0 : -1e30f; sc[SP + s] = ok ? d1 : -1e30f; sc[2 * SP + s] = ok ? d2 : -1e30f; sc[3 * SP + s] = ok ? d3 : -1e30f; }
          __syncthreads();
          softmax_rows(sc, 1024);
          if (tid < 256) { const int h = tid >> 6, d = tid & 63; float a = 0.f;
              for (int s = 0; s < 1024; ++s) { const float p = sc[h * SP + s]; if (p != 0.f) a += p * sel_fetch(ws, cv, pt, smp, b, kv, idx[s >> 6] * 64 + (s & 63), d, WS_VS); }
              oo[tid] += ((const float*)(ws + WS_NG))[m * 32 + (4 * kv + h) * 3 + 1] * a; }
          __syncthreads(); }
        { const int nw = smp ? WIN + DECS : WIN;
          const float* ckw = in[I_CKW]; const float* cvw = in[I_CVW];
          for (int s = tid; s < nw; s += 512) { const int kpos = smp ? PAST - WIN + s : pos - (WIN - 1) + s; const int dp = pos - kpos; const bool ok = dp >= 0 && dp < WIN && kpos >= 0;
              float d0 = 0.f, d1 = 0.f, d2 = 0.f, d3 = 0.f;
              if (ok) for (int d = 0; d < 64; ++d) { float k;
                  if (!smp) k = bf2f(((const bf16*)(ws + WS_KW))[((size_t)b * SEQ + kpos) * 128 + kv * 64 + d]);
                  else if (s < WIN) k = ckw[((size_t)b * WIN + s) * 128 + kv * 64 + d]; else k = bf2f(((const bf16*)(ws + WS_KW))[((size_t)MP + 4 * b + (s - WIN)) * 128 + kv * 64 + d]);
                  d0 += q[512 + (4 * kv + 0) * 64 + d] * k; d1 += q[512 + (4 * kv + 1) * 64 + d] * k; d2 += q[512 + (4 * kv + 2) * 64 + d] * k; d3 += q[512 + (4 * kv + 3) * 64 + d] * k; }
              sc[s] = ok ? d0 : -1e30f; sc[SP + s] = ok ? d1 : -1e30f; sc[2 * SP + s] = ok ? d2 : -1e30f; sc[3 * SP + s] = ok ? d3 : -1e30f; }
          __syncthreads();
          softmax_rows(sc, nw);
          if (tid < 256) { const int h = tid >> 6, d = tid & 63; float a = 0.f;
              for (int s = 0; s < nw; ++s) { const float p = sc[h * SP + s]; if (p == 0.f) continue; const int kpos = smp ? PAST - WIN + s : pos - (WIN - 1) + s; float v;
                  if (!smp) v = bf2f(((const bf16*)(ws + WS_VW))[((size_t)b * SEQ + kpos) * 128 + kv * 64 + d]);
                  else if (s < WIN) v = cvw[((size_t)b * WIN + s) * 128 + kv * 64 + d]; else v = bf2f(((const bf16*)(ws + WS_VW))[((size_t)MP + 4 * b + (s - WIN)) * 128 + kv * 64 + d]);
                  a += p * v; }
              oo[tid] += ((const float*)(ws + WS_NG))[m * 32 + (4 * kv + h) * 3 + 2] * a; }
          __syncthreads(); }
        if (tid < 256) { const float ref = oo[tid], got = bf2f(((const bf16*)(ws + WS_OAB))[m * 1024 + 512 + (4 * kv) * 64 + tid]);
            float e = fabsf(got - ref), r = fabsf(ref); e = wave_max(e); r = wave_max(r);
            if ((tid & 63) == 0) { __hip_atomic_fetch_max((LAS unsigned*)red, __float_as_uint(e), __ATOMIC_RELAXED, __HIP_MEMORY_SCOPE_WORKGROUP); __hip_atomic_fetch_max((LAS unsigned*)red + 1, __float_as_uint(r), __ATOMIC_RELAXED, __HIP_MEMORY_SCOPE_WORKGROUP); } }
        __syncthreads();
    }
    emax = red[0]; rmax = red[1];
    __syncthreads();
}

__device__ __forceinline__ void check_compress(const unsigned char* ws, const float* const* in, const float* out, LAS unsigned char* L, bool smp, int b, int c, int kv, int which, float& emax, float& rmax) {
    const int tid = tidx(), p = tid >> 6, j = tid & 63;
    LAS float* part = (LAS float*)L; LAS float* hdn = part + 512; LAS float* res = hdn + 64;
    const float* w1 = in[which ? I_WCV1 : I_WCK1]; const float* w2 = in[which ? I_WCV2 : I_WCK2]; const float* pe = in[which ? I_PEV : I_PEK];
    const float* cache = in[which ? I_CVC : I_CKC]; const int* pt = (const int*)in[I_PT];
    __syncthreads();
    float s = 0.f;
    for (int i = 256 * p; i < 256 * p + 256; ++i) { const int t = 16 * c + (i >> 6), d = i & 63; float x;
        if (!smp) x = out[(which ? O_PVC : O_PKC) + ((size_t)(b * SEQ + t) * 2 + kv) * 64 + d];
        else { const int pg = pt[b * NPAGES + (t >> 7)]; x = cache[(((size_t)pg * 128 + (t & 127)) * 2 + kv) * 64 + d]; }
        s += (x + pe[i]) * w1[(size_t)i * 64 + j]; }
    part[p * 64 + j] = s;
    __syncthreads();
    if (tid < 64) { float a = 0.f; for (int q = 0; q < 8; ++q) a += part[q * 64 + tid]; const float u = 0.7978845608028654f * (a + 0.044715f * a * a * a); hdn[tid] = 0.5f * a * (1.f + tanhf(u)); }
    __syncthreads();
    if (tid < 64) { float o = 0.f; for (int q = 0; q < 64; ++q) o += hdn[q] * w2[q * 64 + tid]; res[tid] = o; }
    __syncthreads();
    if (tid < 64) { float o = res[tid];
        if (which == 0) { float ss = 0.f; for (int q = 0; q < 64; ++q) ss += res[q] * res[q]; o = o * (1.f / sqrtf(ss / 64.f + EPS)) * in[I_GKC][tid]; }
        const int nc = smp ? NCS : NCP; const float got = bf2f(((const bf16*)(ws + (smp ? (which ? WS_VCS : WS_KCS) : (which ? WS_VCP : WS_KCP))))[((size_t)(b * 2 + kv) * nc + c) * 64 + tid]);
        float e = fabsf(got - o), r = fabsf(o); e = wave_max(e); r = wave_max(r); if (tid == 0) { res[64] = e; res[65] = r; } }
    __syncthreads();
    emax = res[64]; rmax = res[65];
    __syncthreads();
}
}
#endif

#ifndef MK_N_LAUNCHES
#define MK_N_LAUNCHES 1
#endif
constexpr int N_PHASES = 9;
struct Args { const void* in[N_IN]; float* out; unsigned char* ws; int ph_lo, ph_hi; };
static_assert(sizeof(Args) == (N_IN + 2) * 8 + 8, "no padding bytes in Args");

__global__ void __launch_bounds__(NWAVES * 64, 2) hybrid_fwd(Args args) {
    extern __shared__ __attribute__((aligned(16))) unsigned char lds[];
    Frame F;
    F.lds = (LAS unsigned char*)lds;
    F.MISC = (volatile LAS unsigned*)(F.lds + MISC_OFF);
    F.tid = tidx(); F.lane = F.tid & 63; F.wave = __builtin_amdgcn_readfirstlane(F.tid >> 6);
    F.G = gridDim.x; { const int bx = blockIdx.x; F.vcu = (F.G % 8 == 0) ? (bx % 8) * (F.G / 8) + bx / 8 : bx; }
    F.ws = args.ws; F.out = args.out; F.ctl = (gu32*)(args.ws + WS_CTL);
#pragma unroll
    for (int i = 0; i < N_IN; ++i) F.in[i] = (const float*)args.in[i];
    for (int u = F.tid; u < 64; u += NWAVES * 64) ((LAS unsigned*)(F.lds + MISC_OFF))[u] = 0u;
    __syncthreads();
    XcdBarrier bar; bar.bar = (unsigned*)(F.ctl + CW_BAR); bar.x = 0; bar.st = nullptr;
    if (MK_N_LAUNCHES == 1) bar = xcd_barrier_post((unsigned*)(F.ctl + CW_BAR), F.MISC + 8);
#define GRID_BAR() do { if (MK_N_LAUNCHES == 1) xcd_barrier(bar); } while (0)
    const int lo = args.ph_lo, hi = args.ph_hi;
#ifdef TIME_PROBE_A
    unsigned long long* tsp = (unsigned long long*)(args.ws + WS_DBG + 65536);
#define STAMP(k) do { if (blockIdx.x == 0 && F.tid == 0) tsp[k] = __builtin_amdgcn_s_memrealtime(); } while (0)
    STAMP(0);
#else
#define STAMP(k) do { } while (0)
#endif
#ifndef PH_MASK
#define PH_MASK 0x1ff
#endif
#define FRESH_IDS() do { const int t_ = tidx(); F.tid = t_; F.lane = t_ & 63; } while (0)
#define IN(k) (((PH_MASK >> (k)) & 1) && lo <= (k) && (k) < hi)
#define BOTH(k) (IN(k) && IN((k) + 1))
#ifndef DUP_MASK
#define DUP_MASK 0
#endif
#define REP(k) for (int rep_ = 0; rep_ < (((DUP_MASK >> (k)) & 1) ? 2 : 1); ++rep_)

    if (IN(0)) { FRESH_IDS(); REP(0) p0_prologue(F); if (BOTH(0)) GRID_BAR(); STAMP(1); }

    if (IN(1)) { FRESH_IDS();
#ifndef CP_SPEC
#define CP_SPEC 0
#endif
        constexpr int NCPW = CP_SPEC;
        if (NCPW > 0 && F.G == 256 && (int)blockIdx.x < NCPW) { REP(1) compress_tasks<true>(F, (int)blockIdx.x & 1, (int)blockIdx.x >> 1, NCPW > 0 ? NCPW / 2 : 1, DECB * NPAGES); }
        else {
        const bool spec = (NCPW > 0 && F.G == 256);
        pg8::Gemm g{WSP(bf16, WS_XN), WSP(bf16, WS_WINT), MPAD, NIN, DM}; pg8::StaticOrder S; S.init(MPAD, NIN, spec ? F.G - NCPW : F.G, spec ? (int)blockIdx.x - NCPW : (int)blockIdx.x);
        pg8::EpiIn E{F.ws, F.out};
        REP(1) pg8::gemm_phase<pg8::EpiIn, pg8::StaticOrder, true, true>(F.lds, g, S, E);
        }
        if (BOTH(1)) GRID_BAR(); STAMP(2);
    }

    if (IN(2)) { FRESH_IDS();
        STAMP(10);
        if (!(CP_SPEC > 0 && F.G == 256)) { REP(2) for (int which = 0; which < 2; ++which) compress_tasks<true>(F, which, (int)blockIdx.x, F.G, DECB * NPAGES); }
        STAMP(11);
        if (F.G == 256) compress_tasks<false>(F, (int)blockIdx.x >> 7, (int)blockIdx.x & 127, 128, 128);
        else for (int which = 0; which < 2; ++which) compress_tasks<false>(F, which, (int)blockIdx.x, F.G, 128);
        STAMP(12);
        REP(10) for (int n = F.G - 1 - (int)blockIdx.x; n < (F.G == 256 ? 256 : GMLP_UNITS); n += F.G) gmlp_unit(F, n);
        __syncthreads();
        STAMP(13);
        if (BOTH(2)) GRID_BAR(); STAMP(3);
    }

    if (IN(3)) { FRESH_IDS();
        if (F.G == 256) { if ((int)blockIdx.x >= 254) { gmlp_unit(F, 256 + ((int)blockIdx.x - 254)); __syncthreads(); } else { REP(3) compress_stage2(F, (int)blockIdx.x, 254); } }
        else { REP(3) compress_stage2(F, F.vcu, F.G); }
        if (BOTH(3)) GRID_BAR(); STAMP(4); }

    if (IN(4)) { FRESH_IDS();
        #ifndef NO_PROMPT
        REP(4) for (int pr = F.vcu; pr < 256; pr += F.G) { const int bk = pr >> 6, s = pr & 63;
            STAMP(14);
            att::nsa_prompt_unit(F.ws, bk >> 1, bk & 1, 127 - s, (char*)lds);
            STAMP(15);
            att::nsa_prompt_unit(F.ws, bk >> 1, bk & 1, s, (char*)lds);
            STAMP(16); }
#endif
#ifndef NO_SMP
        REP(9) for (int su = (int)blockIdx.x; su < 256; su += F.G) smp::nsa_sample_unit(F.ws, F.in[I_CKS], F.in[I_CVS], F.in[I_CKW], F.in[I_CVW], (const int*)F.in[I_PT], F.lds, su >> 3, (su >> 2) & 1, su & 3);
#endif
        STAMP(17);
        if (BOTH(4)) GRID_BAR(); STAMP(5);
    }

#ifdef ATT_CHECK
    {
        if (!BOTH(4)) GRID_BAR();
        const int i = (int)blockIdx.x; const int special[16] = {0, 1, 30, 31, 32, 63, 64, 65, 127, 128, 1023, 1024, 1025, 4095, 8191, 7680};
        int pos = (int)(((unsigned)i * 2654435761u) >> 19) & 8191;
#pragma unroll
        for (int k = 0; k < 16; ++k) if ((i >> 1) == k) pos = special[k];
        float e, r; float* dbg = WSP(float, WS_DBG);
        chk::check_token(F.ws, F.in, F.lds, false, i & 1, pos, e, r);
        if (F.tid == 0) dbg[i] = e / fmaxf(r, 1e-9f);
        chk::check_token(F.ws, F.in, F.lds, true, (i & 127) >> 2, i & 3, e, r);
        if (F.tid == 0) dbg[256 + i] = e / fmaxf(r, 1e-9f);
        {
            float E = 0.f; const unsigned hsh = (unsigned)i * 2246822519u;
            int cp = (int)((hsh >> 8) % 511u), cs = (int)((hsh >> 10) % 1023u); if (i == 0) { cp = 0; cs = 0; } if (i == 1) { cp = 510; cs = 1022; } if (i == 2) { cp = 509; cs = 7; } if (i == 3) { cp = 255; cs = 8; }
            for (int which = 0; which < 2; ++which) {
                chk::check_compress(F.ws, F.in, F.out, F.lds, false, i & 1, cp, (i >> 1) & 1, which, e, r); E = fmaxf(E, e / fmaxf(r, 1e-9f));
                chk::check_compress(F.ws, F.in, F.out, F.lds, true, i & 31, cs, (i >> 5) & 1, which, e, r); E = fmaxf(E, e / fmaxf(r, 1e-9f)); }
            if (F.tid == 0) dbg[512 + i] = E; }
        __syncthreads();
    }
#endif
    if (IN(5)) { FRESH_IDS();
        skinny_gemm<SkMerge, 1, true>(WSP(bf16, WS_OAB) + (size_t)MP * DM, WSP(bf16, WS_WBT), DM, DM, F.G, (int)blockIdx.x, SkMerge{F.ws});
        pg8::Gemm g{WSP(bf16, WS_OAB), WSP(bf16, WS_WBT), MP, DM, DM}; pg8::StaticOrder S; S.init(MP, DM, F.G, (int)blockIdx.x);
        pg8::EpiMerge E{WSP(bf16, WS_SG), WSP(bf16, WS_MG)};
        REP(5) pg8::gemm_phase<pg8::EpiMerge, pg8::StaticOrder, true, true>(F.lds, g, S, E);
        if (BOTH(5)) GRID_BAR(); STAMP(6);
    }

    if (IN(6)) { FRESH_IDS();
        skinny_gemm(WSP(bf16, WS_MG) + (size_t)MP * DM, WSP(bf16, WS_WOT), DM, DM, F.G, (int)blockIdx.x, SkOut{F.ws, F.in[I_XS], F.out});
        pg8::Gemm g{WSP(bf16, WS_MG), WSP(bf16, WS_WOT), MP, DM, DM}; pg8::StaticOrder S; S.init(MP, DM, F.G, (int)blockIdx.x);
        pg8::EpiOut E{F.in[I_XP], F.in[I_XS], F.out, WSP(bf16, WS_X1B), WSP(float, WS_SSQ)};
        REP(6) pg8::gemm_phase<pg8::EpiOut, pg8::StaticOrder, true, true>(F.lds, g, S, E);
        if (BOTH(6)) GRID_BAR(); STAMP(7);
    }

    if (IN(7)) { FRESH_IDS();
        skinny_gemm(WSP(bf16, WS_X1B) + (size_t)MP * DM, WSP(bf16, WS_WUP), DFF, DM, F.G, (int)blockIdx.x, SkUp{F.ws});
        pg8::Gemm g{WSP(bf16, WS_X1B), WSP(bf16, WS_WUP), MP, DFF, DM}; pg8::StaticOrder S; S.init(MP, DFF, F.G, (int)blockIdx.x);
        pg8::EpiUp E{WSP(float, WS_SSQ), WSP(bf16, WS_H)};
        REP(7) pg8::gemm_phase<pg8::EpiUp, pg8::StaticOrder, true, true>(F.lds, g, S, E);
        if (BOTH(7)) GRID_BAR(); STAMP(8);
    }

    if (IN(8)) { FRESH_IDS();
        skinny_gemm<SkDown, 4>(WSP(bf16, WS_H) + (size_t)MP * DFF, WSP(bf16, WS_WDN), DM, DFF, F.G, (int)blockIdx.x, SkDown{F.out});
        pg8::Gemm g{WSP(bf16, WS_H), WSP(bf16, WS_WDN), MP, DM, DFF}; pg8::StaticOrder S; S.init(MP, DM, F.G, (int)blockIdx.x);
        pg8::EpiDown E{F.out, WSP(bf16, WS_X1B)};
        pg8::gemm_phase<pg8::EpiDown, pg8::StaticOrder, true, true>(F.lds, g, S, E);
    }
#ifdef TIME_PROBE_A
    GRID_BAR(); STAMP(9);
    if (blockIdx.x == 0) {
        #ifndef TIME_PROBE_AE
#define TIME_PROBE_AE (TIME_PROBE_A + 1)
#endif
#ifndef TIME_PROBE_BE
#define TIME_PROBE_BE (TIME_PROBE_B + 1)
#endif
        const float da = (float)(tsp[TIME_PROBE_AE] - tsp[TIME_PROBE_A]) * 0.01f, db = (float)(tsp[TIME_PROBE_BE] - tsp[TIME_PROBE_B]) * 0.01f;
        if (F.tid == 0) F.out[O_YP] += da * 0.01f;
        for (int t = F.tid; t < 4096 * 1024; t += 512) F.out[O_YP + 1024 + t] += db * (1.f / 3000.f); }
#endif
#ifdef ATT_CHECK
    GRID_BAR();
    if (blockIdx.x == 0) { float E = 0.f; const float* dbg = WSP(float, WS_DBG);
        for (int k = 0; k < 768; ++k) { if (!((ATT_CHECK >> (k >> 8)) & 1)) continue; E = fmaxf(E, dbg[k]); }
        for (int t = F.tid; t < 1024; t += 512) F.out[O_YP + t] += E * 2000.f; }
#endif
#undef IN
#undef BOTH
}

extern "C" void kernel_launch(void* const* d_in, const int* in_sizes, int n_in, void* d_out, int out_size, void* d_ws, size_t ws_size, hipStream_t stream) {
    static int grid = 0;
    if (grid == 0) {
        if (n_in != N_IN || in_sizes[0] != MP * DM || (size_t)out_size != O_END || ws_size < WS_END) {
            fprintf(stderr, "kernel_launch: unexpected problem: n_in %d in0 %d out %d ws %zu (need %zu); nothing launched\n", n_in, n_in > 0 ? in_sizes[0] : -1, out_size, ws_size, (size_t)WS_END); grid = -1; return; }
        int dev = 0, cus = 0, per_cu = 0;
        if (hipGetDevice(&dev) != hipSuccess || hipDeviceGetAttribute(&cus, hipDeviceAttributeMultiprocessorCount, dev) != hipSuccess) { grid = -1; return; }
        if (hipFuncSetAttribute((const void*)hybrid_fwd, hipFuncAttributeMaxDynamicSharedMemorySize, LDS_BYTES) != hipSuccess) { fprintf(stderr, "kernel_launch: hipFuncSetAttribute failed\n"); grid = -1; return; }
        if (hipOccupancyMaxActiveBlocksPerMultiprocessor(&per_cu, (const void*)hybrid_fwd, NWAVES * 64, LDS_BYTES) != hipSuccess || per_cu < 1)
            fprintf(stderr, "kernel_launch: note: occupancy query reports %d workgroups per CU\n", per_cu);
        (void)hipGetLastError();
        grid = cus;
    }
    if (grid < 0) return;
    if (hipMemsetAsync((char*)d_ws + WS_CTL, 0, CTL_ZERO_BYTES, stream) != hipSuccess) return;
    Args a{};
    for (int i = 0; i < N_IN; ++i) a.in[i] = d_in[i];
    a.out = (float*)d_out; a.ws = (unsigned char*)d_ws;
    if (MK_N_LAUNCHES == 1) { a.ph_lo = 0; a.ph_hi = N_PHASES; hipLaunchKernelGGL(hybrid_fwd, dim3(grid), dim3(NWAVES * 64), LDS_BYTES, stream, a); }
    else for (int p = 0; p < N_PHASES; ++p) { a.ph_lo = p; a.ph_hi = p + 1; hipLaunchKernelGGL(hybrid_fwd, dim3(grid), dim3(NWAVES * 64), LDS_BYTES, stream, a); }
    const hipError_t le = hipPeekAtLastError();
    if (le != hipSuccess) fprintf(stderr, "kernel_launch: launch failed: %s\n", hipGetErrorName(le));
}
```

```cpp
#include <hip/hip_runtime.h>
#include <hip/hip_bf16.h>
#include <cstdio>
#include <cstdint>
#include <cmath>

constexpr int DM = 1024, SEQ = 8192, NBAT = 2, MP = NBAT * SEQ, NSMP = 128, MT = MP + NSMP, MPAD = 16640;
constexpr int AW = 512, NHEAD = 8, HD = 64, NKV = 2, DFF = 4096, INC = 4376, NIN = 4608;
constexpr int PAST = 16384, NPAGES = 128, DECB = 32, DECS = 4, WIN = 512;
constexpr int NCP = 512, NCS = 1024;
constexpr float EPS = 1e-6f;
constexpr float QC2 = 0.125f * 1.4426950408889634f;

enum { I_XP = 0, I_XS, I_CKC, I_CVC, I_CKS, I_CVS, I_CKW, I_CVW, I_PT, I_G1, I_WIN, I_LNG, I_LNB, I_WS, I_BS, I_GQ, I_GKC, I_GKS, I_GKW,
       I_WCK1, I_WCK2, I_PEK, I_WCV1, I_WCV2, I_PEV, I_WBR, I_WOUT, I_G2, I_WUP, I_WDN, N_IN };
constexpr size_t O_YP = 0, O_YS = O_YP + (size_t)MP * DM, O_PKC = O_YS + (size_t)NSMP * DM, O_PVC = O_PKC + (size_t)MP * 128, O_PKS = O_PVC + (size_t)MP * 128,
                 O_PVS = O_PKS + (size_t)MP * 128, O_PKW = O_PVS + (size_t)MP * 128, O_PVW = O_PKW + (size_t)NBAT * WIN * 128, O_PVA = O_PVW + (size_t)NBAT * WIN * 128,
                 O_SKC = O_PVA + (size_t)NBAT * 128 * AW, O_SVC = O_SKC + NSMP * 128, O_SKS = O_SVC + NSMP * 128, O_SVS = O_SKS + NSMP * 128, O_SKW = O_SVS + NSMP * 128,
                 O_SVW = O_SKW + NSMP * 128, O_SVA = O_SVW + NSMP * 128, O_END = O_SVA + (size_t)NSMP * AW;
static_assert(O_END == 25853952, "output size");

constexpr size_t al256(size_t x) { return (x + 255) & ~(size_t)255; }
constexpr size_t WS_CTL = 0, CTL_ZERO_BYTES = 32768, CTL_RESERVED = 1u << 20;
constexpr size_t WS_WINT = CTL_RESERVED;
constexpr size_t WS_WBT = WS_WINT + (size_t)NIN * DM * 2;
constexpr size_t WS_WOT = WS_WBT + (size_t)DM * DM * 2;
constexpr size_t WS_WUP = WS_WOT + (size_t)DM * DM * 2;
constexpr size_t WS_WDN = WS_WUP + (size_t)DFF * DM * 2;
constexpr size_t WS_WC1K = WS_WDN + (size_t)DM * DFF * 2;
constexpr size_t WS_WC1V = WS_WC1K + 128 * 1024 * 2;
constexpr size_t WS_WSP = WS_WC1V + 128 * 1024 * 2;
constexpr size_t WS_WSS = WS_WSP + 8 * 128 * 128 * 2;
constexpr size_t WS_ROPE = WS_WSS + 8 * 128 * 128 * 2;
constexpr size_t WS_BPART = al256(WS_ROPE + 8196 * 16 * 4);
constexpr size_t WS_GAINS = al256(WS_BPART + 2 * 32 * 64 * 4);
constexpr size_t WS_XN = al256(WS_GAINS + 3 * 64 * 4);
constexpr size_t WS_U = WS_XN + (size_t)MPAD * DM * 2;
constexpr size_t WS_GV = WS_U + (size_t)MPAD * 512 * 2;
constexpr size_t WS_QN = WS_GV + (size_t)MPAD * 512 * 2;
constexpr size_t WS_QR = WS_QN + (size_t)MPAD * 512 * 2;
constexpr size_t WS_KCA = WS_QR + (size_t)MPAD * 512 * 2;
constexpr size_t WS_VCA = WS_KCA + 2048 * 1024 * 2;
constexpr size_t KVROWS = MPAD + 256;
constexpr size_t WS_KS = WS_VCA + 2048 * 1024 * 2;
constexpr size_t WS_VS = WS_KS + KVROWS * 128 * 2;
constexpr size_t WS_KW = WS_VS + KVROWS * 128 * 2;
constexpr size_t WS_VW = WS_KW + KVROWS * 128 * 2;
constexpr size_t WS_SG = WS_VW + KVROWS * 128 * 2;
constexpr size_t WS_NG = WS_SG + (size_t)MPAD * 2048 * 2;
constexpr size_t WS_FSPK = WS_NG + (size_t)MPAD * 32 * 4;
constexpr size_t WS_FSPV = WS_FSPK + 2048 * 128 * 4;
constexpr size_t WS_FSSK = WS_FSPV + 2048 * 128 * 4;
constexpr size_t WS_FSSV = WS_FSSK + (size_t)65536 * 128 * 4;
constexpr size_t WS_KCP = WS_FSSV + (size_t)65536 * 128 * 4;
constexpr size_t WS_VCP = WS_KCP + 4 * NCP * 64 * 2;
constexpr size_t WS_KCS = WS_VCP + 4 * NCP * 64 * 2;
constexpr size_t WS_VCS = WS_KCS + (size_t)64 * NCS * 64 * 2;
constexpr size_t WS_OAB = WS_VCS + (size_t)64 * NCS * 64 * 2;
constexpr size_t WS_MG = WS_OAB + (size_t)MPAD * DM * 2;
constexpr size_t WS_X1B = WS_MG + (size_t)MPAD * DM * 2;
constexpr size_t WS_SSQ = WS_X1B + (size_t)MPAD * DM * 2;
constexpr size_t WS_H = al256(WS_SSQ + (size_t)MPAD * 16 * 4);
constexpr size_t WS_OBF = WS_H + (size_t)MPAD * DFF * 2;
constexpr size_t WS_VST = WS_OBF + (size_t)MP * 512 * 4;
constexpr size_t WS_SSQS = WS_VST + (size_t)4 * 64 * SEQ * 2;
constexpr size_t WS_DBG = WS_SSQS + 128 * 64 * 4;
constexpr size_t WS_END = WS_DBG + (1u << 20);

constexpr int CW_TMO = 0, CW_CODE = 1, CW_BAR = 4096;

constexpr int LDS_BYTES = 147456;
constexpr int MISC_OFF = LDS_BYTES - 256;
constexpr int NWAVES = 8;

#define GAS __attribute__((address_space(1)))
#define LAS __attribute__((address_space(3)))
typedef unsigned short bf16;
typedef unsigned v4u __attribute__((ext_vector_type(4)));
typedef unsigned v2u __attribute__((ext_vector_type(2)));
typedef float f32x4 __attribute__((ext_vector_type(4)));
typedef float f32x16 __attribute__((ext_vector_type(16)));
typedef short bf16x8 __attribute__((ext_vector_type(8)));
typedef GAS unsigned gu32;
#define RLX_AGENT __ATOMIC_RELAXED, __HIP_MEMORY_SCOPE_AGENT
#define LDS_WAIT() asm volatile("s_waitcnt lgkmcnt(0)" ::: "memory")
#define VM_WAIT() asm volatile("s_waitcnt vmcnt(0)" ::: "memory")
__device__ __forceinline__ int tidx() { int t = (int)threadIdx.x; asm volatile("" : "+v"(t)); return t; }
__device__ __forceinline__ unsigned f2bf(float f) { unsigned u = __builtin_bit_cast(unsigned, f); return (u + 0x7fffu + ((u >> 16) & 1u)) >> 16; }
__device__ __forceinline__ unsigned pk2(float lo, float hi) { return f2bf(lo) | (f2bf(hi) << 16); }
__device__ __forceinline__ float bf2f(unsigned h) { return __builtin_bit_cast(float, h << 16); }
__device__ __forceinline__ float bflo(unsigned w) { return __builtin_bit_cast(float, w << 16); }
__device__ __forceinline__ float bfhi(unsigned w) { return __builtin_bit_cast(float, w & 0xffff0000u); }
__device__ __forceinline__ float fast_sigmoid(float x) { return __builtin_amdgcn_rcpf(1.f + __builtin_amdgcn_exp2f(-1.4426950408889634f * x)); }
__device__ __forceinline__ float gelu_tanh(float x) {
    const float u = 1.5957691216057308f * (x + 0.044715f * x * x * x);
    return x * __builtin_amdgcn_rcpf(1.f + __builtin_amdgcn_exp2f(-1.4426950408889634f * u));
}
__device__ __forceinline__ float wave_sum(float v) {
#pragma unroll
    for (int o = 1; o < 64; o <<= 1) v += __shfl_xor(v, o);
    return v;
}
__device__ __forceinline__ float wave_sum_dpp(float v) {
    v += __builtin_bit_cast(float, __builtin_amdgcn_update_dpp(0, __builtin_bit_cast(int, v), 0x111, 0xF, 0xF, true));
    v += __builtin_bit_cast(float, __builtin_amdgcn_update_dpp(0, __builtin_bit_cast(int, v), 0x112, 0xF, 0xF, true));
    v += __builtin_bit_cast(float, __builtin_amdgcn_update_dpp(0, __builtin_bit_cast(int, v), 0x114, 0xF, 0xF, true));
    v += __builtin_bit_cast(float, __builtin_amdgcn_update_dpp(0, __builtin_bit_cast(int, v), 0x118, 0xF, 0xF, true));
    v += __builtin_bit_cast(float, __builtin_amdgcn_update_dpp(0, __builtin_bit_cast(int, v), 0x142, 0xA, 0xF, false));
    v += __builtin_bit_cast(float, __builtin_amdgcn_update_dpp(0, __builtin_bit_cast(int, v), 0x143, 0xC, 0xF, false));
    return __builtin_bit_cast(float, __builtin_amdgcn_readlane(__builtin_bit_cast(int, v), 63));
}
__device__ __forceinline__ float wave_max_dpp(float v) {
    v = fmaxf(v, __builtin_bit_cast(float, __builtin_amdgcn_update_dpp(__builtin_bit_cast(int, v), __builtin_bit_cast(int, v), 0x111, 0xF, 0xF, false)));
    v = fmaxf(v, __builtin_bit_cast(float, __builtin_amdgcn_update_dpp(__builtin_bit_cast(int, v), __builtin_bit_cast(int, v), 0x112, 0xF, 0xF, false)));
    v = fmaxf(v, __builtin_bit_cast(float, __builtin_amdgcn_update_dpp(__builtin_bit_cast(int, v), __builtin_bit_cast(int, v), 0x114, 0xF, 0xF, false)));
    v = fmaxf(v, __builtin_bit_cast(float, __builtin_amdgcn_update_dpp(__builtin_bit_cast(int, v), __builtin_bit_cast(int, v), 0x118, 0xF, 0xF, false)));
    v = fmaxf(v, __builtin_bit_cast(float, __builtin_amdgcn_update_dpp(__builtin_bit_cast(int, v), __builtin_bit_cast(int, v), 0x142, 0xA, 0xF, false)));
    v = fmaxf(v, __builtin_bit_cast(float, __builtin_amdgcn_update_dpp(__builtin_bit_cast(int, v), __builtin_bit_cast(int, v), 0x143, 0xC, 0xF, false)));
    return __builtin_bit_cast(float, __builtin_amdgcn_readlane(__builtin_bit_cast(int, v), 63));
}
__device__ __forceinline__ float wave_max(float v) {
#pragma unroll
    for (int o = 1; o < 64; o <<= 1) v = fmaxf(v, __shfl_xor(v, o));
    return v;
}
__host__ __device__ __forceinline__ int dmap(int s) { if (s >= 16) return s; const int f = s >> 3, p = s & 7; return p < 4 ? 4 * f + p : 4 + 4 * f + p; }
__host__ __device__ __forceinline__ int win_map(int j) {
    const int t = j >> 8, L = j & 255;
    if (t < 4) return j;
    const int h = (L >> 5) & 3, s = ((L >> 7) << 5) | (L & 31);
    if (t < 6) return 1024 + ((t - 4) * 4 + h) * 64 + dmap(s);
    if (t == 6) return 1536 + L;
    if (t == 7) return 1792 + (h >> 1) * 128 + (h & 1) * 64 + dmap(s);
    if (t == 8) return 2048 + (h >> 1) * 128 + (h & 1) * 64 + dmap(s);
    if (t < 17) return 2328 + ((L >> 7) ? 1024 : 0) + 128 * (t - 9) + (L & 127);
    return L < 24 ? 2304 + L : -1;
}
namespace pg8 {
#define PG8_LAS __attribute__((address_space(3)))
typedef unsigned short bf16_t;
typedef short bf16x8 __attribute__((ext_vector_type(8)));
typedef float f32x4 __attribute__((ext_vector_type(4)));
typedef unsigned u32x4 __attribute__((ext_vector_type(4)));
constexpr int BM = 256, BK = 64, HALF = 128, HTB = HALF * BK * 2  , STAGE_BYTES = 8 * HTB, NXCD = 8, WGM = 8;

__host__ __device__ __forceinline__ int lds_byte(int r, int c) { const int st = (r >> 4) * 2 + (c >> 5), rr = r & 15, cc = c & 31, ob = rr * 64 + cc * 2; return st * 1024 + (ob ^ (((ob >> 9) & 1) << 5)); }
__host__ __device__ __forceinline__ void stage_rc(int b, int& R, int& C) { const int st = b / 1024, sb = b % 1024, swz = sb ^ (((sb >> 9) & 1) << 5); R = (st >> 1) * 16 + swz / 64; C = (st & 1) * 32 + (swz % 64) / 2; }
__host__ __device__ __forceinline__ int perm32(int rho) { const int n = rho >> 4, i = rho & 15; return 8 * (i >> 2) + 4 * n + (i & 3); }

struct Unit { int pm, pn; };
struct Gemm { const bf16_t* A; const bf16_t* Bt; int M, N, K; };

struct StaticOrder {
    int nM, nN, nwg, G, c;
    __host__ __device__ void init(int M, int N, int G_, int c_) { nM = M / BM; nN = N / BM; nwg = nM * nN; G = G_; c = c_; }
    __host__ __device__ bool next(int i, Unit& u) const {
        const long L = (long)i * G + c; if (L >= nwg) return false;
        int wgid = (int)L; { const int q = nwg / NXCD, r = nwg % NXCD, xcd = wgid % NXCD, off = wgid / NXCD; wgid = (xcd < r ? xcd * (q + 1) : r * (q + 1) + (xcd - r) * q) + off; }
        const int nig = WGM * nN, gid = wgid / nig, fm = gid * WGM, gsz = (nM - fm) < WGM ? (nM - fm) : WGM;
        u.pm = fm + ((wgid % nig) % gsz); u.pn = (wgid % nig) / gsz; return true;
    }
    __device__ __forceinline__ void a_ready(const Unit&) const {}
    __device__ __forceinline__ void done(const Unit&) const {}
};

__device__ __forceinline__ unsigned cvt_pk_bf16(float lo, float hi) { unsigned r; asm volatile("v_cvt_pk_bf16_f32 %0, %1, %2" : "=v"(r) : "v"(lo), "v"(hi)); return r; }
typedef float f32x2 __attribute__((ext_vector_type(2)));
__device__ __forceinline__ u32x4 pack8(const f32x4 a, const f32x4 b) { u32x4 w; w.x = cvt_pk_bf16(a[0], a[1]); w.y = cvt_pk_bf16(a[2], a[3]); w.z = cvt_pk_bf16(b[0], b[1]); w.w = cvt_pk_bf16(b[2], b[3]); return w; }
typedef unsigned u32x2 __attribute__((ext_vector_type(2)));

struct EpiIn {
    static constexpr bool PERM = true, AFTER_DRAIN = false, HAS_MID = false;
    unsigned char* ws; float* out;
    __device__ __forceinline__ void operator()(const f32x4 (&acc)[2][2][4][2], const Unit& u, int wr, int wc, int fr, int fq) const { asm volatile("" : "+v"(fr));
        const int pn = u.pn, rbase = u.pm * BM + wr * 64 + fr;
        if (pn < 4) {
            bf16_t* dst = (bf16_t*)(ws + (pn < 2 ? WS_U : WS_GV)) + (pn & 1) * 256 + wc * 32 + 8 * fq;
#pragma unroll
            for (int ai = 0; ai < 2; ++ai)
#pragma unroll
                for (int m = 0; m < 4; ++m) { const int row = rbase + ai * HALF + m * 16;
#pragma unroll
                    for (int bj = 0; bj < 2; ++bj) { f32x4 v0 = acc[ai][bj][m][0], v1 = acc[ai][bj][m][1];
#pragma unroll
                        for (int i = 0; i < 4; ++i) { v0[i] = gelu_tanh(v0[i]); v1[i] = gelu_tanh(v1[i]); }
                        *(u32x4*)(dst + (size_t)row * 512 + bj * HALF) = pack8(v0, v1); } }
        } else if (pn < 6 || pn == 7 || pn == 8) {
            const bool isq = pn < 6, isk = isq || wc < 2;
            const float* g = (const float*)(ws + WS_GAINS) + (isq ? 0 : (pn == 7 ? 64 : 128)); const float* rope = (const float*)(ws + WS_ROPE);
            const int d1 = fq < 2 ? 4 * fq : 8 * fq, d2 = fq < 2 ? 8 + 4 * fq : 8 * fq + 4, d3 = 32 + 8 * fq;
            f32x4 g1 = {1.f, 1.f, 1.f, 1.f}, g2 = g1, g3a = g1, g3b = g1;
            if (isk) { g1 = *(const f32x4*)(g + d1); g2 = *(const f32x4*)(g + d2); g3a = *(const f32x4*)(g + d3); g3b = *(const f32x4*)(g + d3 + 4); }
            const float osc = isq ? QC2 : 1.f;
#pragma unroll
            for (int ai = 0; ai < 2; ++ai)
#pragma unroll
                for (int m = 0; m < 4; ++m) { const int row = rbase + ai * HALF + m * 16;
                    f32x4 a = acc[ai][0][m][0], b = acc[ai][0][m][1], c = acc[ai][1][m][0], d = acc[ai][1][m][1];
                    f32x4 ra = a, rb = b;
                    if (isk) {
                        float ss = (a[0] * a[0] + a[1] * a[1]) + (a[2] * a[2] + a[3] * a[3]) + (b[0] * b[0] + b[1] * b[1]) + (b[2] * b[2] + b[3] * b[3])
                                 + (c[0] * c[0] + c[1] * c[1]) + (c[2] * c[2] + c[3] * c[3]) + (d[0] * d[0] + d[1] * d[1]) + (d[2] * d[2] + d[3] * d[3]);
                        ss += __shfl_xor(ss, 16); ss += __shfl_xor(ss, 32);
                        const float rstd = 1.f / sqrtf(ss * (1.f / 64.f) + EPS);
                        a = a * rstd * g1; b = b * rstd * g2; c = c * rstd * g3a; d = d * rstd * g3b;
                        const int pidx = row < MP ? (row & (SEQ - 1)) : SEQ + ((row - MP) & 3);
                        f32x4 cs = {1.f, 1.f, 1.f, 1.f}, sn = {0.f, 0.f, 0.f, 0.f};
                        if (fq < 2) { cs = *(const f32x4*)(rope + pidx * 16 + 4 * fq); sn = *(const f32x4*)(rope + pidx * 16 + 8 + 4 * fq); }
                        ra = a * cs - b * sn; rb = b * cs + a * sn;
                    }
                    if (isq) {
                        const int head = (pn - 4) * 4 + wc; bf16_t* qn = (bf16_t*)(ws + WS_QN) + (size_t)row * 512 + head * 64; bf16_t* qr = (bf16_t*)(ws + WS_QR) + (size_t)row * 512 + head * 64;
                        const f32x4 cc = c * osc, dd = d * osc;
                        { f32x4 x = a * osc, y = b * osc; u32x2 w; w.x = cvt_pk_bf16(x[0], x[1]); w.y = cvt_pk_bf16(x[2], x[3]); *(u32x2*)(qn + d1) = w; w.x = cvt_pk_bf16(y[0], y[1]); w.y = cvt_pk_bf16(y[2], y[3]); *(u32x2*)(qn + d2) = w; }
                        { f32x4 x = ra * osc, y = rb * osc; u32x2 w; w.x = cvt_pk_bf16(x[0], x[1]); w.y = cvt_pk_bf16(x[2], x[3]); *(u32x2*)(qr + d1) = w; w.x = cvt_pk_bf16(y[0], y[1]); w.y = cvt_pk_bf16(y[2], y[3]); *(u32x2*)(qr + d2) = w; }
                        const u32x4 w3 = pack8(cc, dd); *(u32x4*)(qn + d3) = w3; *(u32x4*)(qr + d3) = w3;
                    } else {
                        const int kvh = wc & 1; const bool kw = (pn == 8);
                        bf16_t* bd = (bf16_t*)(ws + (isk ? (kw ? WS_KW : WS_KS) : (kw ? WS_VW : WS_VS))) + (size_t)row * 128 + kvh * 64;
                        { u32x2 w; w.x = cvt_pk_bf16(ra[0], ra[1]); w.y = cvt_pk_bf16(ra[2], ra[3]); *(u32x2*)(bd + d1) = w; w.x = cvt_pk_bf16(rb[0], rb[1]); w.y = cvt_pk_bf16(rb[2], rb[3]); *(u32x2*)(bd + d2) = w; }
                        *(u32x4*)(bd + d3) = pack8(c, d);
                        float* so = nullptr;
                        if (row < MP) { if (!kw) so = out + (isk ? O_PKS : O_PVS) + (size_t)row * 128; else { const int t = row & (SEQ - 1), b = row >> 13; if (t >= SEQ - WIN) so = out + (isk ? O_PKW : O_PVW) + ((size_t)b * WIN + (t - (SEQ - WIN))) * 128; } }
                        else if (row < MT) so = out + (kw ? (isk ? O_SKW : O_SVW) : (isk ? O_SKS : O_SVS)) + (size_t)(row - MP) * 128;
                        if (so) { so += kvh * 64; *(f32x4*)(so + d1) = ra; *(f32x4*)(so + d2) = rb; *(f32x4*)(so + d3) = c; *(f32x4*)(so + d3 + 4) = d; }
                    }
                }
        } else if (pn == 6) {
#pragma unroll
            for (int ai = 0; ai < 2; ++ai)
#pragma unroll
                for (int m = 0; m < 4; ++m) { const int row = rbase + ai * HALF + m * 16;
#pragma unroll
                    for (int bj = 0; bj < 2; ++bj) { const f32x4 v0 = acc[ai][bj][m][0], v1 = acc[ai][bj][m][1]; const int col = wc * 32 + 8 * fq;
                        if (row < MT) { float* so = out + (row < MP ? (bj ? O_PVC : O_PKC) + (size_t)row * 128 : (bj ? O_SVC : O_SKC) + (size_t)(row - MP) * 128) + col; *(f32x4*)so = v0; *(f32x4*)(so + 4) = v1; }
                        if (row < MP) { bf16_t* ca = (bf16_t*)(ws + (bj ? WS_VCA : WS_KCA)) + ((size_t)(row >> 4) * 2 + (wc >> 1)) * 1024 + (row & 15) * 64 + (wc & 1) * 32 + 8 * fq; *(u32x4*)ca = pack8(v0, v1); } } }
        } else if (pn < 17) {
            bf16_t* dst = (bf16_t*)(ws + WS_SG) + (pn - 9) * 128 + wc * 32 + 8 * fq;
#pragma unroll
            for (int ai = 0; ai < 2; ++ai)
#pragma unroll
                for (int m = 0; m < 4; ++m) { const int row = rbase + ai * HALF + m * 16;
                    f32x4 a0 = acc[ai][0][m][0], a1 = acc[ai][0][m][1], b0 = acc[ai][1][m][0], b1 = acc[ai][1][m][1]; f32x4 r0, r1, s0, s1;
#pragma unroll
                    for (int i = 0; i < 4; ++i) { a0[i] = fminf(fmaxf(a0[i], -30.f), 30.f); a1[i] = fminf(fmaxf(a1[i], -30.f), 30.f); b0[i] = fminf(fmaxf(b0[i], -30.f), 30.f); b1[i] = fminf(fmaxf(b1[i], -30.f), 30.f); }
#pragma unroll
                    for (int i = 0; i < 4; ++i) { const float ea0 = 1.f + __builtin_amdgcn_exp2f(-1.4426950408889634f * a0[i]), ea1 = 1.f + __builtin_amdgcn_exp2f(-1.4426950408889634f * a1[i]);
                        const float eb0 = 1.f + __builtin_amdgcn_exp2f(-1.4426950408889634f * b0[i]), eb1 = 1.f + __builtin_amdgcn_exp2f(-1.4426950408889634f * b1[i]);
                        r0[i] = eb0 * __builtin_amdgcn_rcpf(ea0); r1[i] = eb1 * __builtin_amdgcn_rcpf(ea1); s0[i] = __builtin_amdgcn_rcpf(eb0); s1[i] = __builtin_amdgcn_rcpf(eb1); }
                    *(u32x4*)(dst + (size_t)row * 2048) = pack8(r0, r1); *(u32x4*)(dst + (size_t)row * 2048 + 1024) = pack8(s0, s1); }
        } else {
            if (wc == 0 && fq < 3) {
#pragma unroll
                for (int ai = 0; ai < 2; ++ai)
#pragma unroll
                    for (int m = 0; m < 4; ++m) { const int row = rbase + ai * HALF + m * 16; f32x4 v0 = acc[ai][0][m][0], v1 = acc[ai][0][m][1];
#pragma unroll
                        for (int i = 0; i < 4; ++i) { v0[i] = fast_sigmoid(v0[i]); v1[i] = fast_sigmoid(v1[i]); }
                        float* d = (float*)(ws + WS_NG) + (size_t)row * 32 + 8 * fq; *(f32x4*)d = v0; *(f32x4*)(d + 4) = v1; }
            }
        }
    }
};

__device__ __forceinline__ void unpack8(const u32x4 w, float (&f)[8]) {
    f[0] = __builtin_bit_cast(float, w.x << 16); f[1] = __builtin_bit_cast(float, w.x & 0xffff0000u); f[2] = __builtin_bit_cast(float, w.y << 16); f[3] = __builtin_bit_cast(float, w.y & 0xffff0000u);
    f[4] = __builtin_bit_cast(float, w.z << 16); f[5] = __builtin_bit_cast(float, w.z & 0xffff0000u); f[6] = __builtin_bit_cast(float, w.w << 16); f[7] = __builtin_bit_cast(float, w.w & 0xffff0000u);
}
struct EpiMerge {
    static constexpr bool PERM = true, AFTER_DRAIN = false, HAS_MID = true;
    const bf16_t* SG; bf16_t* MG;
    __device__ __forceinline__ void mid(f32x4 (&acc)[2][2][4][2], const Unit& u, int wr, int wc, int fr, int fq) const { asm volatile("" : "+v"(fr));
        const int row0 = u.pm * BM + wr * 64 + fr, col0 = u.pn * BM + wc * 32 + 8 * fq;
#pragma unroll
        for (int ai = 0; ai < 2; ++ai)
#pragma unroll
            for (int m = 0; m < 4; ++m) { const size_t row = (size_t)(row0 + ai * HALF + m * 16);
#pragma unroll
                for (int bj = 0; bj < 2; ++bj) { const int col = col0 + bj * HALF; float rg[8]; unpack8(*(const u32x4*)(SG + row * 2048 + col), rg);
#pragma unroll
                    for (int i = 0; i < 4; ++i) { acc[ai][bj][m][0][i] *= rg[i]; acc[ai][bj][m][1][i] *= rg[4 + i]; } } }
    }
    __device__ __forceinline__ void operator()(const f32x4 (&acc)[2][2][4][2], const Unit& u, int wr, int wc, int fr, int fq) const { asm volatile("" : "+v"(fr));
        const int row0 = u.pm * BM + wr * 64 + fr, col0 = u.pn * BM + wc * 32 + 8 * fq;
#pragma unroll
        for (int ai = 0; ai < 2; ++ai)
#pragma unroll
            for (int m = 0; m < 4; ++m) { const size_t row = (size_t)(row0 + ai * HALF + m * 16);
#pragma unroll
                for (int bj = 0; bj < 2; ++bj) { const int col = col0 + bj * HALF; float gb[8]; unpack8(*(const u32x4*)(SG + row * 2048 + 1024 + col), gb);
                    const f32x4 v0 = acc[ai][bj][m][0], v1 = acc[ai][bj][m][1]; f32x4 o0, o1;
#pragma unroll
                    for (int i = 0; i < 4; ++i) { o0[i] = gb[i] * v0[i]; o1[i] = gb[4 + i] * v1[i]; }
                    *(u32x4*)(MG + row * DM + col) = pack8(o0, o1); } }
    }
};
__device__ __forceinline__ float* yrow(float* out, int row) { return row < MP ? out + O_YP + (size_t)row * DM : out + O_YS + (size_t)(row - MP) * DM; }
struct EpiOut {
    static constexpr bool PERM = true, AFTER_DRAIN = false, HAS_MID = false;
    const float* xp; const float* xs; float* out; bf16_t* X1B; float* SSQ;
    __device__ __forceinline__ void operator()(const f32x4 (&acc)[2][2][4][2], const Unit& u, int wr, int wc, int fr, int fq) const { asm volatile("" : "+v"(fr));
        const int row0 = u.pm * BM + wr * 64 + fr, col0 = u.pn * BM + wc * 32 + 8 * fq;
#pragma unroll
        for (int ai = 0; ai < 2; ++ai)
#pragma unroll
            for (int m = 0; m < 4; ++m) { const int row = row0 + ai * HALF + m * 16; float ss = 0.f;
                const float* xr = xp + (size_t)row * DM; if (row >= MP) xr = xs + (size_t)(row - MP) * DM;
#pragma unroll
                for (int bj = 0; bj < 2; ++bj) { const int col = col0 + bj * HALF; f32x4 v0 = acc[ai][bj][m][0], v1 = acc[ai][bj][m][1];
                    if (row < MT) { v0 = v0 + *(const f32x4*)(xr + col); v1 = v1 + *(const f32x4*)(xr + col + 4); }
                    ss += (v0[0] * v0[0] + v0[1] * v0[1]) + (v0[2] * v0[2] + v0[3] * v0[3]) + (v1[0] * v1[0] + v1[1] * v1[1]) + (v1[2] * v1[2] + v1[3] * v1[3]);
                    *(u32x4*)(X1B + (size_t)row * DM + col) = pack8(v0, v1); }
                ss += __shfl_xor(ss, 16); ss += __shfl_xor(ss, 32);
                if (fq == 0) SSQ[(size_t)row * 16 + u.pn * 4 + wc] = ss; }
    }
};
struct EpiUp {
    static constexpr bool PERM = true, AFTER_DRAIN = false, HAS_MID = false;
    const float* SSQ; bf16_t* H;
    __device__ __forceinline__ void operator()(const f32x4 (&acc)[2][2][4][2], const Unit& u, int wr, int wc, int fr, int fq) const { asm volatile("" : "+v"(fr));
        const int row0 = u.pm * BM + wr * 64 + fr, col0 = u.pn * BM + wc * 32 + 8 * fq;
#pragma unroll
        for (int ai = 0; ai < 2; ++ai)
#pragma unroll
            for (int m = 0; m < 4; ++m) { const size_t row = (size_t)(row0 + ai * HALF + m * 16);
                const f32x4 s0 = *(const f32x4*)(SSQ + row * 16), s1 = *(const f32x4*)(SSQ + row * 16 + 4), s2 = *(const f32x4*)(SSQ + row * 16 + 8), s3 = *(const f32x4*)(SSQ + row * 16 + 12);
                const f32x4 st = (s0 + s1) + (s2 + s3); const float rstd = 1.f / sqrtf(((st[0] + st[1]) + (st[2] + st[3])) * (1.f / DM) + EPS);
#pragma unroll
                for (int bj = 0; bj < 2; ++bj) { f32x4 v0 = acc[ai][bj][m][0] * rstd, v1 = acc[ai][bj][m][1] * rstd;
#pragma unroll
                    for (int i = 0; i < 4; ++i) { const float a = fmaxf(v0[i], 0.f), b = fmaxf(v1[i], 0.f); v0[i] = a * a; v1[i] = b * b; }
                    *(u32x4*)(H + row * DFF + col0 + bj * HALF) = pack8(v0, v1); } }
    }
};
struct EpiDown {
    static constexpr bool PERM = true, AFTER_DRAIN = false, HAS_MID = false;
    float* out; const bf16_t* X1B;
    __device__ __forceinline__ void operator()(const f32x4 (&acc)[2][2][4][2], const Unit& u, int wr, int wc, int fr, int fq) const { asm volatile("" : "+v"(fr));
        const int row0 = u.pm * BM + wr * 64 + fr, col0 = u.pn * BM + wc * 32 + 8 * fq;
#pragma unroll
        for (int ai = 0; ai < 2; ++ai)
#pragma unroll
            for (int m = 0; m < 4; ++m) { const int row = row0 + ai * HALF + m * 16;
                if (row < MT) { float* y = yrow(out, row) + col0; const bf16_t* xb = X1B + (size_t)row * DM + col0;
#pragma unroll
                    for (int bj = 0; bj < 2; ++bj) { float x[8]; unpack8(*(const u32x4*)(xb + bj * HALF), x);
                        *(f32x4*)(y + bj * HALF) = (f32x4){x[0], x[1], x[2], x[3]} + acc[ai][bj][m][0]; *(f32x4*)(y + bj * HALF + 4) = (f32x4){x[4], x[5], x[6], x[7]} + acc[ai][bj][m][1]; } } }
    }
};

template <class Epi, class Sched, bool ALIGN_EPI = false, bool SP2 = false>
__device__ __forceinline__ void gemm_phase(PG8_LAS unsigned char* lds, const Gemm g, const Sched& S, const Epi& E) {
    const int tid = tidx(), wid = __builtin_amdgcn_readfirstlane(tid >> 6), lane = tid & 63, wr = wid >> 2, wc = wid & 3, fr = lane & 15, fq = lane >> 4;
    const int K = g.K, nt = K / BK;
    unsigned voffA[2], voffB[2];
#pragma unroll
    for (int i = 0; i < 2; ++i) { int R, C; stage_rc(tid * 16 + i * 8192, R, C); const int Rb = Epi::PERM ? ((R & ~31) + perm32(R & 31)) : R;
        voffA[i] = (unsigned)(R * K + C) * 2u; voffB[i] = (unsigned)(Rb * K + C) * 2u; }
    const size_t kstep = (size_t)(BK * 2);
    const size_t hstep = (size_t)HALF * K * 2;
    const size_t tstep = 2 * hstep;
    const unsigned ldsw = (unsigned)wid * 1024u;
    const int aoff = lds_byte(wr * 64 + fr, fq * 8), boff = lds_byte(wc * 32 + fr, fq * 8);
#define PG8_SA(b, h) (((b) * 2 + (h)) * HTB)
#define PG8_SB(b, h) ((4 + (b) * 2 + (h)) * HTB)
#define PG8_STAGE(bufoff, gbase, voff) do { _Pragma("unroll") for (int _i = 0; _i < 2; ++_i) \
        __builtin_amdgcn_global_load_lds((const unsigned*)((const char*)(gbase) + (voff)[_i]), (PG8_LAS unsigned*)(lds + (bufoff) + ldsw + _i * 8192), 16, 0, 0); } while (0)
#define PG8_LDA(dst, b, h) do { _Pragma("unroll") for (int m = 0; m < 4; ++m) _Pragma("unroll") for (int k = 0; k < 2; ++k) dst[m][k] = *(const PG8_LAS bf16x8*)(lds + PG8_SA(b, h) + aoff + m * 2048 + k * 1024); } while (0)
#define PG8_LDB(dst, b, h) do { _Pragma("unroll") for (int n = 0; n < 2; ++n) _Pragma("unroll") for (int k = 0; k < 2; ++k) dst[n][k] = *(const PG8_LAS bf16x8*)(lds + PG8_SB(b, h) + boff + n * 2048 + k * 1024); } while (0)
#define PG8_MMA(ai, bj, At, Bt) do { __builtin_amdgcn_s_setprio(1); _Pragma("unroll") for (int m = 0; m < 4; ++m) _Pragma("unroll") for (int n = 0; n < 2; ++n) _Pragma("unroll") for (int k = 0; k < 2; ++k) \
        acc[ai][bj][m][n] = __builtin_amdgcn_mfma_f32_16x16x32_bf16(Bt[n][k], At[m][k], acc[ai][bj][m][n], 0, 0, 0); __builtin_amdgcn_s_setprio(0); } while (0)
#define PG8_WAIT_V(n) asm volatile("s_waitcnt vmcnt(" #n ")" ::: "memory")
#define PG8_WAIT_L(n) asm volatile("s_waitcnt lgkmcnt(" #n ")" ::: "memory")
#define PG8_BAR __builtin_amdgcn_s_barrier()
#define PG8_SCHED __builtin_amdgcn_sched_barrier(0)
    Unit cur, nxt; int ui = 0;
    if (!S.next(0, cur)) return;
    f32x4 acc[2][2][4][2];
#pragma unroll
    for (int a = 0; a < 2; ++a)
#pragma unroll
        for (int b = 0; b < 2; ++b)
#pragma unroll
            for (int m = 0; m < 4; ++m)
#pragma unroll
                for (int n = 0; n < 2; ++n) acc[a][b][m][n] = (f32x4){0.f, 0.f, 0.f, 0.f};
    bf16x8 At[4][2], B0[2][2], B1[2][2];
    const char* cA = (const char*)g.A + (size_t)cur.pm * tstep; const char* cB = (const char*)g.Bt + (size_t)cur.pn * tstep;
    S.a_ready(cur);
    if constexpr (SP2) {
        PG8_STAGE(PG8_SB(0, 0), cB, voffB); PG8_STAGE(PG8_SB(0, 1), cB + hstep, voffB); PG8_STAGE(PG8_SA(0, 0), cA, voffA); PG8_STAGE(PG8_SA(0, 1), cA + hstep, voffA);
        if (wr == 1) PG8_BAR;
        PG8_WAIT_V(2); PG8_BAR;
        PG8_STAGE(PG8_SB(1, 0), cB + kstep, voffB); PG8_STAGE(PG8_SA(1, 0), cA + kstep, voffA); PG8_STAGE(PG8_SB(1, 1), cB + hstep + kstep, voffB);
        PG8_WAIT_V(6); PG8_BAR;
    } else {
        PG8_STAGE(PG8_SB(0, 0), cB, voffB); PG8_STAGE(PG8_SA(0, 0), cA, voffA); PG8_STAGE(PG8_SB(0, 1), cB + hstep, voffB); PG8_STAGE(PG8_SA(0, 1), cA + hstep, voffA);
        if (wr == 1) PG8_BAR;
        PG8_WAIT_V(4); PG8_BAR;
        PG8_STAGE(PG8_SB(1, 0), cB + kstep, voffB); PG8_STAGE(PG8_SA(1, 0), cA + kstep, voffA); PG8_STAGE(PG8_SB(1, 1), cB + hstep + kstep, voffB);
        PG8_WAIT_V(6); PG8_BAR;
    }
    for (;;) {
        const bool has_next = S.next(ui + 1, nxt);
        const char* nA = has_next ? (const char*)g.A + (size_t)nxt.pm * tstep : cA; const char* nB = has_next ? (const char*)g.Bt + (size_t)nxt.pn * tstep : cB;
        for (int t = 0; t < nt; t += 2) {
            const bool last = (t == nt - 2);
            const char* a1 = cA + (size_t)(t + 1) * kstep;
            const char* a2 = last ? nA : cA + (size_t)(t + 2) * kstep; const char* b2 = last ? nB : cB + (size_t)(t + 2) * kstep;
            const char* a3 = a2 + kstep; const char* b3 = b2 + kstep;
            if (last && has_next) S.a_ready(nxt);
            if constexpr (SP2) {
            PG8_LDB(B0, 0, 0); PG8_LDB(B1, 0, 1); PG8_SCHED; PG8_LDA(At, 0, 0); PG8_STAGE(PG8_SA(1, 1), a1 + hstep, voffA);
            PG8_WAIT_V(8); PG8_WAIT_L(0); PG8_BAR; PG8_MMA(0, 0, At, B0); PG8_MMA(0, 1, At, B1); PG8_BAR; PG8_SCHED;
            PG8_LDA(At, 0, 1); PG8_STAGE(PG8_SB(0, 0), b2, voffB); PG8_STAGE(PG8_SB(0, 1), b2 + hstep, voffB); PG8_STAGE(PG8_SA(0, 0), a2, voffA);
            PG8_WAIT_V(8); PG8_WAIT_L(0); PG8_BAR; PG8_MMA(1, 0, At, B0); PG8_MMA(1, 1, At, B1); PG8_BAR; PG8_SCHED;
            PG8_LDB(B0, 1, 0); PG8_LDB(B1, 1, 1); PG8_SCHED; PG8_LDA(At, 1, 0); PG8_STAGE(PG8_SA(0, 1), a2 + hstep, voffA);
            PG8_WAIT_V(8); PG8_WAIT_L(0); PG8_BAR; PG8_MMA(0, 0, At, B0); PG8_MMA(0, 1, At, B1); PG8_BAR; PG8_SCHED;
            PG8_LDA(At, 1, 1); PG8_STAGE(PG8_SB(1, 0), b3, voffB); PG8_STAGE(PG8_SB(1, 1), b3 + hstep, voffB); PG8_STAGE(PG8_SA(1, 0), a3, voffA);
            PG8_WAIT_V(8); PG8_WAIT_L(0); PG8_BAR; PG8_MMA(1, 0, At, B0); PG8_MMA(1, 1, At, B1); PG8_BAR; PG8_SCHED;
            if constexpr (Epi::HAS_MID) { if (t == nt / 2 - 2) { E.mid(acc, cur, wr, wc, fr, fq); PG8_WAIT_V(0); PG8_SCHED; } }
            } else {
            PG8_LDB(B0, 0, 0); PG8_SCHED; PG8_LDA(At, 0, 0); PG8_STAGE(PG8_SA(1, 1), a1 + hstep, voffA);
            PG8_WAIT_L(8); PG8_BAR; PG8_WAIT_L(0); PG8_MMA(0, 0, At, B0); PG8_BAR; PG8_SCHED;
            PG8_LDB(B1, 0, 1); PG8_STAGE(PG8_SB(0, 0), b2, voffB);
            PG8_BAR; PG8_WAIT_L(0); PG8_MMA(0, 1, At, B1); PG8_BAR;
            PG8_LDA(At, 0, 1); PG8_STAGE(PG8_SA(0, 0), a2, voffA);
            PG8_BAR; PG8_WAIT_L(0); PG8_MMA(1, 0, At, B0); PG8_BAR; PG8_SCHED;
            PG8_STAGE(PG8_SB(0, 1), b2 + hstep, voffB);
            PG8_WAIT_V(6); PG8_BAR; PG8_MMA(1, 1, At, B1); PG8_BAR;
            PG8_LDB(B0, 1, 0); PG8_SCHED; PG8_LDA(At, 1, 0); PG8_STAGE(PG8_SA(0, 1), a2 + hstep, voffA);
            PG8_WAIT_L(8); PG8_BAR; PG8_WAIT_L(0); PG8_MMA(0, 0, At, B0); PG8_BAR; PG8_SCHED;
            PG8_LDB(B1, 1, 1); PG8_STAGE(PG8_SB(1, 0), b3, voffB);
            PG8_BAR; PG8_WAIT_L(0); PG8_MMA(0, 1, At, B1); PG8_BAR;
            PG8_LDA(At, 1, 1); PG8_STAGE(PG8_SA(1, 0), a3, voffA);
            PG8_BAR; PG8_WAIT_L(0); PG8_MMA(1, 0, At, B0); PG8_BAR; PG8_SCHED;
            PG8_STAGE(PG8_SB(1, 1), b3 + hstep, voffB);
            PG8_WAIT_V(6); PG8_BAR; PG8_MMA(1, 1, At, B1); PG8_BAR;
            }
        }
        if constexpr (ALIGN_EPI) { if (wr == 0) PG8_BAR; }
        if constexpr (!Epi::AFTER_DRAIN) { E(acc, cur, wr, wc, fr, fq); S.done(cur); }
        if (!has_next) break;
#pragma unroll
        for (int a = 0; a < 2; ++a)
#pragma unroll
            for (int b = 0; b < 2; ++b)
#pragma unroll
                for (int m = 0; m < 4; ++m)
#pragma unroll
                    for (int n = 0; n < 2; ++n) acc[a][b][m][n] = (f32x4){0.f, 0.f, 0.f, 0.f};
        cur = nxt; cA = nA; cB = nB; ++ui;
        if constexpr (ALIGN_EPI) { if (wr == 1) PG8_BAR; }
    }
    PG8_WAIT_V(0);
    if constexpr (!ALIGN_EPI) { if (wr == 0) PG8_BAR; }
    PG8_BAR;
    if constexpr (Epi::AFTER_DRAIN) { E.fused(acc, cur, wr, wc, fr, fq, lds, wid, lane); S.done(cur); }
#undef PG8_SA
#undef PG8_SB
#undef PG8_STAGE
#undef PG8_LDA
#undef PG8_LDB
#undef PG8_MMA
#undef PG8_WAIT_V
#undef PG8_WAIT_L
#undef PG8_BAR
#undef PG8_SCHED
}
}
#define XB_TMO      128
#define XB_XCNT(j)  (256  + 64 * (j))
#define XB_XSUB(j)  (1280 + 64 * (j))
#define XB_XGEN(j)  (2304 + 64 * (j))
#define XB_TOP      3328
#define XB_TOPGEN   3392
#define XCD_BAR_WORDS 3456
#define XB_SPIN_CAP (1u << 18)

__device__ __forceinline__ unsigned xb_ld(unsigned* p)              { return __hip_atomic_load(p, __ATOMIC_RELAXED, __HIP_MEMORY_SCOPE_AGENT); }
__device__ __forceinline__ unsigned xb_add(unsigned* p, unsigned v) { return __hip_atomic_fetch_add(p, v, __ATOMIC_RELAXED, __HIP_MEMORY_SCOPE_AGENT); }
__device__ __forceinline__ unsigned xb_xcc_id() { return (unsigned)__builtin_amdgcn_s_getreg((3 << 11) | 20) & 0xFu; }
#define XB_SPIN(cond, bar) do { unsigned _sp = 0; while (cond) { __builtin_amdgcn_s_sleep(1); \
    if ((++_sp & 255u) == 0u) { if (xb_ld(&(bar)[XB_TMO])) break; if (_sp > XB_SPIN_CAP) { atomicAdd(&(bar)[XB_TMO], 1u); break; } } } } while (0)

struct XcdBarrier {
    unsigned* bar; unsigned x;
    volatile LAS unsigned* st;
};

__device__ __forceinline__ XcdBarrier xcd_barrier_post(unsigned* bar, volatile LAS unsigned* st) {
    XcdBarrier b; b.bar = bar; b.x = xb_xcc_id(); b.st = st;
    if (tidx() == 0) (void)xb_add(&bar[XB_XCNT(b.x)], 1u);
    return b;
}
__device__ __forceinline__ void xcd_barrier_complete(unsigned* bar, unsigned x, unsigned& nloc, unsigned& nx) {
    const unsigned G = gridDim.x * gridDim.y * gridDim.z;
    unsigned sum, cnt, mine, sp = 0u;
    for (;;) {
        sum = 0u; cnt = 0u; mine = 0u;
#pragma unroll
        for (unsigned j = 0; j < 16; ++j) { const unsigned c = xb_ld(&bar[XB_XCNT(j)]); sum += c; cnt += (c > 0u) ? 1u : 0u; mine = (j == x) ? c : mine; }
        if (sum == G) break;
        __builtin_amdgcn_s_sleep(1);
        if ((++sp & 255u) == 0u) { if (xb_ld(&bar[XB_TMO])) break; if (sp > XB_SPIN_CAP) { atomicAdd(&bar[XB_TMO], 1u); break; } }
    }
    nloc = mine > 0u ? mine : 1u; nx = cnt > 0u ? cnt : 1u;
}

__device__ __forceinline__ void xcd_barrier(const XcdBarrier& b) {
    asm volatile("s_waitcnt vmcnt(0)" ::: "memory");
    __syncthreads();
    if (tidx() == 0) {
        unsigned* bar = b.bar;
        __builtin_amdgcn_s_waitcnt(0);
        unsigned nloc = b.st[0], nx = b.st[1];
        if (nloc == 0u) { xcd_barrier_complete(bar, b.x, nloc, nx); b.st[0] = nloc; b.st[1] = nx; }
        const unsigned old = xb_add(&bar[XB_XSUB(b.x)], 1u);
        const unsigned gen = old / nloc;
        if (old + 1u == (gen + 1u) * nloc) {
            __builtin_amdgcn_fence(__ATOMIC_RELEASE, "agent");
            asm volatile("s_waitcnt vmcnt(0)" ::: "memory");
            const unsigned og = xb_add(&bar[XB_TOP], 1u);
            const unsigned tg = og / nx;
            if (og + 1u == (tg + 1u) * nx) xb_add(&bar[XB_TOPGEN], 1u);
            else XB_SPIN(xb_ld(&bar[XB_TOPGEN]) == tg, bar);
            __builtin_amdgcn_fence(__ATOMIC_ACQUIRE, "agent");
            xb_add(&bar[XB_XGEN(b.x)], 1u);
            asm volatile("s_waitcnt vmcnt(0)" ::: "memory");
        } else {
            XB_SPIN(xb_ld(&bar[XB_XGEN(b.x)]) == gen, bar);
            __builtin_amdgcn_fence(__ATOMIC_ACQUIRE, "agent");
            asm volatile("s_waitcnt vmcnt(0)" ::: "memory");
        }
    }
    __syncthreads();
}
struct Frame {
    LAS unsigned char* lds; volatile LAS unsigned* MISC; gu32* ctl;
    int tid, lane, wave, vcu, G;
    const float* in[N_IN]; float* out; unsigned char* ws;
};
#define WSP(T, off) ((T*)(F.ws + (off)))
typedef __attribute__((address_space(3))) float lds_f;

template <class Map>
__device__ __forceinline__ void tr_item(const float* W, int ldw, int K, bf16* WT, LAS float* scr, int item, int nblk, int lane, const Map& map, const float* kscale) {
    const int kb = item / nblk, nb = item % nblk, k0 = 64 * kb, n0 = 32 * nb;
    const int sc = map(n0 + (lane & 31));
#pragma unroll
    for (int i = 0; i < 32; ++i) { const int kk = 2 * i + (lane >> 5); float v = sc >= 0 ? W[(size_t)(k0 + kk) * ldw + sc] : 0.f; if (kscale) v *= kscale[k0 + kk]; scr[kk * 33 + (lane & 31)] = v; }
    LDS_WAIT(); asm volatile("" ::: "memory");
    const int c = lane & 7;
#pragma unroll
    for (int j = 0; j < 4; ++j) { const int n = (lane >> 3) + 8 * j; const LAS float* s = scr + (8 * c) * 33 + n;
        v4u o; o.x = pk2(s[0 * 33], s[1 * 33]); o.y = pk2(s[2 * 33], s[3 * 33]); o.z = pk2(s[4 * 33], s[5 * 33]); o.w = pk2(s[6 * 33], s[7 * 33]);
        *(GAS v4u*)(WT + (size_t)(n0 + n) * K + k0 + 8 * c) = o; }
    LDS_WAIT(); asm volatile("" ::: "memory");
}
struct MapId { __device__ __forceinline__ int operator()(int j) const { return j; } };
struct MapWin { __device__ __forceinline__ int operator()(int j) const { return win_map(j); } };

__device__ __forceinline__ void rms_row_to_bf16(int lane, const float* xrow, const float* g, bf16* orow) {
    const GAS f32x4* xr = (const GAS f32x4*)xrow + lane; const GAS f32x4* gr = (const GAS f32x4*)g + lane;
    f32x4 v[4]; float s = 0.f;
#pragma unroll
    for (int j = 0; j < 4; ++j) { v[j] = xr[64 * j]; s += (v[j].x * v[j].x + v[j].y * v[j].y) + (v[j].z * v[j].z + v[j].w * v[j].w); }
    const float rstd = 1.f / sqrtf(wave_sum_dpp(s) * (1.f / DM) + EPS);
    GAS unsigned long long* o8 = (GAS unsigned long long*)orow + lane;
#pragma unroll
    for (int j = 0; j < 4; ++j) { const f32x4 gg = gr[64 * j]; o8[64 * j] = (unsigned long long)pk2(v[j].x * rstd * gg.x, v[j].y * rstd * gg.y) | ((unsigned long long)pk2(v[j].z * rstd * gg.z, v[j].w * rstd * gg.w) << 32); }
}

struct TrItem { const float* W; const float* ks; bf16* WT; int ldw, K, k0, n0, sc; };
__device__ __forceinline__ void tr_load(const TrItem& t, int lane, float (&v)[32]) {
#pragma unroll
    for (int i = 0; i < 32; ++i) { const int kk = 2 * i + (lane >> 5); float x = t.sc >= 0 ? t.W[(size_t)(t.k0 + kk) * t.ldw + t.sc] : 0.f; if (t.ks) x *= t.ks[t.k0 + kk]; v[i] = x; }
}
__device__ __forceinline__ void tr_store(const TrItem& t, int lane, const float (&v)[32], LAS float* scr) {
#pragma unroll
    for (int i = 0; i < 32; ++i) scr[(2 * i + (lane >> 5)) * 33 + (lane & 31)] = v[i];
    LDS_WAIT(); asm volatile("" ::: "memory");
    const int c = lane & 7;
#pragma unroll
    for (int j = 0; j < 4; ++j) { const int n = (lane >> 3) + 8 * j; const LAS float* s = scr + (8 * c) * 33 + n;
        v4u o; o.x = pk2(s[0 * 33], s[1 * 33]); o.y = pk2(s[2 * 33], s[3 * 33]); o.z = pk2(s[4 * 33], s[5 * 33]); o.w = pk2(s[6 * 33], s[7 * 33]);
        *(GAS v4u*)(t.WT + (size_t)(t.n0 + n) * t.K + t.k0 + 8 * c) = o; }
    LDS_WAIT(); asm volatile("" ::: "memory");
}
__device__ __forceinline__ void p0_prologue(Frame& F) {
    LAS float* scr = (LAS float*)(F.lds + F.wave * 16384);
    const int gw = F.vcu * NWAVES + F.wave, NGW = F.G * NWAVES;
    constexpr int I_IN = 16 * (NIN / 32), I_BA = 16 * 32, I_O = 16 * 32, I_UP = 16 * (DFF / 32), I_DN = 64 * 32, I_C = 16 * 2;
    constexpr int NITEMS = I_IN + I_BA + I_O + I_UP + I_DN + 4 * I_C;
    auto describe = [&](int it, TrItem& t) {
        int r = it, nblk; bool win = false; t.ks = nullptr;
        if (r < I_IN) { t.W = F.in[I_WIN]; t.ldw = INC; t.K = DM; t.WT = WSP(bf16, WS_WINT); nblk = NIN / 32; win = true; }
        else if ((r -= I_IN) < I_BA) { t.W = F.in[I_WBR]; t.ldw = DM; t.K = DM; t.WT = WSP(bf16, WS_WBT); nblk = 32; }
        else if ((r -= I_BA) < I_O) { t.W = F.in[I_WOUT]; t.ldw = DM; t.K = DM; t.WT = WSP(bf16, WS_WOT); nblk = 32; }
        else if ((r -= I_O) < I_UP) { t.W = F.in[I_WUP]; t.ldw = DFF; t.K = DM; t.WT = WSP(bf16, WS_WUP); nblk = DFF / 32; t.ks = F.in[I_G2]; }
        else if ((r -= I_UP) < I_DN) { t.W = F.in[I_WDN]; t.ldw = DM; t.K = DFF; t.WT = WSP(bf16, WS_WDN); nblk = 32; }
        else { r -= I_DN; const int which = r / I_C; r = r % I_C;
               const float* w1 = (which >> 1) ? F.in[I_WCV1] : F.in[I_WCK1]; t.W = w1 + (size_t)(which & 1) * 1024 * 64; t.ldw = 64; t.K = 1024;
               t.WT = ((which >> 1) ? WSP(bf16, WS_WC1V) : WSP(bf16, WS_WC1K)) + (size_t)(which & 1) * 64 * 1024; nblk = 2; }
        t.k0 = 64 * (r / nblk); t.n0 = 32 * (r % nblk); const int j = t.n0 + (F.lane & 31); t.sc = win ? win_map(j) : j;
    };
    if (gw < NITEMS) {
        TrItem cur; describe(gw, cur); float vc[32]; tr_load(cur, F.lane, vc);
        for (int it = gw; it < NITEMS; it += NGW) {
            TrItem nxt = cur; float vn[32]; const bool more = it + NGW < NITEMS;
            if (more) { describe(it + NGW, nxt); tr_load(nxt, F.lane, vn); }
            tr_store(cur, F.lane, vc, scr);
            if (more) { cur = nxt;
#pragma unroll
                for (int i = 0; i < 32; ++i) vc[i] = vn[i]; }
        }
    }
    {
        auto rowp = [&](int m) { return m < MP ? F.in[I_XP] + (size_t)m * DM : F.in[I_XS] + (size_t)(m - MP) * DM; };
        f32x4 gg[4], c0[4], c1[4];
        { const GAS f32x4* gr = (const GAS f32x4*)F.in[I_G1] + F.lane;
#pragma unroll
          for (int j = 0; j < 4; ++j) gg[j] = gr[64 * j]; }
        if (gw < MT) { const GAS f32x4* xr0 = (const GAS f32x4*)rowp(gw) + F.lane; const GAS f32x4* xr1 = (const GAS f32x4*)rowp(gw + NGW < MT ? gw + NGW : gw) + F.lane;
#pragma unroll
            for (int j = 0; j < 4; ++j) { c0[j] = xr0[64 * j]; c1[j] = xr1[64 * j]; } }
        for (int m0 = gw; m0 < MPAD; m0 += 2 * NGW) {
            const int m1 = m0 + NGW; const bool two = m1 < MT; const int mn = m0 + 2 * NGW;
            f32x4 n0[4], n1[4];
            if (mn < MT) { const GAS f32x4* xr0 = (const GAS f32x4*)rowp(mn) + F.lane; const GAS f32x4* xr1 = (const GAS f32x4*)rowp(mn + NGW < MT ? mn + NGW : mn) + F.lane;
#pragma unroll
                for (int j = 0; j < 4; ++j) { n0[j] = xr0[64 * j]; n1[j] = xr1[64 * j]; } }
            if (m0 < MT) {
                float s0 = 0.f, s1 = 0.f;
#pragma unroll
                for (int j = 0; j < 4; ++j) { s0 += (c0[j].x * c0[j].x + c0[j].y * c0[j].y) + (c0[j].z * c0[j].z + c0[j].w * c0[j].w); s1 += (c1[j].x * c1[j].x + c1[j].y * c1[j].y) + (c1[j].z * c1[j].z + c1[j].w * c1[j].w); }
                const float r0 = 1.f / sqrtf(wave_sum_dpp(s0) * (1.f / DM) + EPS), r1 = 1.f / sqrtf(wave_sum_dpp(s1) * (1.f / DM) + EPS);
                GAS unsigned long long* o0 = (GAS unsigned long long*)(WSP(bf16, WS_XN) + (size_t)m0 * DM) + F.lane; GAS unsigned long long* o1 = (GAS unsigned long long*)(WSP(bf16, WS_XN) + (size_t)m1 * DM) + F.lane;
#pragma unroll
                for (int j = 0; j < 4; ++j) { o0[64 * j] = (unsigned long long)pk2(c0[j].x * r0 * gg[j].x, c0[j].y * r0 * gg[j].y) | ((unsigned long long)pk2(c0[j].z * r0 * gg[j].z, c0[j].w * r0 * gg[j].w) << 32);
                    if (two) o1[64 * j] = (unsigned long long)pk2(c1[j].x * r1 * gg[j].x, c1[j].y * r1 * gg[j].y) | ((unsigned long long)pk2(c1[j].z * r1 * gg[j].z, c1[j].w * r1 * gg[j].w) << 32); }
            }
            for (int q = 0; q < 2; ++q) { const int m = m0 + q * NGW; if (m >= MT && m < MPAD) {
                GAS v4u* z = (GAS v4u*)(WSP(bf16, WS_XN) + (size_t)m * DM) + F.lane; z[0] = (v4u){0, 0, 0, 0}; z[64] = (v4u){0, 0, 0, 0};
                GAS v4u* za = (GAS v4u*)(WSP(bf16, WS_OAB) + (size_t)m * 1024) + F.lane; za[0] = (v4u){0, 0, 0, 0}; za[64] = (v4u){0, 0, 0, 0}; } }
#pragma unroll
            for (int j = 0; j < 4; ++j) { c0[j] = n0[j]; c1[j] = n1[j]; }
        }
    }
    const int gt = F.vcu * (NWAVES * 64) + F.tid, NGT = F.G * NWAVES * 64;
    for (int e = gt; e < 8196 * 8; e += NGT) {
        const int pidx = e >> 3, i = e & 7; const float pos = (float)(pidx < SEQ ? pidx : PAST + pidx - SEQ);
        const float inv = powf(500000.0f, -(float)(2 * i) / 16.0f); const float ang = pos * inv;
        WSP(float, WS_ROPE)[pidx * 16 + i] = cosf(ang); WSP(float, WS_ROPE)[pidx * 16 + 8 + i] = sinf(ang);
    }
    for (int e = gt; e < 8 * 128 * 128; e += NGT) {
        const int g = e >> 14, p = (e >> 7) & 127, r = e & 127; const float* ws = F.in[I_WS] + (size_t)g * 128 * 128;
        WSP(bf16, WS_WSP)[e] = (bf16)(r <= p ? f2bf(ws[p * 128 + r]) : 0u);
        WSP(bf16, WS_WSS)[e] = (bf16)(((p >> 2) == (r >> 2) && (r & 3) <= (p & 3)) ? f2bf(ws[(p & 3) * 128 + (r & 3)]) : 0u);
    }
    if (gt < 64) WSP(float, WS_GAINS)[gt] = F.in[I_GQ][gt]; else if (gt < 128) WSP(float, WS_GAINS)[gt] = F.in[I_GKS][gt - 64]; else if (gt < 192) WSP(float, WS_GAINS)[gt] = F.in[I_GKW][gt - 128];
    for (int it = gw; it < 64; it += NGW) { const int which = it >> 5, part = it & 31; const float* pe = F.in[which ? I_PEV : I_PEK]; const float* w1 = F.in[which ? I_WCV1 : I_WCK1];
        float s = 0.f;
#pragma unroll 16
        for (int i = 0; i < 64; ++i) { const int ii = part * 64 + i; s += pe[ii] * w1[(size_t)ii * 64 + F.lane]; }
        WSP(float, WS_BPART)[(which * 32 + part) * 64 + F.lane] = s; }
}

constexpr int CP_RED = 8 * 8 * 64 * 4;
constexpr int CP_PITCH = 2064;
template <bool SMP>
__device__ __forceinline__ void compress_tasks(Frame& F, const int which, const int first, const int stride, const int ntask) {
    const int tid_ = tidx(); const int lane = tid_ & 63, w = __builtin_amdgcn_readfirstlane(tid_ >> 6), fr = lane & 15, fq = lane >> 4;
    LAS float* red = (LAS float*)F.lds;
    LAS unsigned char* Pg = F.lds + CP_RED * 4;
    const bf16* Wc = WSP(bf16, which ? WS_WC1V : WS_WC1K) + (size_t)fr * 1024 + 128 * w + 8 * fq;
    bf16x8 wf[8][4];
#pragma unroll
    for (int nb = 0; nb < 8; ++nb)
#pragma unroll
        for (int ks = 0; ks < 4; ++ks) wf[nb][ks] = *(const bf16x8*)(Wc + (size_t)nb * 16 * 1024 + 32 * ks);
    const float* cache = F.in[which ? I_CVC : I_CKC]; const int* pt = (const int*)F.in[I_PT];
    const int nmine = first < ntask ? (ntask - first + stride - 1) / stride : 0;
    LAS int* pgl = (LAS int*)(Pg + 16 * CP_PITCH);
    __syncthreads();
    if (SMP) for (int i = tid_; i < nmine; i += NWAVES * 64) pgl[i] = pt[first + i * stride];
    __syncthreads();
    constexpr int DEPTH = SMP ? 2 : 1;
    f32x4 pf[DEPTH][8]; v4u pb[DEPTH][4];
#define CP_FETCH(slot, n_) do { const int nn_ = (n_); if (nn_ < nmine) { \
        if (SMP) { const f32x4* src = (const f32x4*)(cache + (size_t)pgl[nn_] * (128 * 128) + (size_t)w * 2048) + lane; \
            _Pragma("unroll") for (int i = 0; i < 8; ++i) pf[slot][i] = __builtin_nontemporal_load(src + 64 * i); } \
        else { const v4u* src = (const v4u*)(WSP(bf16, which ? WS_VCA : WS_KCA) + (size_t)(first + nn_ * stride) * 16 * 1024 + (size_t)w * 2048) + lane; \
            _Pragma("unroll") for (int i = 0; i < 4; ++i) pb[slot][i] = src[64 * i]; } } } while (0)
#define CP_COMPUTE(slot, n_) do { const int nc_ = (n_); if (nc_ < nmine) { \
        if (SMP) { LAS unsigned char* dst = Pg + (2 * w + ((lane >> 4) & 1)) * CP_PITCH + ((lane >> 5) * 64 + 4 * (lane & 15)) * 2; \
            _Pragma("unroll") for (int i = 0; i < 8; ++i) { const f32x4 a = pf[slot][i]; v2u pk; pk.x = pg8::cvt_pk_bf16(a.x, a.y); pk.y = pg8::cvt_pk_bf16(a.z, a.w); *(LAS v2u*)(dst + i * 256) = pk; } } \
        else { _Pragma("unroll") for (int i = 0; i < 4; ++i) { const int q = 64 * i + lane; *(LAS v4u*)(Pg + (2 * w + (q >> 7)) * CP_PITCH + (q & 127) * 16) = pb[slot][i]; } } \
        __syncthreads(); \
        bf16x8 af[4]; \
        _Pragma("unroll") for (int ks = 0; ks < 4; ++ks) af[ks] = *(const LAS bf16x8*)(Pg + fr * CP_PITCH + (128 * w + 32 * ks + 8 * fq) * 2); \
        _Pragma("unroll") for (int nb = 0; nb < 8; ++nb) { f32x4 acc = {0.f, 0.f, 0.f, 0.f}; \
            _Pragma("unroll") for (int ks = 0; ks < 4; ++ks) acc = __builtin_amdgcn_mfma_f32_16x16x32_bf16(wf[nb][ks], af[ks], acc, 0, 0, 0); \
            *(LAS f32x4*)(red + ((w * 8 + nb) * 64 + lane) * 4) = acc; } \
        __syncthreads(); \
        { f32x4 s = *(const LAS f32x4*)(red + ((0 * 8 + w) * 64 + lane) * 4); \
          _Pragma("unroll") for (int sw = 1; sw < 8; ++sw) s = s + *(const LAS f32x4*)(red + ((sw * 8 + w) * 64 + lane) * 4); \
          bf16* fs = WSP(bf16, SMP ? (which ? WS_FSSV : WS_FSSK) : (which ? WS_FSPV : WS_FSPK)) + (size_t)(first + nc_ * stride) * 16 * 128;     \
          v2u pk_; pk_.x = pg8::cvt_pk_bf16(s.x, s.y); pk_.y = pg8::cvt_pk_bf16(s.z, s.w); *(v2u*)(fs + (size_t)fr * 128 + 16 * w + 4 * fq) = pk_; } } } while (0)
#pragma unroll
    for (int s = 0; s < DEPTH; ++s) CP_FETCH(s, s);
    for (int n = 0; n < nmine; n += DEPTH) {
#pragma unroll
        for (int s = 0; s < DEPTH; ++s) { CP_COMPUTE(s, n + s); CP_FETCH(s, n + s + DEPTH); }
    }
#undef CP_FETCH
#undef CP_COMPUTE
    __syncthreads();
}

__device__ __forceinline__ void compress_stage2(Frame& F, const int wg, const int nwg) {
    const int lane = F.lane, fr = lane & 15, fq = lane >> 4, gw = wg * NWAVES + F.wave, NGW = nwg * NWAVES;
    constexpr int NRS = DECB * NCS * 2, NRP = NBAT * NCP * 2, NGRP = (NRS + NRP) / 16;
    LAS float* biasL = (LAS float*)F.lds;
    __syncthreads();
    if (F.tid < 128) { float s = 0.f;
#pragma unroll 4
        for (int p = 0; p < 32; ++p) s += WSP(float, WS_BPART)[((F.tid >> 6) * 32 + p) * 64 + (F.tid & 63)];
        biasL[F.tid] = s; }
    __syncthreads();
    for (int which = 0; which < 2; ++which) {
        float bias[2][8]; const float* w2 = F.in[which ? I_WCV2 : I_WCK2]; bf16x8 wfr[4][2];
#pragma unroll
        for (int ks = 0; ks < 2; ++ks)
#pragma unroll
            for (int j = 0; j < 8; ++j) bias[ks][j] = biasL[which * 64 + 32 * ks + 8 * fq + j];
#pragma unroll
        for (int nb = 0; nb < 4; ++nb)
#pragma unroll
            for (int ks = 0; ks < 2; ++ks) { unsigned short t[8];
#pragma unroll
                for (int j = 0; j < 8; ++j) t[j] = (unsigned short)f2bf(w2[(32 * ks + 8 * fq + j) * 64 + 16 * nb + fr]);
                wfr[nb][ks] = (bf16x8){(short)t[0], (short)t[1], (short)t[2], (short)t[3], (short)t[4], (short)t[5], (short)t[6], (short)t[7]}; }
        f32x4 gk[4];
#pragma unroll
        for (int nb = 0; nb < 4; ++nb) { const float g = F.in[I_GKC][16 * nb + fr]; gk[nb] = (f32x4){g, g, g, g}; }
        for (int grp = which ? NGW - 1 - gw : gw; grp < NGRP; grp += NGW) {
            const bool smp = grp < NRS / 16; const int rr0 = smp ? grp * 16 : grp * 16 - NRS; const int nr = smp ? NRS : NRP, nc = smp ? NCS : NCP;
            const bf16* fs = WSP(bf16, smp ? (which ? WS_FSSV : WS_FSSK) : (which ? WS_FSPV : WS_FSPK));
            const int rr = rr0 + fr; const int rr2 = rr + 2 < nr ? rr + 2 : nr - 1;
            bf16x8 af[2];
#pragma unroll
            for (int ks = 0; ks < 2; ++ks) { const int k0 = 32 * ks + 8 * fq;
                const v4u ra = *(const v4u*)(fs + (size_t)rr * 128 + k0), rb = *(const v4u*)(fs + (size_t)rr2 * 128 + 64 + k0);
                const f32x4 a0 = {bflo(ra.x), bfhi(ra.x), bflo(ra.y), bfhi(ra.y)}, a1 = {bflo(ra.z), bfhi(ra.z), bflo(ra.w), bfhi(ra.w)}, b0 = {bflo(rb.x), bfhi(rb.x), bflo(rb.y), bfhi(rb.y)}, b1 = {bflo(rb.z), bfhi(rb.z), bflo(rb.w), bfhi(rb.w)};
                float h[8];
#pragma unroll
                for (int j = 0; j < 4; ++j) { h[j] = gelu_tanh(a0[j] + b0[j] + bias[ks][j]); h[4 + j] = gelu_tanh(a1[j] + b1[j] + bias[ks][4 + j]); }
                v4u pk; pk.x = pk2(h[0], h[1]); pk.y = pk2(h[2], h[3]); pk.z = pk2(h[4], h[5]); pk.w = pk2(h[6], h[7]); af[ks] = __builtin_bit_cast(bf16x8, pk); }
            f32x4 acc[4];
#pragma unroll
            for (int nb = 0; nb < 4; ++nb) { acc[nb] = __builtin_amdgcn_mfma_f32_16x16x32_bf16(af[0], wfr[nb][0], (f32x4){0.f, 0.f, 0.f, 0.f}, 0, 0, 0); acc[nb] = __builtin_amdgcn_mfma_f32_16x16x32_bf16(af[1], wfr[nb][1], acc[nb], 0, 0, 0); }
            if (which == 0) {
                f32x4 ss = acc[0] * acc[0] + acc[1] * acc[1] + acc[2] * acc[2] + acc[3] * acc[3];
#pragma unroll
                for (int r = 0; r < 4; ++r) { float v = ss[r]; v += __shfl_xor(v, 1); v += __shfl_xor(v, 2); v += __shfl_xor(v, 4); v += __shfl_xor(v, 8); ss[r] = 1.f / sqrtf(v * (1.f / 64.f) + EPS); }
#pragma unroll
                for (int nb = 0; nb < 4; ++nb) acc[nb] = acc[nb] * ss * gk[nb];
            }
            bf16* dstb = WSP(bf16, smp ? (which ? WS_VCS : WS_KCS) : (which ? WS_VCP : WS_KCP));
#pragma unroll
            for (int r = 0; r < 4; ++r) { const int row = rr0 + 4 * fq + r; const int kv = row & 1, bc = row >> 1; const int b = bc / nc, c = bc % nc; const bool zero = (c == nc - 1);
                bf16* dst = dstb + ((size_t)(b * 2 + kv) * nc + c) * 64 + fr;
#pragma unroll
                for (int nb = 0; nb < 4; ++nb) dst[16 * nb] = zero ? (bf16)0 : (bf16)f2bf(acc[nb][r]); }
        }
    }
}

constexpr int VT_PITCH = 136;
constexpr int GMLP_UNITS = 129 * 2;
__device__ __forceinline__ void gmlp_unit(Frame& F, int unit) {
    const int tid_ = tidx(); const int lane = tid_ & 63, w = __builtin_amdgcn_readfirstlane(tid_ >> 6), r32 = lane & 31, hi = lane >> 5, n = unit >> 1, hf = unit & 1;
    LAS bf16* vT = (LAS bf16*)F.lds;
    const int m0 = n * 128; const bool smp = (n == 128);
    __syncthreads();
    {
        float gg[8], bb[8];
#pragma unroll
        for (int k = 0; k < 8; ++k) { gg[k] = F.in[I_LNG][lane + 64 * k]; bb[k] = F.in[I_LNB][lane + 64 * k]; }
        const bf16* gv = WSP(bf16, WS_GV) + (size_t)(m0 + 16 * w) * 512 + lane;
#pragma unroll
        for (int i = 0; i < 16; i += 2) { const int r = 16 * w + i;
            float x[2][8];
#pragma unroll
            for (int k = 0; k < 8; ++k) { x[0][k] = bf2f(gv[(size_t)i * 512 + 64 * k]); x[1][k] = bf2f(gv[(size_t)(i + 1) * 512 + 64 * k]); }
            float y[2][8];
#pragma unroll
            for (int e = 0; e < 2; ++e) { float s = 0.f;
#pragma unroll
                for (int k = 0; k < 8; ++k) s += x[e][k];
                const float mean = wave_sum_dpp(s) * (1.f / 512.f); float s2 = 0.f;
#pragma unroll
                for (int k = 0; k < 8; ++k) { x[e][k] -= mean; s2 += x[e][k] * x[e][k]; }
                const float rstd = 1.f / sqrtf(wave_sum_dpp(s2) * (1.f / 512.f) + EPS);
#pragma unroll
                for (int k = 0; k < 8; ++k) y[e][k] = x[e][k] * rstd * gg[k] + bb[k];
                float* so = nullptr;
                if (smp) so = F.out + O_SVA + (size_t)(r + e) * 512; else if ((n & 63) == 63) so = F.out + O_PVA + ((size_t)(n >> 6) * 128 + r + e) * 512;
                if (so) {
#pragma unroll
                    for (int k = 0; k < 8; ++k) if ((k >> 2) == hf) so[lane + 64 * k] = y[e][k]; } }
#pragma unroll
            for (int k = 0; k < 8; ++k) if ((k >> 2) == hf) *(LAS unsigned*)(vT + (lane + 64 * (k & 3)) * VT_PITCH + r) = pk2(y[0][k], y[1][k]);
        }
    }
    __syncthreads();
    {
        const int gl = w & 3, g = 4 * hf + gl; const bf16* Wg = WSP(bf16, smp ? WS_WSS : WS_WSP) + (size_t)g * 128 * 128; const float* bs = F.in[I_BS] + g * 128;
#pragma unroll
        for (int ii = 0; ii < 2; ++ii) { const int ib = (w < 4) ? (ii ? 3 : 0) : (ii ? 2 : 1);
            bf16x8 a[8];
#pragma unroll
            for (int kb = 0; kb < 8; ++kb) a[kb] = *(const bf16x8*)(Wg + (size_t)(32 * ib + r32) * 128 + 16 * kb + 8 * hi);
            unsigned short uu[2][16];
#pragma unroll
            for (int r = 0; r < 16; ++r) { const int p = 32 * ib + (r & 3) + 8 * (r >> 2) + 4 * hi; const bf16* up = WSP(bf16, WS_U) + (size_t)(m0 + p) * 512 + 64 * g + r32; uu[0][r] = up[0]; uu[1][r] = up[32]; }
            f32x16 acc0 = {}, acc1 = {};
#pragma unroll
            for (int kb = 0; kb < 8; ++kb) {
                const bf16x8 b0 = *(const LAS bf16x8*)(vT + (64 * gl + r32) * VT_PITCH + 16 * kb + 8 * hi);
                const bf16x8 b1 = *(const LAS bf16x8*)(vT + (64 * gl + 32 + r32) * VT_PITCH + 16 * kb + 8 * hi);
                acc0 = __builtin_amdgcn_mfma_f32_32x32x16_bf16(a[kb], b0, acc0, 0, 0, 0); acc1 = __builtin_amdgcn_mfma_f32_32x32x16_bf16(a[kb], b1, acc1, 0, 0, 0);
            }
#pragma unroll
            for (int r = 0; r < 16; ++r) { const int p = 32 * ib + (r & 3) + 8 * (r >> 2) + 4 * hi; const size_t m = (size_t)(m0 + p);
                const float bias = bs[smp ? (p & 3) : p]; bf16* op = WSP(bf16, WS_OAB) + m * 1024 + 64 * g + r32;
                op[0] = (bf16)f2bf(bf2f(uu[0][r]) * (acc0[r] + bias)); op[32] = (bf16)f2bf(bf2f(uu[1][r]) * (acc1[r] + bias)); }
        }
    }
}

constexpr size_t WS_SSQS_DUMMY = 0;
template <class Epi, int KSPLIT = 1, bool MID = false>
__device__ __forceinline__ void skinny_gemm(const bf16* A, const bf16* Bt, int N, int K, int G, int first, const Epi& E) {
    const int lane = tidx() & 63, w = __builtin_amdgcn_readfirstlane(tidx() >> 6), fr = lane & 15, fq = lane >> 4;
    for (int it = first; it < (N / 16) * KSPLIT; it += G) {
        const int cb = it / KSPLIT, kq = it % KSPLIT, Kp = K / KSPLIT;
        const bf16* ap = A + (size_t)(16 * w + fr) * K + kq * Kp + 8 * fq;
        const bf16* bp = Bt + (size_t)(16 * cb + fr) * K + kq * Kp + 8 * fq;
        f32x4 acc = {0.f, 0.f, 0.f, 0.f};
        if constexpr (MID) {
#pragma unroll 16
            for (int ks = 0; ks < Kp / 64; ++ks) { const bf16x8 a = *(const bf16x8*)(ap + 32 * ks); const bf16x8 b = *(const bf16x8*)(bp + 32 * ks); acc = __builtin_amdgcn_mfma_f32_16x16x32_bf16(b, a, acc, 0, 0, 0); }
            E.mid(acc, 16 * w + fr, 16 * cb + 4 * fq);
#pragma unroll 16
            for (int ks = Kp / 64; ks < Kp / 32; ++ks) { const bf16x8 a = *(const bf16x8*)(ap + 32 * ks); const bf16x8 b = *(const bf16x8*)(bp + 32 * ks); acc = __builtin_amdgcn_mfma_f32_16x16x32_bf16(b, a, acc, 0, 0, 0); }
        } else {
#pragma unroll 16
        for (int ks = 0; ks < Kp / 32; ++ks) { const bf16x8 a = *(const bf16x8*)(ap + 32 * ks); const bf16x8 b = *(const bf16x8*)(bp + 32 * ks); acc = __builtin_amdgcn_mfma_f32_16x16x32_bf16(b, a, acc, 0, 0, 0); }
        }
        E(16 * w + fr, 16 * cb + 4 * fq, acc, fq);
    }
}
__device__ __forceinline__ v2u pack4(const f32x4 v) { v2u o; o.x = pk2(v.x, v.y); o.y = pk2(v.z, v.w); return o; }
__device__ __forceinline__ f32x4 unpack4(const v2u w) { return (f32x4){bflo(w.x), bfhi(w.x), bflo(w.y), bfhi(w.y)}; }
struct SkMerge { unsigned char* ws;
    __device__ __forceinline__ void mid(f32x4& acc, int r, int c) const { const size_t row = MP + r;
        acc = acc * unpack4(*(const v2u*)((const bf16*)(ws + WS_SG) + row * 2048 + c)); }
    __device__ __forceinline__ void operator()(int r, int c, const f32x4 acc, int) const { const size_t row = MP + r;
        const f32x4 gb = unpack4(*(const v2u*)((const bf16*)(ws + WS_SG) + row * 2048 + 1024 + c)); *(v2u*)((bf16*)(ws + WS_MG) + row * DM + c) = pack4(gb * acc); } };
struct SkOut { unsigned char* ws; const float* xs; float* out; __device__ __forceinline__ void operator()(int r, int c, const f32x4 acc, int fq) const {
    const f32x4 v = acc + *(const f32x4*)(xs + (size_t)r * DM + c); *(f32x4*)(out + O_YS + (size_t)r * DM + c) = v; *(v2u*)((bf16*)(ws + WS_X1B) + (size_t)(MP + r) * DM + c) = pack4(v);
    float ss = (v.x * v.x + v.y * v.y) + (v.z * v.z + v.w * v.w); ss += __shfl_xor(ss, 16); ss += __shfl_xor(ss, 32);
    if (fq == 0) ((float*)(ws + WS_SSQS))[r * 64 + (c >> 4)] = ss; } };
struct SkUp { unsigned char* ws; __device__ __forceinline__ void operator()(int r, int c, const f32x4 acc, int) const {
    const f32x4* sp = (const f32x4*)((const float*)(ws + WS_SSQS) + r * 64); f32x4 s = sp[0];
#pragma unroll
    for (int i = 1; i < 16; ++i) s = s + sp[i];
    const float rstd = 1.f / sqrtf(((s.x + s.y) + (s.z + s.w)) * (1.f / DM) + EPS); f32x4 v = acc * rstd;
#pragma unroll
    for (int i = 0; i < 4; ++i) { const float a = fmaxf(v[i], 0.f); v[i] = a * a; }
    *(v2u*)((bf16*)(ws + WS_H) + (size_t)(MP + r) * DFF + c) = pack4(v); } };
struct SkDown { float* out; __device__ __forceinline__ void operator()(int r, int c, const f32x4 acc, int) const { float* y = out + O_YS + (size_t)r * DM + c;
#pragma unroll
    for (int i = 0; i < 4; ++i) __hip_atomic_fetch_add(y + i, acc[i], __ATOMIC_RELAXED, __HIP_MEMORY_SCOPE_AGENT); } };

__device__ __forceinline__ void vst_tile(Frame& F, int tile) {
    const int tid = tidx(); LAS bf16* T = (LAS bf16*)F.lds;
    const int bk = tile >> 7, tb = tile & 127, b = bk >> 1, kv = bk & 1;
    __syncthreads();
    { const int t = tid >> 3, dc = tid & 7; const v4u v = *(const v4u*)(WSP(bf16, WS_VS) + ((size_t)b * SEQ + 64 * tb + t) * 128 + kv * 64 + 8 * dc);
      const unsigned w[4] = {v.x, v.y, v.z, v.w};
#pragma unroll
      for (int i = 0; i < 4; ++i) { T[(8 * dc + 2 * i) * 72 + t] = (bf16)(w[i] & 0xffffu); T[(8 * dc + 2 * i + 1) * 72 + t] = (bf16)(w[i] >> 16); } }
    __syncthreads();
    { const int dd = tid >> 3, tc = tid & 7; *(v4u*)(WSP(bf16, WS_VST) + ((size_t)(b * 2 + kv) * 64 + dd) * SEQ + 64 * tb + 8 * tc) = *(const LAS v4u*)(T + dd * 72 + 8 * tc); }
}

namespace att {
using s16x4 = __attribute__((ext_vector_type(4))) short;
using u32x4 = __attribute__((ext_vector_type(4))) unsigned;
constexpr int NW = 8, KVBLK = 64;
constexpr int NSLOT = 3, SLOTB = 8192;
constexpr int LDS_K = 0, LDS_V = NSLOT * SLOTB, LDS_WS = 2 * NSLOT * SLOTB, LDS_Q = LDS_WS + NW * 64 * 4, LDS_OST = LDS_Q, LDS_SELB = LDS_OST + NW * 8192, LDS_END = LDS_SELB + NW * 8 * 16;
constexpr int BLKS_PITCH = 132;
static_assert(NW * 8 * BLKS_PITCH * 4 <= LDS_WS, "block scores fit the ring region");
#define SBAR() __builtin_amdgcn_sched_barrier(0)
__device__ __forceinline__ int crow(int r, int hi) { return (r & 3) + 8 * (r >> 2) + 4 * hi; }
__device__ __forceinline__ void glds16(const void* gsrc, unsigned lds_dst) { unsigned keep;
  asm volatile("s_mov_b32 %0, m0\n\ts_mov_b32 m0, %2\n\ts_nop 0\n\tglobal_load_lds_dwordx4 %1, off\n\ts_mov_b32 m0, %0" : "=&s"(keep) : "v"(gsrc), "s"(lds_dst) : "memory"); }
__device__ __forceinline__ float max3f(float a, float b, float c) { float r; asm("v_max3_f32 %0, %1, %2, %3" : "=v"(r) : "v"(a), "v"(b), "v"(c)); return r; }
__device__ __forceinline__ float max2f(float a, float b) { float r; asm("v_max_f32_e32 %0, %1, %2" : "=v"(r) : "v"(a), "v"(b)); return r; }
__device__ __forceinline__ float fadd_s(float a, float b) { float r; asm("v_add_f32_e32 %0, %1, %2" : "=v"(r) : "v"(a), "v"(b)); return r; }
__device__ __forceinline__ float fsub_s(float a, float b) { float r; asm("v_sub_f32_e32 %0, %1, %2" : "=v"(r) : "v"(a), "v"(b)); return r; }
typedef float f32x2_t __attribute__((ext_vector_type(2))); typedef __bf16 bf16x2_t __attribute__((ext_vector_type(2)));
__device__ __forceinline__ unsigned cvtpk_s(float lo, float hi) { f32x2_t v = {lo, hi}; bf16x2_t b = __builtin_convertvector(v, bf16x2_t); return __builtin_bit_cast(unsigned, b); }
#define WAIT_BAR(N) asm volatile("s_waitcnt vmcnt(" #N ") lgkmcnt(0)\n\ts_barrier" ::: "memory")

typedef __attribute__((address_space(3))) const char* lds_cptr;
__device__ __forceinline__ void qkt(f32x16& p0, f32x16& p1, const char* Kslot, lds_cptr qp, int r32, int hi) { const f32x16 negm = f32x16{}; bf16x8 qr[4];
  _Pragma("unroll") for (int d0 = 0; d0 < 4; ++d0) qr[d0] = *(const __attribute__((address_space(3))) bf16x8*)(qp + d0 * 1024);
  const char* kb = Kslot + hi * 1024 + r32 * 16;
#pragma unroll
  for (int d0 = 0; d0 < 4; ++d0) {
    const bf16x8 b0 = *reinterpret_cast<const bf16x8*>(kb + d0 * 2048);
    const bf16x8 b1 = *reinterpret_cast<const bf16x8*>(kb + d0 * 2048 + 512);
    if (d0 == 0) { p0 = __builtin_amdgcn_mfma_f32_32x32x16_bf16(b0, qr[0], negm, 0, 0, 0); p1 = __builtin_amdgcn_mfma_f32_32x32x16_bf16(b1, qr[0], negm, 0, 0, 0); }
    else { p0 = __builtin_amdgcn_mfma_f32_32x32x16_bf16(b0, qr[d0], p0, 0, 0, 0); p1 = __builtin_amdgcn_mfma_f32_32x32x16_bf16(b1, qr[d0], p1, 0, 0, 0); } }
}
__device__ __forceinline__ void qkt_r(f32x16& p0, f32x16& p1, const char* Kslot, const bf16x8* qr, int r32, int hi) { const f32x16 negm = f32x16{};
  const char* kb = Kslot + hi * 1024 + r32 * 16;
#pragma unroll
  for (int d0 = 0; d0 < 4; ++d0) {
    const bf16x8 b0 = *reinterpret_cast<const bf16x8*>(kb + d0 * 2048);
    const bf16x8 b1 = *reinterpret_cast<const bf16x8*>(kb + d0 * 2048 + 512);
    if (d0 == 0) { p0 = __builtin_amdgcn_mfma_f32_32x32x16_bf16(b0, qr[0], negm, 0, 0, 0); p1 = __builtin_amdgcn_mfma_f32_32x32x16_bf16(b1, qr[0], negm, 0, 0, 0); }
    else { p0 = __builtin_amdgcn_mfma_f32_32x32x16_bf16(b0, qr[d0], p0, 0, 0, 0); p1 = __builtin_amdgcn_mfma_f32_32x32x16_bf16(b1, qr[d0], p1, 0, 0, 0); } }
}
typedef short v4i16_t __attribute__((ext_vector_type(4)));
__device__ __forceinline__ void kload8(bf16x8* kf, lds_cptr kp) {
  kf[0] = *(const __attribute__((address_space(3))) bf16x8*)(kp);        kf[1] = *(const __attribute__((address_space(3))) bf16x8*)(kp + 512);
  kf[2] = *(const __attribute__((address_space(3))) bf16x8*)(kp + 2048); kf[3] = *(const __attribute__((address_space(3))) bf16x8*)(kp + 2560);
  kf[4] = *(const __attribute__((address_space(3))) bf16x8*)(kp + 4096); kf[5] = *(const __attribute__((address_space(3))) bf16x8*)(kp + 4608);
  kf[6] = *(const __attribute__((address_space(3))) bf16x8*)(kp + 6144); kf[7] = *(const __attribute__((address_space(3))) bf16x8*)(kp + 6656);
}
__device__ __forceinline__ void kload2(bf16x8* kf, lds_cptr kp, int j) { kf[2 * j] = *(const __attribute__((address_space(3))) bf16x8*)(kp + j * 2048); kf[2 * j + 1] = *(const __attribute__((address_space(3))) bf16x8*)(kp + j * 2048 + 512); }
__device__ __forceinline__ s16x4 vtr(lds_cptr p) { return __builtin_bit_cast(s16x4, __builtin_amdgcn_ds_read_tr16_b64_v4i16((__attribute__((address_space(3))) v4i16_t*)p)); }
__device__ __forceinline__ float rowmax(const f32x16& p0, const f32x16& p1) {
  float a = max3f(p0[0], p0[1], p1[0]), b = max3f(p0[2], p0[3], p1[1]); a = max3f(a, p1[2], p1[3]);
#pragma unroll
  for (int r = 4; r < 16; r += 4) { a = max3f(a, p0[r], p0[r + 1]); b = max3f(b, p0[r + 2], p0[r + 3]); a = max3f(a, p1[r], p1[r + 1]); b = max3f(b, p1[r + 2], p1[r + 3]); }
  const float m = max2f(a, b);
  auto rr = __builtin_amdgcn_permlane32_swap(__float_as_uint(m), __float_as_uint(m), false, false);
  return max2f(__uint_as_float(rr[0]), __uint_as_float(rr[1]));
}
__device__ __forceinline__ void pv(f32x16* o, int vb, bf16x8 pa0, bf16x8 pa1, bf16x8 pa2, bf16x8 pa3) {
#pragma unroll
  for (int d0 = 0; d0 < 2; ++d0) { s16x4 lo[4], hi[4];
#pragma unroll
    for (int ks = 0; ks < 4; ++ks) {
      asm volatile("ds_read_b64_tr_b16 %0,%1 offset:%c2" : "=&v"(lo[ks]) : "v"(vb), "i"(d0 * 4096 + ks * 1024) : "memory");
      asm volatile("ds_read_b64_tr_b16 %0,%1 offset:%c2" : "=&v"(hi[ks]) : "v"(vb), "i"(d0 * 4096 + ks * 1024 + 512) : "memory"); }
    asm volatile("s_waitcnt lgkmcnt(0)" ::: "memory"); SBAR();
#define PK(k) (bf16x8){lo[k][0], lo[k][1], lo[k][2], lo[k][3], hi[k][0], hi[k][1], hi[k][2], hi[k][3]}
    o[d0] = __builtin_amdgcn_mfma_f32_32x32x16_bf16(pa0, PK(0), o[d0], 0, 0, 0);
    o[d0] = __builtin_amdgcn_mfma_f32_32x32x16_bf16(pa1, PK(1), o[d0], 0, 0, 0);
    o[d0] = __builtin_amdgcn_mfma_f32_32x32x16_bf16(pa2, PK(2), o[d0], 0, 0, 0);
    o[d0] = __builtin_amdgcn_mfma_f32_32x32x16_bf16(pa3, PK(3), o[d0], 0, 0, 0);
#undef PK
  }
}
template <int MODE> __device__ __forceinline__ void amask(f32x16& p0, f32x16& p1, int tabs, int blk, int hi, int mlo, int mspan1, const unsigned selword, const float mh) {
  const float NEG = -1e30f;
  const int kb = 64 * tabs + 4 * hi;
  int hiB;
  if (MODE == 1) {
    const bool en = (selword >> (tabs & 31)) & 1u;
    if (tabs < blk) { const float mht = en ? mh : 1e30f;
#pragma unroll
      for (int r = 0; r < 16; ++r) { p0[r] -= mht; p1[r] -= mht; }
      return; }
    hiB = en ? mspan1 - kb : 0;
  } else if (MODE == 0) hiB = mspan1 - kb;
  else {
    if (tabs < blk) {
      if (tabs + 8 <= blk) { const int loB = mlo - kb;
#pragma unroll
        for (int r = 0; r < 16; ++r) { const int c = (r & 3) + 8 * (r >> 2); p0[r] = (loB <= c) ? p0[r] - mh : NEG; p1[r] = (loB <= c + 32) ? p1[r] - mh : NEG; }
      } else {
#pragma unroll
        for (int r = 0; r < 16; ++r) { p0[r] -= mh; p1[r] -= mh; }
      }
      return; }
    hiB = mlo + mspan1 - kb;
  }
#pragma unroll
  for (int r = 0; r < 16; ++r) { const int c = (r & 3) + 8 * (r >> 2); p0[r] = (hiB > c) ? p0[r] - mh : NEG; p1[r] = (hiB > c + 32) ? p1[r] - mh : NEG; }
}

template <int MODE, int THRL>
__device__ __forceinline__ void attn_unit(const bf16* Qlane, const bf16* __restrict__ Kt, const bf16* __restrict__ Vt, const int t0abs, const int NT, const int blk,
                                          const int pos, const float* gatep, float* obf, bf16* ob, char* shm, float& mhat_o, float& rl_o) {
  constexpr int KP = (MODE == 0) ? 64 : 128;
  const int tid = tidx(), lane = tid & 63, r32 = lane & 31, hi = lane >> 5; const int wid = __builtin_amdgcn_readfirstlane(tid >> 6);
  const unsigned lds0 = (unsigned)(uintptr_t)shm;
  float* wsf = (float*)(shm + LDS_WS) + wid * 64;
  const bf16* ksrc = Kt + (long)lane * KP + wid * 8;
  const bf16* vsrc = Vt + (long)(16 * (wid & 3) + (lane >> 2)) * KP + (wid >> 2) * 32 + (lane & 3) * 8;
  const unsigned kdst = lds0 + LDS_K + wid * 1024, vdst = lds0 + LDS_V + wid * 1024;
#define DMA_K(t, slot) glds16(ksrc + (long)(t) * KVBLK * KP, (unsigned)__builtin_amdgcn_readfirstlane(kdst + (slot)))
#define DMA_V(t, slot) glds16(vsrc + (long)(t) * KVBLK * KP, (unsigned)__builtin_amdgcn_readfirstlane(vdst + (slot)))
  const int vb0 = (int)(lds0 + LDS_V) + ((lane >> 4) & 1) * 32 + (lane & 3) * 8 + (4 * hi + ((lane & 15) >> 2)) * 64;
  const char* Kbase = shm + LDS_K; bf16x8 kf[8];
  const lds_cptr shm3 = (lds_cptr)shm; const lds_cptr kp0 = shm3 + LDS_K + hi * 1024 + r32 * 16; const lds_cptr vp0 = shm3 + LDS_V + ((lane >> 4) & 1) * 32 + (lane & 3) * 8 + (4 * hi + ((lane & 15) >> 2)) * 64;
  const lds_cptr qp = shm3 + LDS_Q + wid * 4096 + lane * 16;
  const lds_cptr selp = shm3 + LDS_SELB + wid * 128 + (r32 >> 2) * 16;
#ifndef ATT_QREG
#define ATT_QREG 7
#endif
  constexpr bool QREG = (ATT_QREG >> MODE) & 1;
  bf16x8 qrg[4];
#define QF(j) (QREG ? qrg[j] : *(const __attribute__((address_space(3))) bf16x8*)(qp + (j) * 1024))
  const float gate_v = *gatep;
  DMA_K(0, 0); DMA_V(0, 0); DMA_K(1, SLOTB);
#pragma unroll
  for (int d0 = 0; d0 < 4; ++d0) { qrg[d0] = *reinterpret_cast<const bf16x8*>(&Qlane[d0 * 16 + hi * 8]); if (!QREG) *(__attribute__((address_space(3))) bf16x8*)((__attribute__((address_space(3))) char*)qp + d0 * 1024) = qrg[d0]; }
  float mhat = 0.f, l_reg = 0.f; f32x16 o[2]; o[0] = f32x16{}; o[1] = f32x16{}; const f32x16 zero16 = f32x16{};
  const int mlo = (MODE == 2) ? pos - (WIN - 1) : 0;
  const int mspan1 = (MODE == 0) ? (((pos - 31) >> 4) + 1 > 0 ? ((pos - 31) >> 4) + 1 : 0) : (MODE == 1 ? pos + 1 : WIN);
#define SELW(t) (MODE == 1 ? *(const __attribute__((address_space(3))) unsigned*)(selp + (((t0abs + (t)) >> 5) << 2)) : 0u)
#define CMASK(P0, P1, t, SW) amask<MODE>(P0, P1, t0abs + (t), blk, hi, mlo, mspan1, SW, mhat)
  bool resc = false;
#define START(P0, P1) do { const float rm = max2f(rowmax(P0, P1), -500.f); resc = false; \
    { const float dl = rm; mhat = fadd_s(mhat, dl); \
      _Pragma("unroll") for (int r = 0; r < 16; ++r) { P0[r] = fsub_s(P0[r], dl); P1[r] = fsub_s(P1[r], dl); } } \
    _Pragma("unroll") for (int r = 0; r < 16; ++r) P0[r] = __builtin_amdgcn_exp2f(P0[r]); } while (0)
#define RESC() do { if (resc) { asm volatile("s_waitcnt lgkmcnt(0)" ::: "memory"); \
      _Pragma("unroll") for (int d_ = 0; d_ < 2; ++d_) _Pragma("unroll") for (int r = 0; r < 16; ++r) o[d_][r] *= wsf[crow(r, hi)]; } } while (0)
  f32x16 pA0, pA1, pB0, pB1;
  int sl_prev = 0, sl_cur = 0, sl_next = SLOTB;
#define ROT() do { sl_prev = sl_cur; sl_cur = sl_next; sl_next = (sl_next == (NSLOT - 1) * SLOTB) ? 0 : sl_next + SLOTB; } while (0)
  DMA_K(2, 2 * SLOTB);
  WAIT_BAR(3);
  { const unsigned sw0 = SELW(0); if (QREG) qkt_r(pA0, pA1, Kbase, qrg, r32, hi); else qkt(pA0, pA1, Kbase, qp, r32, hi); asm volatile("s_nop 15\n\ts_nop 7" : "+v"(pA0), "+v"(pA1)); CMASK(pA0, pA1, 0, sw0); }
  START(pA0, pA1);
  _Pragma("unroll") for (int r = 0; r < 16; ++r) pA1[r] = __builtin_amdgcn_exp2f(pA1[r]);
  WAIT_BAR(0);
  DMA_K(3, 0); DMA_V(1, SLOTB);
  ROT();
  kload8(kf, kp0 + sl_cur);
  WAIT_BAR(2);
  s16x4 vlo[8], vhi[8]; u32x4 pw0, pw1, pw2, pw3;
#define PKW(P, B) cvtpk_s(P[B], P[B + 1])
#define PAF(k) __builtin_bit_cast(bf16x8, pw##k)
#define VFR(i) (bf16x8){vlo[i][0], vlo[i][1], vlo[i][2], vlo[i][3], vhi[i][0], vhi[i][1], vhi[i][2], vhi[i][3]}
#define PIN(x) asm volatile("" : "+v"(x))
#define MX3(a, b, c) __builtin_fmaxf(__builtin_fmaxf((a), (b)), (c))
#define GAPA(MF, A0, A1, A2, A3, W0, W1, PW) do { MF; sacc += A0; sacc += A1; sacc += A2; sacc += A3; PIN(sacc); W0; W1; PIN(PW); SBAR(); } while (0)
#define EX(v) __builtin_amdgcn_exp2f(v)
#define GAPB(MF, X, B) do { MF; X[B] = EX(X[B]); X[B + 1] = EX(X[B + 1]); X[B + 2] = EX(X[B + 2]); X[B + 3] = EX(X[B + 3]); PIN(X); SBAR(); } while (0)
#define VRD(i) do { vlo[i] = vtr(vp_ + (((i) >> 2) * 4096 + ((i) & 3) * 1024)); vhi[i] = vtr(vp_ + (((i) >> 2) * 4096 + ((i) & 3) * 1024 + 512)); } while (0)
#define KRD(G, j) do { if (G) { kload2(kf, kp0 + sl_next, j); SBAR(); } } while (0)
#define STEP(C0, C1, P0, P1, t, GK, GV, GL) do { SBAR(); \
    const lds_cptr vp_ = vp0 + sl_prev; const unsigned sw_ = SELW(t); \
    bf16x8 qa_ = QF(0); \
    VRD(0); SBAR(); float sacc = (P0[0] + P0[1]); \
    GAPA(C0 = __builtin_amdgcn_mfma_f32_32x32x16_bf16(kf[0], qa_, zero16, 0, 0, 0), P0[2], P0[3], P0[4], P0[5],     pw0[0] = PKW(P0, 0), pw0[1] = PKW(P0, 2), pw0); \
    VRD(4); SBAR(); GAPA(C1 = __builtin_amdgcn_mfma_f32_32x32x16_bf16(kf[1], qa_, zero16, 0, 0, 0), P0[6], P0[7], P0[8], P0[9],     pw0[2] = PKW(P0, 4), pw0[3] = PKW(P0, 6), pw0); \
    qa_ = QF(1); \
    VRD(1); SBAR(); GAPA(C0 = __builtin_amdgcn_mfma_f32_32x32x16_bf16(kf[2], qa_, C0, 0, 0, 0),   P0[10], P0[11], P0[12], P0[13], pw1[0] = PKW(P0, 8), pw1[1] = PKW(P0, 10), pw1); \
    VRD(5); SBAR(); GAPA(C1 = __builtin_amdgcn_mfma_f32_32x32x16_bf16(kf[3], qa_, C1, 0, 0, 0),   P0[14], P0[15], P1[0], P1[1],   pw1[2] = PKW(P0, 12), pw1[3] = PKW(P0, 14), pw1); \
    qa_ = QF(2); \
    VRD(2); SBAR(); GAPA(C0 = __builtin_amdgcn_mfma_f32_32x32x16_bf16(kf[4], qa_, C0, 0, 0, 0),   P1[2], P1[3], P1[4], P1[5],     pw2[0] = PKW(P1, 0), pw2[1] = PKW(P1, 2), pw2); \
    VRD(6); SBAR(); GAPA(C1 = __builtin_amdgcn_mfma_f32_32x32x16_bf16(kf[5], qa_, C1, 0, 0, 0),   P1[6], P1[7], P1[8], P1[9],     pw2[2] = PKW(P1, 4), pw2[3] = PKW(P1, 6), pw2); \
    qa_ = QF(3); \
    VRD(3); SBAR(); GAPA(C0 = __builtin_amdgcn_mfma_f32_32x32x16_bf16(kf[6], qa_, C0, 0, 0, 0),   P1[10], P1[11], P1[12], P1[13], pw3[0] = PKW(P1, 8), pw3[1] = PKW(P1, 10), pw3); \
    VRD(7); SBAR(); GAPA(C1 = __builtin_amdgcn_mfma_f32_32x32x16_bf16(kf[7], qa_, C1, 0, 0, 0),   P1[14], P1[15], 0.f, 0.f,       pw3[2] = PKW(P1, 12), pw3[3] = PKW(P1, 14), pw3); \
    l_reg += sacc; \
    if (GK) { DMA_K((t) + 3, sl_cur); } if (GV) { DMA_V((t) + 1, sl_next); } \
    CMASK(C0, C1, t, sw_); \
    { float a = MX3(C0[0], C0[1], C1[0]), b = MX3(C0[2], C0[3], C1[1]); a = MX3(a, C1[2], C1[3]); \
      _Pragma("unroll") for (int r = 4; r < 16; r += 4) { a = MX3(a, C0[r], C0[r + 1]); b = MX3(b, C0[r + 2], C0[r + 3]); a = MX3(a, C1[r], C1[r + 1]); b = MX3(b, C1[r + 2], C1[r + 3]); } \
      float rm = __builtin_fmaxf(a, b); { auto rr = __builtin_amdgcn_permlane32_swap(__float_as_uint(rm), __float_as_uint(rm), false, false); rm = __builtin_fmaxf(__uint_as_float(rr[0]), __uint_as_float(rr[1])); } \
      resc = false; \
      if (__builtin_expect(__any(rm > (float)THRL), 0)) { const float dl = __builtin_fmaxf(rm, 0.f); mhat += dl; \
        _Pragma("unroll") for (int r = 0; r < 16; ++r) { C0[r] -= dl; C1[r] -= dl; } \
        const float f = __builtin_amdgcn_exp2f(-dl); l_reg *= f; if (hi == 0) wsf[r32] = f; resc = true; } } \
    SBAR(); \
    GAPB(o[0] = __builtin_amdgcn_mfma_f32_32x32x16_bf16(PAF(0), VFR(0), o[0], 0, 0, 0), C0, 0); \
    GAPB(o[1] = __builtin_amdgcn_mfma_f32_32x32x16_bf16(PAF(0), VFR(4), o[1], 0, 0, 0), C0, 4); \
    KRD(GL, 0); GAPB(o[0] = __builtin_amdgcn_mfma_f32_32x32x16_bf16(PAF(1), VFR(1), o[0], 0, 0, 0), C0, 8); \
    KRD(GL, 1); GAPB(o[1] = __builtin_amdgcn_mfma_f32_32x32x16_bf16(PAF(1), VFR(5), o[1], 0, 0, 0), C0, 12); \
    KRD(GL, 2); GAPB(o[0] = __builtin_amdgcn_mfma_f32_32x32x16_bf16(PAF(2), VFR(2), o[0], 0, 0, 0), C1, 0); \
    KRD(GL, 3); GAPB(o[1] = __builtin_amdgcn_mfma_f32_32x32x16_bf16(PAF(2), VFR(6), o[1], 0, 0, 0), C1, 4); \
    GAPB(o[0] = __builtin_amdgcn_mfma_f32_32x32x16_bf16(PAF(3), VFR(3), o[0], 0, 0, 0), C1, 8); \
    GAPB(o[1] = __builtin_amdgcn_mfma_f32_32x32x16_bf16(PAF(3), VFR(7), o[1], 0, 0, 0), C1, 12); \
    } while (0)
  int t = 1;
  for (; t + 5 < NT; t += 2) {
    STEP(pB0, pB1, pA0, pA1, t, true, true, true);     WAIT_BAR(2); RESC(); ROT();
    STEP(pA0, pA1, pB0, pB1, t + 1, true, true, true); WAIT_BAR(2); RESC(); ROT();
  }
#define ENDW(tt) do { if ((tt) + 3 < NT) { WAIT_BAR(2); } else if ((tt) + 2 < NT) { WAIT_BAR(1); } else { WAIT_BAR(0); } } while (0)
  for (; t + 1 < NT; t += 2) {
    STEP(pB0, pB1, pA0, pA1, t, (t + 3 < NT), (t + 1 < NT), (t + 1 < NT));         ENDW(t);     RESC(); ROT();
    STEP(pA0, pA1, pB0, pB1, t + 1, (t + 4 < NT), (t + 2 < NT), (t + 2 < NT));     ENDW(t + 1); RESC(); ROT();
  }
  STEP(pB0, pB1, pA0, pA1, NT - 1, false, false, false); RESC();
  { float sacc = pB0[0] + pB0[1]; _Pragma("unroll") for (int r = 2; r < 16; ++r) sacc += pB0[r]; _Pragma("unroll") for (int r = 0; r < 16; ++r) sacc += pB1[r]; l_reg += sacc;
    pw0 = (u32x4){PKW(pB0, 0), PKW(pB0, 2), PKW(pB0, 4), PKW(pB0, 6)}; pw1 = (u32x4){PKW(pB0, 8), PKW(pB0, 10), PKW(pB0, 12), PKW(pB0, 14)}; pw2 = (u32x4){PKW(pB1, 0), PKW(pB1, 2), PKW(pB1, 4), PKW(pB1, 6)}; pw3 = (u32x4){PKW(pB1, 8), PKW(pB1, 10), PKW(pB1, 12), PKW(pB1, 14)};
    SBAR(); pv(o, vb0 + sl_cur, PAF(0), PAF(1), PAF(2), PAF(3)); }
#undef PKW
#undef PAF
#undef VFR
#undef PIN
#undef MX3
#undef GAPA
#undef GAPB
#undef EX
#undef VRD
#undef KRD
#undef STEP
#undef ENDW
  { auto rr = __builtin_amdgcn_permlane32_swap(__float_as_uint(l_reg), __float_as_uint(l_reg), false, false); l_reg = __uint_as_float(rr[0]) + __uint_as_float(rr[1]); }
  const float rl = l_reg > 0.f ? __builtin_amdgcn_rcpf(l_reg) : 0.f;
  mhat_o = mhat; rl_o = rl;
  if (hi == 0) wsf[32 + r32] = rl * gate_v; asm volatile("s_waitcnt lgkmcnt(0)" ::: "memory");
  { __attribute__((address_space(3))) float* ost = (__attribute__((address_space(3))) float*)(shm3 + LDS_OST) + wid * 2048;
#pragma unroll
    for (int r = 0; r < 16; ++r) { const int orow = crow(r, hi); const float sc = wsf[32 + orow];
#pragma unroll
      for (int d0 = 0; d0 < 2; ++d0) { __attribute__((address_space(3))) float* p = ost + orow * 64 + 32 * d0 + r32; float v = o[d0][r] * sc;
        if (MODE != 0) v += *p;
        if (MODE == 2) ob[(2 * (r >> 2)) * 1024 + (r & 3) * 64 + 32 * d0] = (bf16)f2bf(v); else *p = v; } } }
  (void)obf;
  asm volatile("s_waitcnt lgkmcnt(0)\n\ts_barrier" ::: "memory");
#undef DMA_K
#undef DMA_V
#undef CMASK
#undef SELW
#undef QF
#undef START
#undef RESC
#undef ROT
}

__device__ __forceinline__ int dppx1(int v) { return __builtin_amdgcn_mov_dpp(v, 0xB1, 0xF, 0xF, true); }
__device__ __forceinline__ int dppx2(int v) { return __builtin_amdgcn_mov_dpp(v, 0x4E, 0xF, 0xF, true); }
__device__ __forceinline__ float quad_sum(float v) { v += __builtin_bit_cast(float, dppx1(__builtin_bit_cast(int, v))); v += __builtin_bit_cast(float, dppx2(__builtin_bit_cast(int, v))); return v; }

__device__ __forceinline__ void nsa_prompt_unit(const unsigned char* ws, int b, int kv, int blk, char* shm) {
  float mhat = 0.f, rl = 0.f, dm0, dm1;
#define LANE_SETUP() const int lane = tidx() & 63, r32 = lane & 31, hi = lane >> 5; const int wid = __builtin_amdgcn_readfirstlane(tidx() >> 6); \
    const int tl = r32 >> 2, hl = r32 & 3, pos = 64 * blk + 8 * wid + tl; const size_t m = (size_t)b * SEQ + pos; const int head = 4 * kv + hl; (void)hi; (void)head; (void)m; (void)tl; (void)hl; \
    const size_t obo = ((size_t)b * SEQ + 64 * blk + 8 * wid + hi) * 512 + (4 * kv) * 64 + r32; const size_t obb = ((size_t)b * SEQ + 64 * blk + 8 * wid + hi) * 1024 + 512 + (4 * kv) * 64 + r32; (void)obo; (void)obb
  const int ntc_real = blk / 16 + 1;
  { LANE_SETUP(); const int NTc = ntc_real < 4 ? 4 : ((ntc_real + 1) & ~1);
    const bf16* kc = (const bf16*)(ws + WS_KCP) + (size_t)(b * 2 + kv) * NCP * 64; const bf16* vc = (const bf16*)(ws + WS_VCP) + (size_t)(b * 2 + kv) * NCP * 64;
#ifndef NO_M0
    attn_unit<0, 8>((const bf16*)(ws + WS_QN) + m * 512 + head * 64, kc, vc, 0, NTc, blk, pos, (const float*)(ws + WS_NG) + m * 32 + head * 3 + 0, (float*)(ws + WS_OBF) + obo, (bf16*)(ws + WS_OAB) + obb, shm, mhat, rl);
#endif
 }
  {
    LANE_SETUP();
    LAS float* bsw = (LAS float*)(shm + LDS_K) + wid * 8 * BLKS_PITCH;
    for (int i = lane; i < 8 * BLKS_PITCH; i += 64) bsw[i] = 0.f;
    asm volatile("s_waitcnt lgkmcnt(0)" ::: "memory");
    const int cthr = (pos - 31) >> 4; const int cspan = cthr + 1 > 0 ? cthr + 1 : 0;
    const bf16* kc = (const bf16*)(ws + WS_KCP) + (size_t)(b * 2 + kv) * NCP * 64; const bf16* qn = (const bf16*)(ws + WS_QN) + m * 512 + head * 64;
    bf16x8 qf[4];
#pragma unroll
    for (int d0 = 0; d0 < 4; ++d0) qf[d0] = *reinterpret_cast<const bf16x8*>(&qn[d0 * 16 + hi * 8]);
    const f32x16 zero16 = f32x16{};
    bf16x8 kb0[4], kb1[4], nb0[4], nb1[4];
#define IMP_LOAD(D0, D1, t_) do { const bf16* kr = kc + (size_t)(64 * (t_) + r32) * 64 + hi * 8; \
      _Pragma("unroll") for (int d0 = 0; d0 < 4; ++d0) { D0[d0] = *reinterpret_cast<const bf16x8*>(kr + d0 * 16); D1[d0] = *reinterpret_cast<const bf16x8*>(kr + 32 * 64 + d0 * 16); } } while (0)
    IMP_LOAD(kb0, kb1, 0);
    for (int t = 0; t < ntc_real; ++t) {
      if (t + 1 < ntc_real) IMP_LOAD(nb0, nb1, t + 1);
      f32x16 p0, p1;
#pragma unroll
      for (int d0 = 0; d0 < 4; ++d0) {
        if (d0 == 0) { p0 = __builtin_amdgcn_mfma_f32_32x32x16_bf16(kb0[0], qf[0], zero16, 0, 0, 0); p1 = __builtin_amdgcn_mfma_f32_32x32x16_bf16(kb1[0], qf[0], zero16, 0, 0, 0); }
        else { p0 = __builtin_amdgcn_mfma_f32_32x32x16_bf16(kb0[d0], qf[d0], p0, 0, 0, 0); p1 = __builtin_amdgcn_mfma_f32_32x32x16_bf16(kb1[d0], qf[d0], p1, 0, 0, 0); } }
      const int base = 64 * t + 4 * hi;
#pragma unroll
      for (int r = 0; r < 16; ++r) { const int c0 = base + (r & 3) + 8 * (r >> 2); p0[r] = (c0 < cspan) ? __builtin_amdgcn_exp2f(p0[r] - mhat) * rl : 0.f; p1[r] = (c0 + 32 < cspan) ? __builtin_amdgcn_exp2f(p1[r] - mhat) * rl : 0.f; }
#pragma unroll
      for (int ph = 0; ph < 2; ++ph)
#pragma unroll
        for (int g = 0; g < 4; ++g) { const float a0 = ph ? p1[4 * g] : p0[4 * g], a1 = ph ? p1[4 * g + 1] : p0[4 * g + 1], a2 = ph ? p1[4 * g + 2] : p0[4 * g + 2], a3 = ph ? p1[4 * g + 3] : p0[4 * g + 3];
          const float A = quad_sum(2.f * (a0 + a1 + a2) + a3), B = quad_sum(a3);
          const int j = 16 * t + 8 * ph + 2 * g + hi;
          if (hl == 0) { __hip_atomic_fetch_add(bsw + tl * BLKS_PITCH + j, A, __ATOMIC_RELAXED, __HIP_MEMORY_SCOPE_WORKGROUP); __hip_atomic_fetch_add(bsw + tl * BLKS_PITCH + j + 1, B, __ATOMIC_RELAXED, __HIP_MEMORY_SCOPE_WORKGROUP); } }
#pragma unroll
      for (int d0 = 0; d0 < 4; ++d0) { kb0[d0] = nb0[d0]; kb1[d0] = nb1[d0]; }
    }
#undef IMP_LOAD
    asm volatile("s_waitcnt lgkmcnt(0)" ::: "memory");
    LAS unsigned* selb = (LAS unsigned*)(shm + LDS_SELB) + wid * 32;
    const int cur = blk, nf = cur >= 2 ? 3 : cur + 1, need = 16 - nf;
    {
      const int j0 = lane, j1 = lane + 64;
      const bool c0 = (j0 >= 1 && j0 <= cur - 2), c1 = (j1 <= cur - 2);
      float v0[8], v1[8]; unsigned sm0 = (j0 == 0 || j0 == cur || j0 == cur - 1) ? 0xFFu : 0u, sm1 = (j1 == cur || j1 == cur - 1) ? 0xFFu : 0u;
#pragma unroll
      for (int tk = 0; tk < 8; ++tk) { const LAS float* bs = bsw + tk * BLKS_PITCH; v0[tk] = c0 ? bs[j0] : -1.f; v1[tk] = c1 ? bs[j1] : -1.f; }
      if (cur - 2 <= need) {
#pragma unroll
        for (int tk = 0; tk < 8; ++tk) { if (v0[tk] >= 0.f) sm0 |= 1u << tk; if (v1[tk] >= 0.f) sm1 |= 1u << tk; } }
      else for (int k = 0; k < need; ++k) {
#pragma unroll
        for (int tk = 0; tk < 8; ++tk) {
          const float mx = wave_max_dpp(fmaxf(v0[tk], v1[tk]));
          const unsigned long long b0 = __ballot(v0[tk] == mx), b1 = __ballot(v1[tk] == mx);
          const int l = __builtin_ctzll(b0 ? b0 : b1);
          const bool t0 = (b0 != 0ull) && lane == l, t1 = (b0 == 0ull) && lane == l;
          if (t0) { sm0 |= 1u << tk; v0[tk] = -1.f; }
          if (t1) { sm1 |= 1u << tk; v1[tk] = -1.f; } } }
#pragma unroll
      for (int tk = 0; tk < 8; ++tk) { const unsigned long long m0 = __ballot(((sm0 >> tk) & 1u) != 0u), m1 = __ballot(((sm1 >> tk) & 1u) != 0u);
        if (lane == 0) { selb[tk * 4 + 0] = (unsigned)m0; selb[tk * 4 + 1] = (unsigned)(m0 >> 32); selb[tk * 4 + 2] = (unsigned)m1; selb[tk * 4 + 3] = (unsigned)(m1 >> 32); } }
    }
    asm volatile("s_waitcnt lgkmcnt(0)\n\ts_barrier" ::: "memory");
  }
  { LANE_SETUP(); const int nt_real = blk + 1; const int NTs = nt_real < 4 ? 4 : ((nt_real + 1) & ~1);
    const bf16* ks = (const bf16*)(ws + WS_KS) + (size_t)b * SEQ * 128 + kv * 64; const bf16* vs = (const bf16*)(ws + WS_VS) + (size_t)b * SEQ * 128 + kv * 64;
#ifndef NO_M1
    attn_unit<1, 8>((const bf16*)(ws + WS_QR) + m * 512 + head * 64, ks, vs, 0, NTs, blk, pos, (const float*)(ws + WS_NG) + m * 32 + head * 3 + 1, (float*)(ws + WS_OBF) + obo, (bf16*)(ws + WS_OAB) + obb, shm, dm0, dm1);
#endif
 }
  { LANE_SETUP(); int t0, NTw; if (blk >= 9) { t0 = blk - 9; NTw = 10; } else { t0 = 0; const int nt_real = blk + 1; NTw = nt_real < 4 ? 4 : ((nt_real + 1) & ~1); }
    const bf16* kw = (const bf16*)(ws + WS_KW) + ((size_t)b * SEQ + 64 * t0) * 128 + kv * 64; const bf16* vw = (const bf16*)(ws + WS_VW) + ((size_t)b * SEQ + 64 * t0) * 128 + kv * 64;
#ifndef NO_M2
    attn_unit<2, 8>((const bf16*)(ws + WS_QR) + m * 512 + head * 64, kw, vw, t0, NTw, blk, pos, (const float*)(ws + WS_NG) + m * 32 + head * 3 + 2, (float*)(ws + WS_OBF) + obo, (bf16*)(ws + WS_OAB) + obb, shm, dm0, dm1);
#endif
 }
#undef LANE_SETUP
}
#undef SBAR
#undef WAIT_BAR
}

namespace smp {
typedef unsigned long long u64x2 __attribute__((ext_vector_type(2)));
constexpr int SCP = 1040;
constexpr int L_SC = 0, L_PART = L_SC + 4 * SCP * 4, L_OB = L_PART + 32 * 256 * 4, L_BLK = L_OB + 1024, L_SEL = L_BLK + 272 * 8, L_PT = L_SEL + 256, L_RS = L_PT + 4 * NPAGES, L_END = L_RS + 16;
constexpr float NEG = -1e30f;
constexpr int UKS_DEF = 4, UKP_DEF = 3;

__device__ __forceinline__ void ld16(const float* row, int c, float (&v)[16]) {
#pragma unroll
    for (int j = 0; j < 4; ++j) { const f32x4 t = *(const f32x4*)(row + 16 * j + 4 * c); v[4 * j] = t.x; v[4 * j + 1] = t.y; v[4 * j + 2] = t.z; v[4 * j + 3] = t.w; }
}
__device__ __forceinline__ void ld16(const bf16* row, int c, float (&v)[16]) {
#pragma unroll
    for (int j = 0; j < 4; ++j) { const v2u t = *(const v2u*)(row + 16 * j + 4 * c); v[4 * j] = bflo(t.x); v[4 * j + 1] = bfhi(t.x); v[4 * j + 2] = bflo(t.y); v[4 * j + 3] = bfhi(t.y); }
}
__device__ __forceinline__ void ldq(const bf16* row, int c, v2u (&r)[4][4]) {
#pragma unroll
    for (int h = 0; h < 4; ++h)
#pragma unroll
        for (int j = 0; j < 4; ++j) r[h][j] = *(const v2u*)(row + h * 64 + 16 * j + 4 * c);
}
__device__ __forceinline__ void cvtq(const v2u (&r)[4][4], float (&q)[4][16]) {
#pragma unroll
    for (int h = 0; h < 4; ++h)
#pragma unroll
        for (int j = 0; j < 4; ++j) { q[h][4 * j] = bflo(r[h][j].x); q[h][4 * j + 1] = bfhi(r[h][j].x); q[h][4 * j + 2] = bflo(r[h][j].y); q[h][4 * j + 3] = bfhi(r[h][j].y); }
}
__device__ __forceinline__ float qsum(float v) { v += __builtin_bit_cast(float, __builtin_amdgcn_mov_dpp(__builtin_bit_cast(int, v), 0xB1, 0xF, 0xF, true)); v += __builtin_bit_cast(float, __builtin_amdgcn_mov_dpp(__builtin_bit_cast(int, v), 0x4E, 0xF, 0xF, true)); return v; }

template <int UKS = UKS_DEF, class LD>
__device__ __forceinline__ void scores(LAS float* sc, int s0, int n, const float (&q)[4][16], const LD& ld) {
    const int lane = tidx() & 63, w = tidx() >> 6, ks = lane >> 2, c = lane & 3;
    for (int base = w * 16 * UKS; base < n; base += 8 * 16 * UKS) {
        float kx[UKS][16]; bool ok[UKS];
#pragma unroll
        for (int u = 0; u < UKS; ++u) { const int sl = base + 16 * u + ks; ok[u] = sl < n; if (ok[u]) ld(sl, c, kx[u]); else { _Pragma("unroll") for (int i = 0; i < 16; ++i) kx[u][i] = 0.f; } }
#pragma unroll
        for (int u = 0; u < UKS; ++u) { float s[4];
#pragma unroll
            for (int h = 0; h < 4; ++h) { float a = 0.f; _Pragma("unroll") for (int i = 0; i < 16; ++i) a += q[h][i] * kx[u][i]; s[h] = qsum(a); }
            const float sv = c == 0 ? s[0] : (c == 1 ? s[1] : (c == 2 ? s[2] : s[3]));
            if (ok[u]) sc[c * SCP + s0 + base + 16 * u + ks] = sv; }
    }
}
template <int UKP = UKP_DEF, class LD>
__device__ __forceinline__ void pvacc(const LAS float* sc, int s0, int n, float (&acc)[4][16], const LD& ld) {
    const int lane = tidx() & 63, w = tidx() >> 6, ks = lane >> 2, c = lane & 3;
    for (int base = w * 16 * UKP; base < n; base += 8 * 16 * UKP) {
        float vx[UKP][16];
#pragma unroll
        for (int u = 0; u < UKP; ++u) { const int sl = base + 16 * u + ks; const int slc = sl < n ? sl : 0;
            ld(slc, c, vx[u]); }
#pragma unroll
        for (int u = 0; u < UKP; ++u) { const int sl = base + 16 * u + ks; const bool ok = sl < n; const int slc = ok ? sl : 0;
#pragma unroll
            for (int h = 0; h < 4; ++h) { const float pr = sc[h * SCP + s0 + slc]; const float pv = ok ? pr : 0.f;
#pragma unroll
                for (int i = 0; i < 16; ++i) acc[h][i] += pv * vx[u][i]; } }
    }
}
__device__ __forceinline__ void softmax4(LAS float* sc, LAS float* rs, int n) {
    const int lane = tidx() & 63, w = tidx() >> 6;
    __syncthreads();
    if (w < 4) { LAS float* s = sc + w * SCP; float mx = -500.f;
        for (int i = lane; i < n; i += 64) mx = fmaxf(mx, s[i]);
        mx = wave_max(mx); float sum = 0.f;
        for (int i = lane; i < n; i += 64) { const float e = __builtin_amdgcn_exp2f(s[i] - mx); s[i] = e; sum += e; }
        sum = wave_sum(sum); if (lane == 0) rs[w] = sum > 0.f ? 1.f / sum : 0.f; }
    __syncthreads();
}
__device__ __forceinline__ float rowsum4(float v) {
    v += __builtin_bit_cast(float, __builtin_amdgcn_update_dpp(0, __builtin_bit_cast(int, v), 0x124, 0xF, 0xF, false));
    v += __builtin_bit_cast(float, __builtin_amdgcn_update_dpp(0, __builtin_bit_cast(int, v), 0x128, 0xF, 0xF, false));
    return v; }
__device__ __forceinline__ void finish(LAS unsigned char* L, float (&acc)[4][16], const float gate) {
    const int tid = tidx(), lane = tid & 63, w = tid >> 6, c = lane & 3;
    LAS float* part = (LAS float*)(L + L_PART); LAS float* ob = (LAS float*)(L + L_OB); const LAS float* rs = (const LAS float*)(L + L_RS);
#pragma unroll
    for (int h = 0; h < 4; ++h)
#pragma unroll
        for (int i = 0; i < 16; ++i) acc[h][i] = rowsum4(acc[h][i]);
    if ((lane & 12) == 0) {
#pragma unroll
        for (int h = 0; h < 4; ++h)
#pragma unroll
            for (int j = 0; j < 4; ++j) *(LAS f32x4*)(part + (w * 4 + (lane >> 4)) * 256 + h * 64 + 16 * j + 4 * c) = (f32x4){acc[h][4 * j], acc[h][4 * j + 1], acc[h][4 * j + 2], acc[h][4 * j + 3]};
    }
    __syncthreads();
    if (tid < 256) { float s0 = 0.f, s1 = 0.f;
#pragma unroll
        for (int ww = 0; ww < 32; ww += 2) { s0 += part[ww * 256 + tid]; s1 += part[(ww + 1) * 256 + tid]; }
        ob[tid] += gate * rs[tid >> 6] * (s0 + s1); }
    __syncthreads();
}

__device__ __forceinline__ void nsa_sample_unit(const unsigned char* ws, const float* cks, const float* cvs, const float* ckw, const float* cvw, const int* ptab, LAS unsigned char* L, int sb, int kv, int st) {
    const int tid = tidx(), lane = tid & 63, c = lane & 3;
    const size_t m = (size_t)MP + 4 * sb + st;
    LAS float* sc = (LAS float*)(L + L_SC); LAS float* ob = (LAS float*)(L + L_OB); LAS unsigned long long* bk = (LAS unsigned long long*)(L + L_BLK); LAS int* sel = (LAS int*)(L + L_SEL);
    const float* gates = (const float*)(ws + WS_NG) + m * 32 + (4 * kv) * 3;
    const bf16* KSn = (const bf16*)(ws + WS_KS) + ((size_t)MP + 4 * sb) * 128 + kv * 64; const bf16* VSn = (const bf16*)(ws + WS_VS) + ((size_t)MP + 4 * sb) * 128 + kv * 64;
    const bf16* KWn = (const bf16*)(ws + WS_KW) + ((size_t)MP + 4 * sb) * 128 + kv * 64; const bf16* VWn = (const bf16*)(ws + WS_VW) + ((size_t)MP + 4 * sb) * 128 + kv * 64;
#ifdef TIME_PROBE_A
#define SSTAMP(k) do { if (blockIdx.x == 0 && tid == 0) ((unsigned long long*)(ws + WS_DBG + 65536))[k] = __builtin_amdgcn_s_memrealtime(); } while (0)
#else
#define SSTAMP(k) do { } while (0)
#endif
    float gt[3]; { const float* gp = gates + ((tid & 255) >> 6) * 3; gt[0] = gp[0]; gt[1] = gp[1]; gt[2] = gp[2]; }
    LAS float* rsL = (LAS float*)(L + L_RS);
    v2u qrr[4][4];
    __syncthreads();
    SSTAMP(20);
    if (tid < 256) ob[tid] = 0.f;
    if (tid < 2) sel[tid] = tid * 255; if (tid == 2) sel[32] = tid;
    LAS int* ptl = (LAS int*)(L + L_PT); if (tid >= 512 - NPAGES) ptl[tid - (512 - NPAGES)] = ptab[sb * NPAGES + tid - (512 - NPAGES)];
    {
        float q[4][16];
#pragma unroll
        for (int h = 0; h < 4; ++h) ld16((const bf16*)(ws + WS_QN) + m * 512 + (4 * kv + h) * 64, c, q[h]);
        const bf16* kc = (const bf16*)(ws + WS_KCS) + (size_t)(sb * 2 + kv) * NCS * 64; const bf16* vc = (const bf16*)(ws + WS_VCS) + (size_t)(sb * 2 + kv) * NCS * 64;
        auto kp = [&](int sl, int cc, float (&v)[16]) { ld16(kc + (size_t)sl * 64, cc, v); }; auto vp = [&](int sl, int cc, float (&v)[16]) { ld16(vc + (size_t)sl * 64, cc, v); };
        scores(sc, 0, NCS - 1, q, kp);
        ldq((const bf16*)(ws + WS_QR) + m * 512 + (4 * kv) * 64, c, qrr);
        softmax4(sc, rsL, NCS - 1);
        float acc[4][16] = {};
        pvacc(sc, 0, NCS - 1, acc, vp);
        finish(L, acc, gt[0]);
    }
    SSTAMP(21);
    if (tid < 257) { const int j = tid; float v[5]; const float r0 = rsL[0], r1 = rsL[1], r2 = rsL[2], r3 = rsL[3];
#pragma unroll
        for (int i = 0; i < 5; ++i) { const int cc = 4 * j - 1 + i; v[i] = (cc >= 0 && cc < NCS - 1) ? (r0 * sc[cc] + r1 * sc[SCP + cc]) + (r2 * sc[2 * SCP + cc] + r3 * sc[3 * SCP + cc]) : 0.f; }
        const float bs = v[0] + 2.f * (v[1] + v[2] + v[3]) + v[4];
        const unsigned ub = __builtin_bit_cast(unsigned, bs); const unsigned so = ub ^ ((ub >> 31) ? 0xFFFFFFFFu : 0x80000000u);
        bk[j] = (j == 0 || j >= 255) ? 0ull : (((unsigned long long)so << 32) | (unsigned)(255 - j)); }
    __syncthreads();
    SSTAMP(26);
    {
        const int j = tid >> 1, hfr = tid & 1; const unsigned long long kj = bk[j]; int cnt = 0;
#pragma unroll 8
        for (int i0 = 0; i0 < 128; i0 += 2) { const u64x2 v = *(const LAS u64x2*)(bk + 128 * hfr + i0); cnt += (v.x > kj ? 1 : 0) + (v.y > kj ? 1 : 0); }
        cnt += __shfl_xor(cnt, 1);
        if (hfr == 0 && j >= 1 && j <= 254 && cnt < 13) { const int k = __hip_atomic_fetch_add(sel + 32, 1, __ATOMIC_RELAXED, __HIP_MEMORY_SCOPE_WORKGROUP); if (k < 15) sel[k] = j; } }
    __syncthreads();
    SSTAMP(27);
    if (tid < 15) { const int b = sel[tid]; sel[16 + tid] = ptl[b >> 1] * 128 + (b & 1) * 64; }
    __syncthreads();
    SSTAMP(22);
    {
        float q[4][16]; cvtq(qrr, q);
        auto kp = [&](int sl, int cc, float (&v)[16]) { if (sl < 960) ld16(cks + ((size_t)sel[16 + (sl >> 6)] + (sl & 63)) * 128 + kv * 64, cc, v); else ld16(KSn + (size_t)(sl - 960) * 128, cc, v); };
        auto vp = [&](int sl, int cc, float (&v)[16]) { if (sl < 960) ld16(cvs + ((size_t)sel[16 + (sl >> 6)] + (sl & 63)) * 128 + kv * 64, cc, v); else ld16(VSn + (size_t)(sl - 960) * 128, cc, v); };
        scores(sc, 0, 960 + st + 1, q, kp);
        softmax4(sc, rsL, 960 + st + 1);
        float acc[4][16] = {};
        pvacc(sc, 0, 960 + st + 1, acc, vp);
        finish(L, acc, gt[1]);
    }
    SSTAMP(24);
    {
        float q[4][16]; cvtq(qrr, q);
        const float* ck = ckw + ((size_t)sb * WIN + st + 1) * 128 + kv * 64; const float* cv = cvw + ((size_t)sb * WIN + st + 1) * 128 + kv * 64; const int nc = WIN - 1 - st;
        auto kp = [&](int sl, int cc, float (&v)[16]) { if (sl < nc) ld16(ck + (size_t)sl * 128, cc, v); else ld16(KWn + (size_t)(sl - nc) * 128, cc, v); };
        auto vp = [&](int sl, int cc, float (&v)[16]) { if (sl < nc) ld16(cv + (size_t)sl * 128, cc, v); else ld16(VWn + (size_t)(sl - nc) * 128, cc, v); };
        scores(sc, 0, WIN, q, kp);
        softmax4(sc, rsL, WIN);
        float acc[4][16] = {};
        pvacc(sc, 0, WIN, acc, vp);
        finish(L, acc, gt[2]);
    }
    SSTAMP(25);
    if (tid < 256) ((bf16*)(ws + WS_OAB))[m * 1024 + 512 + (4 * kv) * 64 + tid] = (bf16)f2bf(ob[tid]);
    __syncthreads();
}
}

#ifdef ATT_CHECK
namespace chk {
constexpr int C_Q = 0, C_SC = C_Q + 2 * 8 * 64 * 4, C_IMP = C_SC + 4 * 1032 * 4, C_BLK = C_IMP + 1032 * 4, C_IDX = C_BLK + 264 * 4, C_O = C_IDX + 64, C_RED = C_O + 256 * 4, C_END = C_RED + 64;
constexpr int SP = 1032;
struct Src { const unsigned char* ws; const float* const* in; };

__device__ __forceinline__ float sel_fetch(const unsigned char* ws, const float* cache, const int* pt, bool smp, int b, int kv, int kpos, int d, size_t wsoff) {
    if (!smp) { int p = kpos < 0 ? 0 : (kpos > SEQ - 1 ? SEQ - 1 : kpos); return bf2f(((const bf16*)(ws + wsoff))[((size_t)b * SEQ + p) * 128 + kv * 64 + d]); }
    if (kpos < PAST) { int pc = kpos < 0 ? 0 : kpos; const int pg = pt[b * NPAGES + (pc >> 7)]; return cache[((size_t)pg * 128 + (pc & 127)) * 128 + kv * 64 + d]; }
    int pn = kpos - PAST; pn = pn > 3 ? 3 : pn; return bf2f(((const bf16*)(ws + wsoff))[((size_t)MP + 4 * b + pn) * 128 + kv * 64 + d]);
}
__device__ __forceinline__ void softmax_rows(LAS float* sc, int n) {
    const int lane = tidx() & 63, w = tidx() >> 6;
    if (w < 4) { LAS float* s = sc + w * SP; float mx = -3e38f;
        for (int i = lane; i < n; i += 64) mx = fmaxf(mx, s[i]);
        mx = wave_max(mx); const bool any = mx > -1e29f; float sum = 0.f;
        for (int i = lane; i < n; i += 64) { const float e = (any && s[i] > -1e29f) ? exp2f(s[i] - mx) : 0.f; s[i] = e; sum += e; }
        sum = wave_sum(sum); const float rs = sum > 0.f ? 1.f / sum : 0.f;
        for (int i = lane; i < n; i += 64) s[i] *= rs; }
    __syncthreads();
}
__device__ __forceinline__ void check_token(const unsigned char* ws, const float* const* in, LAS unsigned char* L, bool smp, int b, int tq, float& emax, float& rmax) {
    const int tid = tidx();
    LAS float* q = (LAS float*)(L + C_Q); LAS float* sc = (LAS float*)(L + C_SC); LAS float* imp = (LAS float*)(L + C_IMP); LAS float* blk = (LAS float*)(L + C_BLK);
    LAS int* idx = (LAS int*)(L + C_IDX); LAS float* oo = (LAS float*)(L + C_O); LAS float* red = (LAS float*)(L + C_RED);
    const int pos = smp ? PAST + tq : tq; const size_t m = smp ? (size_t)MP + 4 * b + tq : (size_t)b * SEQ + tq;
    const int NC = smp ? NCS - 1 : NCP - 1, n_sel = smp ? 257 : 128, n_ch = 4 * n_sel, cur = pos >> 6;
    const int* pt = (const int*)in[I_PT];
    __syncthreads();
    for (int i = tid; i < 1024; i += 512) { const int ty = i >> 9, r = i & 511; q[i] = bf2f(((const bf16*)(ws + (ty ? WS_QR : WS_QN)))[m * 512 + r]); }
    if (tid == 0) { red[0] = 0.f; red[1] = 0.f; }
    __syncthreads();
    for (int kv = 0; kv < 2; ++kv) {
        if (tid < 256) oo[tid] = 0.f;
        __syncthreads();
        { const bf16* kc = (const bf16*)(ws + (smp ? WS_KCS : WS_KCP)) + (size_t)(b * 2 + kv) * (smp ? NCS : NCP) * 64; const bf16* vc = (const bf16*)(ws + (smp ? WS_VCS : WS_VCP)) + (size_t)(b * 2 + kv) * (smp ? NCS : NCP) * 64;
          for (int c = tid; c < NC; c += 512) { float d0 = 0.f, d1 = 0.f, d2 = 0.f, d3 = 0.f;
              for (int d = 0; d < 64; ++d) { const float k = bf2f(kc[(size_t)c * 64 + d]); d0 += q[(4 * kv + 0) * 64 + d] * k; d1 += q[(4 * kv + 1) * 64 + d] * k; d2 += q[(4 * kv + 2) * 64 + d] * k; d3 += q[(4 * kv + 3) * 64 + d] * k; }
              const bool ok = (c * 16 + 31 <= pos); sc[c] = ok ? d0 : -1e30f; sc[SP + c] = ok ? d1 : -1e30f; sc[2 * SP + c] = ok ? d2 : -1e30f; sc[3 * SP + c] = ok ? d3 : -1e30f; }
          __syncthreads();
          softmax_rows(sc, NC);
          if (tid < 256) { const int h = tid >> 6, d = tid & 63; float a = 0.f; for (int c = 0; c < NC; ++c) a += sc[h * SP + c] * bf2f(vc[(size_t)c * 64 + d]);
              oo[tid] += ((const float*)(ws + WS_NG))[m * 32 + (4 * kv + h) * 3 + 0] * a; }
          for (int c = tid; c < 1032; c += 512) imp[c] = c < NC ? (sc[c] + sc[SP + c]) + (sc[2 * SP + c] + sc[3 * SP + c]) : 0.f;
          __syncthreads(); }
        for (int j = tid; j < n_sel; j += 512) { float s = 0.f;
            for (int i = 0; i < 4; ++i) { const int c = 4 * j + i; const float a = (c < NC && c < n_ch) ? imp[c] : 0.f; const float bsh = (c >= 1 && c - 1 < NC) ? imp[c - 1] : 0.f; s += a + bsh; }
            const bool forced = (j == 0) || (j == cur) || (j == cur - 1), valid = (j * 64 <= pos);
            blk[j] = forced ? 1e4f : (valid ? s : -1e4f); }
        __syncthreads();
        if (tid == 0) { for (int k = 0; k < 16; ++k) { int bi = 0; float bv = -3e38f; for (int j = 0; j < n_sel; ++j) if (blk[j] > bv) { bv = blk[j]; bi = j; } idx[k] = bi; blk[bi] = -3e38f; } }
        __syncthreads();
        { const float* ck = in[I_CKS]; const float* cv = in[I_CVS];
          for (int s = tid; s < 1024; s += 512) { const int bi = idx[s >> 6], kpos = bi * 64 + (s & 63); const bool ok = (bi * 64 <= pos) && (kpos <= pos);
              float d0 = 0.f, d1 = 0.f, d2 = 0.f, d3 = 0.f;
              if (ok) for (int d = 0; d < 64; ++d) { const float k = sel_fetch(ws, ck, pt, smp, b, kv, kpos, d, WS_KS); d0 += q[512 + (4 * kv + 0) * 64 + d] * k; d1 += q[512 + (4 * kv + 1) * 64 + d] * k; d2 += q[512 + (4 * kv + 2) * 64 + d] * k; d3 += q[512 + (4 * kv + 3) * 64 + d] * k; }
              sc[s] = ok ? d0 : -1e30f; sc[SP + s] = ok ? d1 : -1e30f; sc[2 * SP + s] = ok ? d2 : -1e30f; sc[3 * SP + s] = ok ? d3 : -1e30f; }
          __syncthreads();
          softmax_rows(sc, 1024);
          if (tid < 256) { const int h = tid >> 6, d = tid & 63; float a = 0.f;
              for (int s = 0; s < 1024; ++s) { const float p = sc[h * SP + s]; if (p != 0.f) a += p * sel_fetch(ws, cv, pt, smp, b, kv, idx[s >> 6] * 64 + (s & 63), d, WS_VS); }
              oo[tid] += ((const float*)(ws + WS_NG))[m * 32 + (4 * kv + h) * 3 + 1] * a; }
          __syncthreads(); }
        { const int nw = smp ? WIN + DECS : WIN;
          const float* ckw = in[I_CKW]; const float* cvw = in[I_CVW];
          for (int s = tid; s < nw; s += 512) { const int kpos = smp ? PAST - WIN + s : pos - (WIN - 1) + s; const int dp = pos - kpos; const bool ok = dp >= 0 && dp < WIN && kpos >= 0;
              float d0 = 0.f, d1 = 0.f, d2 = 0.f, d3 = 0.f;
              if (ok) for (int d = 0; d < 64; ++d) { float k;
                  if (!smp) k = bf2f(((const bf16*)(ws + WS_KW))[((size_t)b * SEQ + kpos) * 128 + kv * 64 + d]);
                  else if (s < WIN) k = ckw[((size_t)b * WIN + s) * 128 + kv * 64 + d]; else k = bf2f(((const bf16*)(ws + WS_KW))[((size_t)MP + 4 * b + (s - WIN)) * 128 + kv * 64 + d]);
                  d0 += q[512 + (4 * kv + 0) * 64 + d] * k; d1 += q[512 + (4 * kv + 1) * 64 + d] * k; d2 += q[512 + (4 * kv + 2) * 64 + d] * k; d3 += q[512 + (4 * kv + 3) * 64 + d] * k; }
              sc[s] = ok ? d0 : -1e30f; sc[SP + s] = ok ? d1 : -1e30f; sc[2 * SP + s] = ok ? d2 : -1e30f; sc[3 * SP + s] = ok ? d3 : -1e30f; }
          __syncthreads();
          softmax_rows(sc, nw);
          if (tid < 256) { const int h = tid >> 6, d = tid & 63; float a = 0.f;
              for (int s = 0; s < nw; ++s) { const float p = sc[h * SP + s]; if (p == 0.f) continue; const int kpos = smp ? PAST - WIN + s : pos - (WIN - 1) + s; float v;
                  if (!smp) v = bf2f(((const bf16*)(ws + WS_VW))[((size_t)b * SEQ + kpos) * 128 + kv * 64 + d]);
                  else if (s < WIN) v = cvw[((size_t)b * WIN + s) * 128 + kv * 64 + d]; else v = bf2f(((const bf16*)(ws + WS_VW))[((size_t)MP + 4 * b + (s - WIN)) * 128 + kv * 64 + d]);
                  a += p * v; }
              oo[tid] += ((const float*)(ws + WS_NG))[m * 32 + (4 * kv + h) * 3 + 2] * a; }
          __syncthreads(); }
        if (tid < 256) { const float ref = oo[tid], got = bf2f(((const bf16*)(ws + WS_OAB))[m * 1024 + 512 + (4 * kv) * 64 + tid]);
            float e = fabsf(got - ref), r = fabsf(ref); e = wave_max(e); r = wave_max(r);
            if ((tid & 63) == 0) { __hip_atomic_fetch_max((LAS unsigned*)red, __float_as_uint(e), __ATOMIC_RELAXED, __HIP_MEMORY_SCOPE_WORKGROUP); __hip_atomic_fetch_max((LAS unsigned*)red + 1, __float_as_uint(r), __ATOMIC_RELAXED, __HIP_MEMORY_SCOPE_WORKGROUP); } }
        __syncthreads();
    }
    emax = red[0]; rmax = red[1];
    __syncthreads();
}

__device__ __forceinline__ void check_compress(const unsigned char* ws, const float* const* in, const float* out, LAS unsigned char* L, bool smp, int b, int c, int kv, int which, float& emax, float& rmax) {
    const int tid = tidx(), p = tid >> 6, j = tid & 63;
    LAS float* part = (LAS float*)L; LAS float* hdn = part + 512; LAS float* res = hdn + 64;
    const float* w1 = in[which ? I_WCV1 : I_WCK1]; const float* w2 = in[which ? I_WCV2 : I_WCK2]; const float* pe = in[which ? I_PEV : I_PEK];
    const float* cache = in[which ? I_CVC : I_CKC]; const int* pt = (const int*)in[I_PT];
    __syncthreads();
    float s = 0.f;
    for (int i = 256 * p; i < 256 * p + 256; ++i) { const int t = 16 * c + (i >> 6), d = i & 63; float x;
        if (!smp) x = out[(which ? O_PVC : O_PKC) + ((size_t)(b * SEQ + t) * 2 + kv) * 64 + d];
        else { const int pg = pt[b * NPAGES + (t >> 7)]; x = cache[(((size_t)pg * 128 + (t & 127)) * 2 + kv) * 64 + d]; }
        s += (x + pe[i]) * w1[(size_t)i * 64 + j]; }
    part[p * 64 + j] = s;
    __syncthreads();
    if (tid < 64) { float a = 0.f; for (int q = 0; q < 8; ++q) a += part[q * 64 + tid]; const float u = 0.7978845608028654f * (a + 0.044715f * a * a * a); hdn[tid] = 0.5f * a * (1.f + tanhf(u)); }
    __syncthreads();
    if (tid < 64) { float o = 0.f; for (int q = 0; q < 64; ++q) o += hdn[q] * w2[q * 64 + tid]; res[tid] = o; }
    __syncthreads();
    if (tid < 64) { float o = res[tid];
        if (which == 0) { float ss = 0.f; for (int q = 0; q < 64; ++q) ss += res[q] * res[q]; o = o * (1.f / sqrtf(ss / 64.f + EPS)) * in[I_GKC][tid]; }
        const int nc = smp ? NCS : NCP; const float got = bf2f(((const bf16*)(ws + (smp ? (which ? WS_VCS : WS_KCS) : (which ? WS_VCP : WS_KCP))))[((size_t)(b * 2 + kv) * nc + c) * 64 + tid]);
        float e = fabsf(got - o), r = fabsf(o); e = wave_max(e); r = wave_max(r); if (tid == 0) { res[64] = e; res[65] = r; } }
    __syncthreads();
    emax = res[64]; rmax = res[65];
    __syncthreads();
}
}
#endif

#ifndef MK_N_LAUNCHES
#define MK_N_LAUNCHES 1
#endif
constexpr int N_PHASES = 9;
struct Args { const void* in[N_IN]; float* out; unsigned char* ws; int ph_lo, ph_hi; };
static_assert(sizeof(Args) == (N_IN + 2) * 8 + 8, "no padding bytes in Args");

__global__ void __launch_bounds__(NWAVES * 64, 2) hybrid_fwd(Args args) {
    extern __shared__ __attribute__((aligned(16))) unsigned char lds[];
    Frame F;
    F.lds = (LAS unsigned char*)lds;
    F.MISC = (volatile LAS unsigned*)(F.lds + MISC_OFF);
    F.tid = tidx(); F.lane = F.tid & 63; F.wave = __builtin_amdgcn_readfirstlane(F.tid >> 6);
    F.G = gridDim.x; { const int bx = blockIdx.x; F.vcu = (F.G % 8 == 0) ? (bx % 8) * (F.G / 8) + bx / 8 : bx; }
    F.ws = args.ws; F.out = args.out; F.ctl = (gu32*)(args.ws + WS_CTL);
#pragma unroll
    for (int i = 0; i < N_IN; ++i) F.in[i] = (const float*)args.in[i];
    for (int u = F.tid; u < 64; u += NWAVES * 64) ((LAS unsigned*)(F.lds + MISC_OFF))[u] = 0u;
    __syncthreads();
    XcdBarrier bar; bar.bar = (unsigned*)(F.ctl + CW_BAR); bar.x = 0; bar.st = nullptr;
    if (MK_N_LAUNCHES == 1) bar = xcd_barrier_post((unsigned*)(F.ctl + CW_BAR), F.MISC + 8);
#define GRID_BAR() do { if (MK_N_LAUNCHES == 1) xcd_barrier(bar); } while (0)
    const int lo = args.ph_lo, hi = args.ph_hi;
#ifdef TIME_PROBE_A
    unsigned long long* tsp = (unsigned long long*)(args.ws + WS_DBG + 65536);
#define STAMP(k) do { if (blockIdx.x == 0 && F.tid == 0) tsp[k] = __builtin_amdgcn_s_memrealtime(); } while (0)
    STAMP(0);
#else
#define STAMP(k) do { } while (0)
#endif
#ifndef PH_MASK
#define PH_MASK 0x1ff
#endif
#define FRESH_IDS() do { const int t_ = tidx(); F.tid = t_; F.lane = t_ & 63; } while (0)
#define IN(k) (((PH_MASK >> (k)) & 1) && lo <= (k) && (k) < hi)
#define BOTH(k) (IN(k) && IN((k) + 1))
#ifndef DUP_MASK
#define DUP_MASK 0
#endif
#define REP(k) for (int rep_ = 0; rep_ < (((DUP_MASK >> (k)) & 1) ? 2 : 1); ++rep_)

    if (IN(0)) { FRESH_IDS(); REP(0) p0_prologue(F); if (BOTH(0)) GRID_BAR(); STAMP(1); }

    if (IN(1)) { FRESH_IDS();
#ifndef CP_SPEC
#define CP_SPEC 0
#endif
        constexpr int NCPW = CP_SPEC;
        if (NCPW > 0 && F.G == 256 && (int)blockIdx.x < NCPW) { REP(1) compress_tasks<true>(F, (int)blockIdx.x & 1, (int)blockIdx.x >> 1, NCPW > 0 ? NCPW / 2 : 1, DECB * NPAGES); }
        else {
        const bool spec = (NCPW > 0 && F.G == 256);
        pg8::Gemm g{WSP(bf16, WS_XN), WSP(bf16, WS_WINT), MPAD, NIN, DM}; pg8::StaticOrder S; S.init(MPAD, NIN, spec ? F.G - NCPW : F.G, spec ? (int)blockIdx.x - NCPW : (int)blockIdx.x);
        pg8::EpiIn E{F.ws, F.out};
        REP(1) pg8::gemm_phase<pg8::EpiIn, pg8::StaticOrder, true, true>(F.lds, g, S, E);
        }
        if (BOTH(1)) GRID_BAR(); STAMP(2);
    }

    if (IN(2)) { FRESH_IDS();
        STAMP(10);
        if (!(CP_SPEC > 0 && F.G == 256)) { REP(2) for (int which = 0; which < 2; ++which) compress_tasks<true>(F, which, (int)blockIdx.x, F.G, DECB * NPAGES); }
        STAMP(11);
        if (F.G == 256) compress_tasks<false>(F, (int)blockIdx.x >> 7, (int)blockIdx.x & 127, 128, 128);
        else for (int which = 0; which < 2; ++which) compress_tasks<false>(F, which, (int)blockIdx.x, F.G, 128);
        STAMP(12);
        REP(10) for (int n = F.G - 1 - (int)blockIdx.x; n < (F.G == 256 ? 256 : GMLP_UNITS); n += F.G) gmlp_unit(F, n);
        __syncthreads();
        STAMP(13);
        if (BOTH(2)) GRID_BAR(); STAMP(3);
    }

    if (IN(3)) { FRESH_IDS();
        if (F.G == 256) { if ((int)blockIdx.x >= 254) { gmlp_unit(F, 256 + ((int)blockIdx.x - 254)); __syncthreads(); } else { REP(3) compress_stage2(F, (int)blockIdx.x, 254); } }
        else { REP(3) compress_stage2(F, F.vcu, F.G); }
        if (BOTH(3)) GRID_BAR(); STAMP(4); }

    if (IN(4)) { FRESH_IDS();
        #ifndef NO_PROMPT
        REP(4) for (int pr = F.vcu; pr < 256; pr += F.G) { const int bk = pr >> 6, s = pr & 63;
            STAMP(14);
            att::nsa_prompt_unit(F.ws, bk >> 1, bk & 1, 127 - s, (char*)lds);
            STAMP(15);
            att::nsa_prompt_unit(F.ws, bk >> 1, bk & 1, s, (char*)lds);
            STAMP(16); }
#endif
#ifndef NO_SMP
        REP(9) for (int su = (int)blockIdx.x; su < 256; su += F.G) smp::nsa_sample_unit(F.ws, F.in[I_CKS], F.in[I_CVS], F.in[I_CKW], F.in[I_CVW], (const int*)F.in[I_PT], F.lds, su >> 3, (su >> 2) & 1, su & 3);
#endif
        STAMP(17);
        if (BOTH(4)) GRID_BAR(); STAMP(5);
    }

#ifdef ATT_CHECK
    {
        if (!BOTH(4)) GRID_BAR();
        const int i = (int)blockIdx.x; const int special[16] = {0, 1, 30, 31, 32, 63, 64, 65, 127, 128, 1023, 1024, 1025, 4095, 8191, 7680};
        int pos = (int)(((unsigned)i * 2654435761u) >> 19) & 8191;
#pragma unroll
        for (int k = 0; k < 16; ++k) if ((i >> 1) == k) pos = special[k];
        float e, r; float* dbg = WSP(float, WS_DBG);
        chk::check_token(F.ws, F.in, F.lds, false, i & 1, pos, e, r);
        if (F.tid == 0) dbg[i] = e / fmaxf(r, 1e-9f);
        chk::check_token(F.ws, F.in, F.lds, true, (i & 127) >> 2, i & 3, e, r);
        if (F.tid == 0) dbg[256 + i] = e / fmaxf(r, 1e-9f);
        {
            float E = 0.f; const unsigned hsh = (unsigned)i * 2246822519u;
            int cp = (int)((hsh >> 8) % 511u), cs = (int)((hsh >> 10) % 1023u); if (i == 0) { cp = 0; cs = 0; } if (i == 1) { cp = 510; cs = 1022; } if (i == 2) { cp = 509; cs = 7; } if (i == 3) { cp = 255; cs = 8; }
            for (int which = 0; which < 2; ++which) {
                chk::check_compress(F.ws, F.in, F.out, F.lds, false, i & 1, cp, (i >> 1) & 1, which, e, r); E = fmaxf(E, e / fmaxf(r, 1e-9f));
                chk::check_compress(F.ws, F.in, F.out, F.lds, true, i & 31, cs, (i >> 5) & 1, which, e, r); E = fmaxf(E, e / fmaxf(r, 1e-9f)); }
            if (F.tid == 0) dbg[512 + i] = E; }
        __syncthreads();
    }
#endif
    if (IN(5)) { FRESH_IDS();
        skinny_gemm<SkMerge, 1, true>(WSP(bf16, WS_OAB) + (size_t)MP * DM, WSP(bf16, WS_WBT), DM, DM, F.G, (int)blockIdx.x, SkMerge{F.ws});
        pg8::Gemm g{WSP(bf16, WS_OAB), WSP(bf16, WS_WBT), MP, DM, DM}; pg8::StaticOrder S; S.init(MP, DM, F.G, (int)blockIdx.x);
        pg8::EpiMerge E{WSP(bf16, WS_SG), WSP(bf16, WS_MG)};
        REP(5) pg8::gemm_phase<pg8::EpiMerge, pg8::StaticOrder, true, true>(F.lds, g, S, E);
        if (BOTH(5)) GRID_BAR(); STAMP(6);
    }

    if (IN(6)) { FRESH_IDS();
        skinny_gemm(WSP(bf16, WS_MG) + (size_t)MP * DM, WSP(bf16, WS_WOT), DM, DM, F.G, (int)blockIdx.x, SkOut{F.ws, F.in[I_XS], F.out});
        pg8::Gemm g{WSP(bf16, WS_MG), WSP(bf16, WS_WOT), MP, DM, DM}; pg8::StaticOrder S; S.init(MP, DM, F.G, (int)blockIdx.x);
        pg8::EpiOut E{F.in[I_XP], F.in[I_XS], F.out, WSP(bf16, WS_X1B), WSP(float, WS_SSQ)};
        REP(6) pg8::gemm_phase<pg8::EpiOut, pg8::StaticOrder, true, true>(F.lds, g, S, E);
        if (BOTH(6)) GRID_BAR(); STAMP(7);
    }

    if (IN(7)) { FRESH_IDS();
        skinny_gemm(WSP(bf16, WS_X1B) + (size_t)MP * DM, WSP(bf16, WS_WUP), DFF, DM, F.G, (int)blockIdx.x, SkUp{F.ws});
        pg8::Gemm g{WSP(bf16, WS_X1B), WSP(bf16, WS_WUP), MP, DFF, DM}; pg8::StaticOrder S; S.init(MP, DFF, F.G, (int)blockIdx.x);
        pg8::EpiUp E{WSP(float, WS_SSQ), WSP(bf16, WS_H)};
        REP(7) pg8::gemm_phase<pg8::EpiUp, pg8::StaticOrder, true, true>(F.lds, g, S, E);
        if (BOTH(7)) GRID_BAR(); STAMP(8);
    }

    if (IN(8)) { FRESH_IDS();
        skinny_gemm<SkDown, 4>(WSP(bf16, WS_H) + (size_t)MP * DFF, WSP(bf16, WS_WDN), DM, DFF, F.G, (int)blockIdx.x, SkDown{F.out});
        pg8::Gemm g{WSP(bf16, WS_H), WSP(bf16, WS_WDN), MP, DM, DFF}; pg8::StaticOrder S; S.init(MP, DM, F.G, (int)blockIdx.x);
        pg8::EpiDown E{F.out, WSP(bf16, WS_X1B)};
        pg8::gemm_phase<pg8::EpiDown, pg8::StaticOrder, true, true>(F.lds, g, S, E);
    }
#ifdef TIME_PROBE_A
    GRID_BAR(); STAMP(9);
    if (blockIdx.x == 0) {
        #ifndef TIME_PROBE_AE
#define TIME_PROBE_AE (TIME_PROBE_A + 1)
#endif
#ifndef TIME_PROBE_BE
#define TIME_PROBE_BE (TIME_PROBE_B + 1)
#endif
        const float da = (float)(tsp[TIME_PROBE_AE] - tsp[TIME_PROBE_A]) * 0.01f, db = (float)(tsp[TIME_PROBE_BE] - tsp[TIME_PROBE_B]) * 0.01f;
        if (F.tid == 0) F.out[O_YP] += da * 0.01f;
        for (int t = F.tid; t < 4096 * 1024; t += 512) F.out[O_YP + 1024 + t] += db * (1.f / 3000.f); }
#endif
#ifdef ATT_CHECK
    GRID_BAR();
    if (blockIdx.x == 0) { float E = 0.f; const float* dbg = WSP(float, WS_DBG);
        for (int k = 0; k < 768; ++k) { if (!((ATT_CHECK >> (k >> 8)) & 1)) continue; E = fmaxf(E, dbg[k]); }
        for (int t = F.tid; t < 1024; t += 512) F.out[O_YP + t] += E * 2000.f; }
#endif
#undef IN
#undef BOTH
}

extern "C" void kernel_launch(void* const* d_in, const int* in_sizes, int n_in, void* d_out, int out_size, void* d_ws, size_t ws_size, hipStream_t stream) {
    static int grid = 0;
    if (grid == 0) {
        if (n_in != N_IN || in_sizes[0] != MP * DM || (size_t)out_size != O_END || ws_size < WS_END) {
            fprintf(stderr, "kernel_launch: unexpected problem: n_in %d in0 %d out %d ws %zu (need %zu); nothing launched\n", n_in, n_in > 0 ? in_sizes[0] : -1, out_size, ws_size, (size_t)WS_END); grid = -1; return; }
        int dev = 0, cus = 0, per_cu = 0;
        if (hipGetDevice(&dev) != hipSuccess || hipDeviceGetAttribute(&cus, hipDeviceAttributeMultiprocessorCount, dev) != hipSuccess) { grid = -1; return; }
        if (hipFuncSetAttribute((const void*)hybrid_fwd, hipFuncAttributeMaxDynamicSharedMemorySize, LDS_BYTES) != hipSuccess) { fprintf(stderr, "kernel_launch: hipFuncSetAttribute failed\n"); grid = -1; return; }
        if (hipOccupancyMaxActiveBlocksPerMultiprocessor(&per_cu, (const void*)hybrid_fwd, NWAVES * 64, LDS_BYTES) != hipSuccess || per_cu < 1)
            fprintf(stderr, "kernel_launch: note: occupancy query reports %d workgroups per CU\n", per_cu);
        (void)hipGetLastError();
        grid = cus;
    }
    if (grid < 0) return;
    if (hipMemsetAsync((char*)d_ws + WS_CTL, 0, CTL_ZERO_BYTES, stream) != hipSuccess) return;
    Args a{};
    for (int i = 0; i < N_IN; ++i) a.in[i] = d_in[i];
    a.out = (float*)d_out; a.ws = (unsigned char*)d_ws;
    if (MK_N_LAUNCHES == 1) { a.ph_lo = 0; a.ph_hi = N_PHASES; hipLaunchKernelGGL(hybrid_fwd, dim3(grid), dim3(NWAVES * 64), LDS_BYTES, stream, a); }
    else for (int p = 0; p < N_PHASES; ++p) { a.ph_lo = p; a.ph_hi = p + 1; hipLaunchKernelGGL(hybrid_fwd, dim3(grid), dim3(NWAVES * 64), LDS_BYTES, stream, a); }
    const hipError_t le = hipPeekAtLastError();
    if (le != hipSuccess) fprintf(stderr, "kernel_launch: launch failed: %s\n", hipGetErrorName(le));
}
```

```cpp
#include <hip/hip_runtime.h>
#include <hip/hip_bf16.h>
#include <cstdio>
#include <cstdint>
#include <cmath>

constexpr int DM = 1024, SEQ = 8192, NBAT = 2, MP = NBAT * SEQ, NSMP = 128, MT = MP + NSMP, MPAD = 16640;
constexpr int AW = 512, NHEAD = 8, HD = 64, NKV = 2, DFF = 4096, INC = 4376, NIN = 4608;
constexpr int PAST = 16384, NPAGES = 128, DECB = 32, DECS = 4, WIN = 512;
constexpr int NCP = 512, NCS = 1024;
constexpr float EPS = 1e-6f;
constexpr float QC2 = 0.125f * 1.4426950408889634f;

enum { I_XP = 0, I_XS, I_CKC, I_CVC, I_CKS, I_CVS, I_CKW, I_CVW, I_PT, I_G1, I_WIN, I_LNG, I_LNB, I_WS, I_BS, I_GQ, I_GKC, I_GKS, I_GKW,
       I_WCK1, I_WCK2, I_PEK, I_WCV1, I_WCV2, I_PEV, I_WBR, I_WOUT, I_G2, I_WUP, I_WDN, N_IN };
constexpr size_t O_YP = 0, O_YS = O_YP + (size_t)MP * DM, O_PKC = O_YS + (size_t)NSMP * DM, O_PVC = O_PKC + (size_t)MP * 128, O_PKS = O_PVC + (size_t)MP * 128,
                 O_PVS = O_PKS + (size_t)MP * 128, O_PKW = O_PVS + (size_t)MP * 128, O_PVW = O_PKW + (size_t)NBAT * WIN * 128, O_PVA = O_PVW + (size_t)NBAT * WIN * 128,
                 O_SKC = O_PVA + (size_t)NBAT * 128 * AW, O_SVC = O_SKC + NSMP * 128, O_SKS = O_SVC + NSMP * 128, O_SVS = O_SKS + NSMP * 128, O_SKW = O_SVS + NSMP * 128,
                 O_SVW = O_SKW + NSMP * 128, O_SVA = O_SVW + NSMP * 128, O_END = O_SVA + (size_t)NSMP * AW;
static_assert(O_END == 25853952, "output size");

constexpr size_t al256(size_t x) { return (x + 255) & ~(size_t)255; }
constexpr size_t WS_CTL = 0, CTL_ZERO_BYTES = 32768, CTL_RESERVED = 1u << 20;
constexpr size_t WS_WINT = CTL_RESERVED;
constexpr size_t WS_WBT = WS_WINT + (size_t)NIN * DM * 2;
constexpr size_t WS_WOT = WS_WBT + (size_t)DM * DM * 2;
constexpr size_t WS_WUP = WS_WOT + (size_t)DM * DM * 2;
constexpr size_t WS_WDN = WS_WUP + (size_t)DFF * DM * 2;
constexpr size_t WS_WC1K = WS_WDN + (size_t)DM * DFF * 2;
constexpr size_t WS_WC1V = WS_WC1K + 128 * 1024 * 2;
constexpr size_t WS_WSP = WS_WC1V + 128 * 1024 * 2;
constexpr size_t WS_WSS = WS_WSP + 8 * 128 * 128 * 2;
constexpr size_t WS_ROPE = WS_WSS + 8 * 128 * 128 * 2;
constexpr size_t WS_BPART = al256(WS_ROPE + 8196 * 16 * 4);
constexpr size_t WS_GAINS = al256(WS_BPART + 2 * 32 * 64 * 4);
constexpr size_t WS_XN = al256(WS_GAINS + 3 * 64 * 4);
constexpr size_t WS_U = WS_XN + (size_t)MPAD * DM * 2;
constexpr size_t WS_GV = WS_U + (size_t)MPAD * 512 * 2;
constexpr size_t WS_QN = WS_GV + (size_t)MPAD * 512 * 2;
constexpr size_t WS_QR = WS_QN + (size_t)MPAD * 512 * 2;
constexpr size_t WS_KCA = WS_QR + (size_t)MPAD * 512 * 2;
constexpr size_t WS_VCA = WS_KCA + 2048 * 1024 * 2;
constexpr size_t KVROWS = MPAD + 256;
constexpr size_t WS_KS = WS_VCA + 2048 * 1024 * 2;
constexpr size_t WS_VS = WS_KS + KVROWS * 128 * 2;
constexpr size_t WS_KW = WS_VS + KVROWS * 128 * 2;
constexpr size_t WS_VW = WS_KW + KVROWS * 128 * 2;
constexpr size_t WS_SG = WS_VW + KVROWS * 128 * 2;
constexpr size_t WS_NG = WS_SG + (size_t)MPAD * 2048 * 2;
constexpr size_t WS_FSPK = WS_NG + (size_t)MPAD * 32 * 4;
constexpr size_t WS_FSPV = WS_FSPK + 2048 * 128 * 4;
constexpr size_t WS_FSSK = WS_FSPV + 2048 * 128 * 4;
constexpr size_t WS_FSSV = WS_FSSK + (size_t)65536 * 128 * 4;
constexpr size_t WS_KCP = WS_FSSV + (size_t)65536 * 128 * 4;
constexpr size_t WS_VCP = WS_KCP + 4 * NCP * 64 * 2;
constexpr size_t WS_KCS = WS_VCP + 4 * NCP * 64 * 2;
constexpr size_t WS_VCS = WS_KCS + (size_t)64 * NCS * 64 * 2;
constexpr size_t WS_OAB = WS_VCS + (size_t)64 * NCS * 64 * 2;
constexpr size_t WS_MG = WS_OAB + (size_t)MPAD * DM * 2;
constexpr size_t WS_X1B = WS_MG + (size_t)MPAD * DM * 2;
constexpr size_t WS_SSQ = WS_X1B + (size_t)MPAD * DM * 2;
constexpr size_t WS_H = al256(WS_SSQ + (size_t)MPAD * 16 * 4);
constexpr size_t WS_OBF = WS_H + (size_t)MPAD * DFF * 2;
constexpr size_t WS_VST = WS_OBF + (size_t)MP * 512 * 4;
constexpr size_t WS_SSQS = WS_VST + (size_t)4 * 64 * SEQ * 2;
constexpr size_t WS_DBG = WS_SSQS + 128 * 64 * 4;
constexpr size_t WS_END = WS_DBG + (1u << 20);

constexpr int CW_TMO = 0, CW_CODE = 1, CW_BAR = 4096;

constexpr int LDS_BYTES = 147456;
constexpr int MISC_OFF = LDS_BYTES - 256;
constexpr int NWAVES = 8;

#define GAS __attribute__((address_space(1)))
#define LAS __attribute__((address_space(3)))
typedef unsigned short bf16;
typedef unsigned v4u __attribute__((ext_vector_type(4)));
typedef unsigned v2u __attribute__((ext_vector_type(2)));
typedef float f32x4 __attribute__((ext_vector_type(4)));
typedef float f32x16 __attribute__((ext_vector_type(16)));
typedef short bf16x8 __attribute__((ext_vector_type(8)));
typedef GAS unsigned gu32;
#define RLX_AGENT __ATOMIC_RELAXED, __HIP_MEMORY_SCOPE_AGENT
#define LDS_WAIT() asm volatile("s_waitcnt lgkmcnt(0)" ::: "memory")
#define VM_WAIT() asm volatile("s_waitcnt vmcnt(0)" ::: "memory")
__device__ __forceinline__ int tidx() { int t = (int)threadIdx.x; asm volatile("" : "+v"(t)); return t; }
__device__ __forceinline__ unsigned f2bf(float f) { unsigned u = __builtin_bit_cast(unsigned, f); return (u + 0x7fffu + ((u >> 16) & 1u)) >> 16; }
__device__ __forceinline__ unsigned pk2(float lo, float hi) { return f2bf(lo) | (f2bf(hi) << 16); }
__device__ __forceinline__ float bf2f(unsigned h) { return __builtin_bit_cast(float, h << 16); }
__device__ __forceinline__ float bflo(unsigned w) { return __builtin_bit_cast(float, w << 16); }
__device__ __forceinline__ float bfhi(unsigned w) { return __builtin_bit_cast(float, w & 0xffff0000u); }
__device__ __forceinline__ float fast_sigmoid(float x) { return __builtin_amdgcn_rcpf(1.f + __builtin_amdgcn_exp2f(-1.4426950408889634f * x)); }
__device__ __forceinline__ float gelu_tanh(float x) {
    const float u = 1.5957691216057308f * (x + 0.044715f * x * x * x);
    return x * __builtin_amdgcn_rcpf(1.f + __builtin_amdgcn_exp2f(-1.4426950408889634f * u));
}
__device__ __forceinline__ float wave_sum(float v) {
#pragma unroll
    for (int o = 1; o < 64; o <<= 1) v += __shfl_xor(v, o);
    return v;
}
__device__ __forceinline__ float wave_sum_dpp(float v) {
    v += __builtin_bit_cast(float, __builtin_amdgcn_update_dpp(0, __builtin_bit_cast(int, v), 0x111, 0xF, 0xF, true));
    v += __builtin_bit_cast(float, __builtin_amdgcn_update_dpp(0, __builtin_bit_cast(int, v), 0x112, 0xF, 0xF, true));
    v += __builtin_bit_cast(float, __builtin_amdgcn_update_dpp(0, __builtin_bit_cast(int, v), 0x114, 0xF, 0xF, true));
    v += __builtin_bit_cast(float, __builtin_amdgcn_update_dpp(0, __builtin_bit_cast(int, v), 0x118, 0xF, 0xF, true));
    v += __builtin_bit_cast(float, __builtin_amdgcn_update_dpp(0, __builtin_bit_cast(int, v), 0x142, 0xA, 0xF, false));
    v += __builtin_bit_cast(float, __builtin_amdgcn_update_dpp(0, __builtin_bit_cast(int, v), 0x143, 0xC, 0xF, false));
    return __builtin_bit_cast(float, __builtin_amdgcn_readlane(__builtin_bit_cast(int, v), 63));
}
__device__ __forceinline__ float wave_max_dpp(float v) {
    v = fmaxf(v, __builtin_bit_cast(float, __builtin_amdgcn_update_dpp(__builtin_bit_cast(int, v), __builtin_bit_cast(int, v), 0x111, 0xF, 0xF, false)));
    v = fmaxf(v, __builtin_bit_cast(float, __builtin_amdgcn_update_dpp(__builtin_bit_cast(int, v), __builtin_bit_cast(int, v), 0x112, 0xF, 0xF, false)));
    v = fmaxf(v, __builtin_bit_cast(float, __builtin_amdgcn_update_dpp(__builtin_bit_cast(int, v), __builtin_bit_cast(int, v), 0x114, 0xF, 0xF, false)));
    v = fmaxf(v, __builtin_bit_cast(float, __builtin_amdgcn_update_dpp(__builtin_bit_cast(int, v), __builtin_bit_cast(int, v), 0x118, 0xF, 0xF, false)));
    v = fmaxf(v, __builtin_bit_cast(float, __builtin_amdgcn_update_dpp(__builtin_bit_cast(int, v), __builtin_bit_cast(int, v), 0x142, 0xA, 0xF, false)));
    v = fmaxf(v, __builtin_bit_cast(float, __builtin_amdgcn_update_dpp(__builtin_bit_cast(int, v), __builtin_bit_cast(int, v), 0x143, 0xC, 0xF, false)));
    return __builtin_bit_cast(float, __builtin_amdgcn_readlane(__builtin_bit_cast(int, v), 63));
}
__device__ __forceinline__ float wave_max(float v) {
#pragma unroll
    for (int o = 1; o < 64; o <<= 1) v = fmaxf(v, __shfl_xor(v, o));
    return v;
}
__host__ __device__ __forceinline__ int dmap(int s) { if (s >= 16) return s; const int f = s >> 3, p = s & 7; return p < 4 ? 4 * f + p : 4 + 4 * f + p; }
__host__ __device__ __forceinline__ int win_map(int j) {
    const int t = j >> 8, L = j & 255;
    if (t < 4) return j;
    const int h = (L >> 5) & 3, s = ((L >> 7) << 5) | (L & 31);
    if (t < 6) return 1024 + ((t - 4) * 4 + h) * 64 + dmap(s);
    if (t == 6) return 1536 + L;
    if (t == 7) return 1792 + (h >> 1) * 128 + (h & 1) * 64 + dmap(s);
    if (t == 8) return 2048 + (h >> 1) * 128 + (h & 1) * 64 + dmap(s);
    if (t < 17) return 2328 + ((L >> 7) ? 1024 : 0) + 128 * (t - 9) + (L & 127);
    return L < 24 ? 2304 + L : -1;
}
namespace pg8 {
#define PG8_LAS __attribute__((address_space(3)))
typedef unsigned short bf16_t;
typedef short bf16x8 __attribute__((ext_vector_type(8)));
typedef float f32x4 __attribute__((ext_vector_type(4)));
typedef unsigned u32x4 __attribute__((ext_vector_type(4)));
constexpr int BM = 256, BK = 64, HALF = 128, HTB = HALF * BK * 2  , STAGE_BYTES = 8 * HTB, NXCD = 8, WGM = 8;

__host__ __device__ __forceinline__ int lds_byte(int r, int c) { const int st = (r >> 4) * 2 + (c >> 5), rr = r & 15, cc = c & 31, ob = rr * 64 + cc * 2; return st * 1024 + (ob ^ (((ob >> 9) & 1) << 5)); }
__host__ __device__ __forceinline__ void stage_rc(int b, int& R, int& C) { const int st = b / 1024, sb = b % 1024, swz = sb ^ (((sb >> 9) & 1) << 5); R = (st >> 1) * 16 + swz / 64; C = (st & 1) * 32 + (swz % 64) / 2; }
__host__ __device__ __forceinline__ int perm32(int rho) { const int n = rho >> 4, i = rho & 15; return 8 * (i >> 2) + 4 * n + (i & 3); }

struct Unit { int pm, pn; };
struct Gemm { const bf16_t* A; const bf16_t* Bt; int M, N, K; };

struct StaticOrder {
    int nM, nN, nwg, G, c;
    __host__ __device__ void init(int M, int N, int G_, int c_) { nM = M / BM; nN = N / BM; nwg = nM * nN; G = G_; c = c_; }
    __host__ __device__ bool next(int i, Unit& u) const {
        const long L = (long)i * G + c; if (L >= nwg) return false;
        int wgid = (int)L; { const int q = nwg / NXCD, r = nwg % NXCD, xcd = wgid % NXCD, off = wgid / NXCD; wgid = (xcd < r ? xcd * (q + 1) : r * (q + 1) + (xcd - r) * q) + off; }
        const int nig = WGM * nN, gid = wgid / nig, fm = gid * WGM, gsz = (nM - fm) < WGM ? (nM - fm) : WGM;
        u.pm = fm + ((wgid % nig) % gsz); u.pn = (wgid % nig) / gsz; return true;
    }
    __device__ __forceinline__ void a_ready(const Unit&) const {}
    __device__ __forceinline__ void done(const Unit&) const {}
};

__device__ __forceinline__ unsigned cvt_pk_bf16(float lo, float hi) { unsigned r; asm volatile("v_cvt_pk_bf16_f32 %0, %1, %2" : "=v"(r) : "v"(lo), "v"(hi)); return r; }
typedef float f32x2 __attribute__((ext_vector_type(2)));
__device__ __forceinline__ u32x4 pack8(const f32x4 a, const f32x4 b) { u32x4 w; w.x = cvt_pk_bf16(a[0], a[1]); w.y = cvt_pk_bf16(a[2], a[3]); w.z = cvt_pk_bf16(b[0], b[1]); w.w = cvt_pk_bf16(b[2], b[3]); return w; }
typedef unsigned u32x2 __attribute__((ext_vector_type(2)));

struct EpiIn {
    static constexpr bool PERM = true, AFTER_DRAIN = false, HAS_MID = false;
    unsigned char* ws; float* out;
    __device__ __forceinline__ void operator()(const f32x4 (&acc)[2][2][4][2], const Unit& u, int wr, int wc, int fr, int fq) const { asm volatile("" : "+v"(fr));
        const int pn = u.pn, rbase = u.pm * BM + wr * 64 + fr;
        if (pn < 4) {
            bf16_t* dst = (bf16_t*)(ws + (pn < 2 ? WS_U : WS_GV)) + (pn & 1) * 256 + wc * 32 + 8 * fq;
#pragma unroll
            for (int ai = 0; ai < 2; ++ai)
#pragma unroll
                for (int m = 0; m < 4; ++m) { const int row = rbase + ai * HALF + m * 16;
#pragma unroll
                    for (int bj = 0; bj < 2; ++bj) { f32x4 v0 = acc[ai][bj][m][0], v1 = acc[ai][bj][m][1];
#pragma unroll
                        for (int i = 0; i < 4; ++i) { v0[i] = gelu_tanh(v0[i]); v1[i] = gelu_tanh(v1[i]); }
                        *(u32x4*)(dst + (size_t)row * 512 + bj * HALF) = pack8(v0, v1); } }
        } else if (pn < 6 || pn == 7 || pn == 8) {
            const bool isq = pn < 6, isk = isq || wc < 2;
            const float* g = (const float*)(ws + WS_GAINS) + (isq ? 0 : (pn == 7 ? 64 : 128)); const float* rope = (const float*)(ws + WS_ROPE);
            const int d1 = fq < 2 ? 4 * fq : 8 * fq, d2 = fq < 2 ? 8 + 4 * fq : 8 * fq + 4, d3 = 32 + 8 * fq;
            f32x4 g1 = {1.f, 1.f, 1.f, 1.f}, g2 = g1, g3a = g1, g3b = g1;
            if (isk) { g1 = *(const f32x4*)(g + d1); g2 = *(const f32x4*)(g + d2); g3a = *(const f32x4*)(g + d3); g3b = *(const f32x4*)(g + d3 + 4); }
            const float osc = isq ? QC2 : 1.f;
#pragma unroll
            for (int ai = 0; ai < 2; ++ai)
#pragma unroll
                for (int m = 0; m < 4; ++m) { const int row = rbase + ai * HALF + m * 16;
                    f32x4 a = acc[ai][0][m][0], b = acc[ai][0][m][1], c = acc[ai][1][m][0], d = acc[ai][1][m][1];
                    f32x4 ra = a, rb = b;
                    if (isk) {
                        float ss = (a[0] * a[0] + a[1] * a[1]) + (a[2] * a[2] + a[3] * a[3]) + (b[0] * b[0] + b[1] * b[1]) + (b[2] * b[2] + b[3] * b[3])
                                 + (c[0] * c[0] + c[1] * c[1]) + (c[2] * c[2] + c[3] * c[3]) + (d[0] * d[0] + d[1] * d[1]) + (d[2] * d[2] + d[3] * d[3]);
                        ss += __shfl_xor(ss, 16); ss += __shfl_xor(ss, 32);
                        const float rstd = 1.f / sqrtf(ss * (1.f / 64.f) + EPS);
                        a = a * rstd * g1; b = b * rstd * g2; c = c * rstd * g3a; d = d * rstd * g3b;
                        const int pidx = row < MP ? (row & (SEQ - 1)) : SEQ + ((row - MP) & 3);
                        f32x4 cs = {1.f, 1.f, 1.f, 1.f}, sn = {0.f, 0.f, 0.f, 0.f};
                        if (fq < 2) { cs = *(const f32x4*)(rope + pidx * 16 + 4 * fq); sn = *(const f32x4*)(rope + pidx * 16 + 8 + 4 * fq); }
                        ra = a * cs - b * sn; rb = b * cs + a * sn;
                    }
                    if (isq) {
                        const int head = (pn - 4) * 4 + wc; bf16_t* qn = (bf16_t*)(ws + WS_QN) + (size_t)row * 512 + head * 64; bf16_t* qr = (bf16_t*)(ws + WS_QR) + (size_t)row * 512 + head * 64;
                        const f32x4 cc = c * osc, dd = d * osc;
                        { f32x4 x = a * osc, y = b * osc; u32x2 w; w.x = cvt_pk_bf16(x[0], x[1]); w.y = cvt_pk_bf16(x[2], x[3]); *(u32x2*)(qn + d1) = w; w.x = cvt_pk_bf16(y[0], y[1]); w.y = cvt_pk_bf16(y[2], y[3]); *(u32x2*)(qn + d2) = w; }
                        { f32x4 x = ra * osc, y = rb * osc; u32x2 w; w.x = cvt_pk_bf16(x[0], x[1]); w.y = cvt_pk_bf16(x[2], x[3]); *(u32x2*)(qr + d1) = w; w.x = cvt_pk_bf16(y[0], y[1]); w.y = cvt_pk_bf16(y[2], y[3]); *(u32x2*)(qr + d2) = w; }
                        const u32x4 w3 = pack8(cc, dd); *(u32x4*)(qn + d3) = w3; *(u32x4*)(qr + d3) = w3;
                    } else {
                        const int kvh = wc & 1; const bool kw = (pn == 8);
                        bf16_t* bd = (bf16_t*)(ws + (isk ? (kw ? WS_KW : WS_KS) : (kw ? WS_VW : WS_VS))) + (size_t)row * 128 + kvh * 64;
                        { u32x2 w; w.x = cvt_pk_bf16(ra[0], ra[1]); w.y = cvt_pk_bf16(ra[2], ra[3]); *(u32x2*)(bd + d1) = w; w.x = cvt_pk_bf16(rb[0], rb[1]); w.y = cvt_pk_bf16(rb[2], rb[3]); *(u32x2*)(bd + d2) = w; }
                        *(u32x4*)(bd + d3) = pack8(c, d);
                        float* so = nullptr;
                        if (row < MP) { if (!kw) so = out + (isk ? O_PKS : O_PVS) + (size_t)row * 128; else { const int t = row & (SEQ - 1), b = row >> 13; if (t >= SEQ - WIN) so = out + (isk ? O_PKW : O_PVW) + ((size_t)b * WIN + (t - (SEQ - WIN))) * 128; } }
                        else if (row < MT) so = out + (kw ? (isk ? O_SKW : O_SVW) : (isk ? O_SKS : O_SVS)) + (size_t)(row - MP) * 128;
                        if (so) { so += kvh * 64; *(f32x4*)(so + d1) = ra; *(f32x4*)(so + d2) = rb; *(f32x4*)(so + d3) = c; *(f32x4*)(so + d3 + 4) = d; }
                    }
                }
        } else if (pn == 6) {
#pragma unroll
            for (int ai = 0; ai < 2; ++ai)
#pragma unroll
                for (int m = 0; m < 4; ++m) { const int row = rbase + ai * HALF + m * 16;
#pragma unroll
                    for (int bj = 0; bj < 2; ++bj) { const f32x4 v0 = acc[ai][bj][m][0], v1 = acc[ai][bj][m][1]; const int col = wc * 32 + 8 * fq;
                        if (row < MT) { float* so = out + (row < MP ? (bj ? O_PVC : O_PKC) + (size_t)row * 128 : (bj ? O_SVC : O_SKC) + (size_t)(row - MP) * 128) + col; *(f32x4*)so = v0; *(f32x4*)(so + 4) = v1; }
                        if (row < MP) { bf16_t* ca = (bf16_t*)(ws + (bj ? WS_VCA : WS_KCA)) + ((size_t)(row >> 4) * 2 + (wc >> 1)) * 1024 + (row & 15) * 64 + (wc & 1) * 32 + 8 * fq; *(u32x4*)ca = pack8(v0, v1); } } }
        } else if (pn < 17) {
            bf16_t* dst = (bf16_t*)(ws + WS_SG) + (pn - 9) * 128 + wc * 32 + 8 * fq;
#pragma unroll
            for (int ai = 0; ai < 2; ++ai)
#pragma unroll
                for (int m = 0; m < 4; ++m) { const int row = rbase + ai * HALF + m * 16;
                    f32x4 a0 = acc[ai][0][m][0], a1 = acc[ai][0][m][1], b0 = acc[ai][1][m][0], b1 = acc[ai][1][m][1]; f32x4 r0, r1, s0, s1;
#pragma unroll
                    for (int i = 0; i < 4; ++i) { a0[i] = fminf(fmaxf(a0[i], -30.f), 30.f); a1[i] = fminf(fmaxf(a1[i], -30.f), 30.f); b0[i] = fminf(fmaxf(b0[i], -30.f), 30.f); b1[i] = fminf(fmaxf(b1[i], -30.f), 30.f); }
#pragma unroll
                    for (int i = 0; i < 4; ++i) { const float ea0 = 1.f + __builtin_amdgcn_exp2f(-1.4426950408889634f * a0[i]), ea1 = 1.f + __builtin_amdgcn_exp2f(-1.4426950408889634f * a1[i]);
                        const float eb0 = 1.f + __builtin_amdgcn_exp2f(-1.4426950408889634f * b0[i]), eb1 = 1.f + __builtin_amdgcn_exp2f(-1.4426950408889634f * b1[i]);
                        r0[i] = eb0 * __builtin_amdgcn_rcpf(ea0); r1[i] = eb1 * __builtin_amdgcn_rcpf(ea1); s0[i] = __builtin_amdgcn_rcpf(eb0); s1[i] = __builtin_amdgcn_rcpf(eb1); }
                    *(u32x4*)(dst + (size_t)row * 2048) = pack8(r0, r1); *(u32x4*)(dst + (size_t)row * 2048 + 1024) = pack8(s0, s1); }
        } else {
            if (wc == 0 && fq < 3) {
#pragma unroll
                for (int ai = 0; ai < 2; ++ai)
#pragma unroll
                    for (int m = 0; m < 4; ++m) { const int row = rbase + ai * HALF + m * 16; f32x4 v0 = acc[ai][0][m][0], v1 = acc[ai][0][m][1];
#pragma unroll
                        for (int i = 0; i < 4; ++i) { v0[i] = fast_sigmoid(v0[i]); v1[i] = fast_sigmoid(v1[i]); }
                        float* d = (float*)(ws + WS_NG) + (size_t)row * 32 + 8 * fq; *(f32x4*)d = v0; *(f32x4*)(d + 4) = v1; }
            }
        }
    }
};

__device__ __forceinline__ void unpack8(const u32x4 w, float (&f)[8]) {
    f[0] = __builtin_bit_cast(float, w.x << 16); f[1] = __builtin_bit_cast(float, w.x & 0xffff0000u); f[2] = __builtin_bit_cast(float, w.y << 16); f[3] = __builtin_bit_cast(float, w.y & 0xffff0000u);
    f[4] = __builtin_bit_cast(float, w.z << 16); f[5] = __builtin_bit_cast(float, w.z & 0xffff0000u); f[6] = __builtin_bit_cast(float, w.w << 16); f[7] = __builtin_bit_cast(float, w.w & 0xffff0000u);
}
struct EpiMerge {
    static constexpr bool PERM = true, AFTER_DRAIN = false, HAS_MID = true;
    const bf16_t* SG; bf16_t* MG;
    __device__ __forceinline__ void mid(f32x4 (&acc)[2][2][4][2], const Unit& u, int wr, int wc, int fr, int fq) const { asm volatile("" : "+v"(fr));
        const int row0 = u.pm * BM + wr * 64 + fr, col0 = u.pn * BM + wc * 32 + 8 * fq;
#pragma unroll
        for (int ai = 0; ai < 2; ++ai)
#pragma unroll
            for (int m = 0; m < 4; ++m) { const size_t row = (size_t)(row0 + ai * HALF + m * 16);
#pragma unroll
                for (int bj = 0; bj < 2; ++bj) { const int col = col0 + bj * HALF; float rg[8]; unpack8(*(const u32x4*)(SG + row * 2048 + col), rg);
#pragma unroll
                    for (int i = 0; i < 4; ++i) { acc[ai][bj][m][0][i] *= rg[i]; acc[ai][bj][m][1][i] *= rg[4 + i]; } } }
    }
    __device__ __forceinline__ void operator()(const f32x4 (&acc)[2][2][4][2], const Unit& u, int wr, int wc, int fr, int fq) const { asm volatile("" : "+v"(fr));
        const int row0 = u.pm * BM + wr * 64 + fr, col0 = u.pn * BM + wc * 32 + 8 * fq;
#pragma unroll
        for (int ai = 0; ai < 2; ++ai)
#pragma unroll
            for (int m = 0; m < 4; ++m) { const size_t row = (size_t)(row0 + ai * HALF + m * 16);
#pragma unroll
                for (int bj = 0; bj < 2; ++bj) { const int col = col0 + bj * HALF; float gb[8]; unpack8(*(const u32x4*)(SG + row * 2048 + 1024 + col), gb);
                    const f32x4 v0 = acc[ai][bj][m][0], v1 = acc[ai][bj][m][1]; f32x4 o0, o1;
#pragma unroll
                    for (int i = 0; i < 4; ++i) { o0[i] = gb[i] * v0[i]; o1[i] = gb[4 + i] * v1[i]; }
                    *(u32x4*)(MG + row * DM + col) = pack8(o0, o1); } }
    }
};
__device__ __forceinline__ float* yrow(float* out, int row) { return row < MP ? out + O_YP + (size_t)row * DM : out + O_YS + (size_t)(row - MP) * DM; }
struct EpiOut {
    static constexpr bool PERM = true, AFTER_DRAIN = false, HAS_MID = false;
    const float* xp; const float* xs; float* out; bf16_t* X1B; float* SSQ;
    __device__ __forceinline__ void operator()(const f32x4 (&acc)[2][2][4][2], const Unit& u, int wr, int wc, int fr, int fq) const { asm volatile("" : "+v"(fr));
        const int row0 = u.pm * BM + wr * 64 + fr, col0 = u.pn * BM + wc * 32 + 8 * fq;
#pragma unroll
        for (int ai = 0; ai < 2; ++ai)
#pragma unroll
            for (int m = 0; m < 4; ++m) { const int row = row0 + ai * HALF + m * 16; float ss = 0.f;
                const float* xr = xp + (size_t)row * DM; if (row >= MP) xr = xs + (size_t)(row - MP) * DM;
#pragma unroll
                for (int bj = 0; bj < 2; ++bj) { const int col = col0 + bj * HALF; f32x4 v0 = acc[ai][bj][m][0], v1 = acc[ai][bj][m][1];
                    if (row < MT) { v0 = v0 + *(const f32x4*)(xr + col); v1 = v1 + *(const f32x4*)(xr + col + 4); }
                    ss += (v0[0] * v0[0] + v0[1] * v0[1]) + (v0[2] * v0[2] + v0[3] * v0[3]) + (v1[0] * v1[0] + v1[1] * v1[1]) + (v1[2] * v1[2] + v1[3] * v1[3]);
                    *(u32x4*)(X1B + (size_t)row * DM + col) = pack8(v0, v1); }
                ss += __shfl_xor(ss, 16); ss += __shfl_xor(ss, 32);
                if (fq == 0) SSQ[(size_t)row * 16 + u.pn * 4 + wc] = ss; }
    }
};
struct EpiUp {
    static constexpr bool PERM = true, AFTER_DRAIN = false, HAS_MID = false;
    const float* SSQ; bf16_t* H;
    __device__ __forceinline__ void operator()(const f32x4 (&acc)[2][2][4][2], const Unit& u, int wr, int wc, int fr, int fq) const { asm volatile("" : "+v"(fr));
        const int row0 = u.pm * BM + wr * 64 + fr, col0 = u.pn * BM + wc * 32 + 8 * fq;
#pragma unroll
        for (int ai = 0; ai < 2; ++ai)
#pragma unroll
            for (int m = 0; m < 4; ++m) { const size_t row = (size_t)(row0 + ai * HALF + m * 16);
                const f32x4 s0 = *(const f32x4*)(SSQ + row * 16), s1 = *(const f32x4*)(SSQ + row * 16 + 4), s2 = *(const f32x4*)(SSQ + row * 16 + 8), s3 = *(const f32x4*)(SSQ + row * 16 + 12);
                const f32x4 st = (s0 + s1) + (s2 + s3); const float rstd = 1.f / sqrtf(((st[0] + st[1]) + (st[2] + st[3])) * (1.f / DM) + EPS);
#pragma unroll
                for (int bj = 0; bj < 2; ++bj) { f32x4 v0 = acc[ai][bj][m][0] * rstd, v1 = acc[ai][bj][m][1] * rstd;
#pragma unroll
                    for (int i = 0; i < 4; ++i) { const float a = fmaxf(v0[i], 0.f), b = fmaxf(v1[i], 0.f); v0[i] = a * a; v1[i] = b * b; }
                    *(u32x4*)(H + row * DFF + col0 + bj * HALF) = pack8(v0, v1); } }
    }
};
struct EpiDown {
    static constexpr bool PERM = true, AFTER_DRAIN = false, HAS_MID = false;
    float* out; const bf16_t* X1B;
    __device__ __forceinline__ void operator()(const f32x4 (&acc)[2][2][4][2], const Unit& u, int wr, int wc, int fr, int fq) const { asm volatile("" : "+v"(fr));
        const int row0 = u.pm * BM + wr * 64 + fr, col0 = u.pn * BM + wc * 32 + 8 * fq;
#pragma unroll
        for (int ai = 0; ai < 2; ++ai)
#pragma unroll
            for (int m = 0; m < 4; ++m) { const int row = row0 + ai * HALF + m * 16;
                if (row < MT) { float* y = yrow(out, row) + col0; const bf16_t* xb = X1B + (size_t)row * DM + col0;
#pragma unroll
                    for (int bj = 0; bj < 2; ++bj) { float x[8]; unpack8(*(const u32x4*)(xb + bj * HALF), x);
                        *(f32x4*)(y + bj * HALF) = (f32x4){x[0], x[1], x[2], x[3]} + acc[ai][bj][m][0]; *(f32x4*)(y + bj * HALF + 4) = (f32x4){x[4], x[5], x[6], x[7]} + acc[ai][bj][m][1]; } } }
    }
};

template <class Epi, class Sched, bool ALIGN_EPI = false, bool SP2 = false>
__device__ __forceinline__ void gemm_phase(PG8_LAS unsigned char* lds, const Gemm g, const Sched& S, const Epi& E) {
    const int tid = tidx(), wid = __builtin_amdgcn_readfirstlane(tid >> 6), lane = tid & 63, wr = wid >> 2, wc = wid & 3, fr = lane & 15, fq = lane >> 4;
    const int K = g.K, nt = K / BK;
    unsigned voffA[2], voffB[2];
#pragma unroll
    for (int i = 0; i < 2; ++i) { int R, C; stage_rc(tid * 16 + i * 8192, R, C); const int Rb = Epi::PERM ? ((R & ~31) + perm32(R & 31)) : R;
        voffA[i] = (unsigned)(R * K + C) * 2u; voffB[i] = (unsigned)(Rb * K + C) * 2u; }
    const size_t kstep = (size_t)(BK * 2);
    const size_t hstep = (size_t)HALF * K * 2;
    const size_t tstep = 2 * hstep;
    const unsigned ldsw = (unsigned)wid * 1024u;
    const int aoff = lds_byte(wr * 64 + fr, fq * 8), boff = lds_byte(wc * 32 + fr, fq * 8);
#define PG8_SA(b, h) (((b) * 2 + (h)) * HTB)
#define PG8_SB(b, h) ((4 + (b) * 2 + (h)) * HTB)
#define PG8_STAGE(bufoff, gbase, voff) do { _Pragma("unroll") for (int _i = 0; _i < 2; ++_i) \
        __builtin_amdgcn_global_load_lds((const unsigned*)((const char*)(gbase) + (voff)[_i]), (PG8_LAS unsigned*)(lds + (bufoff) + ldsw + _i * 8192), 16, 0, 0); } while (0)
#define PG8_LDA(dst, b, h) do { _Pragma("unroll") for (int m = 0; m < 4; ++m) _Pragma("unroll") for (int k = 0; k < 2; ++k) dst[m][k] = *(const PG8_LAS bf16x8*)(lds + PG8_SA(b, h) + aoff + m * 2048 + k * 1024); } while (0)
#define PG8_LDB(dst, b, h) do { _Pragma("unroll") for (int n = 0; n < 2; ++n) _Pragma("unroll") for (int k = 0; k < 2; ++k) dst[n][k] = *(const PG8_LAS bf16x8*)(lds + PG8_SB(b, h) + boff + n * 2048 + k * 1024); } while (0)
#define PG8_MMA(ai, bj, At, Bt) do { __builtin_amdgcn_s_setprio(1); _Pragma("unroll") for (int m = 0; m < 4; ++m) _Pragma("unroll") for (int n = 0; n < 2; ++n) _Pragma("unroll") for (int k = 0; k < 2; ++k) \
        acc[ai][bj][m][n] = __builtin_amdgcn_mfma_f32_16x16x32_bf16(Bt[n][k], At[m][k], acc[ai][bj][m][n], 0, 0, 0); __builtin_amdgcn_s_setprio(0); } while (0)
#define PG8_WAIT_V(n) asm volatile("s_waitcnt vmcnt(" #n ")" ::: "memory")
#define PG8_WAIT_L(n) asm volatile("s_waitcnt lgkmcnt(" #n ")" ::: "memory")
#define PG8_BAR __builtin_amdgcn_s_barrier()
#define PG8_SCHED __builtin_amdgcn_sched_barrier(0)
    Unit cur, nxt; int ui = 0;
    if (!S.next(0, cur)) return;
    f32x4 acc[2][2][4][2];
#pragma unroll
    for (int a = 0; a < 2; ++a)
#pragma unroll
        for (int b = 0; b < 2; ++b)
#pragma unroll
            for (int m = 0; m < 4; ++m)
#pragma unroll
                for (int n = 0; n < 2; ++n) acc[a][b][m][n] = (f32x4){0.f, 0.f, 0.f, 0.f};
    bf16x8 At[4][2], B0[2][2], B1[2][2];
    const char* cA = (const char*)g.A + (size_t)cur.pm * tstep; const char* cB = (const char*)g.Bt + (size_t)cur.pn * tstep;
    S.a_ready(cur);
    if constexpr (SP2) {
        PG8_STAGE(PG8_SB(0, 0), cB, voffB); PG8_STAGE(PG8_SB(0, 1), cB + hstep, voffB); PG8_STAGE(PG8_SA(0, 0), cA, voffA); PG8_STAGE(PG8_SA(0, 1), cA + hstep, voffA);
        if (wr == 1) PG8_BAR;
        PG8_WAIT_V(2); PG8_BAR;
        PG8_STAGE(PG8_SB(1, 0), cB + kstep, voffB); PG8_STAGE(PG8_SA(1, 0), cA + kstep, voffA); PG8_STAGE(PG8_SB(1, 1), cB + hstep + kstep, voffB);
        PG8_WAIT_V(6); PG8_BAR;
    } else {
        PG8_STAGE(PG8_SB(0, 0), cB, voffB); PG8_STAGE(PG8_SA(0, 0), cA, voffA); PG8_STAGE(PG8_SB(0, 1), cB + hstep, voffB); PG8_STAGE(PG8_SA(0, 1), cA + hstep, voffA);
        if (wr == 1) PG8_BAR;
        PG8_WAIT_V(4); PG8_BAR;
        PG8_STAGE(PG8_SB(1, 0), cB + kstep, voffB); PG8_STAGE(PG8_SA(1, 0), cA + kstep, voffA); PG8_STAGE(PG8_SB(1, 1), cB + hstep + kstep, voffB);
        PG8_WAIT_V(6); PG8_BAR;
    }
    for (;;) {
        const bool has_next = S.next(ui + 1, nxt);
        const char* nA = has_next ? (const char*)g.A + (size_t)nxt.pm * tstep : cA; const char* nB = has_next ? (const char*)g.Bt + (size_t)nxt.pn * tstep : cB;
        for (int t = 0; t < nt; t += 2) {
            const bool last = (t == nt - 2);
            const char* a1 = cA + (size_t)(t + 1) * kstep;
            const char* a2 = last ? nA : cA + (size_t)(t + 2) * kstep; const char* b2 = last ? nB : cB + (size_t)(t + 2) * kstep;
            const char* a3 = a2 + kstep; const char* b3 = b2 + kstep;
            if (last && has_next) S.a_ready(nxt);
            if constexpr (SP2) {
            PG8_LDB(B0, 0, 0); PG8_LDB(B1, 0, 1); PG8_SCHED; PG8_LDA(At, 0, 0); PG8_STAGE(PG8_SA(1, 1), a1 + hstep, voffA);
            PG8_WAIT_V(8); PG8_WAIT_L(0); PG8_BAR; PG8_MMA(0, 0, At, B0); PG8_MMA(0, 1, At, B1); PG8_BAR; PG8_SCHED;
            PG8_LDA(At, 0, 1); PG8_STAGE(PG8_SB(0, 0), b2, voffB); PG8_STAGE(PG8_SB(0, 1), b2 + hstep, voffB); PG8_STAGE(PG8_SA(0, 0), a2, voffA);
            PG8_WAIT_V(8); PG8_WAIT_L(0); PG8_BAR; PG8_MMA(1, 0, At, B0); PG8_MMA(1, 1, At, B1); PG8_BAR; PG8_SCHED;
            PG8_LDB(B0, 1, 0); PG8_LDB(B1, 1, 1); PG8_SCHED; PG8_LDA(At, 1, 0); PG8_STAGE(PG8_SA(0, 1), a2 + hstep, voffA);
            PG8_WAIT_V(8); PG8_WAIT_L(0); PG8_BAR; PG8_MMA(0, 0, At, B0); PG8_MMA(0, 1, At, B1); PG8_BAR; PG8_SCHED;
            PG8_LDA(At, 1, 1); PG8_STAGE(PG8_SB(1, 0), b3, voffB); PG8_STAGE(PG8_SB(1, 1), b3 + hstep, voffB); PG8_STAGE(PG8_SA(1, 0), a3, voffA);
            PG8_WAIT_V(8); PG8_WAIT_L(0); PG8_BAR; PG8_MMA(1, 0, At, B0); PG8_MMA(1, 1, At, B1); PG8_BAR; PG8_SCHED;
            if constexpr (Epi::HAS_MID) { if (t == nt / 2 - 2) { E.mid(acc, cur, wr, wc, fr, fq); PG8_WAIT_V(0); PG8_SCHED; } }
            } else {
            PG8_LDB(B0, 0, 0); PG8_SCHED; PG8_LDA(At, 0, 0); PG8_STAGE(PG8_SA(1, 1), a1 + hstep, voffA);
            PG8_WAIT_L(8); PG8_BAR; PG8_WAIT_L(0); PG8_MMA(0, 0, At, B0); PG8_BAR; PG8_SCHED;
            PG8_LDB(B1, 0, 1); PG8_STAGE(PG8_SB(0, 0), b2, voffB);
            PG8_BAR; PG8_WAIT_L(0); PG8_MMA(0, 1, At, B1); PG8_BAR;
            PG8_LDA(At, 0, 1); PG8_STAGE(PG8_SA(0, 0), a2, voffA);
            PG8_BAR; PG8_WAIT_L(0); PG8_MMA(1, 0, At, B0); PG8_BAR; PG8_SCHED;
            PG8_STAGE(PG8_SB(0, 1), b2 + hstep, voffB);
            PG8_WAIT_V(6); PG8_BAR; PG8_MMA(1, 1, At, B1); PG8_BAR;
            PG8_LDB(B0, 1, 0); PG8_SCHED; PG8_LDA(At, 1, 0); PG8_STAGE(PG8_SA(0, 1), a2 + hstep, voffA);
            PG8_WAIT_L(8); PG8_BAR; PG8_WAIT_L(0); PG8_MMA(0, 0, At, B0); PG8_BAR; PG8_SCHED;
            PG8_LDB(B1, 1, 1); PG8_STAGE(PG8_SB(1, 0), b3, voffB);
            PG8_BAR; PG8_WAIT_L(0); PG8_MMA(0, 1, At, B1); PG8_BAR;
            PG8_LDA(At, 1, 1); PG8_STAGE(PG8_SA(1, 0), a3, voffA);
            PG8_BAR; PG8_WAIT_L(0); PG8_MMA(1, 0, At, B0); PG8_BAR; PG8_SCHED;
            PG8_STAGE(PG8_SB(1, 1), b3 + hstep, voffB);
            PG8_WAIT_V(6); PG8_BAR; PG8_MMA(1, 1, At, B1); PG8_BAR;
            }
        }
        if constexpr (ALIGN_EPI) { if (wr == 0) PG8_BAR; }
        if constexpr (!Epi::AFTER_DRAIN) { E(acc, cur, wr, wc, fr, fq); S.done(cur); }
        if (!has_next) break;
#pragma unroll
        for (int a = 0; a < 2; ++a)
#pragma unroll
            for (int b = 0; b < 2; ++b)
#pragma unroll
                for (int m = 0; m < 4; ++m)
#pragma unroll
                    for (int n = 0; n < 2; ++n) acc[a][b][m][n] = (f32x4){0.f, 0.f, 0.f, 0.f};
        cur = nxt; cA = nA; cB = nB; ++ui;
        if constexpr (ALIGN_EPI) { if (wr == 1) PG8_BAR; }
    }
    PG8_WAIT_V(0);
    if constexpr (!ALIGN_EPI) { if (wr == 0) PG8_BAR; }
    PG8_BAR;
    if constexpr (Epi::AFTER_DRAIN) { E.fused(acc, cur, wr, wc, fr, fq, lds, wid, lane); S.done(cur); }
#undef PG8_SA
#undef PG8_SB
#undef PG8_STAGE
#undef PG8_LDA
#undef PG8_LDB
#undef PG8_MMA
#undef PG8_WAIT_V
#undef PG8_WAIT_L
#undef PG8_BAR
#undef PG8_SCHED
}
}
#define XB_TMO      128
#define XB_XCNT(j)  (256  + 64 * (j))
#define XB_XSUB(j)  (1280 + 64 * (j))
#define XB_XGEN(j)  (2304 + 64 * (j))
#define XB_TOP      3328
#define XB_TOPGEN   3392
#define XCD_BAR_WORDS 3456
#define XB_SPIN_CAP (1u << 18)

__device__ __forceinline__ unsigned xb_ld(unsigned* p)              { return __hip_atomic_load(p, __ATOMIC_RELAXED, __HIP_MEMORY_SCOPE_AGENT); }
__device__ __forceinline__ unsigned xb_add(unsigned* p, unsigned v) { return __hip_atomic_fetch_add(p, v, __ATOMIC_RELAXED, __HIP_MEMORY_SCOPE_AGENT); }
__device__ __forceinline__ unsigned xb_xcc_id() { return (unsigned)__builtin_amdgcn_s_getreg((3 << 11) | 20) & 0xFu; }
#define XB_SPIN(cond, bar) do { unsigned _sp = 0; while (cond) { __builtin_amdgcn_s_sleep(1); \
    if ((++_sp & 255u) == 0u) { if (xb_ld(&(bar)[XB_TMO])) break; if (_sp > XB_SPIN_CAP) { atomicAdd(&(bar)[XB_TMO], 1u); break; } } } } while (0)

struct XcdBarrier {
    unsigned* bar; unsigned x;
    volatile LAS unsigned* st;
};

__device__ __forceinline__ XcdBarrier xcd_barrier_post(unsigned* bar, volatile LAS unsigned* st) {
    XcdBarrier b; b.bar = bar; b.x = xb_xcc_id(); b.st = st;
    if (tidx() == 0) (void)xb_add(&bar[XB_XCNT(b.x)], 1u);
    return b;
}
__device__ __forceinline__ void xcd_barrier_complete(unsigned* bar, unsigned x, unsigned& nloc, unsigned& nx) {
    const unsigned G = gridDim.x * gridDim.y * gridDim.z;
    unsigned sum, cnt, mine, sp = 0u;
    for (;;) {
        sum = 0u; cnt = 0u; mine = 0u;
#pragma unroll
        for (unsigned j = 0; j < 16; ++j) { const unsigned c = xb_ld(&bar[XB_XCNT(j)]); sum += c; cnt += (c > 0u) ? 1u : 0u; mine = (j == x) ? c : mine; }
        if (sum == G) break;
        __builtin_amdgcn_s_sleep(1);
        if ((++sp & 255u) == 0u) { if (xb_ld(&bar[XB_TMO])) break; if (sp > XB_SPIN_CAP) { atomicAdd(&bar[XB_TMO], 1u); break; } }
    }
    nloc = mine > 0u ? mine : 1u; nx = cnt > 0u ? cnt : 1u;
}

__device__ __forceinline__ void xcd_barrier(const XcdBarrier& b) {
    asm volatile("s_waitcnt vmcnt(0)" ::: "memory");
    __syncthreads();
    if (tidx() == 0) {
        unsigned* bar = b.bar;
        __builtin_amdgcn_s_waitcnt(0);
        unsigned nloc = b.st[0], nx = b.st[1];
        if (nloc == 0u) { xcd_barrier_complete(bar, b.x, nloc, nx); b.st[0] = nloc; b.st[1] = nx; }
        const unsigned old = xb_add(&bar[XB_XSUB(b.x)], 1u);
        const unsigned gen = old / nloc;
        if (old + 1u == (gen + 1u) * nloc) {
            __builtin_amdgcn_fence(__ATOMIC_RELEASE, "agent");
            asm volatile("s_waitcnt vmcnt(0)" ::: "memory");
            const unsigned og = xb_add(&bar[XB_TOP], 1u);
            const unsigned tg = og / nx;
            if (og + 1u == (tg + 1u) * nx) xb_add(&bar[XB_TOPGEN], 1u);
            else XB_SPIN(xb_ld(&bar[XB_TOPGEN]) == tg, bar);
            __builtin_amdgcn_fence(__ATOMIC_ACQUIRE, "agent");
            xb_add(&bar[XB_XGEN(b.x)], 1u);
            asm volatile("s_waitcnt vmcnt(0)" ::: "memory");
        } else {
            XB_SPIN(xb_ld(&bar[XB_XGEN(b.x)]) == gen, bar);
            __builtin_amdgcn_fence(__ATOMIC_ACQUIRE, "agent");
            asm volatile("s_waitcnt vmcnt(0)" ::: "memory");
        }
    }
    __syncthreads();
}
struct Frame {
    LAS unsigned char* lds; volatile LAS unsigned* MISC; gu32* ctl;
    int tid, lane, wave, vcu, G;
    const float* in[N_IN]; float* out; unsigned char* ws;
};
#define WSP(T, off) ((T*)(F.ws + (off)))
typedef __attribute__((address_space(3))) float lds_f;

template <class Map>
__device__ __forceinline__ void tr_item(const float* W, int ldw, int K, bf16* WT, LAS float* scr, int item, int nblk, int lane, const Map& map, const float* kscale) {
    const int kb = item / nblk, nb = item % nblk, k0 = 64 * kb, n0 = 32 * nb;
    const int sc = map(n0 + (lane & 31));
#pragma unroll
    for (int i = 0; i < 32; ++i) { const int kk = 2 * i + (lane >> 5); float v = sc >= 0 ? W[(size_t)(k0 + kk) * ldw + sc] : 0.f; if (kscale) v *= kscale[k0 + kk]; scr[kk * 33 + (lane & 31)] = v; }
    LDS_WAIT(); asm volatile("" ::: "memory");
    const int c = lane & 7;
#pragma unroll
    for (int j = 0; j < 4; ++j) { const int n = (lane >> 3) + 8 * j; const LAS float* s = scr + (8 * c) * 33 + n;
        v4u o; o.x = pk2(s[0 * 33], s[1 * 33]); o.y = pk2(s[2 * 33], s[3 * 33]); o.z = pk2(s[4 * 33], s[5 * 33]); o.w = pk2(s[6 * 33], s[7 * 33]);
        *(GAS v4u*)(WT + (size_t)(n0 + n) * K + k0 + 8 * c) = o; }
    LDS_WAIT(); asm volatile("" ::: "memory");
}
struct MapId { __device__ __forceinline__ int operator()(int j) const { return j; } };
struct MapWin { __device__ __forceinline__ int operator()(int j) const { return win_map(j); } };

__device__ __forceinline__ void rms_row_to_bf16(int lane, const float* xrow, const float* g, bf16* orow) {
    const GAS f32x4* xr = (const GAS f32x4*)xrow + lane; const GAS f32x4* gr = (const GAS f32x4*)g + lane;
    f32x4 v[4]; float s = 0.f;
#pragma unroll
    for (int j = 0; j < 4; ++j) { v[j] = xr[64 * j]; s += (v[j].x * v[j].x + v[j].y * v[j].y) + (v[j].z * v[j].z + v[j].w * v[j].w); }
    const float rstd = 1.f / sqrtf(wave_sum_dpp(s) * (1.f / DM) + EPS);
    GAS unsigned long long* o8 = (GAS unsigned long long*)orow + lane;
#pragma unroll
    for (int j = 0; j < 4; ++j) { const f32x4 gg = gr[64 * j]; o8[64 * j] = (unsigned long long)pk2(v[j].x * rstd * gg.x, v[j].y * rstd * gg.y) | ((unsigned long long)pk2(v[j].z * rstd * gg.z, v[j].w * rstd * gg.w) << 32); }
}

struct TrItem { const float* W; const float* ks; bf16* WT; int ldw, K, k0, n0, sc; };
__device__ __forceinline__ void tr_load(const TrItem& t, int lane, float (&v)[32]) {
#pragma unroll
    for (int i = 0; i < 8; ++i) { const int kk = 8 * i + (lane >> 3); f32x4 x = {0.f, 0.f, 0.f, 0.f}; if (t.sc >= 0) x = *(const GAS f32x4*)(t.W + (size_t)(t.k0 + kk) * t.ldw + t.sc);
        if (t.ks) x = x * t.ks[t.k0 + kk]; v[4 * i] = x.x; v[4 * i + 1] = x.y; v[4 * i + 2] = x.z; v[4 * i + 3] = x.w; }
}
__device__ __forceinline__ void tr_store(const TrItem& t, int lane, const float (&v)[32], LAS float* scr) {
#pragma unroll
    for (int i = 0; i < 8; ++i)
#pragma unroll
        for (int e = 0; e < 4; ++e) scr[(8 * i + (lane >> 3)) * 33 + 4 * (lane & 7) + e] = v[4 * i + e];
    LDS_WAIT(); asm volatile("" ::: "memory");
    const int c = lane & 7;
#pragma unroll
    for (int j = 0; j < 4; ++j) { const int n = (lane >> 3) + 8 * j; const LAS float* s = scr + (8 * c) * 33 + n;
        v4u o; o.x = pk2(s[0 * 33], s[1 * 33]); o.y = pk2(s[2 * 33], s[3 * 33]); o.z = pk2(s[4 * 33], s[5 * 33]); o.w = pk2(s[6 * 33], s[7 * 33]);
        *(GAS v4u*)(t.WT + (size_t)(t.n0 + n) * t.K + t.k0 + 8 * c) = o; }
    LDS_WAIT(); asm volatile("" ::: "memory");
}
__device__ __forceinline__ void p0_prologue(Frame& F) {
    LAS float* scr = (LAS float*)(F.lds + F.wave * 16384);
    const int gw = F.vcu * NWAVES + F.wave, NGW = F.G * NWAVES;
    constexpr int I_IN = 16 * (NIN / 32), I_BA = 16 * 32, I_O = 16 * 32, I_UP = 16 * (DFF / 32), I_DN = 64 * 32, I_C = 16 * 2;
    constexpr int NITEMS = I_IN + I_BA + I_O + I_UP + I_DN + 4 * I_C;
    auto describe = [&](int it, TrItem& t) {
        int r = it, nblk; bool win = false; t.ks = nullptr;
        if (r < I_IN) { t.W = F.in[I_WIN]; t.ldw = INC; t.K = DM; t.WT = WSP(bf16, WS_WINT); nblk = NIN / 32; win = true; }
        else if ((r -= I_IN) < I_BA) { t.W = F.in[I_WBR]; t.ldw = DM; t.K = DM; t.WT = WSP(bf16, WS_WBT); nblk = 32; }
        else if ((r -= I_BA) < I_O) { t.W = F.in[I_WOUT]; t.ldw = DM; t.K = DM; t.WT = WSP(bf16, WS_WOT); nblk = 32; }
        else if ((r -= I_O) < I_UP) { t.W = F.in[I_WUP]; t.ldw = DFF; t.K = DM; t.WT = WSP(bf16, WS_WUP); nblk = DFF / 32; t.ks = F.in[I_G2]; }
        else if ((r -= I_UP) < I_DN) { t.W = F.in[I_WDN]; t.ldw = DM; t.K = DFF; t.WT = WSP(bf16, WS_WDN); nblk = 32; }
        else { r -= I_DN; const int which = r / I_C; r = r % I_C;
               const float* w1 = (which >> 1) ? F.in[I_WCV1] : F.in[I_WCK1]; t.W = w1 + (size_t)(which & 1) * 1024 * 64; t.ldw = 64; t.K = 1024;
               t.WT = ((which >> 1) ? WSP(bf16, WS_WC1V) : WSP(bf16, WS_WC1K)) + (size_t)(which & 1) * 64 * 1024; nblk = 2; }
        t.k0 = 64 * (r / nblk); t.n0 = 32 * (r % nblk); const int j = t.n0 + 4 * (F.lane & 7); t.sc = win ? win_map(j) : j;
    };
    if (gw < NITEMS) {
        TrItem cur; describe(gw, cur); float vc[32]; tr_load(cur, F.lane, vc);
        for (int it = gw; it < NITEMS; it += NGW) {
            TrItem nxt = cur; float vn[32]; const bool more = it + NGW < NITEMS;
            if (more) { describe(it + NGW, nxt); tr_load(nxt, F.lane, vn); }
            tr_store(cur, F.lane, vc, scr);
            if (more) { cur = nxt;
#pragma unroll
                for (int i = 0; i < 32; ++i) vc[i] = vn[i]; }
        }
    }
    {
        auto rowp = [&](int m) { return m < MP ? F.in[I_XP] + (size_t)m * DM : F.in[I_XS] + (size_t)(m - MP) * DM; };
        f32x4 gg[4], c0[4], c1[4];
        { const GAS f32x4* gr = (const GAS f32x4*)F.in[I_G1] + F.lane;
#pragma unroll
          for (int j = 0; j < 4; ++j) gg[j] = gr[64 * j]; }
        if (gw < MT) { const GAS f32x4* xr0 = (const GAS f32x4*)rowp(gw) + F.lane; const GAS f32x4* xr1 = (const GAS f32x4*)rowp(gw + NGW < MT ? gw + NGW : gw) + F.lane;
#pragma unroll
            for (int j = 0; j < 4; ++j) { c0[j] = xr0[64 * j]; c1[j] = xr1[64 * j]; } }
        for (int m0 = gw; m0 < MPAD; m0 += 2 * NGW) {
            const int m1 = m0 + NGW; const bool two = m1 < MT; const int mn = m0 + 2 * NGW;
            f32x4 n0[4], n1[4];
            if (mn < MT) { const GAS f32x4* xr0 = (const GAS f32x4*)rowp(mn) + F.lane; const GAS f32x4* xr1 = (const GAS f32x4*)rowp(mn + NGW < MT ? mn + NGW : mn) + F.lane;
#pragma unroll
                for (int j = 0; j < 4; ++j) { n0[j] = xr0[64 * j]; n1[j] = xr1[64 * j]; } }
            if (m0 < MT) {
                float s0 = 0.f, s1 = 0.f;
#pragma unroll
                for (int j = 0; j < 4; ++j) { s0 += (c0[j].x * c0[j].x + c0[j].y * c0[j].y) + (c0[j].z * c0[j].z + c0[j].w * c0[j].w); s1 += (c1[j].x * c1[j].x + c1[j].y * c1[j].y) + (c1[j].z * c1[j].z + c1[j].w * c1[j].w); }
                const float r0 = 1.f / sqrtf(wave_sum_dpp(s0) * (1.f / DM) + EPS), r1 = 1.f / sqrtf(wave_sum_dpp(s1) * (1.f / DM) + EPS);
                GAS unsigned long long* o0 = (GAS unsigned long long*)(WSP(bf16, WS_XN) + (size_t)m0 * DM) + F.lane; GAS unsigned long long* o1 = (GAS unsigned long long*)(WSP(bf16, WS_XN) + (size_t)m1 * DM) + F.lane;
#pragma unroll
                for (int j = 0; j < 4; ++j) { o0[64 * j] = (unsigned long long)pk2(c0[j].x * r0 * gg[j].x, c0[j].y * r0 * gg[j].y) | ((unsigned long long)pk2(c0[j].z * r0 * gg[j].z, c0[j].w * r0 * gg[j].w) << 32);
                    if (two) o1[64 * j] = (unsigned long long)pk2(c1[j].x * r1 * gg[j].x, c1[j].y * r1 * gg[j].y) | ((unsigned long long)pk2(c1[j].z * r1 * gg[j].z, c1[j].w * r1 * gg[j].w) << 32); }
            }
            for (int q = 0; q < 2; ++q) { const int m = m0 + q * NGW; if (m >= MT && m < MPAD) {
                GAS v4u* z = (GAS v4u*)(WSP(bf16, WS_XN) + (size_t)m * DM) + F.lane; z[0] = (v4u){0, 0, 0, 0}; z[64] = (v4u){0, 0, 0, 0};
                GAS v4u* za = (GAS v4u*)(WSP(bf16, WS_OAB) + (size_t)m * 1024) + F.lane; za[0] = (v4u){0, 0, 0, 0}; za[64] = (v4u){0, 0, 0, 0}; } }
#pragma unroll
            for (int j = 0; j < 4; ++j) { c0[j] = n0[j]; c1[j] = n1[j]; }
        }
    }
    const int gt = F.vcu * (NWAVES * 64) + F.tid, NGT = F.G * NWAVES * 64;
    for (int e = gt; e < 8196 * 8; e += NGT) {
        const int pidx = e >> 3, i = e & 7; const float pos = (float)(pidx < SEQ ? pidx : PAST + pidx - SEQ);
        const float inv = powf(500000.0f, -(float)(2 * i) / 16.0f); const float ang = pos * inv;
        WSP(float, WS_ROPE)[pidx * 16 + i] = cosf(ang); WSP(float, WS_ROPE)[pidx * 16 + 8 + i] = sinf(ang);
    }
    for (int e = gt; e < 8 * 128 * 128; e += NGT) {
        const int g = e >> 14, p = (e >> 7) & 127, r = e & 127; const float* ws = F.in[I_WS] + (size_t)g * 128 * 128;
        WSP(bf16, WS_WSP)[e] = (bf16)(r <= p ? f2bf(ws[p * 128 + r]) : 0u);
        WSP(bf16, WS_WSS)[e] = (bf16)(((p >> 2) == (r >> 2) && (r & 3) <= (p & 3)) ? f2bf(ws[(p & 3) * 128 + (r & 3)]) : 0u);
    }
    if (gt < 64) WSP(float, WS_GAINS)[gt] = F.in[I_GQ][gt]; else if (gt < 128) WSP(float, WS_GAINS)[gt] = F.in[I_GKS][gt - 64]; else if (gt < 192) WSP(float, WS_GAINS)[gt] = F.in[I_GKW][gt - 128];
    for (int it = gw; it < 64; it += NGW) { const int which = it >> 5, part = it & 31; const float* pe = F.in[which ? I_PEV : I_PEK]; const float* w1 = F.in[which ? I_WCV1 : I_WCK1];
        float s = 0.f;
#pragma unroll 16
        for (int i = 0; i < 64; ++i) { const int ii = part * 64 + i; s += pe[ii] * w1[(size_t)ii * 64 + F.lane]; }
        WSP(float, WS_BPART)[(which * 32 + part) * 64 + F.lane] = s; }
}

constexpr int CP_RED = 8 * 8 * 64 * 4;
constexpr int CP_PITCH = 2064;
template <bool SMP>
__device__ __forceinline__ void compress_tasks(Frame& F, const int which, const int first, const int stride, const int ntask) {
    const int tid_ = tidx(); const int lane = tid_ & 63, w = __builtin_amdgcn_readfirstlane(tid_ >> 6), fr = lane & 15, fq = lane >> 4;
    LAS float* red = (LAS float*)F.lds;
    LAS unsigned char* Pg = F.lds + CP_RED * 4;
    const bf16* Wc = WSP(bf16, which ? WS_WC1V : WS_WC1K) + (size_t)fr * 1024 + 128 * w + 8 * fq;
    bf16x8 wf[8][4];
#pragma unroll
    for (int nb = 0; nb < 8; ++nb)
#pragma unroll
        for (int ks = 0; ks < 4; ++ks) wf[nb][ks] = *(const bf16x8*)(Wc + (size_t)nb * 16 * 1024 + 32 * ks);
    const float* cache = F.in[which ? I_CVC : I_CKC]; const int* pt = (const int*)F.in[I_PT];
    const int nmine = first < ntask ? (ntask - first + stride - 1) / stride : 0;
    LAS int* pgl = (LAS int*)(Pg + 16 * CP_PITCH);
    __syncthreads();
    if (SMP) for (int i = tid_; i < nmine; i += NWAVES * 64) pgl[i] = pt[first + i * stride];
    __syncthreads();
    constexpr int DEPTH = SMP ? 2 : 1;
    f32x4 pf[DEPTH][8]; v4u pb[DEPTH][4];
#define CP_FETCH(slot, n_) do { const int nn_ = (n_); if (nn_ < nmine) { \
        if (SMP) { const f32x4* src = (const f32x4*)(cache + (size_t)pgl[nn_] * (128 * 128) + (size_t)w * 2048) + lane; \
            _Pragma("unroll") for (int i = 0; i < 8; ++i) pf[slot][i] = __builtin_nontemporal_load(src + 64 * i); } \
        else { const v4u* src = (const v4u*)(WSP(bf16, which ? WS_VCA : WS_KCA) + (size_t)(first + nn_ * stride) * 16 * 1024 + (size_t)w * 2048) + lane; \
            _Pragma("unroll") for (int i = 0; i < 4; ++i) pb[slot][i] = src[64 * i]; } } } while (0)
#define CP_COMPUTE(slot, n_) do { const int nc_ = (n_); if (nc_ < nmine) { \
        if (SMP) { LAS unsigned char* dst = Pg + (2 * w + ((lane >> 4) & 1)) * CP_PITCH + ((lane >> 5) * 64 + 4 * (lane & 15)) * 2; \
            _Pragma("unroll") for (int i = 0; i < 8; ++i) { const f32x4 a = pf[slot][i]; v2u pk; pk.x = pg8::cvt_pk_bf16(a.x, a.y); pk.y = pg8::cvt_pk_bf16(a.z, a.w); *(LAS v2u*)(dst + i * 256) = pk; } } \
        else { _Pragma("unroll") for (int i = 0; i < 4; ++i) { const int q = 64 * i + lane; *(LAS v4u*)(Pg + (2 * w + (q >> 7)) * CP_PITCH + (q & 127) * 16) = pb[slot][i]; } } \
        __syncthreads(); \
        bf16x8 af[4]; \
        _Pragma("unroll") for (int ks = 0; ks < 4; ++ks) af[ks] = *(const LAS bf16x8*)(Pg + fr * CP_PITCH + (128 * w + 32 * ks + 8 * fq) * 2); \
        _Pragma("unroll") for (int nb = 0; nb < 8; ++nb) { f32x4 acc = {0.f, 0.f, 0.f, 0.f}; \
            _Pragma("unroll") for (int ks = 0; ks < 4; ++ks) acc = __builtin_amdgcn_mfma_f32_16x16x32_bf16(wf[nb][ks], af[ks], acc, 0, 0, 0); \
            *(LAS f32x4*)(red + ((w * 8 + nb) * 64 + lane) * 4) = acc; } \
        __syncthreads(); \
        { f32x4 s = *(const LAS f32x4*)(red + ((0 * 8 + w) * 64 + lane) * 4); \
          _Pragma("unroll") for (int sw = 1; sw < 8; ++sw) s = s + *(const LAS f32x4*)(red + ((sw * 8 + w) * 64 + lane) * 4); \
          bf16* fs = WSP(bf16, SMP ? (which ? WS_FSSV : WS_FSSK) : (which ? WS_FSPV : WS_FSPK)) + (size_t)(first + nc_ * stride) * 16 * 128;     \
          v2u pk_; pk_.x = pg8::cvt_pk_bf16(s.x, s.y); pk_.y = pg8::cvt_pk_bf16(s.z, s.w); *(v2u*)(fs + (size_t)fr * 128 + 16 * w + 4 * fq) = pk_; } } } while (0)
#pragma unroll
    for (int s = 0; s < DEPTH; ++s) CP_FETCH(s, s);
    for (int n = 0; n < nmine; n += DEPTH) {
#pragma unroll
        for (int s = 0; s < DEPTH; ++s) { CP_COMPUTE(s, n + s); CP_FETCH(s, n + s + DEPTH); }
    }
#undef CP_FETCH
#undef CP_COMPUTE
    __syncthreads();
}

__device__ __forceinline__ void compress_stage2(Frame& F, const int wg, const int nwg) {
    const int lane = F.lane, fr = lane & 15, fq = lane >> 4, gw = wg * NWAVES + F.wave, NGW = nwg * NWAVES;
    constexpr int NRS = DECB * NCS * 2, NRP = NBAT * NCP * 2, NGRP = (NRS + NRP) / 16;
    LAS float* biasL = (LAS float*)F.lds;
    __syncthreads();
    if (F.tid < 128) { float s = 0.f;
#pragma unroll 4
        for (int p = 0; p < 32; ++p) s += WSP(float, WS_BPART)[((F.tid >> 6) * 32 + p) * 64 + (F.tid & 63)];
        biasL[F.tid] = s; }
    __syncthreads();
    for (int which = 0; which < 2; ++which) {
        float bias[2][8]; const float* w2 = F.in[which ? I_WCV2 : I_WCK2]; bf16x8 wfr[4][2];
#pragma unroll
        for (int ks = 0; ks < 2; ++ks)
#pragma unroll
            for (int j = 0; j < 8; ++j) bias[ks][j] = biasL[which * 64 + 32 * ks + 8 * fq + j];
#pragma unroll
        for (int nb = 0; nb < 4; ++nb)
#pragma unroll
            for (int ks = 0; ks < 2; ++ks) { unsigned short t[8];
#pragma unroll
                for (int j = 0; j < 8; ++j) t[j] = (unsigned short)f2bf(w2[(32 * ks + 8 * fq + j) * 64 + 16 * nb + fr]);
                wfr[nb][ks] = (bf16x8){(short)t[0], (short)t[1], (short)t[2], (short)t[3], (short)t[4], (short)t[5], (short)t[6], (short)t[7]}; }
        f32x4 gk[4];
#pragma unroll
        for (int nb = 0; nb < 4; ++nb) { const float g = F.in[I_GKC][16 * nb + fr]; gk[nb] = (f32x4){g, g, g, g}; }
        for (int grp = which ? NGW - 1 - gw : gw; grp < NGRP; grp += NGW) {
            const bool smp = grp < NRS / 16; const int rr0 = smp ? grp * 16 : grp * 16 - NRS; const int nr = smp ? NRS : NRP, nc = smp ? NCS : NCP;
            const bf16* fs = WSP(bf16, smp ? (which ? WS_FSSV : WS_FSSK) : (which ? WS_FSPV : WS_FSPK));
            const int rr = rr0 + fr; const int rr2 = rr + 2 < nr ? rr + 2 : nr - 1;
            bf16x8 af[2];
#pragma unroll
            for (int ks = 0; ks < 2; ++ks) { const int k0 = 32 * ks + 8 * fq;
                const v4u ra = *(const v4u*)(fs + (size_t)rr * 128 + k0), rb = *(const v4u*)(fs + (size_t)rr2 * 128 + 64 + k0);
                const f32x4 a0 = {bflo(ra.x), bfhi(ra.x), bflo(ra.y), bfhi(ra.y)}, a1 = {bflo(ra.z), bfhi(ra.z), bflo(ra.w), bfhi(ra.w)}, b0 = {bflo(rb.x), bfhi(rb.x), bflo(rb.y), bfhi(rb.y)}, b1 = {bflo(rb.z), bfhi(rb.z), bflo(rb.w), bfhi(rb.w)};
                float h[8];
#pragma unroll
                for (int j = 0; j < 4; ++j) { h[j] = gelu_tanh(a0[j] + b0[j] + bias[ks][j]); h[4 + j] = gelu_tanh(a1[j] + b1[j] + bias[ks][4 + j]); }
                v4u pk; pk.x = pk2(h[0], h[1]); pk.y = pk2(h[2], h[3]); pk.z = pk2(h[4], h[5]); pk.w = pk2(h[6], h[7]); af[ks] = __builtin_bit_cast(bf16x8, pk); }
            f32x4 acc[4];
#pragma unroll
            for (int nb = 0; nb < 4; ++nb) { acc[nb] = __builtin_amdgcn_mfma_f32_16x16x32_bf16(af[0], wfr[nb][0], (f32x4){0.f, 0.f, 0.f, 0.f}, 0, 0, 0); acc[nb] = __builtin_amdgcn_mfma_f32_16x16x32_bf16(af[1], wfr[nb][1], acc[nb], 0, 0, 0); }
            if (which == 0) {
                f32x4 ss = acc[0] * acc[0] + acc[1] * acc[1] + acc[2] * acc[2] + acc[3] * acc[3];
#pragma unroll
                for (int r = 0; r < 4; ++r) { float v = ss[r]; v += __shfl_xor(v, 1); v += __shfl_xor(v, 2); v += __shfl_xor(v, 4); v += __shfl_xor(v, 8); ss[r] = 1.f / sqrtf(v * (1.f / 64.f) + EPS); }
#pragma unroll
                for (int nb = 0; nb < 4; ++nb) acc[nb] = acc[nb] * ss * gk[nb];
            }
            bf16* dstb = WSP(bf16, smp ? (which ? WS_VCS : WS_KCS) : (which ? WS_VCP : WS_KCP));
#pragma unroll
            for (int r = 0; r < 4; ++r) { const int row = rr0 + 4 * fq + r; const int kv = row & 1, bc = row >> 1; const int b = bc / nc, c = bc % nc; const bool zero = (c == nc - 1);
                bf16* dst = dstb + ((size_t)(b * 2 + kv) * nc + c) * 64 + fr;
#pragma unroll
                for (int nb = 0; nb < 4; ++nb) dst[16 * nb] = zero ? (bf16)0 : (bf16)f2bf(acc[nb][r]); }
        }
    }
}

constexpr int VT_PITCH = 136;
constexpr int GMLP_UNITS = 129 * 2;
__device__ __forceinline__ void gmlp_unit(Frame& F, int unit) {
    const int tid_ = tidx(); const int lane = tid_ & 63, w = __builtin_amdgcn_readfirstlane(tid_ >> 6), r32 = lane & 31, hi = lane >> 5, n = unit >> 1, hf = unit & 1;
    LAS bf16* vT = (LAS bf16*)F.lds;
    const int m0 = n * 128; const bool smp = (n == 128);
    __syncthreads();
    {
        float gg[8], bb[8];
#pragma unroll
        for (int k = 0; k < 8; ++k) { gg[k] = F.in[I_LNG][lane + 64 * k]; bb[k] = F.in[I_LNB][lane + 64 * k]; }
        const bf16* gv = WSP(bf16, WS_GV) + (size_t)(m0 + 16 * w) * 512 + lane;
#pragma unroll
        for (int i = 0; i < 16; i += 2) { const int r = 16 * w + i;
            float x[2][8];
#pragma unroll
            for (int k = 0; k < 8; ++k) { x[0][k] = bf2f(gv[(size_t)i * 512 + 64 * k]); x[1][k] = bf2f(gv[(size_t)(i + 1) * 512 + 64 * k]); }
            float y[2][8];
#pragma unroll
            for (int e = 0; e < 2; ++e) { float s = 0.f;
#pragma unroll
                for (int k = 0; k < 8; ++k) s += x[e][k];
                const float mean = wave_sum_dpp(s) * (1.f / 512.f); float s2 = 0.f;
#pragma unroll
                for (int k = 0; k < 8; ++k) { x[e][k] -= mean; s2 += x[e][k] * x[e][k]; }
                const float rstd = 1.f / sqrtf(wave_sum_dpp(s2) * (1.f / 512.f) + EPS);
#pragma unroll
                for (int k = 0; k < 8; ++k) y[e][k] = x[e][k] * rstd * gg[k] + bb[k];
                float* so = nullptr;
                if (smp) so = F.out + O_SVA + (size_t)(r + e) * 512; else if ((n & 63) == 63) so = F.out + O_PVA + ((size_t)(n >> 6) * 128 + r + e) * 512;
                if (so) {
#pragma unroll
                    for (int k = 0; k < 8; ++k) if ((k >> 2) == hf) so[lane + 64 * k] = y[e][k]; } }
#pragma unroll
            for (int k = 0; k < 8; ++k) if ((k >> 2) == hf) *(LAS unsigned*)(vT + (lane + 64 * (k & 3)) * VT_PITCH + r) = pk2(y[0][k], y[1][k]);
        }
    }
    __syncthreads();
    {
        const int gl = w & 3, g = 4 * hf + gl; const bf16* Wg = WSP(bf16, smp ? WS_WSS : WS_WSP) + (size_t)g * 128 * 128; const float* bs = F.in[I_BS] + g * 128;
#pragma unroll
        for (int ii = 0; ii < 2; ++ii) { const int ib = (w < 4) ? (ii ? 3 : 0) : (ii ? 2 : 1);
            bf16x8 a[8];
#pragma unroll
            for (int kb = 0; kb < 8; ++kb) a[kb] = *(const bf16x8*)(Wg + (size_t)(32 * ib + r32) * 128 + 16 * kb + 8 * hi);
            unsigned short uu[2][16];
#pragma unroll
            for (int r = 0; r < 16; ++r) { const int p = 32 * ib + (r & 3) + 8 * (r >> 2) + 4 * hi; const bf16* up = WSP(bf16, WS_U) + (size_t)(m0 + p) * 512 + 64 * g + r32; uu[0][r] = up[0]; uu[1][r] = up[32]; }
            f32x16 acc0 = {}, acc1 = {};
#pragma unroll
            for (int kb = 0; kb < 8; ++kb) {
                const bf16x8 b0 = *(const LAS bf16x8*)(vT + (64 * gl + r32) * VT_PITCH + 16 * kb + 8 * hi);
                const bf16x8 b1 = *(const LAS bf16x8*)(vT + (64 * gl + 32 + r32) * VT_PITCH + 16 * kb + 8 * hi);
                acc0 = __builtin_amdgcn_mfma_f32_32x32x16_bf16(a[kb], b0, acc0, 0, 0, 0); acc1 = __builtin_amdgcn_mfma_f32_32x32x16_bf16(a[kb], b1, acc1, 0, 0, 0);
            }
#pragma unroll
            for (int r = 0; r < 16; ++r) { const int p = 32 * ib + (r & 3) + 8 * (r >> 2) + 4 * hi; const size_t m = (size_t)(m0 + p);
                const float bias = bs[smp ? (p & 3) : p]; bf16* op = WSP(bf16, WS_OAB) + m * 1024 + 64 * g + r32;
                op[0] = (bf16)f2bf(bf2f(uu[0][r]) * (acc0[r] + bias)); op[32] = (bf16)f2bf(bf2f(uu[1][r]) * (acc1[r] + bias)); }
        }
    }
}

constexpr size_t WS_SSQS_DUMMY = 0;
template <class Epi, int KSPLIT = 1, bool MID = false>
__device__ __forceinline__ void skinny_gemm(const bf16* A, const bf16* Bt, int N, int K, int G, int first, const Epi& E) {
    const int lane = tidx() & 63, w = __builtin_amdgcn_readfirstlane(tidx() >> 6), fr = lane & 15, fq = lane >> 4;
    for (int it = first; it < (N / 16) * KSPLIT; it += G) {
        const int cb = it / KSPLIT, kq = it % KSPLIT, Kp = K / KSPLIT;
        const bf16* ap = A + (size_t)(16 * w + fr) * K + kq * Kp + 8 * fq;
        const bf16* bp = Bt + (size_t)(16 * cb + fr) * K + kq * Kp + 8 * fq;
        f32x4 acc = {0.f, 0.f, 0.f, 0.f};
        if constexpr (MID) {
#pragma unroll 16
            for (int ks = 0; ks < Kp / 64; ++ks) { const bf16x8 a = *(const bf16x8*)(ap + 32 * ks); const bf16x8 b = *(const bf16x8*)(bp + 32 * ks); acc = __builtin_amdgcn_mfma_f32_16x16x32_bf16(b, a, acc, 0, 0, 0); }
            E.mid(acc, 16 * w + fr, 16 * cb + 4 * fq);
#pragma unroll 16
            for (int ks = Kp / 64; ks < Kp / 32; ++ks) { const bf16x8 a = *(const bf16x8*)(ap + 32 * ks); const bf16x8 b = *(const bf16x8*)(bp + 32 * ks); acc = __builtin_amdgcn_mfma_f32_16x16x32_bf16(b, a, acc, 0, 0, 0); }
        } else {
#pragma unroll 16
        for (int ks = 0; ks < Kp / 32; ++ks) { const bf16x8 a = *(const bf16x8*)(ap + 32 * ks); const bf16x8 b = *(const bf16x8*)(bp + 32 * ks); acc = __builtin_amdgcn_mfma_f32_16x16x32_bf16(b, a, acc, 0, 0, 0); }
        }
        E(16 * w + fr, 16 * cb + 4 * fq, acc, fq);
    }
}
__device__ __forceinline__ v2u pack4(const f32x4 v) { v2u o; o.x = pk2(v.x, v.y); o.y = pk2(v.z, v.w); return o; }
__device__ __forceinline__ f32x4 unpack4(const v2u w) { return (f32x4){bflo(w.x), bfhi(w.x), bflo(w.y), bfhi(w.y)}; }
struct SkMerge { unsigned char* ws;
    __device__ __forceinline__ void mid(f32x4& acc, int r, int c) const { const size_t row = MP + r;
        acc = acc * unpack4(*(const v2u*)((const bf16*)(ws + WS_SG) + row * 2048 + c)); }
    __device__ __forceinline__ void operator()(int r, int c, const f32x4 acc, int) const { const size_t row = MP + r;
        const f32x4 gb = unpack4(*(const v2u*)((const bf16*)(ws + WS_SG) + row * 2048 + 1024 + c)); *(v2u*)((bf16*)(ws + WS_MG) + row * DM + c) = pack4(gb * acc); } };
struct SkOut { unsigned char* ws; const float* xs; float* out; __device__ __forceinline__ void operator()(int r, int c, const f32x4 acc, int fq) const {
    const f32x4 v = acc + *(const f32x4*)(xs + (size_t)r * DM + c); *(f32x4*)(out + O_YS + (size_t)r * DM + c) = v; *(v2u*)((bf16*)(ws + WS_X1B) + (size_t)(MP + r) * DM + c) = pack4(v);
    float ss = (v.x * v.x + v.y * v.y) + (v.z * v.z + v.w * v.w); ss += __shfl_xor(ss, 16); ss += __shfl_xor(ss, 32);
    if (fq == 0) ((float*)(ws + WS_SSQS))[r * 64 + (c >> 4)] = ss; } };
struct SkUp { unsigned char* ws; __device__ __forceinline__ void operator()(int r, int c, const f32x4 acc, int) const {
    const f32x4* sp = (const f32x4*)((const float*)(ws + WS_SSQS) + r * 64); f32x4 s = sp[0];
#pragma unroll
    for (int i = 1; i < 16; ++i) s = s + sp[i];
    const float rstd = 1.f / sqrtf(((s.x + s.y) + (s.z + s.w)) * (1.f / DM) + EPS); f32x4 v = acc * rstd;
#pragma unroll
    for (int i = 0; i < 4; ++i) { const float a = fmaxf(v[i], 0.f); v[i] = a * a; }
    *(v2u*)((bf16*)(ws + WS_H) + (size_t)(MP + r) * DFF + c) = pack4(v); } };
struct SkDown { float* out; __device__ __forceinline__ void operator()(int r, int c, const f32x4 acc, int) const { float* y = out + O_YS + (size_t)r * DM + c;
#pragma unroll
    for (int i = 0; i < 4; ++i) __hip_atomic_fetch_add(y + i, acc[i], __ATOMIC_RELAXED, __HIP_MEMORY_SCOPE_AGENT); } };

__device__ __forceinline__ void vst_tile(Frame& F, int tile) {
    const int tid = tidx(); LAS bf16* T = (LAS bf16*)F.lds;
    const int bk = tile >> 7, tb = tile & 127, b = bk >> 1, kv = bk & 1;
    __syncthreads();
    { const int t = tid >> 3, dc = tid & 7; const v4u v = *(const v4u*)(WSP(bf16, WS_VS) + ((size_t)b * SEQ + 64 * tb + t) * 128 + kv * 64 + 8 * dc);
      const unsigned w[4] = {v.x, v.y, v.z, v.w};
#pragma unroll
      for (int i = 0; i < 4; ++i) { T[(8 * dc + 2 * i) * 72 + t] = (bf16)(w[i] & 0xffffu); T[(8 * dc + 2 * i + 1) * 72 + t] = (bf16)(w[i] >> 16); } }
    __syncthreads();
    { const int dd = tid >> 3, tc = tid & 7; *(v4u*)(WSP(bf16, WS_VST) + ((size_t)(b * 2 + kv) * 64 + dd) * SEQ + 64 * tb + 8 * tc) = *(const LAS v4u*)(T + dd * 72 + 8 * tc); }
}

namespace att {
using s16x4 = __attribute__((ext_vector_type(4))) short;
using u32x4 = __attribute__((ext_vector_type(4))) unsigned;
constexpr int NW = 8, KVBLK = 64;
constexpr int NSLOT = 3, SLOTB = 8192;
constexpr int LDS_K = 0, LDS_V = NSLOT * SLOTB, LDS_WS = 2 * NSLOT * SLOTB, LDS_Q = LDS_WS + NW * 64 * 4, LDS_OST = LDS_Q, LDS_SELB = LDS_OST + NW * 8192, LDS_END = LDS_SELB + NW * 8 * 16;
constexpr int BLKS_PITCH = 132;
static_assert(NW * 8 * BLKS_PITCH * 4 <= LDS_WS, "block scores fit the ring region");
#define SBAR() __builtin_amdgcn_sched_barrier(0)
__device__ __forceinline__ int crow(int r, int hi) { return (r & 3) + 8 * (r >> 2) + 4 * hi; }
__device__ __forceinline__ void glds16(const void* gsrc, unsigned lds_dst) { unsigned keep;
  asm volatile("s_mov_b32 %0, m0\n\ts_mov_b32 m0, %2\n\ts_nop 0\n\tglobal_load_lds_dwordx4 %1, off\n\ts_mov_b32 m0, %0" : "=&s"(keep) : "v"(gsrc), "s"(lds_dst) : "memory"); }
__device__ __forceinline__ float max3f(float a, float b, float c) { float r; asm("v_max3_f32 %0, %1, %2, %3" : "=v"(r) : "v"(a), "v"(b), "v"(c)); return r; }
__device__ __forceinline__ float max2f(float a, float b) { float r; asm("v_max_f32_e32 %0, %1, %2" : "=v"(r) : "v"(a), "v"(b)); return r; }
__device__ __forceinline__ float fadd_s(float a, float b) { float r; asm("v_add_f32_e32 %0, %1, %2" : "=v"(r) : "v"(a), "v"(b)); return r; }
__device__ __forceinline__ float fsub_s(float a, float b) { float r; asm("v_sub_f32_e32 %0, %1, %2" : "=v"(r) : "v"(a), "v"(b)); return r; }
typedef float f32x2_t __attribute__((ext_vector_type(2))); typedef __bf16 bf16x2_t __attribute__((ext_vector_type(2)));
__device__ __forceinline__ unsigned cvtpk_s(float lo, float hi) { f32x2_t v = {lo, hi}; bf16x2_t b = __builtin_convertvector(v, bf16x2_t); return __builtin_bit_cast(unsigned, b); }
#define WAIT_BAR(N) asm volatile("s_waitcnt vmcnt(" #N ") lgkmcnt(0)\n\ts_barrier" ::: "memory")

typedef __attribute__((address_space(3))) const char* lds_cptr;
__device__ __forceinline__ void qkt(f32x16& p0, f32x16& p1, const char* Kslot, lds_cptr qp, int r32, int hi) { const f32x16 negm = f32x16{}; bf16x8 qr[4];
  _Pragma("unroll") for (int d0 = 0; d0 < 4; ++d0) qr[d0] = *(const __attribute__((address_space(3))) bf16x8*)(qp + d0 * 1024);
  const char* kb = Kslot + hi * 1024 + r32 * 16;
#pragma unroll
  for (int d0 = 0; d0 < 4; ++d0) {
    const bf16x8 b0 = *reinterpret_cast<const bf16x8*>(kb + d0 * 2048);
    const bf16x8 b1 = *reinterpret_cast<const bf16x8*>(kb + d0 * 2048 + 512);
    if (d0 == 0) { p0 = __builtin_amdgcn_mfma_f32_32x32x16_bf16(b0, qr[0], negm, 0, 0, 0); p1 = __builtin_amdgcn_mfma_f32_32x32x16_bf16(b1, qr[0], negm, 0, 0, 0); }
    else { p0 = __builtin_amdgcn_mfma_f32_32x32x16_bf16(b0, qr[d0], p0, 0, 0, 0); p1 = __builtin_amdgcn_mfma_f32_32x32x16_bf16(b1, qr[d0], p1, 0, 0, 0); } }
}
__device__ __forceinline__ void qkt_r(f32x16& p0, f32x16& p1, const char* Kslot, const bf16x8* qr, int r32, int hi) { const f32x16 negm = f32x16{};
  const char* kb = Kslot + hi * 1024 + r32 * 16;
#pragma unroll
  for (int d0 = 0; d0 < 4; ++d0) {
    const bf16x8 b0 = *reinterpret_cast<const bf16x8*>(kb + d0 * 2048);
    const bf16x8 b1 = *reinterpret_cast<const bf16x8*>(kb + d0 * 2048 + 512);
    if (d0 == 0) { p0 = __builtin_amdgcn_mfma_f32_32x32x16_bf16(b0, qr[0], negm, 0, 0, 0); p1 = __builtin_amdgcn_mfma_f32_32x32x16_bf16(b1, qr[0], negm, 0, 0, 0); }
    else { p0 = __builtin_amdgcn_mfma_f32_32x32x16_bf16(b0, qr[d0], p0, 0, 0, 0); p1 = __builtin_amdgcn_mfma_f32_32x32x16_bf16(b1, qr[d0], p1, 0, 0, 0); } }
}
typedef short v4i16_t __attribute__((ext_vector_type(4)));
__device__ __forceinline__ void kload8(bf16x8* kf, lds_cptr kp) {
  kf[0] = *(const __attribute__((address_space(3))) bf16x8*)(kp);        kf[1] = *(const __attribute__((address_space(3))) bf16x8*)(kp + 512);
  kf[2] = *(const __attribute__((address_space(3))) bf16x8*)(kp + 2048); kf[3] = *(const __attribute__((address_space(3))) bf16x8*)(kp + 2560);
  kf[4] = *(const __attribute__((address_space(3))) bf16x8*)(kp + 4096); kf[5] = *(const __attribute__((address_space(3))) bf16x8*)(kp + 4608);
  kf[6] = *(const __attribute__((address_space(3))) bf16x8*)(kp + 6144); kf[7] = *(const __attribute__((address_space(3))) bf16x8*)(kp + 6656);
}
__device__ __forceinline__ void kload2(bf16x8* kf, lds_cptr kp, int j) { kf[2 * j] = *(const __attribute__((address_space(3))) bf16x8*)(kp + j * 2048); kf[2 * j + 1] = *(const __attribute__((address_space(3))) bf16x8*)(kp + j * 2048 + 512); }
__device__ __forceinline__ s16x4 vtr(lds_cptr p) { return __builtin_bit_cast(s16x4, __builtin_amdgcn_ds_read_tr16_b64_v4i16((__attribute__((address_space(3))) v4i16_t*)p)); }
__device__ __forceinline__ float rowmax(const f32x16& p0, const f32x16& p1) {
  float a = max3f(p0[0], p0[1], p1[0]), b = max3f(p0[2], p0[3], p1[1]); a = max3f(a, p1[2], p1[3]);
#pragma unroll
  for (int r = 4; r < 16; r += 4) { a = max3f(a, p0[r], p0[r + 1]); b = max3f(b, p0[r + 2], p0[r + 3]); a = max3f(a, p1[r], p1[r + 1]); b = max3f(b, p1[r + 2], p1[r + 3]); }
  const float m = max2f(a, b);
  auto rr = __builtin_amdgcn_permlane32_swap(__float_as_uint(m), __float_as_uint(m), false, false);
  return max2f(__uint_as_float(rr[0]), __uint_as_float(rr[1]));
}
__device__ __forceinline__ void pv(f32x16* o, int vb, bf16x8 pa0, bf16x8 pa1, bf16x8 pa2, bf16x8 pa3) {
#pragma unroll
  for (int d0 = 0; d0 < 2; ++d0) { s16x4 lo[4], hi[4];
#pragma unroll
    for (int ks = 0; ks < 4; ++ks) {
      asm volatile("ds_read_b64_tr_b16 %0,%1 offset:%c2" : "=&v"(lo[ks]) : "v"(vb), "i"(d0 * 4096 + ks * 1024) : "memory");
      asm volatile("ds_read_b64_tr_b16 %0,%1 offset:%c2" : "=&v"(hi[ks]) : "v"(vb), "i"(d0 * 4096 + ks * 1024 + 512) : "memory"); }
    asm volatile("s_waitcnt lgkmcnt(0)" ::: "memory"); SBAR();
#define PK(k) (bf16x8){lo[k][0], lo[k][1], lo[k][2], lo[k][3], hi[k][0], hi[k][1], hi[k][2], hi[k][3]}
    o[d0] = __builtin_amdgcn_mfma_f32_32x32x16_bf16(pa0, PK(0), o[d0], 0, 0, 0);
    o[d0] = __builtin_amdgcn_mfma_f32_32x32x16_bf16(pa1, PK(1), o[d0], 0, 0, 0);
    o[d0] = __builtin_amdgcn_mfma_f32_32x32x16_bf16(pa2, PK(2), o[d0], 0, 0, 0);
    o[d0] = __builtin_amdgcn_mfma_f32_32x32x16_bf16(pa3, PK(3), o[d0], 0, 0, 0);
#undef PK
  }
}
template <int MODE> __device__ __forceinline__ void amask(f32x16& p0, f32x16& p1, int tabs, int blk, int hi, int mlo, int mspan1, const unsigned selword, const float mh) {
  const float NEG = -1e30f;
  const int kb = 64 * tabs + 4 * hi;
  int hiB;
  if (MODE == 1) {
    const bool en = (selword >> (tabs & 31)) & 1u;
    if (tabs < blk) { const float mht = en ? mh : 1e30f;
#pragma unroll
      for (int r = 0; r < 16; ++r) { p0[r] -= mht; p1[r] -= mht; }
      return; }
    hiB = en ? mspan1 - kb : 0;
  } else if (MODE == 0) hiB = mspan1 - kb;
  else {
    if (tabs < blk) {
      if (tabs + 8 <= blk) { const int loB = mlo - kb;
#pragma unroll
        for (int r = 0; r < 16; ++r) { const int c = (r & 3) + 8 * (r >> 2); p0[r] = (loB <= c) ? p0[r] - mh : NEG; p1[r] = (loB <= c + 32) ? p1[r] - mh : NEG; }
      } else {
#pragma unroll
        for (int r = 0; r < 16; ++r) { p0[r] -= mh; p1[r] -= mh; }
      }
      return; }
    hiB = mlo + mspan1 - kb;
  }
#pragma unroll
  for (int r = 0; r < 16; ++r) { const int c = (r & 3) + 8 * (r >> 2); p0[r] = (hiB > c) ? p0[r] - mh : NEG; p1[r] = (hiB > c + 32) ? p1[r] - mh : NEG; }
}

template <int MODE, int THRL>
__device__ __forceinline__ void attn_unit(const bf16* Qlane, const bf16* __restrict__ Kt, const bf16* __restrict__ Vt, const int t0abs, const int NT, const int blk,
                                          const int pos, const float* gatep, float* obf, bf16* ob, char* shm, float& mhat_o, float& rl_o) {
  constexpr int KP = (MODE == 0) ? 64 : 128;
  const int tid = tidx(), lane = tid & 63, r32 = lane & 31, hi = lane >> 5; const int wid = __builtin_amdgcn_readfirstlane(tid >> 6);
  const unsigned lds0 = (unsigned)(uintptr_t)shm;
  float* wsf = (float*)(shm + LDS_WS) + wid * 64;
  const bf16* ksrc = Kt + (long)lane * KP + wid * 8;
  const bf16* vsrc = Vt + (long)(16 * (wid & 3) + (lane >> 2)) * KP + (wid >> 2) * 32 + (lane & 3) * 8;
  const unsigned kdst = lds0 + LDS_K + wid * 1024, vdst = lds0 + LDS_V + wid * 1024;
#define DMA_K(t, slot) glds16(ksrc + (long)(t) * KVBLK * KP, (unsigned)__builtin_amdgcn_readfirstlane(kdst + (slot)))
#define DMA_V(t, slot) glds16(vsrc + (long)(t) * KVBLK * KP, (unsigned)__builtin_amdgcn_readfirstlane(vdst + (slot)))
  const int vb0 = (int)(lds0 + LDS_V) + ((lane >> 4) & 1) * 32 + (lane & 3) * 8 + (4 * hi + ((lane & 15) >> 2)) * 64;
  const char* Kbase = shm + LDS_K; bf16x8 kf[8];
  const lds_cptr shm3 = (lds_cptr)shm; const lds_cptr kp0 = shm3 + LDS_K + hi * 1024 + r32 * 16; const lds_cptr vp0 = shm3 + LDS_V + ((lane >> 4) & 1) * 32 + (lane & 3) * 8 + (4 * hi + ((lane & 15) >> 2)) * 64;
  const lds_cptr qp = shm3 + LDS_Q + wid * 4096 + lane * 16;
  const lds_cptr selp = shm3 + LDS_SELB + wid * 128 + (r32 >> 2) * 16;
#ifndef ATT_QREG
#define ATT_QREG 7
#endif
  constexpr bool QREG = (ATT_QREG >> MODE) & 1;
  bf16x8 qrg[4];
#define QF(j) (QREG ? qrg[j] : *(const __attribute__((address_space(3))) bf16x8*)(qp + (j) * 1024))
  const float gate_v = *gatep;
  DMA_K(0, 0); DMA_V(0, 0); DMA_K(1, SLOTB);
#pragma unroll
  for (int d0 = 0; d0 < 4; ++d0) { qrg[d0] = *reinterpret_cast<const bf16x8*>(&Qlane[d0 * 16 + hi * 8]); if (!QREG) *(__attribute__((address_space(3))) bf16x8*)((__attribute__((address_space(3))) char*)qp + d0 * 1024) = qrg[d0]; }
  float mhat = 0.f, l_reg = 0.f; f32x16 o[2]; o[0] = f32x16{}; o[1] = f32x16{}; const f32x16 zero16 = f32x16{};
  const int mlo = (MODE == 2) ? pos - (WIN - 1) : 0;
  const int mspan1 = (MODE == 0) ? (((pos - 31) >> 4) + 1 > 0 ? ((pos - 31) >> 4) + 1 : 0) : (MODE == 1 ? pos + 1 : WIN);
#define SELW(t) (MODE == 1 ? *(const __attribute__((address_space(3))) unsigned*)(selp + (((t0abs + (t)) >> 5) << 2)) : 0u)
#define CMASK(P0, P1, t, SW) amask<MODE>(P0, P1, t0abs + (t), blk, hi, mlo, mspan1, SW, mhat)
  bool resc = false;
#define START(P0, P1) do { const float rm = max2f(rowmax(P0, P1), -500.f); resc = false; \
    { const float dl = rm; mhat = fadd_s(mhat, dl); \
      _Pragma("unroll") for (int r = 0; r < 16; ++r) { P0[r] = fsub_s(P0[r], dl); P1[r] = fsub_s(P1[r], dl); } } \
    _Pragma("unroll") for (int r = 0; r < 16; ++r) P0[r] = __builtin_amdgcn_exp2f(P0[r]); } while (0)
#define RESC() do { if (resc) { asm volatile("s_waitcnt lgkmcnt(0)" ::: "memory"); \
      _Pragma("unroll") for (int d_ = 0; d_ < 2; ++d_) _Pragma("unroll") for (int r = 0; r < 16; ++r) o[d_][r] *= wsf[crow(r, hi)]; } } while (0)
  f32x16 pA0, pA1, pB0, pB1;
  int sl_prev = 0, sl_cur = 0, sl_next = SLOTB;
#define ROT() do { sl_prev = sl_cur; sl_cur = sl_next; sl_next = (sl_next == (NSLOT - 1) * SLOTB) ? 0 : sl_next + SLOTB; } while (0)
  DMA_K(2, 2 * SLOTB);
  WAIT_BAR(3);
  { const unsigned sw0 = SELW(0); if (QREG) qkt_r(pA0, pA1, Kbase, qrg, r32, hi); else qkt(pA0, pA1, Kbase, qp, r32, hi); asm volatile("s_nop 15\n\ts_nop 7" : "+v"(pA0), "+v"(pA1)); CMASK(pA0, pA1, 0, sw0); }
  START(pA0, pA1);
  _Pragma("unroll") for (int r = 0; r < 16; ++r) pA1[r] = __builtin_amdgcn_exp2f(pA1[r]);
  WAIT_BAR(0);
  DMA_K(3, 0); DMA_V(1, SLOTB);
  ROT();
  kload8(kf, kp0 + sl_cur);
  WAIT_BAR(2);
  s16x4 vlo[8], vhi[8]; u32x4 pw0, pw1, pw2, pw3;
#define PKW(P, B) cvtpk_s(P[B], P[B + 1])
#define PAF(k) __builtin_bit_cast(bf16x8, pw##k)
#define VFR(i) (bf16x8){vlo[i][0], vlo[i][1], vlo[i][2], vlo[i][3], vhi[i][0], vhi[i][1], vhi[i][2], vhi[i][3]}
#define PIN(x) asm volatile("" : "+v"(x))
#define MX3(a, b, c) __builtin_fmaxf(__builtin_fmaxf((a), (b)), (c))
#define GAPA(MF, A0, A1, A2, A3, W0, W1, PW) do { MF; sacc += A0; sacc += A1; sacc += A2; sacc += A3; PIN(sacc); W0; W1; PIN(PW); SBAR(); } while (0)
#define EX(v) __builtin_amdgcn_exp2f(v)
#define GAPB(MF, X, B) do { MF; X[B] = EX(X[B]); X[B + 1] = EX(X[B + 1]); X[B + 2] = EX(X[B + 2]); X[B + 3] = EX(X[B + 3]); PIN(X); SBAR(); } while (0)
#define VRD(i) do { vlo[i] = vtr(vp_ + (((i) >> 2) * 4096 + ((i) & 3) * 1024)); vhi[i] = vtr(vp_ + (((i) >> 2) * 4096 + ((i) & 3) * 1024 + 512)); } while (0)
#define KRD(G, j) do { if (G) { kload2(kf, kp0 + sl_next, j); SBAR(); } } while (0)
#define STEP(C0, C1, P0, P1, t, GK, GV, GL) do { SBAR(); \
    const lds_cptr vp_ = vp0 + sl_prev; const unsigned sw_ = SELW(t); \
    bf16x8 qa_ = QF(0); \
    VRD(0); SBAR(); float sacc = (P0[0] + P0[1]); \
    GAPA(C0 = __builtin_amdgcn_mfma_f32_32x32x16_bf16(kf[0], qa_, zero16, 0, 0, 0), P0[2], P0[3], P0[4], P0[5],     pw0[0] = PKW(P0, 0), pw0[1] = PKW(P0, 2), pw0); \
    VRD(4); SBAR(); GAPA(C1 = __builtin_amdgcn_mfma_f32_32x32x16_bf16(kf[1], qa_, zero16, 0, 0, 0), P0[6], P0[7], P0[8], P0[9],     pw0[2] = PKW(P0, 4), pw0[3] = PKW(P0, 6), pw0); \
    qa_ = QF(1); \
    VRD(1); SBAR(); GAPA(C0 = __builtin_amdgcn_mfma_f32_32x32x16_bf16(kf[2], qa_, C0, 0, 0, 0),   P0[10], P0[11], P0[12], P0[13], pw1[0] = PKW(P0, 8), pw1[1] = PKW(P0, 10), pw1); \
    VRD(5); SBAR(); GAPA(C1 = __builtin_amdgcn_mfma_f32_32x32x16_bf16(kf[3], qa_, C1, 0, 0, 0),   P0[14], P0[15], P1[0], P1[1],   pw1[2] = PKW(P0, 12), pw1[3] = PKW(P0, 14), pw1); \
    qa_ = QF(2); \
    VRD(2); SBAR(); GAPA(C0 = __builtin_amdgcn_mfma_f32_32x32x16_bf16(kf[4], qa_, C0, 0, 0, 0),   P1[2], P1[3], P1[4], P1[5],     pw2[0] = PKW(P1, 0), pw2[1] = PKW(P1, 2), pw2); \
    VRD(6); SBAR(); GAPA(C1 = __builtin_amdgcn_mfma_f32_32x32x16_bf16(kf[5], qa_, C1, 0, 0, 0),   P1[6], P1[7], P1[8], P1[9],     pw2[2] = PKW(P1, 4), pw2[3] = PKW(P1, 6), pw2); \
    qa_ = QF(3); \
    VRD(3); SBAR(); GAPA(C0 = __builtin_amdgcn_mfma_f32_32x32x16_bf16(kf[6], qa_, C0, 0, 0, 0),   P1[10], P1[11], P1[12], P1[13], pw3[0] = PKW(P1, 8), pw3[1] = PKW(P1, 10), pw3); \
    VRD(7); SBAR(); GAPA(C1 = __builtin_amdgcn_mfma_f32_32x32x16_bf16(kf[7], qa_, C1, 0, 0, 0),   P1[14], P1[15], 0.f, 0.f,       pw3[2] = PKW(P1, 12), pw3[3] = PKW(P1, 14), pw3); \
    l_reg += sacc; \
    if (GK) { DMA_K((t) + 3, sl_cur); } if (GV) { DMA_V((t) + 1, sl_next); } \
    CMASK(C0, C1, t, sw_); \
    { float a = MX3(C0[0], C0[1], C1[0]), b = MX3(C0[2], C0[3], C1[1]); a = MX3(a, C1[2], C1[3]); \
      _Pragma("unroll") for (int r = 4; r < 16; r += 4) { a = MX3(a, C0[r], C0[r + 1]); b = MX3(b, C0[r + 2], C0[r + 3]); a = MX3(a, C1[r], C1[r + 1]); b = MX3(b, C1[r + 2], C1[r + 3]); } \
      float rm = __builtin_fmaxf(a, b); { auto rr = __builtin_amdgcn_permlane32_swap(__float_as_uint(rm), __float_as_uint(rm), false, false); rm = __builtin_fmaxf(__uint_as_float(rr[0]), __uint_as_float(rr[1])); } \
      resc = false; \
      if (__builtin_expect(__any(rm > (float)THRL), 0)) { const float dl = __builtin_fmaxf(rm, 0.f); mhat += dl; \
        _Pragma("unroll") for (int r = 0; r < 16; ++r) { C0[r] -= dl; C1[r] -= dl; } \
        const float f = __builtin_amdgcn_exp2f(-dl); l_reg *= f; if (hi == 0) wsf[r32] = f; resc = true; } } \
    SBAR(); \
    GAPB(o[0] = __builtin_amdgcn_mfma_f32_32x32x16_bf16(PAF(0), VFR(0), o[0], 0, 0, 0), C0, 0); \
    GAPB(o[1] = __builtin_amdgcn_mfma_f32_32x32x16_bf16(PAF(0), VFR(4), o[1], 0, 0, 0), C0, 4); \
    KRD(GL, 0); GAPB(o[0] = __builtin_amdgcn_mfma_f32_32x32x16_bf16(PAF(1), VFR(1), o[0], 0, 0, 0), C0, 8); \
    KRD(GL, 1); GAPB(o[1] = __builtin_amdgcn_mfma_f32_32x32x16_bf16(PAF(1), VFR(5), o[1], 0, 0, 0), C0, 12); \
    KRD(GL, 2); GAPB(o[0] = __builtin_amdgcn_mfma_f32_32x32x16_bf16(PAF(2), VFR(2), o[0], 0, 0, 0), C1, 0); \
    KRD(GL, 3); GAPB(o[1] = __builtin_amdgcn_mfma_f32_32x32x16_bf16(PAF(2), VFR(6), o[1], 0, 0, 0), C1, 4); \
    GAPB(o[0] = __builtin_amdgcn_mfma_f32_32x32x16_bf16(PAF(3), VFR(3), o[0], 0, 0, 0), C1, 8); \
    GAPB(o[1] = __builtin_amdgcn_mfma_f32_32x32x16_bf16(PAF(3), VFR(7), o[1], 0, 0, 0), C1, 12); \
    } while (0)
  int t = 1;
  for (; t + 5 < NT; t += 2) {
    STEP(pB0, pB1, pA0, pA1, t, true, true, true);     WAIT_BAR(2); RESC(); ROT();
    STEP(pA0, pA1, pB0, pB1, t + 1, true, true, true); WAIT_BAR(2); RESC(); ROT();
  }
#define ENDW(tt) do { if ((tt) + 3 < NT) { WAIT_BAR(2); } else if ((tt) + 2 < NT) { WAIT_BAR(1); } else { WAIT_BAR(0); } } while (0)
  for (; t + 1 < NT; t += 2) {
    STEP(pB0, pB1, pA0, pA1, t, (t + 3 < NT), (t + 1 < NT), (t + 1 < NT));         ENDW(t);     RESC(); ROT();
    STEP(pA0, pA1, pB0, pB1, t + 1, (t + 4 < NT), (t + 2 < NT), (t + 2 < NT));     ENDW(t + 1); RESC(); ROT();
  }
  STEP(pB0, pB1, pA0, pA1, NT - 1, false, false, false); RESC();
  { float sacc = pB0[0] + pB0[1]; _Pragma("unroll") for (int r = 2; r < 16; ++r) sacc += pB0[r]; _Pragma("unroll") for (int r = 0; r < 16; ++r) sacc += pB1[r]; l_reg += sacc;
    pw0 = (u32x4){PKW(pB0, 0), PKW(pB0, 2), PKW(pB0, 4), PKW(pB0, 6)}; pw1 = (u32x4){PKW(pB0, 8), PKW(pB0, 10), PKW(pB0, 12), PKW(pB0, 14)}; pw2 = (u32x4){PKW(pB1, 0), PKW(pB1, 2), PKW(pB1, 4), PKW(pB1, 6)}; pw3 = (u32x4){PKW(pB1, 8), PKW(pB1, 10), PKW(pB1, 12), PKW(pB1, 14)};
    SBAR(); pv(o, vb0 + sl_cur, PAF(0), PAF(1), PAF(2), PAF(3)); }
#undef PKW
#undef PAF
#undef VFR
#undef PIN
#undef MX3
#undef GAPA
#undef GAPB
#undef EX
#undef VRD
#undef KRD
#undef STEP
#undef ENDW
  { auto rr = __builtin_amdgcn_permlane32_swap(__float_as_uint(l_reg), __float_as_uint(l_reg), false, false); l_reg = __uint_as_float(rr[0]) + __uint_as_float(rr[1]); }
  const float rl = l_reg > 0.f ? __builtin_amdgcn_rcpf(l_reg) : 0.f;
  mhat_o = mhat; rl_o = rl;
  if (hi == 0) wsf[32 + r32] = rl * gate_v; asm volatile("s_waitcnt lgkmcnt(0)" ::: "memory");
  { __attribute__((address_space(3))) float* ost = (__attribute__((address_space(3))) float*)(shm3 + LDS_OST) + wid * 2048;
#pragma unroll
    for (int r = 0; r < 16; ++r) { const int orow = crow(r, hi); const float sc = wsf[32 + orow];
#pragma unroll
      for (int d0 = 0; d0 < 2; ++d0) { __attribute__((address_space(3))) float* p = ost + orow * 64 + 32 * d0 + r32; float v = o[d0][r] * sc;
        if (MODE != 0) v += *p;
        if (MODE == 2) ob[(2 * (r >> 2)) * 1024 + (r & 3) * 64 + 32 * d0] = (bf16)f2bf(v); else *p = v; } } }
  (void)obf;
  asm volatile("s_waitcnt lgkmcnt(0)\n\ts_barrier" ::: "memory");
#undef DMA_K
#undef DMA_V
#undef CMASK
#undef SELW
#undef QF
#undef START
#undef RESC
#undef ROT
}

__device__ __forceinline__ int dppx1(int v) { return __builtin_amdgcn_mov_dpp(v, 0xB1, 0xF, 0xF, true); }
__device__ __forceinline__ int dppx2(int v) { return __builtin_amdgcn_mov_dpp(v, 0x4E, 0xF, 0xF, true); }
__device__ __forceinline__ float quad_sum(float v) { v += __builtin_bit_cast(float, dppx1(__builtin_bit_cast(int, v))); v += __builtin_bit_cast(float, dppx2(__builtin_bit_cast(int, v))); return v; }

__device__ __forceinline__ void nsa_prompt_unit(const unsigned char* ws, int b, int kv, int blk, char* shm) {
  float mhat = 0.f, rl = 0.f, dm0, dm1;
#define LANE_SETUP() const int lane = tidx() & 63, r32 = lane & 31, hi = lane >> 5; const int wid = __builtin_amdgcn_readfirstlane(tidx() >> 6); \
    const int tl = r32 >> 2, hl = r32 & 3, pos = 64 * blk + 8 * wid + tl; const size_t m = (size_t)b * SEQ + pos; const int head = 4 * kv + hl; (void)hi; (void)head; (void)m; (void)tl; (void)hl; \
    const size_t obo = ((size_t)b * SEQ + 64 * blk + 8 * wid + hi) * 512 + (4 * kv) * 64 + r32; const size_t obb = ((size_t)b * SEQ + 64 * blk + 8 * wid + hi) * 1024 + 512 + (4 * kv) * 64 + r32; (void)obo; (void)obb
  const int ntc_real = blk / 16 + 1;
  { LANE_SETUP(); const int NTc = ntc_real < 4 ? 4 : ((ntc_real + 1) & ~1);
    const bf16* kc = (const bf16*)(ws + WS_KCP) + (size_t)(b * 2 + kv) * NCP * 64; const bf16* vc = (const bf16*)(ws + WS_VCP) + (size_t)(b * 2 + kv) * NCP * 64;
#ifndef NO_M0
    attn_unit<0, 8>((const bf16*)(ws + WS_QN) + m * 512 + head * 64, kc, vc, 0, NTc, blk, pos, (const float*)(ws + WS_NG) + m * 32 + head * 3 + 0, (float*)(ws + WS_OBF) + obo, (bf16*)(ws + WS_OAB) + obb, shm, mhat, rl);
#endif
 }
  {
    LANE_SETUP();
    LAS float* bsw = (LAS float*)(shm + LDS_K) + wid * 8 * BLKS_PITCH;
    for (int i = lane; i < 8 * BLKS_PITCH; i += 64) bsw[i] = 0.f;
    asm volatile("s_waitcnt lgkmcnt(0)" ::: "memory");
    const int cthr = (pos - 31) >> 4; const int cspan = cthr + 1 > 0 ? cthr + 1 : 0;
    const bf16* kc = (const bf16*)(ws + WS_KCP) + (size_t)(b * 2 + kv) * NCP * 64; const bf16* qn = (const bf16*)(ws + WS_QN) + m * 512 + head * 64;
    bf16x8 qf[4];
#pragma unroll
    for (int d0 = 0; d0 < 4; ++d0) qf[d0] = *reinterpret_cast<const bf16x8*>(&qn[d0 * 16 + hi * 8]);
    const f32x16 zero16 = f32x16{};
    bf16x8 kb0[4], kb1[4], nb0[4], nb1[4];
#define IMP_LOAD(D0, D1, t_) do { const bf16* kr = kc + (size_t)(64 * (t_) + r32) * 64 + hi * 8; \
      _Pragma("unroll") for (int d0 = 0; d0 < 4; ++d0) { D0[d0] = *reinterpret_cast<const bf16x8*>(kr + d0 * 16); D1[d0] = *reinterpret_cast<const bf16x8*>(kr + 32 * 64 + d0 * 16); } } while (0)
    IMP_LOAD(kb0, kb1, 0);
    for (int t = 0; t < ntc_real; ++t) {
      if (t + 1 < ntc_real) IMP_LOAD(nb0, nb1, t + 1);
      f32x16 p0, p1;
#pragma unroll
      for (int d0 = 0; d0 < 4; ++d0) {
        if (d0 == 0) { p0 = __builtin_amdgcn_mfma_f32_32x32x16_bf16(kb0[0], qf[0], zero16, 0, 0, 0); p1 = __builtin_amdgcn_mfma_f32_32x32x16_bf16(kb1[0], qf[0], zero16, 0, 0, 0); }
        else { p0 = __builtin_amdgcn_mfma_f32_32x32x16_bf16(kb0[d0], qf[d0], p0, 0, 0, 0); p1 = __builtin_amdgcn_mfma_f32_32x32x16_bf16(kb1[d0], qf[d0], p1, 0, 0, 0); } }
      const int base = 64 * t + 4 * hi;
#pragma unroll
      for (int r = 0; r < 16; ++r) { const int c0 = base + (r & 3) + 8 * (r >> 2); p0[r] = (c0 < cspan) ? __builtin_amdgcn_exp2f(p0[r] - mhat) * rl : 0.f; p1[r] = (c0 + 32 < cspan) ? __builtin_amdgcn_exp2f(p1[r] - mhat) * rl : 0.f; }
#pragma unroll
      for (int ph = 0; ph < 2; ++ph)
#pragma unroll
        for (int g = 0; g < 4; ++g) { const float a0 = ph ? p1[4 * g] : p0[4 * g], a1 = ph ? p1[4 * g + 1] : p0[4 * g + 1], a2 = ph ? p1[4 * g + 2] : p0[4 * g + 2], a3 = ph ? p1[4 * g + 3] : p0[4 * g + 3];
          const float A = quad_sum(2.f * (a0 + a1 + a2) + a3), B = quad_sum(a3);
          const int j = 16 * t + 8 * ph + 2 * g + hi;
          if (hl == 0) { __hip_atomic_fetch_add(bsw + tl * BLKS_PITCH + j, A, __ATOMIC_RELAXED, __HIP_MEMORY_SCOPE_WORKGROUP); __hip_atomic_fetch_add(bsw + tl * BLKS_PITCH + j + 1, B, __ATOMIC_RELAXED, __HIP_MEMORY_SCOPE_WORKGROUP); } }
#pragma unroll
      for (int d0 = 0; d0 < 4; ++d0) { kb0[d0] = nb0[d0]; kb1[d0] = nb1[d0]; }
    }
#undef IMP_LOAD
    asm volatile("s_waitcnt lgkmcnt(0)" ::: "memory");
    LAS unsigned* selb = (LAS unsigned*)(shm + LDS_SELB) + wid * 32;
    const int cur = blk, nf = cur >= 2 ? 3 : cur + 1, need = 16 - nf;
    {
      const int j0 = lane, j1 = lane + 64;
      const bool c0 = (j0 >= 1 && j0 <= cur - 2), c1 = (j1 <= cur - 2);
      float v0[8], v1[8]; unsigned sm0 = (j0 == 0 || j0 == cur || j0 == cur - 1) ? 0xFFu : 0u, sm1 = (j1 == cur || j1 == cur - 1) ? 0xFFu : 0u;
#pragma unroll
      for (int tk = 0; tk < 8; ++tk) { const LAS float* bs = bsw + tk * BLKS_PITCH; v0[tk] = c0 ? bs[j0] : -1.f; v1[tk] = c1 ? bs[j1] : -1.f; }
      if (cur - 2 <= need) {
#pragma unroll
        for (int tk = 0; tk < 8; ++tk) { if (v0[tk] >= 0.f) sm0 |= 1u << tk; if (v1[tk] >= 0.f) sm1 |= 1u << tk; } }
      else for (int k = 0; k < need; ++k) {
#pragma unroll
        for (int tk = 0; tk < 8; ++tk) {
          const float mx = wave_max_dpp(fmaxf(v0[tk], v1[tk]));
          const unsigned long long b0 = __ballot(v0[tk] == mx), b1 = __ballot(v1[tk] == mx);
          const int l = __builtin_ctzll(b0 ? b0 : b1);
          const bool t0 = (b0 != 0ull) && lane == l, t1 = (b0 == 0ull) && lane == l;
          if (t0) { sm0 |= 1u << tk; v0[tk] = -1.f; }
          if (t1) { sm1 |= 1u << tk; v1[tk] = -1.f; } } }
#pragma unroll
      for (int tk = 0; tk < 8; ++tk) { const unsigned long long m0 = __ballot(((sm0 >> tk) & 1u) != 0u), m1 = __ballot(((sm1 >> tk) & 1u) != 0u);
        if (lane == 0) { selb[tk * 4 + 0] = (unsigned)m0; selb[tk * 4 + 1] = (unsigned)(m0 >> 32); selb[tk * 4 + 2] = (unsigned)m1; selb[tk * 4 + 3] = (unsigned)(m1 >> 32); } }
    }
    asm volatile("s_waitcnt lgkmcnt(0)\n\ts_barrier" ::: "memory");
  }
  { LANE_SETUP(); const int nt_real = blk + 1; const int NTs = nt_real < 4 ? 4 : ((nt_real + 1) & ~1);
    const bf16* ks = (const bf16*)(ws + WS_KS) + (size_t)b * SEQ * 128 + kv * 64; const bf16* vs = (const bf16*)(ws + WS_VS) + (size_t)b * SEQ * 128 + kv * 64;
#ifndef NO_M1
    attn_unit<1, 8>((const bf16*)(ws + WS_QR) + m * 512 + head * 64, ks, vs, 0, NTs, blk, pos, (const float*)(ws + WS_NG) + m * 32 + head * 3 + 1, (float*)(ws + WS_OBF) + obo, (bf16*)(ws + WS_OAB) + obb, shm, dm0, dm1);
#endif
 }
  { LANE_SETUP(); int t0, NTw; if (blk >= 9) { t0 = blk - 9; NTw = 10; } else { t0 = 0; const int nt_real = blk + 1; NTw = nt_real < 4 ? 4 : ((nt_real + 1) & ~1); }
    const bf16* kw = (const bf16*)(ws + WS_KW) + ((size_t)b * SEQ + 64 * t0) * 128 + kv * 64; const bf16* vw = (const bf16*)(ws + WS_VW) + ((size_t)b * SEQ + 64 * t0) * 128 + kv * 64;
#ifndef NO_M2
    attn_unit<2, 8>((const bf16*)(ws + WS_QR) + m * 512 + head * 64, kw, vw, t0, NTw, blk, pos, (const float*)(ws + WS_NG) + m * 32 + head * 3 + 2, (float*)(ws + WS_OBF) + obo, (bf16*)(ws + WS_OAB) + obb, shm, dm0, dm1);
#endif
 }
#undef LANE_SETUP
}
#undef SBAR
#undef WAIT_BAR
}

namespace smp {
typedef unsigned long long u64x2 __attribute__((ext_vector_type(2)));
constexpr int SCP = 1040;
constexpr int L_SC = 0, L_PART = L_SC + 4 * SCP * 4, L_OB = L_PART + 32 * 256 * 4, L_BLK = L_OB + 1024, L_SEL = L_BLK + 272 * 8, L_PT = L_SEL + 256, L_RS = L_PT + 4 * NPAGES, L_END = L_RS + 16;
constexpr float NEG = -1e30f;
constexpr int UKS_DEF = 4, UKP_DEF = 3;

__device__ __forceinline__ void ld16(const float* row, int c, float (&v)[16]) {
#pragma unroll
    for (int j = 0; j < 4; ++j) { const f32x4 t = *(const f32x4*)(row + 16 * j + 4 * c); v[4 * j] = t.x; v[4 * j + 1] = t.y; v[4 * j + 2] = t.z; v[4 * j + 3] = t.w; }
}
__device__ __forceinline__ void ld16(const bf16* row, int c, float (&v)[16]) {
#pragma unroll
    for (int j = 0; j < 4; ++j) { const v2u t = *(const v2u*)(row + 16 * j + 4 * c); v[4 * j] = bflo(t.x); v[4 * j + 1] = bfhi(t.x); v[4 * j + 2] = bflo(t.y); v[4 * j + 3] = bfhi(t.y); }
}
__device__ __forceinline__ void ldq(const bf16* row, int c, v2u (&r)[4][4]) {
#pragma unroll
    for (int h = 0; h < 4; ++h)
#pragma unroll
        for (int j = 0; j < 4; ++j) r[h][j] = *(const v2u*)(row + h * 64 + 16 * j + 4 * c);
}
__device__ __forceinline__ void cvtq(const v2u (&r)[4][4], float (&q)[4][16]) {
#pragma unroll
    for (int h = 0; h < 4; ++h)
#pragma unroll
        for (int j = 0; j < 4; ++j) { q[h][4 * j] = bflo(r[h][j].x); q[h][4 * j + 1] = bfhi(r[h][j].x); q[h][4 * j + 2] = bflo(r[h][j].y); q[h][4 * j + 3] = bfhi(r[h][j].y); }
}
__device__ __forceinline__ float qsum(float v) { v += __builtin_bit_cast(float, __builtin_amdgcn_mov_dpp(__builtin_bit_cast(int, v), 0xB1, 0xF, 0xF, true)); v += __builtin_bit_cast(float, __builtin_amdgcn_mov_dpp(__builtin_bit_cast(int, v), 0x4E, 0xF, 0xF, true)); return v; }

template <int UKS = UKS_DEF, class LD>
__device__ __forceinline__ void scores(LAS float* sc, int s0, int n, const float (&q)[4][16], const LD& ld) {
    const int lane = tidx() & 63, w = tidx() >> 6, ks = lane >> 2, c = lane & 3;
    for (int base = w * 16 * UKS; base < n; base += 8 * 16 * UKS) {
        float kx[UKS][16]; bool ok[UKS];
#pragma unroll
        for (int u = 0; u < UKS; ++u) { const int sl = base + 16 * u + ks; ok[u] = sl < n; if (ok[u]) ld(sl, c, kx[u]); else { _Pragma("unroll") for (int i = 0; i < 16; ++i) kx[u][i] = 0.f; } }
#pragma unroll
        for (int u = 0; u < UKS; ++u) { float s[4];
#pragma unroll
            for (int h = 0; h < 4; ++h) { float a = 0.f; _Pragma("unroll") for (int i = 0; i < 16; ++i) a += q[h][i] * kx[u][i]; s[h] = qsum(a); }
            const float sv = c == 0 ? s[0] : (c == 1 ? s[1] : (c == 2 ? s[2] : s[3]));
            if (ok[u]) sc[c * SCP + s0 + base + 16 * u + ks] = sv; }
    }
}
template <int UKP = UKP_DEF, class LD>
__device__ __forceinline__ void pvacc(const LAS float* sc, int s0, int n, float (&acc)[4][16], const LD& ld) {
    const int lane = tidx() & 63, w = tidx() >> 6, ks = lane >> 2, c = lane & 3;
    for (int base = w * 16 * UKP; base < n; base += 8 * 16 * UKP) {
        float vx[UKP][16];
#pragma unroll
        for (int u = 0; u < UKP; ++u) { const int sl = base + 16 * u + ks; const int slc = sl < n ? sl : 0;
            ld(slc, c, vx[u]); }
#pragma unroll
        for (int u = 0; u < UKP; ++u) { const int sl = base + 16 * u + ks; const bool ok = sl < n; const int slc = ok ? sl : 0;
#pragma unroll
            for (int h = 0; h < 4; ++h) { const float pr = sc[h * SCP + s0 + slc]; const float pv = ok ? pr : 0.f;
#pragma unroll
                for (int i = 0; i < 16; ++i) acc[h][i] += pv * vx[u][i]; } }
    }
}
__device__ __forceinline__ void softmax4(LAS float* sc, LAS float* rs, int n) {
    const int lane = tidx() & 63, w = tidx() >> 6;
    __syncthreads();
    if (w < 4) { LAS float* s = sc + w * SCP; float mx = -500.f;
        for (int i = lane; i < n; i += 64) mx = fmaxf(mx, s[i]);
        mx = wave_max(mx); float sum = 0.f;
        for (int i = lane; i < n; i += 64) { const float e = __builtin_amdgcn_exp2f(s[i] - mx); s[i] = e; sum += e; }
        sum = wave_sum(sum); if (lane == 0) rs[w] = sum > 0.f ? 1.f / sum : 0.f; }
    __syncthreads();
}
__device__ __forceinline__ float rowsum4(float v) {
    v += __builtin_bit_cast(float, __builtin_amdgcn_update_dpp(0, __builtin_bit_cast(int, v), 0x124, 0xF, 0xF, false));
    v += __builtin_bit_cast(float, __builtin_amdgcn_update_dpp(0, __builtin_bit_cast(int, v), 0x128, 0xF, 0xF, false));
    return v; }
__device__ __forceinline__ void finish(LAS unsigned char* L, float (&acc)[4][16], const float gate) {
    const int tid = tidx(), lane = tid & 63, w = tid >> 6, c = lane & 3;
    LAS float* part = (LAS float*)(L + L_PART); LAS float* ob = (LAS float*)(L + L_OB); const LAS float* rs = (const LAS float*)(L + L_RS);
#pragma unroll
    for (int h = 0; h < 4; ++h)
#pragma unroll
        for (int i = 0; i < 16; ++i) acc[h][i] = rowsum4(acc[h][i]);
    if ((lane & 12) == 0) {
#pragma unroll
        for (int h = 0; h < 4; ++h)
#pragma unroll
            for (int j = 0; j < 4; ++j) *(LAS f32x4*)(part + (w * 4 + (lane >> 4)) * 256 + h * 64 + 16 * j + 4 * c) = (f32x4){acc[h][4 * j], acc[h][4 * j + 1], acc[h][4 * j + 2], acc[h][4 * j + 3]};
    }
    __syncthreads();
    if (tid < 256) { float s0 = 0.f, s1 = 0.f;
#pragma unroll
        for (int ww = 0; ww < 32; ww += 2) { s0 += part[ww * 256 + tid]; s1 += part[(ww + 1) * 256 + tid]; }
        ob[tid] += gate * rs[tid >> 6] * (s0 + s1); }
    __syncthreads();
}

__device__ __forceinline__ void nsa_sample_unit(const unsigned char* ws, const float* cks, const float* cvs, const float* ckw, const float* cvw, const int* ptab, LAS unsigned char* L, int sb, int kv, int st) {
    const int tid = tidx(), lane = tid & 63, c = lane & 3;
    const size_t m = (size_t)MP + 4 * sb + st;
    LAS float* sc = (LAS float*)(L + L_SC); LAS float* ob = (LAS float*)(L + L_OB); LAS unsigned long long* bk = (LAS unsigned long long*)(L + L_BLK); LAS int* sel = (LAS int*)(L + L_SEL);
    const float* gates = (const float*)(ws + WS_NG) + m * 32 + (4 * kv) * 3;
    const bf16* KSn = (const bf16*)(ws + WS_KS) + ((size_t)MP + 4 * sb) * 128 + kv * 64; const bf16* VSn = (const bf16*)(ws + WS_VS) + ((size_t)MP + 4 * sb) * 128 + kv * 64;
    const bf16* KWn = (const bf16*)(ws + WS_KW) + ((size_t)MP + 4 * sb) * 128 + kv * 64; const bf16* VWn = (const bf16*)(ws + WS_VW) + ((size_t)MP + 4 * sb) * 128 + kv * 64;
#ifdef TIME_PROBE_A
#define SSTAMP(k) do { if (blockIdx.x == 0 && tid == 0) ((unsigned long long*)(ws + WS_DBG + 65536))[k] = __builtin_amdgcn_s_memrealtime(); } while (0)
#else
#define SSTAMP(k) do { } while (0)
#endif
    float gt[3]; { const float* gp = gates + ((tid & 255) >> 6) * 3; gt[0] = gp[0]; gt[1] = gp[1]; gt[2] = gp[2]; }
    LAS float* rsL = (LAS float*)(L + L_RS);
    v2u qrr[4][4];
    __syncthreads();
    SSTAMP(20);
    if (tid < 256) ob[tid] = 0.f;
    if (tid < 2) sel[tid] = tid * 255; if (tid == 2) sel[32] = tid;
    LAS int* ptl = (LAS int*)(L + L_PT); if (tid >= 512 - NPAGES) ptl[tid - (512 - NPAGES)] = ptab[sb * NPAGES + tid - (512 - NPAGES)];
    {
        float q[4][16];
#pragma unroll
        for (int h = 0; h < 4; ++h) ld16((const bf16*)(ws + WS_QN) + m * 512 + (4 * kv + h) * 64, c, q[h]);
        const bf16* kc = (const bf16*)(ws + WS_KCS) + (size_t)(sb * 2 + kv) * NCS * 64; const bf16* vc = (const bf16*)(ws + WS_VCS) + (size_t)(sb * 2 + kv) * NCS * 64;
        auto kp = [&](int sl, int cc, float (&v)[16]) { ld16(kc + (size_t)sl * 64, cc, v); }; auto vp = [&](int sl, int cc, float (&v)[16]) { ld16(vc + (size_t)sl * 64, cc, v); };
        scores(sc, 0, NCS - 1, q, kp);
        ldq((const bf16*)(ws + WS_QR) + m * 512 + (4 * kv) * 64, c, qrr);
        softmax4(sc, rsL, NCS - 1);
        float acc[4][16] = {};
        pvacc(sc, 0, NCS - 1, acc, vp);
        finish(L, acc, gt[0]);
    }
    SSTAMP(21);
    if (tid < 257) { const int j = tid; float v[5]; const float r0 = rsL[0], r1 = rsL[1], r2 = rsL[2], r3 = rsL[3];
#pragma unroll
        for (int i = 0; i < 5; ++i) { const int cc = 4 * j - 1 + i; v[i] = (cc >= 0 && cc < NCS - 1) ? (r0 * sc[cc] + r1 * sc[SCP + cc]) + (r2 * sc[2 * SCP + cc] + r3 * sc[3 * SCP + cc]) : 0.f; }
        const float bs = v[0] + 2.f * (v[1] + v[2] + v[3]) + v[4];
        const unsigned ub = __builtin_bit_cast(unsigned, bs); const unsigned so = ub ^ ((ub >> 31) ? 0xFFFFFFFFu : 0x80000000u);
        bk[j] = (j == 0 || j >= 255) ? 0ull : (((unsigned long long)so << 32) | (unsigned)(255 - j)); }
    __syncthreads();
    SSTAMP(26);
    {
        const int j = tid >> 1, hfr = tid & 1; const unsigned long long kj = bk[j]; int cnt = 0;
#pragma unroll 8
        for (int i0 = 0; i0 < 128; i0 += 2) { const u64x2 v = *(const LAS u64x2*)(bk + 128 * hfr + i0); cnt += (v.x > kj ? 1 : 0) + (v.y > kj ? 1 : 0); }
        cnt += __shfl_xor(cnt, 1);
        if (hfr == 0 && j >= 1 && j <= 254 && cnt < 13) { const int k = __hip_atomic_fetch_add(sel + 32, 1, __ATOMIC_RELAXED, __HIP_MEMORY_SCOPE_WORKGROUP); if (k < 15) sel[k] = j; } }
    __syncthreads();
    SSTAMP(27);
    if (tid < 15) { const int b = sel[tid]; sel[16 + tid] = ptl[b >> 1] * 128 + (b & 1) * 64; }
    __syncthreads();
    SSTAMP(22);
    {
        float q[4][16]; cvtq(qrr, q);
        auto kp = [&](int sl, int cc, float (&v)[16]) { if (sl < 960) ld16(cks + ((size_t)sel[16 + (sl >> 6)] + (sl & 63)) * 128 + kv * 64, cc, v); else ld16(KSn + (size_t)(sl - 960) * 128, cc, v); };
        auto vp = [&](int sl, int cc, float (&v)[16]) { if (sl < 960) ld16(cvs + ((size_t)sel[16 + (sl >> 6)] + (sl & 63)) * 128 + kv * 64, cc, v); else ld16(VSn + (size_t)(sl - 960) * 128, cc, v); };
        scores(sc, 0, 960 + st + 1, q, kp);
        softmax4(sc, rsL, 960 + st + 1);
        float acc[4][16] = {};
        pvacc(sc, 0, 960 + st + 1, acc, vp);
        finish(L, acc, gt[1]);
    }
    SSTAMP(24);
    {
        float q[4][16]; cvtq(qrr, q);
        const float* ck = ckw + ((size_t)sb * WIN + st + 1) * 128 + kv * 64; const float* cv = cvw + ((size_t)sb * WIN + st + 1) * 128 + kv * 64; const int nc = WIN - 1 - st;
        auto kp = [&](int sl, int cc, float (&v)[16]) { if (sl < nc) ld16(ck + (size_t)sl * 128, cc, v); else ld16(KWn + (size_t)(sl - nc) * 128, cc, v); };
        auto vp = [&](int sl, int cc, float (&v)[16]) { if (sl < nc) ld16(cv + (size_t)sl * 128, cc, v); else ld16(VWn + (size_t)(sl - nc) * 128, cc, v); };
        scores(sc, 0, WIN, q, kp);
        softmax4(sc, rsL, WIN);
        float acc[4][16] = {};
        pvacc(sc, 0, WIN, acc, vp);
        finish(L, acc, gt[2]);
    }
    SSTAMP(25);
    if (tid < 256) ((bf16*)(ws + WS_OAB))[m * 1024 + 512 + (4 * kv) * 64 + tid] = (bf16)f2bf(ob[tid]);
    __syncthreads();
}
}

#ifdef ATT_CHECK
namespace chk {
constexpr int C_Q = 0, C_SC = C_Q + 2 * 8 * 64 * 4, C_IMP = C_SC + 4 * 1032 * 4, C_BLK = C_IMP + 1032 * 4, C_IDX = C_BLK + 264 * 4, C_O = C_IDX + 64, C_RED = C_O + 256 * 4, C_END = C_RED + 64;
constexpr int SP = 1032;
struct Src { const unsigned char* ws; const float* const* in; };

__device__ __forceinline__ float sel_fetch(const unsigned char* ws, const float* cache, const int* pt, bool smp, int b, int kv, int kpos, int d, size_t wsoff) {
    if (!smp) { int p = kpos < 0 ? 0 : (kpos > SEQ - 1 ? SEQ - 1 : kpos); return bf2f(((const bf16*)(ws + wsoff))[((size_t)b * SEQ + p) * 128 + kv * 64 + d]); }
    if (kpos < PAST) { int pc = kpos < 0 ? 0 : kpos; const int pg = pt[b * NPAGES + (pc >> 7)]; return cache[((size_t)pg * 128 + (pc & 127)) * 128 + kv * 64 + d]; }
    int pn = kpos - PAST; pn = pn > 3 ? 3 : pn; return bf2f(((const bf16*)(ws + wsoff))[((size_t)MP + 4 * b + pn) * 128 + kv * 64 + d]);
}
__device__ __forceinline__ void softmax_rows(LAS float* sc, int n) {
    const int lane = tidx() & 63, w = tidx() >> 6;
    if (w < 4) { LAS float* s = sc + w * SP; float mx = -3e38f;
        for (int i = lane; i < n; i += 64) mx = fmaxf(mx, s[i]);
        mx = wave_max(mx); const bool any = mx > -1e29f; float sum = 0.f;
        for (int i = lane; i < n; i += 64) { const float e = (any && s[i] > -1e29f) ? exp2f(s[i] - mx) : 0.f; s[i] = e; sum += e; }
        sum = wave_sum(sum); const float rs = sum > 0.f ? 1.f / sum : 0.f;
        for (int i = lane; i < n; i += 64) s[i] *= rs; }
    __syncthreads();
}
__device__ __forceinline__ void check_token(const unsigned char* ws, const float* const* in, LAS unsigned char* L, bool smp, int b, int tq, float& emax, float& rmax) {
    const int tid = tidx();
    LAS float* q = (LAS float*)(L + C_Q); LAS float* sc = (LAS float*)(L + C_SC); LAS float* imp = (LAS float*)(L + C_IMP); LAS float* blk = (LAS float*)(L + C_BLK);
    LAS int* idx = (LAS int*)(L + C_IDX); LAS float* oo = (LAS float*)(L + C_O); LAS float* red = (LAS float*)(L + C_RED);
    const int pos = smp ? PAST + tq : tq; const size_t m = smp ? (size_t)MP + 4 * b + tq : (size_t)b * SEQ + tq;
    const int NC = smp ? NCS - 1 : NCP - 1, n_sel = smp ? 257 : 128, n_ch = 4 * n_sel, cur = pos >> 6;
    const int* pt = (const int*)in[I_PT];
    __syncthreads();
    for (int i = tid; i < 1024; i += 512) { const int ty = i >> 9, r = i & 511; q[i] = bf2f(((const bf16*)(ws + (ty ? WS_QR : WS_QN)))[m * 512 + r]); }
    if (tid == 0) { red[0] = 0.f; red[1] = 0.f; }
    __syncthreads();
    for (int kv = 0; kv < 2; ++kv) {
        if (tid < 256) oo[tid] = 0.f;
        __syncthreads();
        { const bf16* kc = (const bf16*)(ws + (smp ? WS_KCS : WS_KCP)) + (size_t)(b * 2 + kv) * (smp ? NCS : NCP) * 64; const bf16* vc = (const bf16*)(ws + (smp ? WS_VCS : WS_VCP)) + (size_t)(b * 2 + kv) * (smp ? NCS : NCP) * 64;
          for (int c = tid; c < NC; c += 512) { float d0 = 0.f, d1 = 0.f, d2 = 0.f, d3 = 0.f;
              for (int d = 0; d < 64; ++d) { const float k = bf2f(kc[(size_t)c * 64 + d]); d0 += q[(4 * kv + 0) * 64 + d] * k; d1 += q[(4 * kv + 1) * 64 + d] * k; d2 += q[(4 * kv + 2) * 64 + d] * k; d3 += q[(4 * kv + 3) * 64 + d] * k; }
              const bool ok = (c * 16 + 31 <= pos); sc[c] = ok ? d0 : -1e30f; sc[SP + c] = ok ? d1 : -1e30f; sc[2 * SP + c] = ok ? d2 : -1e30f; sc[3 * SP + c] = ok ? d3 : -1e30f; }
          __syncthreads();
          softmax_rows(sc, NC);
          if (tid < 256) { const int h = tid >> 6, d = tid & 63; float a = 0.f; for (int c = 0; c < NC; ++c) a += sc[h * SP + c] * bf2f(vc[(size_t)c * 64 + d]);
              oo[tid] += ((const float*)(ws + WS_NG))[m * 32 + (4 * kv + h) * 3 + 0] * a; }
          for (int c = tid; c < 1032; c += 512) imp[c] = c < NC ? (sc[c] + sc[SP + c]) + (sc[2 * SP + c] + sc[3 * SP + c]) : 0.f;
          __syncthreads(); }
        for (int j = tid; j < n_sel; j += 512) { float s = 0.f;
            for (int i = 0; i < 4; ++i) { const int c = 4 * j + i; const float a = (c < NC && c < n_ch) ? imp[c] : 0.f; const float bsh = (c >= 1 && c - 1 < NC) ? imp[c - 1] : 0.f; s += a + bsh; }
            const bool forced = (j == 0) || (j == cur) || (j == cur - 1), valid = (j * 64 <= pos);
            blk[j] = forced ? 1e4f : (valid ? s : -1e4f); }
        __syncthreads();
        if (tid == 0) { for (int k = 0; k < 16; ++k) { int bi = 0; float bv = -3e38f; for (int j = 0; j < n_sel; ++j) if (blk[j] > bv) { bv = blk[j]; bi = j; } idx[k] = bi; blk[bi] = -3e38f; } }
        __syncthreads();
        { const float* ck = in[I_CKS]; const float* cv = in[I_CVS];
          for (int s = tid; s < 1024; s += 512) { const int bi = idx[s >> 6], kpos = bi * 64 + (s & 63); const bool ok = (bi * 64 <= pos) && (kpos <= pos);
              float d0 = 0.f, d1 = 0.f, d2 = 0.f, d3 = 0.f;
              if (ok) for (int d = 0; d < 64; ++d) { const float k = sel_fetch(ws, ck, pt, smp, b, kv, kpos, d, WS_KS); d0 += q[512 + (4 * kv + 0) * 64 + d] * k; d1 += q[512 + (4 * kv + 1) * 64 + d] * k; d2 += q[512 + (4 * kv + 2) * 64 + d] * k; d3 += q[512 + (4 * kv + 3) * 64 + d] * k; }
              sc[s] = ok ? d0 : -1e30f; sc[SP + s] = ok ? d1 : -1e30f; sc[2 * SP + s] = ok ? d2 : -1e30f; sc[3 * SP + s] = ok ? d3 : -1e30f; }
          __syncthreads();
          softmax_rows(sc, 1024);
          if (tid < 256) { const int h = tid >> 6, d = tid & 63; float a = 0.f;
              for (int s = 0; s < 1024; ++s) { const float p = sc[h * SP + s]; if (p != 0.f) a += p * sel_fetch(ws, cv, pt, smp, b, kv, idx[s >> 6] * 64 + (s & 63), d, WS_VS); }
              oo[tid] += ((const float*)(ws + WS_NG))[m * 32 + (4 * kv + h) * 3 + 1] * a; }
          __syncthreads(); }
        { const int nw = smp ? WIN + DECS : WIN;
          const float* ckw = in[I_CKW]; const float* cvw = in[I_CVW];
          for (int s = tid; s < nw; s += 512) { const int kpos = smp ? PAST - WIN + s : pos - (WIN - 1) + s; const int dp = pos - kpos; const bool ok = dp >= 0 && dp < WIN && kpos >= 0;
              float d0 = 0.f, d1 = 0.f, d2 = 0.f, d3 = 0.f;
              if (ok) for (int d = 0; d < 64; ++d) { float k;
                  if (!smp) k = bf2f(((const bf16*)(ws + WS_KW))[((size_t)b * SEQ + kpos) * 128 + kv * 64 + d]);
                  else if (s < WIN) k = ckw[((size_t)b * WIN + s) * 128 + kv * 64 + d]; else k = bf2f(((const bf16*)(ws + WS_KW))[((size_t)MP + 4 * b + (s - WIN)) * 128 + kv * 64 + d]);
                  d0 += q[512 + (4 * kv + 0) * 64 + d] * k; d1 += q[512 + (4 * kv + 1) * 64 + d] * k; d2 += q[512 + (4 * kv + 2) * 64 + d] * k; d3 += q[512 + (4 * kv + 3) * 64 + d] * k; }
              sc[s] = ok ? d0 : -1e30f; sc[SP + s] = ok ? d1 : -1e30f; sc[2 * SP + s] = ok ? d2 : -1e30f; sc[3 * SP + s] = ok ? d3 : -1e30f; }
          __syncthreads();
          softmax_rows(sc, nw);
          if (tid < 256) { const int h = tid >> 6, d = tid & 63; float a = 0.f;
              for (int s = 0; s < nw; ++s) { const float p = sc[h * SP + s]; if (p == 0.f) continue; const int kpos = smp ? PAST - WIN + s : pos - (WIN - 1) + s; float v;
                  if (!smp) v = bf2f(((const bf16*)(ws + WS_VW))[((size_t)b * SEQ + kpos) * 128 + kv * 64 + d]);
                  else if (s < WIN) v = cvw[((size_t)b * WIN + s) * 128 + kv * 64 + d]; else v = bf2f(((const bf16*)(ws + WS_VW))[((size_t)MP + 4 * b + (s - WIN)) * 128 + kv * 64 + d]);
                  a += p * v; }
              oo[tid] += ((const float*)(ws + WS_NG))[m * 32 + (4 * kv + h) * 3 + 2] * a; }
          __syncthreads(); }
        if (tid < 256) { const float ref = oo[tid], got = bf2f(((const bf16*)(ws + WS_OAB))[m * 1024 + 512 + (4 * kv) * 64 + tid]);
            float e = fabsf(got - ref), r = fabsf(ref); e = wave_max(e); r = wave_max(r);
            if ((tid & 63) == 0) { __hip_atomic_fetch_max((LAS unsigned*)red, __float_as_uint(e), __ATOMIC_RELAXED, __HIP_MEMORY_SCOPE_WORKGROUP); __hip_atomic_fetch_max((LAS unsigned*)red + 1, __float_as_uint(r), __ATOMIC_RELAXED, __HIP_MEMORY_SCOPE_WORKGROUP); } }
        __syncthreads();
    }
    emax = red[0]; rmax = red[1];
    __syncthreads();
}

__device__ __forceinline__ void check_compress(const unsigned char* ws, const float* const* in, const float* out, LAS unsigned char* L, bool smp, int b, int c, int kv, int which, float& emax, float& rmax) {
    const int tid = tidx(), p = tid >> 6, j = tid & 63;
    LAS float* part = (LAS float*)L; LAS float* hdn = part + 512; LAS float* res = hdn + 64;
    const float* w1 = in[which ? I_WCV1 : I_WCK1]; const float* w2 = in[which ? I_WCV2 : I_WCK2]; const float* pe = in[which ? I_PEV : I_PEK];
    const float* cache = in[which ? I_CVC : I_CKC]; const int* pt = (const int*)in[I_PT];
    __syncthreads();
    float s = 0.f;
    for (int i = 256 * p; i < 256 * p + 256; ++i) { const int t = 16 * c + (i >> 6), d = i & 63; float x;
        if (!smp) x = out[(which ? O_PVC : O_PKC) + ((size_t)(b * SEQ + t) * 2 + kv) * 64 + d];
        else { const int pg = pt[b * NPAGES + (t >> 7)]; x = cache[(((size_t)pg * 128 + (t & 127)) * 2 + kv) * 64 + d]; }
        s += (x + pe[i]) * w1[(size_t)i * 64 + j]; }
    part[p * 64 + j] = s;
    __syncthreads();
    if (tid < 64) { float a = 0.f; for (int q = 0; q < 8; ++q) a += part[q * 64 + tid]; const float u = 0.7978845608028654f * (a + 0.044715f * a * a * a); hdn[tid] = 0.5f * a * (1.f + tanhf(u)); }
    __syncthreads();
    if (tid < 64) { float o = 0.f; for (int q = 0; q < 64; ++q) o += hdn[q] * w2[q * 64 + tid]; res[tid] = o; }
    __syncthreads();
    if (tid < 64) { float o = res[tid];
        if (which == 0) { float ss = 0.f; for (int q = 0; q < 64; ++q) ss += res[q] * res[q]; o = o * (1.f / sqrtf(ss / 64.f + EPS)) * in[I_GKC][tid]; }
        const int nc = smp ? NCS : NCP; const float got = bf2f(((const bf16*)(ws + (smp ? (which ? WS_VCS : WS_KCS) : (which ? WS_VCP : WS_KCP))))[((size_t)(b * 2 + kv) * nc + c) * 64 + tid]);
        float e = fabsf(got - o), r = fabsf(o); e = wave_max(e); r = wave_max(r); if (tid == 0) { res[64] = e; res[65] = r; } }
    __syncthreads();
    emax = res[64]; rmax = res[65];
    __syncthreads();
}
}
#endif

#ifndef MK_N_LAUNCHES
#define MK_N_LAUNCHES 1
#endif
constexpr int N_PHASES = 9;
struct Args { const void* in[N_IN]; float* out; unsigned char* ws; int ph_lo, ph_hi; };
static_assert(sizeof(Args) == (N_IN + 2) * 8 + 8, "no padding bytes in Args");

__global__ void __launch_bounds__(NWAVES * 64, 2) hybrid_fwd(Args args) {
    extern __shared__ __attribute__((aligned(16))) unsigned char lds[];
    Frame F;
    F.lds = (LAS unsigned char*)lds;
    F.MISC = (volatile LAS unsigned*)(F.lds + MISC_OFF);
    F.tid = tidx(); F.lane = F.tid & 63; F.wave = __builtin_amdgcn_readfirstlane(F.tid >> 6);
    F.G = gridDim.x; { const int bx = blockIdx.x; F.vcu = (F.G % 8 == 0) ? (bx % 8) * (F.G / 8) + bx / 8 : bx; }
    F.ws = args.ws; F.out = args.out; F.ctl = (gu32*)(args.ws + WS_CTL);
#pragma unroll
    for (int i = 0; i < N_IN; ++i) F.in[i] = (const float*)args.in[i];
    for (int u = F.tid; u < 64; u += NWAVES * 64) ((LAS unsigned*)(F.lds + MISC_OFF))[u] = 0u;
    __syncthreads();
    XcdBarrier bar; bar.bar = (unsigned*)(F.ctl + CW_BAR); bar.x = 0; bar.st = nullptr;
    if (MK_N_LAUNCHES == 1) bar = xcd_barrier_post((unsigned*)(F.ctl + CW_BAR), F.MISC + 8);
#define GRID_BAR() do { if (MK_N_LAUNCHES == 1) xcd_barrier(bar); } while (0)
    const int lo = args.ph_lo, hi = args.ph_hi;
#ifdef TIME_PROBE_A
    unsigned long long* tsp = (unsigned long long*)(args.ws + WS_DBG + 65536);
#define STAMP(k) do { if (blockIdx.x == 0 && F.tid == 0) tsp[k] = __builtin_amdgcn_s_memrealtime(); } while (0)
    STAMP(0);
#else
#define STAMP(k) do { } while (0)
#endif
#ifndef PH_MASK
#define PH_MASK 0x1ff
#endif
#define FRESH_IDS() do { const int t_ = tidx(); F.tid = t_; F.lane = t_ & 63; } while (0)
#define IN(k) (((PH_MASK >> (k)) & 1) && lo <= (k) && (k) < hi)
#define BOTH(k) (IN(k) && IN((k) + 1))
#ifndef DUP_MASK
#define DUP_MASK 0
#endif
#define REP(k) for (int rep_ = 0; rep_ < (((DUP_MASK >> (k)) & 1) ? 2 : 1); ++rep_)

    if (IN(0)) { FRESH_IDS(); REP(0) p0_prologue(F); if (BOTH(0)) GRID_BAR(); STAMP(1); }

    if (IN(1)) { FRESH_IDS();
#ifndef CP_SPEC
#define CP_SPEC 0
#endif
        constexpr int NCPW = CP_SPEC;
        if (NCPW > 0 && F.G == 256 && (int)blockIdx.x < NCPW) { REP(1) compress_tasks<true>(F, (int)blockIdx.x & 1, (int)blockIdx.x >> 1, NCPW > 0 ? NCPW / 2 : 1, DECB * NPAGES); }
        else {
        const bool spec = (NCPW > 0 && F.G == 256);
        pg8::Gemm g{WSP(bf16, WS_XN), WSP(bf16, WS_WINT), MPAD, NIN, DM}; pg8::StaticOrder S; S.init(MPAD, NIN, spec ? F.G - NCPW : F.G, spec ? (int)blockIdx.x - NCPW : (int)blockIdx.x);
        pg8::EpiIn E{F.ws, F.out};
        REP(1) pg8::gemm_phase<pg8::EpiIn, pg8::StaticOrder, true, true>(F.lds, g, S, E);
        }
        if (BOTH(1)) GRID_BAR(); STAMP(2);
    }

    if (IN(2)) { FRESH_IDS();
        STAMP(10);
        if (!(CP_SPEC > 0 && F.G == 256)) { REP(2) for (int which = 0; which < 2; ++which) compress_tasks<true>(F, which, (int)blockIdx.x, F.G, DECB * NPAGES); }
        STAMP(11);
        if (F.G == 256) compress_tasks<false>(F, (int)blockIdx.x >> 7, (int)blockIdx.x & 127, 128, 128);
        else for (int which = 0; which < 2; ++which) compress_tasks<false>(F, which, (int)blockIdx.x, F.G, 128);
        STAMP(12);
        REP(10) for (int n = F.G - 1 - (int)blockIdx.x; n < (F.G == 256 ? 256 : GMLP_UNITS); n += F.G) gmlp_unit(F, n);
        __syncthreads();
        STAMP(13);
        if (BOTH(2)) GRID_BAR(); STAMP(3);
    }

    if (IN(3)) { FRESH_IDS();
        if (F.G == 256) { if ((int)blockIdx.x >= 254) { gmlp_unit(F, 256 + ((int)blockIdx.x - 254)); __syncthreads(); } else { REP(3) compress_stage2(F, (int)blockIdx.x, 254); } }
        else { REP(3) compress_stage2(F, F.vcu, F.G); }
        if (BOTH(3)) GRID_BAR(); STAMP(4); }

    if (IN(4)) { FRESH_IDS();
        #ifndef NO_PROMPT
        REP(4) for (int pr = F.vcu; pr < 256; pr += F.G) { const int bk = pr >> 6, s = pr & 63;
            STAMP(14);
            att::nsa_prompt_unit(F.ws, bk >> 1, bk & 1, 127 - s, (char*)lds);
            STAMP(15);
            att::nsa_prompt_unit(F.ws, bk >> 1, bk & 1, s, (char*)lds);
            STAMP(16); }
#endif
#ifndef NO_SMP
        REP(9) for (int su = (int)blockIdx.x; su < 256; su += F.G) smp::nsa_sample_unit(F.ws, F.in[I_CKS], F.in[I_CVS], F.in[I_CKW], F.in[I_CVW], (const int*)F.in[I_PT], F.lds, su >> 3, (su >> 2) & 1, su & 3);
#endif
        STAMP(17);
        if (BOTH(4)) GRID_BAR(); STAMP(5);
    }

#ifdef ATT_CHECK
    {
        if (!BOTH(4)) GRID_BAR();
        const int i = (int)blockIdx.x; const int special[16] = {0, 1, 30, 31, 32, 63, 64, 65, 127, 128, 1023, 1024, 1025, 4095, 8191, 7680};
        int pos = (int)(((unsigned)i * 2654435761u) >> 19) & 8191;
#pragma unroll
        for (int k = 0; k < 16; ++k) if ((i >> 1) == k) pos = special[k];
        float e, r; float* dbg = WSP(float, WS_DBG);
        chk::check_token(F.ws, F.in, F.lds, false, i & 1, pos, e, r);
        if (F.tid == 0) dbg[i] = e / fmaxf(r, 1e-9f);
        chk::check_token(F.ws, F.in, F.lds, true, (i & 127) >> 2, i & 3, e, r);
        if (F.tid == 0) dbg[256 + i] = e / fmaxf(r, 1e-9f);
        {
            float E = 0.f; const unsigned hsh = (unsigned)i * 2246822519u;
            int cp = (int)((hsh >> 8) % 511u), cs = (int)((hsh >> 10) % 1023u); if (i == 0) { cp = 0; cs = 0; } if (i == 1) { cp = 510; cs = 1022; } if (i == 2) { cp = 509; cs = 7; } if (i == 3) { cp = 255; cs = 8; }
            for (int which = 0; which < 2; ++which) {
                chk::check_compress(F.ws, F.in, F.out, F.lds, false, i & 1, cp, (i >> 1) & 1, which, e, r); E = fmaxf(E, e / fmaxf(r, 1e-9f));
                chk::check_compress(F.ws, F.in, F.out, F.lds, true, i & 31, cs, (i >> 5) & 1, which, e, r); E = fmaxf(E, e / fmaxf(r, 1e-9f)); }
            if (F.tid == 0) dbg[512 + i] = E; }
        __syncthreads();
    }
#endif
    if (IN(5)) { FRESH_IDS();
        skinny_gemm<SkMerge, 1, true>(WSP(bf16, WS_OAB) + (size_t)MP * DM, WSP(bf16, WS_WBT), DM, DM, F.G, (int)blockIdx.x, SkMerge{F.ws});
        pg8::Gemm g{WSP(bf16, WS_OAB), WSP(bf16, WS_WBT), MP, DM, DM}; pg8::StaticOrder S; S.init(MP, DM, F.G, (int)blockIdx.x);
        pg8::EpiMerge E{WSP(bf16, WS_SG), WSP(bf16, WS_MG)};
        REP(5) pg8::gemm_phase<pg8::EpiMerge, pg8::StaticOrder, true, true>(F.lds, g, S, E);
        if (BOTH(5)) GRID_BAR(); STAMP(6);
    }

    if (IN(6)) { FRESH_IDS();
        skinny_gemm(WSP(bf16, WS_MG) + (size_t)MP * DM, WSP(bf16, WS_WOT), DM, DM, F.G, (int)blockIdx.x, SkOut{F.ws, F.in[I_XS], F.out});
        pg8::Gemm g{WSP(bf16, WS_MG), WSP(bf16, WS_WOT), MP, DM, DM}; pg8::StaticOrder S; S.init(MP, DM, F.G, (int)blockIdx.x);
        pg8::EpiOut E{F.in[I_XP], F.in[I_XS], F.out, WSP(bf16, WS_X1B), WSP(float, WS_SSQ)};
        REP(6) pg8::gemm_phase<pg8::EpiOut, pg8::StaticOrder, true, true>(F.lds, g, S, E);
        if (BOTH(6)) GRID_BAR(); STAMP(7);
    }

    if (IN(7)) { FRESH_IDS();
        skinny_gemm(WSP(bf16, WS_X1B) + (size_t)MP * DM, WSP(bf16, WS_WUP), DFF, DM, F.G, (int)blockIdx.x, SkUp{F.ws});
        pg8::Gemm g{WSP(bf16, WS_X1B), WSP(bf16, WS_WUP), MP, DFF, DM}; pg8::StaticOrder S; S.init(MP, DFF, F.G, (int)blockIdx.x);
        pg8::EpiUp E{WSP(float, WS_SSQ), WSP(bf16, WS_H)};
        REP(7) pg8::gemm_phase<pg8::EpiUp, pg8::StaticOrder, true, true>(F.lds, g, S, E);
        if (BOTH(7)) GRID_BAR(); STAMP(8);
    }

    if (IN(8)) { FRESH_IDS();
        skinny_gemm<SkDown, 4>(WSP(bf16, WS_H) + (size_t)MP * DFF, WSP(bf16, WS_WDN), DM, DFF, F.G, (int)blockIdx.x, SkDown{F.out});
        pg8::Gemm g{WSP(bf16, WS_H), WSP(bf16, WS_WDN), MP, DM, DFF}; pg8::StaticOrder S; S.init(MP, DM, F.G, (int)blockIdx.x);
        pg8::EpiDown E{F.out, WSP(bf16, WS_X1B)};
        pg8::gemm_phase<pg8::EpiDown, pg8::StaticOrder, true, true>(F.lds, g, S, E);
    }
#ifdef TIME_PROBE_A
    GRID_BAR(); STAMP(9);
    if (blockIdx.x == 0) {
        #ifndef TIME_PROBE_AE
#define TIME_PROBE_AE (TIME_PROBE_A + 1)
#endif
#ifndef TIME_PROBE_BE
#define TIME_PROBE_BE (TIME_PROBE_B + 1)
#endif
        const float da = (float)(tsp[TIME_PROBE_AE] - tsp[TIME_PROBE_A]) * 0.01f, db = (float)(tsp[TIME_PROBE_BE] - tsp[TIME_PROBE_B]) * 0.01f;
        if (F.tid == 0) F.out[O_YP] += da * 0.01f;
        for (int t = F.tid; t < 4096 * 1024; t += 512) F.out[O_YP + 1024 + t] += db * (1.f / 3000.f); }
#endif
#ifdef ATT_CHECK
    GRID_BAR();
    if (blockIdx.x == 0) { float E = 0.f; const float* dbg = WSP(float, WS_DBG);
        for (int k = 0; k < 768; ++k) { if (!((ATT_CHECK >> (k >> 8)) & 1)) continue; E = fmaxf(E, dbg[k]); }
        for (int t = F.tid; t < 1024; t += 512) F.out[O_YP + t] += E * 2000.f; }
#endif
#undef IN
#undef BOTH
}

extern "C" void kernel_launch(void* const* d_in, const int* in_sizes, int n_in, void* d_out, int out_size, void* d_ws, size_t ws_size, hipStream_t stream) {
    static int grid = 0;
    if (grid == 0) {
        if (n_in != N_IN || in_sizes[0] != MP * DM || (size_t)out_size != O_END || ws_size < WS_END) {
            fprintf(stderr, "kernel_launch: unexpected problem: n_in %d in0 %d out %d ws %zu (need %zu); nothing launched\n", n_in, n_in > 0 ? in_sizes[0] : -1, out_size, ws_size, (size_t)WS_END); grid = -1; return; }
        int dev = 0, cus = 0, per_cu = 0;
        if (hipGetDevice(&dev) != hipSuccess || hipDeviceGetAttribute(&cus, hipDeviceAttributeMultiprocessorCount, dev) != hipSuccess) { grid = -1; return; }
        if (hipFuncSetAttribute((const void*)hybrid_fwd, hipFuncAttributeMaxDynamicSharedMemorySize, LDS_BYTES) != hipSuccess) { fprintf(stderr, "kernel_launch: hipFuncSetAttribute failed\n"); grid = -1; return; }
        if (hipOccupancyMaxActiveBlocksPerMultiprocessor(&per_cu, (const void*)hybrid_fwd, NWAVES * 64, LDS_BYTES) != hipSuccess || per_cu < 1)
            fprintf(stderr, "kernel_launch: note: occupancy query reports %d workgroups per CU\n", per_cu);
        (void)hipGetLastError();
        grid = cus;
    }
    if (grid < 0) return;
    if (hipMemsetAsync((char*)d_ws + WS_CTL, 0, CTL_ZERO_BYTES, stream) != hipSuccess) return;
    Args a{};
    for (int i = 0; i < N_IN; ++i) a.in[i] = d_in[i];
    a.out = (float*)d_out; a.ws = (unsigned char*)d_ws;
    if (MK_N_LAUNCHES == 1) { a.ph_lo = 0; a.ph_hi = N_PHASES; hipLaunchKernelGGL(hybrid_fwd, dim3(grid), dim3(NWAVES * 64), LDS_BYTES, stream, a); }
    else for (int p = 0; p < N_PHASES; ++p) { a.ph_lo = p; a.ph_hi = p + 1; hipLaunchKernelGGL(hybrid_fwd, dim3(grid), dim3(NWAVES * 64), LDS_BYTES, stream, a); }
    const hipError_t le = hipPeekAtLastError();
    if (le != hipSuccess) fprintf(stderr, "kernel_launch: launch failed: %s\n", hipGetErrorName(le));
}
```
